# Optimizing an MI355X kernel written in HIP

```python
import jax, jax.numpy as jnp
from jax import lax
import numpy as np

D_MODEL = 1024
BATCH = 4
SEQ = 8192
DEPTH = 2

N_MIXERS = 2
RMS_EPS = 1e-6
ROPE_THETA = 10000.0
NEG_INF = -1e30

MOBA_HEADS = 8
MOBA_HEAD_DIM = 128
MOBA_BLOCK = 256
MOBA_TOPK = 3
MOBA_Q_CHUNK = 64

MLA_HEADS = 8
MLA_Q_RANK = 384
MLA_KV_RANK = 256
MLA_NOPE = 128
MLA_ROPE = 64
MLA_V = 128
MLA_Q_BLOCK = 128

N_GROUPS = 4
EXPERTS_PER_GROUP = 4
N_EXPERTS = N_GROUPS * EXPERTS_PER_GROUP
EXPERT_FF = 256
TOPK_IN_GROUP = 2

PLE_DIM = 256

N_MOBA_LAYERS = (DEPTH + 1) // 2
N_MLA_LAYERS = DEPTH // 2

kernel_name = "hybrid_moba_mla_hmoe_ple"


def rms_norm(x, g):
    xf = x.astype(jnp.float32)
    y = xf * lax.rsqrt(jnp.mean(xf * xf, axis=-1, keepdims=True) + RMS_EPS)
    return (y * g.astype(jnp.float32)).astype(x.dtype)


def rope(x, pos):
    half = x.shape[-1] // 2
    inv = ROPE_THETA ** (-jnp.arange(half, dtype=jnp.float32) / half)
    ang = pos[:, None] * inv[None, :]
    cos, sin = jnp.cos(ang), jnp.sin(ang)
    x1 = x[..., :half].astype(jnp.float32)
    x2 = x[..., half:].astype(jnp.float32)
    out = jnp.concatenate([x1 * cos - x2 * sin, x1 * sin + x2 * cos], axis=-1)
    return out.astype(x.dtype)


def moba_attention(h, w_qkv, w_o):
    B, S, _ = h.shape
    H, Dh, L, QC = MOBA_HEADS, MOBA_HEAD_DIM, MOBA_BLOCK, MOBA_Q_CHUNK
    pos = jnp.arange(S, dtype=jnp.float32)
    qkv = (h @ w_qkv).reshape(B, S, 3, H, Dh).transpose(2, 0, 3, 1, 4)
    q = rope(qkv[0], pos)
    k = rope(qkv[1], pos)
    v = qkv[2]
    nb = -(-S // L)
    pad = nb * L - S
    k_p = jnp.pad(k, ((0, 0), (0, 0), (0, pad), (0, 0)))
    v_p = jnp.pad(v, ((0, 0), (0, 0), (0, pad), (0, 0)))
    k_blk = k_p.reshape(B, H, nb, L, Dh)
    v_blk = v_p.reshape(B, H, nb, L, Dh)
    k_mean = jnp.mean(k_blk.astype(jnp.float32), axis=3)
    k_top = min(MOBA_TOPK, nb)
    scale = Dh ** -0.5
    bi = jnp.arange(B)[:, None, None, None]
    hi = jnp.arange(H)[None, :, None, None]

    def chunk(c):
        start = c * QC
        qc = lax.dynamic_slice_in_dim(q, start, QC, axis=2)
        qpos = start + jnp.arange(QC)
        own = start // L
        gate = jnp.einsum('bhqd,bhnd->bhqn', qc.astype(jnp.float32), k_mean)
        fully_past = jnp.arange(nb)[None, None, None, :] < own
        gate = jnp.where(fully_past, gate, -jnp.inf)
        _, sel = lax.top_k(gate, k_top)
        sel_valid = sel < own
        k_sel = k_blk[bi, hi, sel]
        v_sel = v_blk[bi, hi, sel]
        s_sel = jnp.einsum('bhqd,bhqkld->bhqkl', qc, k_sel).astype(jnp.float32) * scale
        s_sel = jnp.where(sel_valid[..., None], s_sel, NEG_INF).reshape(B, H, QC, k_top * L)
        k_own = lax.dynamic_slice_in_dim(k_p, own * L, L, axis=2)
        v_own = lax.dynamic_slice_in_dim(v_p, own * L, L, axis=2)
        s_own = jnp.einsum('bhqd,bhld->bhql', qc, k_own).astype(jnp.float32) * scale
        kpos = own * L + jnp.arange(L)
        s_own = jnp.where(kpos[None, :] <= qpos[:, None], s_own, NEG_INF)
        pr = jax.nn.softmax(jnp.concatenate([s_sel, s_own], axis=-1), axis=-1)
        p_sel = pr[..., :k_top * L].reshape(B, H, QC, k_top, L).astype(v.dtype)
        p_own = pr[..., k_top * L:].astype(v.dtype)
        return (jnp.einsum('bhqkl,bhqkld->bhqd', p_sel, v_sel)
                + jnp.einsum('bhql,bhld->bhqd', p_own, v_own))

    o = lax.map(chunk, jnp.arange(S // QC))
    o = o.transpose(1, 0, 3, 2, 4).reshape(B, S, H * Dh)
    return o @ w_o


def mla_attention(h, w_dq, q_norm, w_uq, w_dkv, kv_norm, w_ukv, w_o):
    B, S, _ = h.shape
    H, QB = MLA_HEADS, MLA_Q_BLOCK
    pos = jnp.arange(S, dtype=jnp.float32)
    cq = rms_norm(h @ w_dq, q_norm)
    q = (cq @ w_uq).reshape(B, S, H, MLA_NOPE + MLA_ROPE).transpose(0, 2, 1, 3)
    q_nope = q[..., :MLA_NOPE]
    q_rope = rope(q[..., MLA_NOPE:], pos)
    kv_a = h @ w_dkv
    ckv = rms_norm(kv_a[..., :MLA_KV_RANK], kv_norm)
    k_rope = rope(kv_a[..., MLA_KV_RANK:], pos)
    kv = (ckv @ w_ukv).reshape(B, S, H, MLA_NOPE + MLA_V).transpose(0, 2, 1, 3)
    k_nope = kv[..., :MLA_NOPE]
    v = kv[..., MLA_NOPE:]
    scale = (MLA_NOPE + MLA_ROPE) ** -0.5
    kpos = jnp.arange(S)

    def qblock(c):
        start = c * QB
        qn = lax.dynamic_slice_in_dim(q_nope, start, QB, axis=2)
        qr = lax.dynamic_slice_in_dim(q_rope, start, QB, axis=2)
        s = (jnp.einsum('bhqd,bhkd->bhqk', qn, k_nope)
             + jnp.einsum('bhqd,bkd->bhqk', qr, k_rope)).astype(jnp.float32) * scale
        qpos = start + jnp.arange(QB)
        s = jnp.where(kpos[None, :] <= qpos[:, None], s, NEG_INF)
        pr = jax.nn.softmax(s, axis=-1).astype(v.dtype)
        return jnp.einsum('bhqk,bhkd->bhqd', pr, v)

    o = lax.map(qblock, jnp.arange(S // QB))
    o = o.transpose(1, 0, 3, 2, 4).reshape(B, S, H * MLA_V)
    return o @ w_o


def hier_moe(h, w_group, w_expert, w_gate, w_up, w_down):
    B, S, _ = h.shape
    hf = h.astype(jnp.float32)
    g_logits = hf @ w_group.astype(jnp.float32)
    g_prob = jax.nn.softmax(g_logits, axis=-1)
    g_sel = jnp.argmax(g_logits, axis=-1)
    g_w = jnp.take_along_axis(g_prob, g_sel[..., None], axis=-1)
    e_logits = (hf @ w_expert.astype(jnp.float32)).reshape(B, S, N_GROUPS, EXPERTS_PER_GROUP)
    e_in = jnp.take_along_axis(e_logits, g_sel[..., None, None], axis=2)[..., 0, :]
    top_v, top_i = lax.top_k(e_in, TOPK_IN_GROUP)
    top_w = jax.nn.softmax(top_v, axis=-1) * g_w
    expert_id = g_sel[..., None] * EXPERTS_PER_GROUP + top_i
    combine = jnp.sum(jax.nn.one_hot(expert_id, N_EXPERTS, dtype=jnp.float32) * top_w[..., None], axis=-2)
    a = jnp.einsum('bsd,edf->bsef', h, w_gate)
    u = jnp.einsum('bsd,edf->bsef', h, w_up)
    act = jax.nn.silu(a) * u * combine.astype(h.dtype)[..., None]
    return jnp.einsum('bsef,efd->bsd', act, w_down)


def setup_inputs(seed: int = 0) -> dict:
    key = jax.random.key(seed)
    ks = iter(jax.random.split(key, 32))
    f32 = jnp.float32

    def w(shape, fan_in):
        return jax.random.normal(next(ks), shape, f32) * (fan_in ** -0.5)

    def gain(shape):
        return 1.0 + 0.02 * jax.random.normal(next(ks), shape, f32)

    D = D_MODEL
    return {
        "x": jax.random.normal(next(ks), (BATCH, SEQ, D), f32),
        "p": jax.random.normal(next(ks), (DEPTH, BATCH, SEQ, PLE_DIM), f32),
        "attn_norm": gain((DEPTH, D)),
        "ffn_norm": gain((DEPTH, D)),
        "ple_norm": gain((DEPTH, D)),
        "final_norm": gain((D,)),
        "moba_wqkv": w((N_MOBA_LAYERS, D, 3 * MOBA_HEADS * MOBA_HEAD_DIM), D),
        "moba_wo": w((N_MOBA_LAYERS, MOBA_HEADS * MOBA_HEAD_DIM, D), MOBA_HEADS * MOBA_HEAD_DIM),
        "mla_wdq": w((N_MLA_LAYERS, D, MLA_Q_RANK), D),
        "mla_qnorm": gain((N_MLA_LAYERS, MLA_Q_RANK)),
        "mla_wuq": w((N_MLA_LAYERS, MLA_Q_RANK, MLA_HEADS * (MLA_NOPE + MLA_ROPE)), MLA_Q_RANK),
        "mla_wdkv": w((N_MLA_LAYERS, D, MLA_KV_RANK + MLA_ROPE), D),
        "mla_kvnorm": gain((N_MLA_LAYERS, MLA_KV_RANK)),
        "mla_wukv": w((N_MLA_LAYERS, MLA_KV_RANK, MLA_HEADS * (MLA_NOPE + MLA_V)), MLA_KV_RANK),
        "mla_wo": w((N_MLA_LAYERS, MLA_HEADS * MLA_V, D), MLA_HEADS * MLA_V),
        "moe_wgroup": w((DEPTH, D, N_GROUPS), D),
        "moe_wexpert": w((DEPTH, D, N_EXPERTS), D),
        "moe_wgate": w((DEPTH, N_EXPERTS, D, EXPERT_FF), D),
        "moe_wup": w((DEPTH, N_EXPERTS, D, EXPERT_FF), D),
        "moe_wdown": w((DEPTH, N_EXPERTS, EXPERT_FF, D), EXPERT_FF),
        "ple_gate": w((DEPTH, D, D), D),
        "ple_proj": w((DEPTH, PLE_DIM, D), PLE_DIM),
    }


def reference(x, p, attn_norm, ffn_norm, ple_norm, final_norm, moba_wqkv, moba_wo,
              mla_wdq, mla_qnorm, mla_wuq, mla_wdkv, mla_kvnorm, mla_wukv, mla_wo,
              moe_wgroup, moe_wexpert, moe_wgate, moe_wup, moe_wdown, ple_gate, ple_proj):
    h = x
    for i in range(DEPTH):
        hn = rms_norm(h, attn_norm[i])
        j = i // N_MIXERS
        if i % N_MIXERS == 0:
            mix = moba_attention(hn, moba_wqkv[j], moba_wo[j])
        else:
            mix = mla_attention(hn, mla_wdq[j], mla_qnorm[j], mla_wuq[j], mla_wdkv[j],
                                mla_kvnorm[j], mla_wukv[j], mla_wo[j])
        h = h + mix
        h = h + hier_moe(rms_norm(h, ffn_norm[i]), moe_wgroup[i], moe_wexpert[i],
                         moe_wgate[i], moe_wup[i], moe_wdown[i])
        gate = jax.nn.sigmoid(rms_norm(h, ple_norm[i]) @ ple_gate[i])
        h = h + gate * (p[i] @ ple_proj[i])
    return rms_norm(h, final_norm)
```

```cpp
#include <hip/hip_runtime.h>
#include <cstdio>
#include <cstdint>
#include <cmath>
namespace fk {
#define LAS __attribute__((address_space(3)))
#define GAS __attribute__((address_space(1)))
typedef unsigned short bf16_t;
typedef short bf16x8 __attribute__((ext_vector_type(8)));
typedef short s16x4 __attribute__((ext_vector_type(4)));
typedef float f32x4 __attribute__((ext_vector_type(4)));
typedef float f32x16 __attribute__((ext_vector_type(16)));
typedef unsigned u32x4 __attribute__((ext_vector_type(4)));
typedef unsigned u32x2 __attribute__((ext_vector_type(2)));
typedef float f32x2_t __attribute__((ext_vector_type(2)));
typedef __bf16 bf16x2_t __attribute__((ext_vector_type(2)));

constexpr int NB = 4, NS = 8192, ND = 1024, NT = NB * NS, NH = 8;
constexpr float EPS = 1e-6f;
constexpr int NWAVES = 8, NTHR = 512;

constexpr size_t MiB = 1u << 20;
constexpr size_t WS_CTL = 0, CTL_ZERO_BYTES = 1 * MiB;
constexpr size_t WS_COSA = 1 * MiB, WS_SINA = 3 * MiB, WS_COSB = 5 * MiB, WS_SINB = 6 * MiB;
constexpr size_t WS_KMEAN = 7 * MiB;
constexpr size_t WS_WRT = 7 * MiB + 512 * 1024;
constexpr size_t WS_HPX = 8 * MiB, WS_HP0 = 10 * MiB, WS_HP1 = 12 * MiB, WS_HP2 = 14 * MiB;
constexpr size_t WS_CQP = 16 * MiB, WS_KVP = 17 * MiB;
constexpr size_t WS_TOKW = 18 * MiB;
constexpr size_t WS_LIST = 19 * MiB;
constexpr size_t WS_WQKV0 = 24 * MiB, WS_WO0 = 30 * MiB, WS_WDQKV = 32 * MiB, WS_WUQ = 34 * MiB, WS_WUKV = 36 * MiB, WS_WO1 = 37 * MiB;
constexpr size_t WS_WGU = 40 * MiB;
constexpr size_t WS_WD = 72 * MiB;
constexpr size_t WS_WPG = 88 * MiB;
constexpr size_t WS_WPP = 92 * MiB;
constexpr size_t WS_HB = 94 * MiB;
constexpr size_t WS_CQ = WS_HB, WS_CKV = WS_HB + 24 * MiB, WS_KROPE = WS_HB + 40 * MiB;
constexpr size_t WS_O = 158 * MiB;
constexpr size_t WS_R = 222 * MiB;
constexpr size_t WS_Q = WS_R, WS_K0 = WS_R + 64 * MiB, WS_V0 = WS_R + 128 * MiB;
constexpr size_t WS_KN1 = WS_R + 96 * MiB, WS_V1 = WS_R + 160 * MiB;
constexpr size_t WS_ACT = WS_R, WS_PB = WS_R + 40 * MiB, WS_PP = WS_R + 64 * MiB;
constexpr size_t WS_END = WS_R + 224 * MiB;
constexpr int CW_CNT = 1024;
constexpr int CW_BAR = 4096;

constexpr int RING_BYTES = 131072;
constexpr int LDS_MISC = RING_BYTES;
constexpr int LDS_BYTES = 147456;

struct Args { const float* in[22]; float* out; unsigned char* ws; int ph_lo, ph_hi; };

__device__ __forceinline__ unsigned cvtpk(float lo, float hi) { f32x2_t v = {lo, hi}; bf16x2_t b = __builtin_convertvector(v, bf16x2_t); return __builtin_bit_cast(unsigned, b); }
__device__ __forceinline__ float bf2f(unsigned short b) { return __builtin_bit_cast(float, (unsigned)b << 16); }
__device__ __forceinline__ u32x4 pack8(f32x4 a, f32x4 b) { u32x4 w = {cvtpk(a[0], a[1]), cvtpk(a[2], a[3]), cvtpk(b[0], b[1]), cvtpk(b[2], b[3])}; return w; }
__device__ __forceinline__ float wave_sum(float v) {
#pragma unroll
    for (int o = 1; o < 64; o <<= 1) v += __shfl_xor(v, o);
    return v;
}
__device__ __forceinline__ float dot4(f32x4 a) { return (a[0] * a[0] + a[1] * a[1]) + (a[2] * a[2] + a[3] * a[3]); }
template <int NP> __device__ __forceinline__ float row_rs(const float* hp, float invd) {
    float s = 0.f;
#pragma unroll
    for (int i = 0; i < NP / 4; ++i) { const f32x4 a = *(const f32x4*)(hp + 4 * i); s += (a[0] + a[1]) + (a[2] + a[3]); }
    return rsqrtf(s * invd + EPS);
}

#define XB_TMO      128
#define XB_XCNT(j)  (256  + 64 * (j))
#define XB_XSUB(j)  (1280 + 64 * (j))
#define XB_XGEN(j)  (2304 + 64 * (j))
#define XB_TOP      3328
#define XB_TOPGEN   3392
#define XCD_BAR_WORDS 3456
#define XB_SPIN_CAP (1u << 18)
__device__ __forceinline__ unsigned xb_ld(unsigned* p)              { return __hip_atomic_load(p, __ATOMIC_RELAXED, __HIP_MEMORY_SCOPE_AGENT); }
__device__ __forceinline__ unsigned xb_add(unsigned* p, unsigned v) { return __hip_atomic_fetch_add(p, v, __ATOMIC_RELAXED, __HIP_MEMORY_SCOPE_AGENT); }
__device__ __forceinline__ unsigned xb_xcc_id() { return (unsigned)__builtin_amdgcn_s_getreg((3 << 11) | 20) & 0xFu; }
#define XB_SPIN(cond, bar) do { unsigned _sp = 0; while (cond) { __builtin_amdgcn_s_sleep(1); \
    if ((++_sp & 255u) == 0u) { if (xb_ld(&(bar)[XB_TMO])) break; if (_sp > XB_SPIN_CAP) { atomicAdd(&(bar)[XB_TMO], 1u); break; } } } } while (0)
struct XcdBarrier { unsigned* bar; unsigned x; volatile LAS unsigned* st; };
__device__ __forceinline__ XcdBarrier xcd_barrier_post(unsigned* bar, volatile LAS unsigned* st) {
    XcdBarrier b; b.bar = bar; b.x = xb_xcc_id(); b.st = st;
    if (threadIdx.x == 0) (void)xb_add(&bar[XB_XCNT(b.x)], 1u);
    return b;
}
__device__ __forceinline__ void xcd_barrier_complete(unsigned* bar, unsigned x, unsigned& nloc, unsigned& nx) {
    const unsigned G = gridDim.x * gridDim.y * gridDim.z;
    unsigned sum, cnt, mine, sp = 0u;
    for (;;) {
        sum = 0u; cnt = 0u; mine = 0u;
#pragma unroll
        for (unsigned j = 0; j < 16; ++j) { const unsigned c = xb_ld(&bar[XB_XCNT(j)]); sum += c; cnt += (c > 0u) ? 1u : 0u; mine = (j == x) ? c : mine; }
        if (sum == G) break;
        __builtin_amdgcn_s_sleep(1);
        if ((++sp & 255u) == 0u) { if (xb_ld(&bar[XB_TMO])) break; if (sp > XB_SPIN_CAP) { atomicAdd(&bar[XB_TMO], 1u); break; } }
    }
    nloc = mine > 0u ? mine : 1u; nx = cnt > 0u ? cnt : 1u;
}
__device__ __forceinline__ void xcd_barrier(const XcdBarrier& b) {
    asm volatile("s_waitcnt vmcnt(0)" ::: "memory");
    __syncthreads();
    if (threadIdx.x == 0) {
        unsigned* bar = b.bar;
        __builtin_amdgcn_s_waitcnt(0);
        unsigned nloc = b.st[0], nx = b.st[1];
        if (nloc == 0u) { xcd_barrier_complete(bar, b.x, nloc, nx); b.st[0] = nloc; b.st[1] = nx; }
        const unsigned old = xb_add(&bar[XB_XSUB(b.x)], 1u);
        const unsigned gen = old / nloc;
        if (old + 1u == (gen + 1u) * nloc) {
            __builtin_amdgcn_fence(__ATOMIC_RELEASE, "agent");
            asm volatile("s_waitcnt vmcnt(0)" ::: "memory");
            const unsigned og = xb_add(&bar[XB_TOP], 1u);
            const unsigned tg = og / nx;
            if (og + 1u == (tg + 1u) * nx) xb_add(&bar[XB_TOPGEN], 1u);
            else XB_SPIN(xb_ld(&bar[XB_TOPGEN]) == tg, bar);
            __builtin_amdgcn_fence(__ATOMIC_ACQUIRE, "agent");
            xb_add(&bar[XB_XGEN(b.x)], 1u);
            asm volatile("s_waitcnt vmcnt(0)" ::: "memory");
        } else {
            XB_SPIN(xb_ld(&bar[XB_XGEN(b.x)]) == gen, bar);
            __builtin_amdgcn_fence(__ATOMIC_ACQUIRE, "agent");
            asm volatile("s_waitcnt vmcnt(0)" ::: "memory");
        }
    }
    __syncthreads();
}

namespace g8 {
constexpr int BM = 256, BK = 64, HALF = 128, HTB = HALF * BK * 2, STAGE_BYTES = 8 * HTB, NXCD = 8, WGM = 8;
__device__ __forceinline__ int lds_byte(int r, int c) { const int st = (r >> 4) * 2 + (c >> 5), rr = r & 15, cc = c & 31, ob = rr * 64 + cc * 2; return st * 1024 + (ob ^ (((ob >> 9) & 1) << 5)); }
__device__ __forceinline__ void stage_rc(int b, int& R, int& C) { const int st = b / 1024, sb = b % 1024, swz = sb ^ (((sb >> 9) & 1) << 5); R = (st >> 1) * 16 + swz / 64; C = (st & 1) * 32 + (swz % 64) / 2; }
__device__ __forceinline__ int perm32(int rho) { const int n = rho >> 4, i = rho & 15; return 8 * (i >> 2) + 4 * n + (i & 3); }
struct Unit { int pm, pn, aux; };
struct AOff { unsigned o[2][2]; };

__device__ __forceinline__ bool static_order(int i, int G, int c, int nM, int nN, int& pm, int& pn) {
    const int nwg = nM * nN; const long L = (long)i * G + c; if (L >= nwg) return false;
    int wgid = (int)L; { const int q = nwg / NXCD, r = nwg % NXCD, xcd = wgid % NXCD, off = wgid / NXCD; wgid = (xcd < r ? xcd * (q + 1) : r * (q + 1) + (xcd - r) * q) + off; }
    const int nig = WGM * nN, gid = wgid / nig, fm = gid * WGM, gsz = (nM - fm) < WGM ? (nM - fm) : WGM;
    pm = fm + ((wgid % nig) % gsz); pn = (wgid % nig) / gsz; return true;
}
struct DenseP {
    const char* A; const char* B; int lda, ldb, K, nM, nN, G, c;
    __device__ __forceinline__ bool next(int i, Unit& u) const { u.aux = 0; return static_order(i, G, c, nM, nN, u.pm, u.pn); }
    __device__ __forceinline__ void aoff(const Unit& u, const int (&R)[2], const int (&C)[2], AOff& o) const {
#pragma unroll
        for (int h = 0; h < 2; ++h)
#pragma unroll
            for (int i = 0; i < 2; ++i) o.o[h][i] = (unsigned)(((u.pm * BM + h * HALF + R[i]) * lda + C[i]) * 2);
    }
    __device__ __forceinline__ const char* bbase(const Unit& u, int kt) const { return B + ((size_t)u.pn * BM * ldb + (size_t)kt * BK) * 2; }
};

template <class Prov, class Epi>
__device__ __forceinline__ void gemm_phase(LAS unsigned char* lds, const Prov& P, const Epi& E) {
    int tid = threadIdx.x; asm volatile("" : "+v"(tid));
    const int wid = __builtin_amdgcn_readfirstlane(tid >> 6), lane = tid & 63, wr = wid >> 2, wc = wid & 3, fr = lane & 15, fq = lane >> 4;
    const int K = P.K, nt = K / BK;
    int R[2], C[2]; unsigned voffB[2];
#pragma unroll
    for (int i = 0; i < 2; ++i) { stage_rc(tid * 16 + i * 8192, R[i], C[i]); const int Rb = (R[i] & ~31) + perm32(R[i] & 31); voffB[i] = (unsigned)(Rb * P.ldb + C[i]) * 2u; }
    const size_t hstepB = (size_t)HALF * P.ldb * 2;
    const unsigned ldsw = (unsigned)wid * 1024u;
    const int aoff = lds_byte(wr * 64 + fr, fq * 8), boff = lds_byte(wc * 32 + fr, fq * 8);
#define G8_SA(b, h) (((b) * 2 + (h)) * HTB)
#define G8_SB(b, h) ((4 + (b) * 2 + (h)) * HTB)
#define G8_STAGE_A(bufoff, h, AO, kb) do { _Pragma("unroll") for (int _i = 0; _i < 2; ++_i) \
        __builtin_amdgcn_global_load_lds((const unsigned*)(P.A + (size_t)((AO).o[h][_i] + (kb))), (LAS unsigned*)(lds + (bufoff) + ldsw + _i * 8192), 16, 0, 0); } while (0)
#define G8_STAGE_B(bufoff, bp) do { _Pragma("unroll") for (int _i = 0; _i < 2; ++_i) \
        __builtin_amdgcn_global_load_lds((const unsigned*)((bp) + voffB[_i]), (LAS unsigned*)(lds + (bufoff) + ldsw + _i * 8192), 16, 0, 0); } while (0)
#define G8_LDA(dst, b, h) do { _Pragma("unroll") for (int m = 0; m < 4; ++m) _Pragma("unroll") for (int k = 0; k < 2; ++k) dst[m][k] = *(const LAS bf16x8*)(lds + G8_SA(b, h) + aoff + m * 2048 + k * 1024); } while (0)
#define G8_LDB(dst, b, h) do { _Pragma("unroll") for (int n = 0; n < 2; ++n) _Pragma("unroll") for (int k = 0; k < 2; ++k) dst[n][k] = *(const LAS bf16x8*)(lds + G8_SB(b, h) + boff + n * 2048 + k * 1024); } while (0)
#define G8_MMA(ai, bj, At, Bt) do { __builtin_amdgcn_s_setprio(1); _Pragma("unroll") for (int m = 0; m < 4; ++m) _Pragma("unroll") for (int n = 0; n < 2; ++n) _Pragma("unroll") for (int k = 0; k < 2; ++k) \
        acc[ai][bj][m][n] = __builtin_amdgcn_mfma_f32_16x16x32_bf16(Bt[n][k], At[m][k], acc[ai][bj][m][n], 0, 0, 0); __builtin_amdgcn_s_setprio(0); } while (0)
#define G8_WAIT_V(n) asm volatile("s_waitcnt vmcnt(" #n ")" ::: "memory")
#define G8_WAIT_L(n) asm volatile("s_waitcnt lgkmcnt(" #n ")" ::: "memory")
#define G8_BAR __builtin_amdgcn_s_barrier()
#define G8_SCHED __builtin_amdgcn_sched_barrier(0)
    Unit cur, nxt; int ui = 0;
    if (!P.next(0, cur)) return;
    f32x4 acc[2][2][4][2];
#pragma unroll
    for (int a = 0; a < 2; ++a)
#pragma unroll
        for (int b = 0; b < 2; ++b)
#pragma unroll
            for (int m = 0; m < 4; ++m)
#pragma unroll
                for (int n = 0; n < 2; ++n) acc[a][b][m][n] = (f32x4){0.f, 0.f, 0.f, 0.f};
    bf16x8 At[4][2], B0[2][2], B1[2][2];
    AOff cA, nA;
    P.aoff(cur, R, C, cA);
    {   const char* b0 = P.bbase(cur, 0); const char* b1 = P.bbase(cur, 1);
        G8_STAGE_B(G8_SB(0, 0), b0); G8_STAGE_B(G8_SB(0, 1), b0 + hstepB); G8_STAGE_A(G8_SA(0, 0), 0, cA, 0u); G8_STAGE_A(G8_SA(0, 1), 1, cA, 0u);
        if (wr == 1) G8_BAR;
        G8_WAIT_V(2); G8_BAR;
        G8_STAGE_B(G8_SB(1, 0), b1); G8_STAGE_A(G8_SA(1, 0), 0, cA, 128u); G8_STAGE_B(G8_SB(1, 1), b1 + hstepB);
        G8_WAIT_V(6); G8_BAR; }
    for (;;) {
        const bool has_next = P.next(ui + 1, nxt);
        if (has_next) P.aoff(nxt, R, C, nA); else { nA = cA; nxt = cur; }
        for (int t = 0; t < nt; t += 2) {
            const bool last = (t == nt - 2);
            const unsigned kb1 = (unsigned)(t + 1) * 128u;
            const unsigned kb2 = last ? 0u : (unsigned)(t + 2) * 128u, kb3 = kb2 + 128u;
            AOff s;
#pragma unroll
            for (int h = 0; h < 2; ++h)
#pragma unroll
                for (int i = 0; i < 2; ++i) s.o[h][i] = last ? nA.o[h][i] : cA.o[h][i];
            const char* b2 = last ? P.bbase(nxt, 0) : P.bbase(cur, t + 2);
            const char* b3 = last ? P.bbase(nxt, 1) : P.bbase(cur, t + 3);
            G8_LDB(B0, 0, 0); G8_LDB(B1, 0, 1); G8_SCHED; G8_LDA(At, 0, 0); G8_STAGE_A(G8_SA(1, 1), 1, cA, kb1);
            G8_WAIT_V(8); G8_WAIT_L(0); G8_BAR; G8_MMA(0, 0, At, B0); G8_MMA(0, 1, At, B1); G8_BAR; G8_SCHED;
            G8_LDA(At, 0, 1); G8_STAGE_B(G8_SB(0, 0), b2); G8_STAGE_B(G8_SB(0, 1), b2 + hstepB); G8_STAGE_A(G8_SA(0, 0), 0, s, kb2);
            G8_WAIT_V(8); G8_WAIT_L(0); G8_BAR; G8_MMA(1, 0, At, B0); G8_MMA(1, 1, At, B1); G8_BAR; G8_SCHED;
            G8_LDB(B0, 1, 0); G8_LDB(B1, 1, 1); G8_SCHED; G8_LDA(At, 1, 0); G8_STAGE_A(G8_SA(0, 1), 1, s, kb2);
            G8_WAIT_V(8); G8_WAIT_L(0); G8_BAR; G8_MMA(0, 0, At, B0); G8_MMA(0, 1, At, B1); G8_BAR; G8_SCHED;
            G8_LDA(At, 1, 1); G8_STAGE_B(G8_SB(1, 0), b3); G8_STAGE_B(G8_SB(1, 1), b3 + hstepB); G8_STAGE_A(G8_SA(1, 0), 0, s, kb3);
            G8_WAIT_V(8); G8_WAIT_L(0); G8_BAR; G8_MMA(1, 0, At, B0); G8_MMA(1, 1, At, B1); G8_BAR; G8_SCHED;
        }
        if (wr == 0) G8_BAR;
        E(acc, cur, wr, wc, fr, fq);
        if (!has_next) break;
#pragma unroll
        for (int a = 0; a < 2; ++a)
#pragma unroll
            for (int b = 0; b < 2; ++b)
#pragma unroll
                for (int m = 0; m < 4; ++m)
#pragma unroll
                    for (int n = 0; n < 2; ++n) acc[a][b][m][n] = (f32x4){0.f, 0.f, 0.f, 0.f};
        cur = nxt; cA = nA; ++ui;
        if (wr == 1) G8_BAR;
    }
    G8_WAIT_V(0);
    G8_BAR;
#undef G8_SA
#undef G8_SB
#undef G8_STAGE_A
#undef G8_STAGE_B
#undef G8_LDA
#undef G8_LDB
#undef G8_MMA
#undef G8_WAIT_V
#undef G8_WAIT_L
#undef G8_BAR
#undef G8_SCHED
}
}
using g8::Unit;


struct EpiQKV {
    const float* hpx; const float* cosA; const float* sinA; bf16_t* Q; bf16_t* Kk; bf16_t* V; float* kmean;
    __device__ __forceinline__ void operator()(const f32x4 (&acc)[2][2][4][2], const Unit& u, int wr, int wc, int fr, int fq) const {
        const int t = u.pn >> 2;
        const int bb = u.pm >> 5;
        if (t < 2) {
            const int hh = 2 * (u.pn & 3) + (wc >> 1), j0 = 32 * (wc & 1) + 8 * fq;
            bf16_t* dst0 = (t == 0 ? Q : Kk) + ((size_t)(bb * NH + hh) * NS) * 128;
            f32x4 ks[2][2] = {{{0.f, 0.f, 0.f, 0.f}, {0.f, 0.f, 0.f, 0.f}}, {{0.f, 0.f, 0.f, 0.f}, {0.f, 0.f, 0.f, 0.f}}};
#pragma unroll
            for (int ai = 0; ai < 2; ++ai)
#pragma unroll
                for (int m = 0; m < 4; ++m) {
                    const int row = u.pm * 256 + 128 * ai + 64 * wr + 16 * m + fr, s = row & (NS - 1);
                    const float rs = row_rs<16>(hpx + (size_t)row * 16, 1.0f / 1024.0f);
                    f32x4 o1[2], o2[2];
#pragma unroll
                    for (int n = 0; n < 2; ++n) {
                        const f32x4 cs = *(const f32x4*)(cosA + (size_t)s * 64 + j0 + 4 * n), sn = *(const f32x4*)(sinA + (size_t)s * 64 + j0 + 4 * n);
                        const f32x4 x1 = acc[ai][0][m][n] * rs, x2 = acc[ai][1][m][n] * rs;
                        o1[n] = x1 * cs - x2 * sn; o2[n] = x1 * sn + x2 * cs;
                        ks[0][n] += o1[n]; ks[1][n] += o2[n];
                    }
                    bf16_t* d = dst0 + (size_t)s * 128 + j0;
                    *(u32x4*)d = pack8(o1[0], o1[1]); *(u32x4*)(d + 64) = pack8(o2[0], o2[1]);
                }
            if (t == 1) {
#pragma unroll
                for (int q = 0; q < 2; ++q)
#pragma unroll
                    for (int n = 0; n < 2; ++n)
#pragma unroll
                        for (int e = 0; e < 4; ++e) { float v = ks[q][n][e]; v += __shfl_xor(v, 1); v += __shfl_xor(v, 2); v += __shfl_xor(v, 4); v += __shfl_xor(v, 8); ks[q][n][e] = v; }
                if (fr == 0) {
                    float* km = kmean + ((size_t)(bb * NH + hh) * 32 + (u.pm & 31)) * 128 + j0;
#pragma unroll
                    for (int q = 0; q < 2; ++q)
#pragma unroll
                        for (int n = 0; n < 2; ++n)
#pragma unroll
                            for (int e = 0; e < 4; ++e) atomicAdd(km + 64 * q + 4 * n + e, ks[q][n][e]);
                }
            }
        } else {
            const int d0 = 32 * wc + 8 * fq;
#pragma unroll
            for (int ai = 0; ai < 2; ++ai)
#pragma unroll
                for (int m = 0; m < 4; ++m) {
                    const int row = u.pm * 256 + 128 * ai + 64 * wr + 16 * m + fr, s = row & (NS - 1);
                    const float rs = row_rs<16>(hpx + (size_t)row * 16, 1.0f / 1024.0f);
#pragma unroll
                    for (int bj = 0; bj < 2; ++bj) {
                        const int hh = 2 * (u.pn - 8) + bj;
                        bf16_t* d = V + ((size_t)(bb * NH + hh) * NS + s) * 128 + d0;
                        *(u32x4*)d = pack8(acc[ai][bj][m][0] * rs, acc[ai][bj][m][1] * rs);
                    }
                }
        }
    }
};

struct EpiResid {
    const float* base; float* h; bf16_t* hb; float* hp;
    __device__ __forceinline__ void operator()(const f32x4 (&acc)[2][2][4][2], const Unit& u, int wr, int wc, int fr, int fq) const {
#pragma unroll
        for (int ai = 0; ai < 2; ++ai)
#pragma unroll
            for (int m = 0; m < 4; ++m) {
                const int row = u.pm * 256 + 128 * ai + 64 * wr + 16 * m + fr;
                float ss = 0.f;
#pragma unroll
                for (int bj = 0; bj < 2; ++bj) {
                    const size_t off = (size_t)row * 1024 + u.pn * 256 + 128 * bj + 32 * wc + 8 * fq;
                    const f32x4 v0 = acc[ai][bj][m][0] + *(const f32x4*)(base + off), v1 = acc[ai][bj][m][1] + *(const f32x4*)(base + off + 4);
                    *(f32x4*)(h + off) = v0; *(f32x4*)(h + off + 4) = v1;
                    *(u32x4*)(hb + off) = pack8(v0, v1);
                    ss += dot4(v0) + dot4(v1);
                }
                ss += __shfl_xor(ss, 16); ss += __shfl_xor(ss, 32);
                if (fq == 0) hp[(size_t)row * 16 + u.pn * 4 + wc] = ss;
                asm volatile("" ::: "memory");
            }
    }
};
namespace at {
constexpr int KVBLK = 64, SHM_V = KVBLK * 128 * 2;
constexpr float THR = 8.f;
#define AT_SBAR() __builtin_amdgcn_sched_barrier(0)
__device__ __forceinline__ int v_st(int k, int c) { const int kk = (k & ~0xC) | ((k & 4) << 1) | ((k & 8) >> 1); return ((kk >> 3) * 4 + (c >> 5)) * 512 + ((kk & 7) * 32 + (c & 31)) * 2; }
__device__ __forceinline__ int v_rd_base(int lane) { return ((lane & 3) << 3) | (((lane >> 2) & 3) << 6) | (((lane >> 4) & 1) << 5) | (((lane >> 5) & 1) << 8); }
constexpr int v_rd_off(int d0, int ks, int half) { return d0 * 512 + ks * 4096 + half * 2048; }
__device__ __forceinline__ int crow(int r, int hi) { return (r & 3) + 8 * (r >> 2) + 4 * hi; }

template <int DQK> __device__ __forceinline__ int kswz(int row, int colB) { return row * (DQK * 2) + (colB ^ ((row & 7) << 4)); }

__device__ __forceinline__ void mask_causal(f32x16& p0, f32x16& p1, int dq) {
    const float NEG = -__builtin_inff();
#pragma unroll
    for (int r = 0; r < 16; ++r) {
        const int c = (r & 3) + 8 * (r >> 2);
        if (dq - c < 0) p0[r] = NEG;
        if (dq - c - 32 < 0) p1[r] = NEG;
    }
}
__device__ __forceinline__ void mask_all(f32x16& p0, f32x16& p1, bool keep) {
    const float NEG = -__builtin_inff();
#pragma unroll
    for (int r = 0; r < 16; ++r) { p0[r] = keep ? p0[r] : NEG; p1[r] = keep ? p1[r] : NEG; }
}
__device__ __forceinline__ void partialSM(f32x16& p0, f32x16& p1, float& m_reg, float& mn, float& alpha, const float SC, const float C2) {
    float pmax = p0[0];
#pragma unroll
    for (int r = 1; r < 16; ++r) pmax = fmaxf(pmax, p0[r]);
#pragma unroll
    for (int r = 0; r < 16; ++r) pmax = fmaxf(pmax, p1[r]);
    { auto rr = __builtin_amdgcn_permlane32_swap(__float_as_uint(pmax), __float_as_uint(pmax), false, false);
      pmax = fmaxf(__uint_as_float(rr[0]), __uint_as_float(rr[1])); }
    if (__builtin_expect(__all((pmax - m_reg) * SC <= THR), 1)) { mn = m_reg; alpha = 1.f; }
    else { mn = fmaxf(m_reg, pmax); alpha = __builtin_amdgcn_exp2f((m_reg - mn) * C2); m_reg = mn; }
    const float mnL = -mn * C2;
#pragma unroll
    for (int r = 0; r < 16; ++r) p0[r] = fmaf(p0[r], C2, mnL);
#pragma unroll
    for (int r = 0; r < 16; ++r) p1[r] = fmaf(p1[r], C2, mnL);
#pragma unroll
    for (int r = 0; r < 16; ++r) p0[r] = __builtin_amdgcn_exp2f(p0[r]);
}
__device__ __forceinline__ void finishSM(f32x16& p0, f32x16& p1, float alpha, float& l_reg, bf16x8& pa0, bf16x8& pa1, bf16x8& pa2, bf16x8& pa3) {
#pragma unroll
    for (int r = 0; r < 16; ++r) p1[r] = __builtin_amdgcn_exp2f(p1[r]);
    float ps = 0;
#pragma unroll
    for (int r = 0; r < 16; ++r) ps += p0[r];
#pragma unroll
    for (int r = 0; r < 16; ++r) ps += p1[r];
    { auto rr = __builtin_amdgcn_permlane32_swap(__float_as_uint(ps), __float_as_uint(ps), false, false);
      ps = __uint_as_float(rr[0]) + __uint_as_float(rr[1]); }
    l_reg = l_reg * alpha + ps;
#define AT_PK4(P, B_, OUT) do { unsigned a0 = cvtpk(P[B_+0], P[B_+1]), a1 = cvtpk(P[B_+2], P[B_+3]);                          \
        unsigned b0 = cvtpk(P[B_+4], P[B_+5]), b1 = cvtpk(P[B_+6], P[B_+7]);                                             \
        auto r0 = __builtin_amdgcn_permlane32_swap(a0, b0, false, false); auto r1 = __builtin_amdgcn_permlane32_swap(a1, b1, false, false); \
        u32x4 w = {r0[0], r1[0], r0[1], r1[1]}; OUT = __builtin_bit_cast(bf16x8, w); } while (0)
    AT_PK4(p0, 0, pa0); AT_PK4(p0, 8, pa1); AT_PK4(p1, 0, pa2); AT_PK4(p1, 8, pa3);
#undef AT_PK4
}
template <int DQK>
__device__ __forceinline__ void qkt(f32x16& p0, f32x16& p1, const char* Kt, int r32, int hi, const bf16x8* qr, bool act) {
    if (!act) { const float NEG = -__builtin_inff();
#pragma unroll
        for (int r = 0; r < 16; ++r) { p0[r] = NEG; p1[r] = NEG; } return; }
    p0 = f32x16{}; p1 = f32x16{};
    const char* kb[4];
#pragma unroll
    for (int dd = 0; dd < 4; ++dd) kb[dd] = Kt + kswz<DQK>(r32, (dd * 16 + hi * 8) * 2);
#pragma unroll
    for (int d0 = 0; d0 < DQK / 16; ++d0) { const char* a = kb[d0 & 3] + (d0 >> 2) * 128;
        bf16x8 b0 = *reinterpret_cast<const bf16x8*>(a);
        bf16x8 b1 = *reinterpret_cast<const bf16x8*>(a + 32 * DQK * 2);
        p0 = __builtin_amdgcn_mfma_f32_32x32x16_bf16(b0, qr[d0], p0, 0, 0, 0);
        p1 = __builtin_amdgcn_mfma_f32_32x32x16_bf16(b1, qr[d0], p1, 0, 0, 0); }
}
template <int VB>
__device__ __forceinline__ void pv_tile(f32x16* o, int vb0, bf16x8 pa0, bf16x8 pa1, bf16x8 pa2, bf16x8 pa3, bool act) {
    if (!act) return;
#define AT_TRRD(dst, off) asm volatile("ds_read_b64_tr_b16 %0, %1 offset:%2" : "=&v"(dst) : "v"(vb0), "i"(off) : "memory")
#define AT_PV_D0(d0) do { s16x4 l0, l1, l2, l3, h0, h1, h2, h3; constexpr int b_ = VB * SHM_V + v_rd_off(d0, 0, 0); \
        AT_TRRD(l0, b_); AT_TRRD(h0, b_ + 2048); AT_TRRD(l1, b_ + 4096); AT_TRRD(h1, b_ + 6144); AT_TRRD(l2, b_ + 8192); AT_TRRD(h2, b_ + 10240); AT_TRRD(l3, b_ + 12288); AT_TRRD(h3, b_ + 14336); \
        asm volatile("s_waitcnt lgkmcnt(0)" ::: "memory"); AT_SBAR();   \
        o[d0] = __builtin_amdgcn_mfma_f32_32x32x16_bf16(pa0, (bf16x8){l0[0], l0[1], l0[2], l0[3], h0[0], h0[1], h0[2], h0[3]}, o[d0], 0, 0, 0);   \
        o[d0] = __builtin_amdgcn_mfma_f32_32x32x16_bf16(pa1, (bf16x8){l1[0], l1[1], l1[2], l1[3], h1[0], h1[1], h1[2], h1[3]}, o[d0], 0, 0, 0);   \
        o[d0] = __builtin_amdgcn_mfma_f32_32x32x16_bf16(pa2, (bf16x8){l2[0], l2[1], l2[2], l2[3], h2[0], h2[1], h2[2], h2[3]}, o[d0], 0, 0, 0);   \
        o[d0] = __builtin_amdgcn_mfma_f32_32x32x16_bf16(pa3, (bf16x8){l3[0], l3[1], l3[2], l3[3], h3[0], h3[1], h3[2], h3[3]}, o[d0], 0, 0, 0); } while (0)
    AT_PV_D0(0); AT_PV_D0(1); AT_PV_D0(2); AT_PV_D0(3);
#undef AT_PV_D0
#undef AT_TRRD
}

template <int DQK> struct Lds { static constexpr int SHM_K = KVBLK * DQK * 2, K_OFF = 2 * SHM_V, WS_OFF = K_OFF + 2 * SHM_K, BYTES = WS_OFF + NWAVES * 64 * 4; };

template <int DQK, int MODE>
__device__ __forceinline__ void attn_unit(char* lds, const bf16_t* Qp, const bf16_t* Kn, const bf16_t* Kr, const bf16_t* Vp, bf16_t* Op, int P0, const float* kms) {
    typedef Lds<DQK> L;
    constexpr int SHM_K = L::SHM_K;
    constexpr float SC = (DQK == 128) ? 0.08838834764831845f : 0.07216878364870323f;
    constexpr float C2 = 1.4426950408889634f * SC;
    constexpr int ND0 = DQK / 16;
    int tid = threadIdx.x; asm volatile("" : "+v"(tid));
    const int wid = __builtin_amdgcn_readfirstlane(tid >> 6), lane = tid & 63, r32 = lane & 31, hi = lane >> 5;
    const int NT = (P0 + 256) / KVBLK;
    const int qlo = P0 + wid * 32, qm = qlo + r32 - 4 * hi;
    char* V_lds = lds; char* K_lds = lds + L::K_OFF;
    float* ws = (float*)(lds + L::WS_OFF) + wid * 64; float* li_l = ws, * al_l = ws + 32;
    float m_reg = -1e30f, l_reg = 0; f32x16 o[4] = {};
    const int sr = tid >> 4, sc = (tid & 15) * 8, vst0 = v_st(sr, sc), vst1 = v_st(32 + sr, sc), kws = kswz<DQK>(sr, sc * 2);
    const int rr_ = tid >> 3, rc_ = (tid & 7) * 8, kws_r = kswz<DQK>(rr_, 256 + rc_ * 2);
    const int vb0 = (int)(uintptr_t)V_lds + v_rd_base(lane);
    bf16x8 qr[ND0];
    {   const unsigned qo = (unsigned)(((wid * 32 + r32) * DQK + hi * 8) * 2);
#pragma unroll
        for (int d0 = 0; d0 < ND0; ++d0) qr[d0] = *(const bf16x8*)((const char*)Qp + qo + d0 * 32); }
    unsigned selmask = 0u; const int own = P0 >> 8;
    if (MODE == 1) {
        {   unsigned ko = (unsigned)((sr * 128 + sc) * 4); asm volatile("" : "+v"(ko));
            const f32x4 a = *(const f32x4*)((const char*)kms + ko) * (1.0f / 256.0f), b = *(const f32x4*)((const char*)kms + ko + 16) * (1.0f / 256.0f);
            const u32x4 h8 = pack8(a, b);
            f32x4 ha, hb_;
#pragma unroll
            for (int e = 0; e < 2; ++e) { ha[2 * e] = __builtin_bit_cast(float, h8[e] << 16); ha[2 * e + 1] = __builtin_bit_cast(float, h8[e] & 0xffff0000u);
                                          hb_[2 * e] = __builtin_bit_cast(float, h8[2 + e] << 16); hb_[2 * e + 1] = __builtin_bit_cast(float, h8[2 + e] & 0xffff0000u); }
            const u32x4 l8 = pack8(a - ha, b - hb_);
            *(u32x4*)(K_lds + kws) = h8; *(u32x4*)(K_lds + SHM_K + kws) = l8; }
        __syncthreads();
        f32x16 g = f32x16{};
        {   const char* kb[4];
#pragma unroll
            for (int dd = 0; dd < 4; ++dd) kb[dd] = K_lds + kswz<DQK>(r32, (dd * 16 + hi * 8) * 2);
#pragma unroll
            for (int d0 = 0; d0 < 8; ++d0) { const char* a = kb[d0 & 3] + (d0 >> 2) * 128;
                g = __builtin_amdgcn_mfma_f32_32x32x16_bf16(*reinterpret_cast<const bf16x8*>(a), qr[d0], g, 0, 0, 0);
                g = __builtin_amdgcn_mfma_f32_32x32x16_bf16(*reinterpret_cast<const bf16x8*>(a + SHM_K), qr[d0], g, 0, 0, 0); } }
        const float NINF = -__builtin_inff();
        float v1 = NINF, v2 = NINF, v3 = NINF; int i1 = 64, i2 = 65, i3 = 66;
        const int ownl = own - 4 * hi;
#pragma unroll
        for (int r = 0; r < 16; ++r) {
            const int idx = (r & 3) + 8 * (r >> 2); const float val = (idx < ownl) ? g[r] : NINF;
            const bool c1 = val > v1, c2 = val > v2, c3 = val > v3;
            v3 = c2 ? v2 : (c3 ? val : v3); i3 = c2 ? i2 : (c3 ? idx : i3);
            v2 = c1 ? v1 : (c2 ? val : v2); i2 = c1 ? i1 : (c2 ? idx : i2);
            v1 = c1 ? val : v1;             i1 = c1 ? idx : i1;
        }
        i1 += 4 * hi; i2 += 4 * hi; i3 += 4 * hi;
        float pv_[3]; int pi_[3];
        pv_[0] = __shfl_xor(v1, 32); pv_[1] = __shfl_xor(v2, 32); pv_[2] = __shfl_xor(v3, 32);
        pi_[0] = __shfl_xor(i1, 32); pi_[1] = __shfl_xor(i2, 32); pi_[2] = __shfl_xor(i3, 32);
#pragma unroll
        for (int c = 0; c < 3; ++c) {
            const float val = pv_[c]; const int idx = pi_[c];
            const bool c1 = (val > v1) || (val == v1 && idx < i1), c2 = (val > v2) || (val == v2 && idx < i2), c3 = (val > v3) || (val == v3 && idx < i3);
            v3 = c2 ? v2 : (c3 ? val : v3); i3 = c2 ? i2 : (c3 ? idx : i3);
            v2 = c1 ? v1 : (c2 ? val : v2); i2 = c1 ? i1 : (c2 ? idx : i2);
            v1 = c1 ? val : v1;             i1 = c1 ? idx : i1;
        }
        selmask = (i1 < 32 ? (1u << i1) : 0u) | (i2 < 32 ? (1u << i2) : 0u) | (i3 < 32 ? (1u << i3) : 0u);
        __syncthreads();
    }
    bf16x8 st_v0, st_v1, st_k0, st_k1, st_k2;
    const unsigned lo_a = (unsigned)((sr * 128 + sc) * 2), lo_r = (unsigned)((rr_ * 64 + rc_) * 2);
#define AT_VMW() asm volatile("s_waitcnt vmcnt(0)" ::: "memory")
    const __amdgpu_buffer_rsrc_t rsV = __builtin_amdgcn_make_buffer_rsrc((void*)Vp, 0, NS * 256, 0x00020000), rsK = __builtin_amdgcn_make_buffer_rsrc((void*)Kn, 0, NS * 256, 0x00020000);
    const __amdgpu_buffer_rsrc_t rsR = __builtin_amdgcn_make_buffer_rsrc((void*)(DQK == 192 ? Kr : Kn), 0, NS * 128, 0x00020000);
#define AT_BL(rs, vo, so) __builtin_bit_cast(bf16x8, __builtin_amdgcn_raw_buffer_load_b128(rs, (int)(vo), (int)(so), 0))
#define AT_SLOAD(k0) do { const int so_ = (k0) * 256; \
                          st_v0 = AT_BL(rsV, lo_a, so_); st_v1 = AT_BL(rsV, lo_a, so_ + 8192); \
                          st_k0 = AT_BL(rsK, lo_a, so_); st_k1 = AT_BL(rsK, lo_a, so_ + 8192); \
                          if (DQK == 192) { st_k2 = AT_BL(rsR, lo_r, (k0) * 128); } } while (0)
#define AT_SWRITE(bf) do { *(bf16x8*)(V_lds + (bf) * SHM_V + vst0) = st_v0; *(bf16x8*)(V_lds + (bf) * SHM_V + vst1) = st_v1; \
                           *(bf16x8*)(K_lds + (bf) * SHM_K + kws) = st_k0; *(bf16x8*)(K_lds + (bf) * SHM_K + kws + 32 * DQK * 2) = st_k1; \
                           if (DQK == 192) *(bf16x8*)(K_lds + (bf) * SHM_K + kws_r) = st_k2; } while (0)
#define AT_RESC(a) do { if (__any((a) < 1.f)) { if (hi == 0) al_l[r32] = (a); asm volatile("s_waitcnt lgkmcnt(0)" ::: "memory");              \
                     _Pragma("unroll") for (int d_ = 0; d_ < 4; ++d_) _Pragma("unroll") for (int r = 0; r < 16; ++r) o[d_][r] *= al_l[crow(r, hi)]; } } while (0)
#define AT_KBASE(t) ((t) * KVBLK)
#define AT_ACT(t) (MODE == 0 ? (AT_KBASE(t) <= qlo + 31) : ((((t) >> 2) < own) ? (__any((selmask >> ((t) >> 2)) & 1u) != 0) : (AT_KBASE(t) <= qlo + 31)))
#define AT_MASKT(P0_, P1_, t) do { const int kb_ = AT_KBASE(t); \
        if (MODE == 1 && ((t) >> 2) < own) { mask_all(P0_, P1_, ((selmask >> ((t) >> 2)) & 1u) != 0u); } \
        else if (kb_ + KVBLK - 1 > qlo && kb_ <= qlo + 31) mask_causal(P0_, P1_, qm - kb_); } while (0)
    f32x16 pA0, pA1, pB0, pB1; float mnA, mnB, alA, alB; bf16x8 pa0, pa1, pa2, pa3;
    AT_SLOAD(AT_KBASE(0)); AT_VMW(); AT_SWRITE(0);
    __syncthreads();
    AT_SLOAD(AT_KBASE(1));
    AT_SBAR(); qkt<DQK>(pA0, pA1, K_lds, r32, hi, qr, AT_ACT(0));
    AT_MASKT(pA0, pA1, 0); partialSM(pA0, pA1, m_reg, mnA, alA, SC, C2);
    AT_VMW(); AT_SWRITE(1);
    __syncthreads();
#define AT_HALF_STEP(PX0, PX1, mnX, alX, PY0, PY1, alY, t, KB, VB, SB) do {                                                      \
        AT_SBAR(); qkt<DQK>(PX0, PX1, K_lds + (KB) * SHM_K, r32, hi, qr, AT_ACT(t));                                             \
        finishSM(PY0, PY1, alY, l_reg, pa0, pa1, pa2, pa3); AT_SBAR();                                                           \
        if ((t) + 1 < NT) { AT_SLOAD(AT_KBASE((t) + 1)); AT_SBAR(); }                                                            \
        pv_tile<VB>(o, vb0, pa0, pa1, pa2, pa3, AT_ACT((t) - 1)); AT_MASKT(PX0, PX1, (t)); partialSM(PX0, PX1, m_reg, mnX, alX, SC, C2); \
        __syncthreads();                                                                                                      \
        if ((t) + 1 < NT) { AT_VMW(); AT_SWRITE(SB); }                                                                           \
        AT_RESC(alX); __syncthreads(); } while (0)
    for (int t = 1; t + 1 < NT; t += 2) {
        AT_HALF_STEP(pB0, pB1, mnB, alB, pA0, pA1, alA, t, 1, 0, 0);
        AT_HALF_STEP(pA0, pA1, mnA, alA, pB0, pB1, alB, t + 1, 0, 1, 1);
    }
    AT_SBAR(); qkt<DQK>(pB0, pB1, K_lds + SHM_K, r32, hi, qr, AT_ACT(NT - 1)); AT_SBAR();
    finishSM(pA0, pA1, alA, l_reg, pa0, pa1, pa2, pa3); AT_SBAR();
    pv_tile<0>(o, vb0, pa0, pa1, pa2, pa3, AT_ACT(NT - 2));
    AT_MASKT(pB0, pB1, NT - 1); partialSM(pB0, pB1, m_reg, mnB, alB, SC, C2); AT_RESC(alB);
    finishSM(pB0, pB1, alB, l_reg, pa0, pa1, pa2, pa3); AT_SBAR(); pv_tile<1>(o, vb0, pa0, pa1, pa2, pa3, AT_ACT(NT - 1));
    if (hi == 0) li_l[r32] = l_reg; asm volatile("s_waitcnt lgkmcnt(0)" ::: "memory");
    float rli[16];
#pragma unroll
    for (int r = 0; r < 16; ++r) rli[r] = __builtin_amdgcn_rcpf(li_l[crow(r, hi)]);
    unsigned lofs = (unsigned)((wid * 32 + 4 * hi) * 1024 + r32);
    asm volatile("" : "+v"(lofs));
    lofs *= 2u;
#pragma unroll
    for (int r = 0; r < 16; ++r) { const int orow = (r & 3) + 8 * (r >> 2);
#pragma unroll
        for (int d0 = 0; d0 < 4; ++d0) { const float v = o[d0][r] * rli[r];
            const float vn = __shfl_xor(v, 1);
            if ((r32 & 1) == 0) *(unsigned*)((char*)Op + (size_t)(orow * 2048 + d0 * 64) + lofs) = cvtpk(v, vn); } }
    __syncthreads();
#undef AT_VMW
#undef AT_SLOAD
#undef AT_BL
#undef AT_SWRITE
#undef AT_RESC
#undef AT_KBASE
#undef AT_ACT
#undef AT_MASKT
#undef AT_HALF_STEP
}
}
__device__ __forceinline__ int pair_lo(int p) { return p < 3 ? 0 : (p < 5 ? 1 : 2); }
__device__ __forceinline__ int pair_hi(int p) { return p < 3 ? p + 1 : (p < 5 ? p - 1 : 3); }
constexpr int LDS_TB = LDS_MISC + 64;

__device__ __forceinline__ void p_route(const Args& a, LAS unsigned char* lds, int layer, int vcu, int G) {
    int tid = threadIdx.x; asm volatile("" : "+v"(tid));
    const int lane = tid & 63, wave = __builtin_amdgcn_readfirstlane(tid >> 6);
    unsigned char* ws = a.ws;
    LAS float* wl = (LAS float*)lds;
    {   const float* wrt = (const float*)(ws + WS_WRT) + (size_t)layer * 20480;
        for (int i = tid; i < 20480; i += NTHR) { const int k = i / 20, c = i % 20; wl[c * 1024 + k] = wrt[i]; } }
    __syncthreads();
    const float* h = a.out;
    float* tokw = (float*)(ws + WS_TOKW); int* list = (int*)(ws + WS_LIST);
    unsigned* cnt = (unsigned*)(ws + WS_CTL) + CW_CNT + layer * 24 * 16;
    const int gw = vcu * NWAVES + wave, NGW = G * NWAVES;
    for (int ch = gw; ch < NT / 16; ch += NGW) {
        int mybucket = 0;
#pragma unroll 1
        for (int j = 0; j < 16; ++j) {
            const int t = ch * 16 + j;
            const f32x4* hr = (const f32x4*)(h + (size_t)t * 1024) + lane;
            f32x4 hv[4]; float ss = 0.f;
#pragma unroll
            for (int q = 0; q < 4; ++q) { hv[q] = hr[64 * q]; ss += dot4(hv[q]); }
            LAS float* sl = (LAS float*)(lds + 81920) + wave * 32;
#pragma unroll 1
            for (int c = 0; c < 20; ++c) { float s = 0.f;
#pragma unroll
                for (int q = 0; q < 4; ++q) { const f32x4 w = *(const LAS f32x4*)(wl + c * 1024 + 256 * q + 4 * lane); s += (hv[q][0] * w[0] + hv[q][1] * w[1]) + (hv[q][2] * w[2] + hv[q][3] * w[3]); }
                s = wave_sum(s);
                if (lane == 0) sl[c] = s; }
            ss = wave_sum(ss);
            asm volatile("s_waitcnt lgkmcnt(0)" ::: "memory");
            float lg[20];
#pragma unroll
            for (int c = 0; c < 20; ++c) lg[c] = sl[c];
            asm volatile("s_waitcnt lgkmcnt(0)" ::: "memory");
            const float rs = rsqrtf(ss * (1.0f / 1024.0f) + EPS);
#pragma unroll
            for (int c = 0; c < 20; ++c) lg[c] *= rs;
            int gs = 0; float gm = lg[0];
#pragma unroll
            for (int i = 1; i < 4; ++i) if (lg[i] > gm) { gm = lg[i]; gs = i; }
            float den = 0.f;
#pragma unroll
            for (int i = 0; i < 4; ++i) den += __expf(lg[i] - gm);
            const float gwt = 1.0f / den;
            float ein[4];
#pragma unroll
            for (int i = 0; i < 4; ++i) ein[i] = gs == 0 ? lg[4 + i] : (gs == 1 ? lg[8 + i] : (gs == 2 ? lg[12 + i] : lg[16 + i]));
            int i1 = 0; float e1 = ein[0];
#pragma unroll
            for (int i = 1; i < 4; ++i) if (ein[i] > e1) { e1 = ein[i]; i1 = i; }
            int i2 = -1; float e2 = 0.f;
#pragma unroll
            for (int i = 0; i < 4; ++i) if (i != i1 && (i2 < 0 || ein[i] > e2)) { e2 = ein[i]; i2 = i; }
            const float x2 = __expf(e2 - e1), w1 = gwt / (1.0f + x2), w2 = gwt * x2 / (1.0f + x2);
            const int lo = i1 < i2 ? i1 : i2, hi = i1 < i2 ? i2 : i1;
            const int pidx = lo == 0 ? hi - 1 : (lo == 1 ? hi + 1 : 5);
            const int bucket = gs * 6 + pidx;
            if (lane == 0) { tokw[(size_t)t * 2] = (i1 == lo) ? w1 : w2; tokw[(size_t)t * 2 + 1] = (i1 == lo) ? w2 : w1; }
            mybucket = (lane == j) ? bucket : mybucket;
        }
        if (lane < 16) { const unsigned pos = __hip_atomic_fetch_add(cnt + mybucket * 16, 1u, __ATOMIC_RELAXED, __HIP_MEMORY_SCOPE_AGENT); list[(size_t)mybucket * NT + pos] = ch * 16 + lane; }
    }
    {   const float* p = a.in[1] + (size_t)layer * NT * 256; bf16_t* pb = (bf16_t*)(ws + WS_PB);
        const int gt = vcu * NTHR + tid, NGT = G * NTHR;
        for (int i = gt; i < NT * 256 / 8; i += NGT) { const f32x4 x0 = *(const f32x4*)(p + (size_t)i * 8), x1 = *(const f32x4*)(p + (size_t)i * 8 + 4); *(u32x4*)(pb + (size_t)i * 8) = pack8(x0, x1); } }
    __syncthreads();
}

__device__ __forceinline__ int moe_prefix(const Args& a, LAS unsigned char* lds, int layer) {
    LAS int* tb = (LAS int*)(lds + LDS_TB);
    if (threadIdx.x == 0) { const unsigned* cnt = (const unsigned*)(a.ws + WS_CTL) + CW_CNT + layer * 24 * 16; int s = 0;
        for (int b = 0; b < 24; ++b) { tb[b] = s; s += (int)((__hip_atomic_load(cnt + b * 16, __ATOMIC_RELAXED, __HIP_MEMORY_SCOPE_AGENT) + 255u) >> 8); }
        tb[24] = s; }
    __syncthreads();
    return __builtin_amdgcn_readfirstlane(tb[24]);
}
struct MoeUnits {
    LAS const int* tb; int NRT, G, c;
    __device__ __forceinline__ bool next(int i, Unit& u) const {
        const int L = i * G + c, rt = L >> 2; if (rt >= NRT) return false;
        int b = 0;
        for (int q = 1; q < 24; ++q) b = (tb[q] <= rt) ? q : b;
        u.pm = rt; u.pn = L & 3; u.aux = __builtin_amdgcn_readfirstlane(b); return true;
    }
};
struct MoeGuP {
    const char* A; const char* W; const int* list; const unsigned* cnt; MoeUnits U; int ldb, K;
    __device__ __forceinline__ bool next(int i, Unit& u) const { return U.next(i, u); }
    __device__ __forceinline__ void aoff(const Unit& u, const int (&R)[2], const int (&C)[2], g8::AOff& o) const {
        const int n = (int)cnt[u.aux * 16], p0 = (u.pm - __builtin_amdgcn_readfirstlane(U.tb[u.aux])) * 256;
#pragma unroll
        for (int h = 0; h < 2; ++h)
#pragma unroll
            for (int i = 0; i < 2; ++i) { int pos = p0 + h * 128 + R[i]; pos = pos < n ? pos : n - 1; const int tok = list[(size_t)u.aux * NT + pos]; o.o[h][i] = (unsigned)((tok * 1024 + C[i]) * 2); }
    }
    __device__ __forceinline__ const char* bbase(const Unit& u, int kt) const {
        const int g = u.aux / 6, pi = u.aux % 6, e = g * 4 + ((u.pn < 2) ? pair_lo(pi) : pair_hi(pi));
        return W + ((size_t)(e * 512 + (u.pn & 1) * 256) * 1024 + (size_t)kt * 64) * 2;
    }
};
struct MoeDownP {
    const char* A; const char* W; MoeUnits U; int ldb, K;
    __device__ __forceinline__ bool next(int i, Unit& u) const { return U.next(i, u); }
    __device__ __forceinline__ void aoff(const Unit& u, const int (&R)[2], const int (&C)[2], g8::AOff& o) const {
#pragma unroll
        for (int h = 0; h < 2; ++h)
#pragma unroll
            for (int i = 0; i < 2; ++i) o.o[h][i] = (unsigned)(((u.pm * 256 + h * 128 + R[i]) * 512 + C[i]) * 2);
    }
    __device__ __forceinline__ const char* bbase(const Unit& u, int kt) const {
        const int g = u.aux / 6, pi = u.aux % 6, e = g * 4 + ((kt < 4) ? pair_lo(pi) : pair_hi(pi));
        return W + ((size_t)(e * 1024 + u.pn * 256) * 256 + (size_t)(kt & 3) * 64) * 2;
    }
};
__device__ __forceinline__ float sigmoidf_fast(float x) { return __builtin_amdgcn_rcpf(1.0f + __builtin_amdgcn_exp2f(-1.4426950408889634f * x)); }

struct EpiGateUp {
    const float* hp; const float* tokw; const int* list; const unsigned* cnt; LAS const int* tb; bf16_t* act;
    __device__ __forceinline__ void operator()(const f32x4 (&acc)[2][2][4][2], const Unit& u, int wr, int wc, int fr, int fq) const {
        const int n = (int)cnt[u.aux * 16], p0 = (u.pm - __builtin_amdgcn_readfirstlane(tb[u.aux])) * 256, half = u.pn >> 1;
#pragma unroll
        for (int ai = 0; ai < 2; ++ai)
#pragma unroll
            for (int m = 0; m < 4; ++m) {
                const int r = 128 * ai + 64 * wr + 16 * m + fr; int pos = p0 + r; pos = pos < n ? pos : n - 1;
                const int tok = list[(size_t)u.aux * NT + pos];
                const float rs = row_rs<16>(hp + (size_t)tok * 16, 1.0f / 1024.0f), w = tokw[(size_t)tok * 2 + half];
                f32x4 o[2];
#pragma unroll
                for (int nn = 0; nn < 2; ++nn)
#pragma unroll
                    for (int e = 0; e < 4; ++e) { const float g = acc[ai][0][m][nn][e] * rs, up = acc[ai][1][m][nn][e] * rs; o[nn][e] = g * sigmoidf_fast(g) * up * w; }
                *(u32x4*)(act + (size_t)(u.pm * 256 + r) * 512 + half * 256 + (u.pn & 1) * 128 + 32 * wc + 8 * fq) = pack8(o[0], o[1]);
            }
    }
};
struct EpiDown {
    float* h; bf16_t* hb; float* hp; const int* list; const unsigned* cnt; LAS const int* tb;
    __device__ __forceinline__ void operator()(const f32x4 (&acc)[2][2][4][2], const Unit& u, int wr, int wc, int fr, int fq) const {
        const int n = (int)cnt[u.aux * 16], p0 = (u.pm - __builtin_amdgcn_readfirstlane(tb[u.aux])) * 256;
#pragma unroll
        for (int ai = 0; ai < 2; ++ai)
#pragma unroll
            for (int m = 0; m < 4; ++m) {
                const int r = 128 * ai + 64 * wr + 16 * m + fr, pos = p0 + r; const bool valid = pos < n;
                const int tok = list[(size_t)u.aux * NT + (valid ? pos : n - 1)];
                float ss = 0.f;
#pragma unroll
                for (int bj = 0; bj < 2; ++bj) {
                    const size_t off = (size_t)tok * 1024 + u.pn * 256 + 128 * bj + 32 * wc + 8 * fq;
                    const f32x4 v0 = acc[ai][bj][m][0] + *(const f32x4*)(h + off), v1 = acc[ai][bj][m][1] + *(const f32x4*)(h + off + 4);
                    if (valid) { *(f32x4*)(h + off) = v0; *(f32x4*)(h + off + 4) = v1; *(u32x4*)(hb + off) = pack8(v0, v1); }
                    ss += dot4(v0) + dot4(v1);
                }
                ss += __shfl_xor(ss, 16); ss += __shfl_xor(ss, 32);
                if (fq == 0 && valid) hp[(size_t)tok * 16 + u.pn * 4 + wc] = ss;
                asm volatile("" ::: "memory");
            }
    }
};
struct EpiStore {
    bf16_t* O; int ldc;
    __device__ __forceinline__ void operator()(const f32x4 (&acc)[2][2][4][2], const Unit& u, int wr, int wc, int fr, int fq) const {
#pragma unroll
        for (int ai = 0; ai < 2; ++ai)
#pragma unroll
            for (int m = 0; m < 4; ++m) { const int row = u.pm * 256 + 128 * ai + 64 * wr + 16 * m + fr;
#pragma unroll
                for (int bj = 0; bj < 2; ++bj) *(u32x4*)(O + (size_t)row * ldc + u.pn * 256 + 128 * bj + 32 * wc + 8 * fq) = pack8(acc[ai][bj][m][0], acc[ai][bj][m][1]); }
    }
};
struct EpiPle {
    const float* hpin; const bf16_t* pp; float* h; bf16_t* hb2; float* hp;
    __device__ __forceinline__ void operator()(const f32x4 (&acc)[2][2][4][2], const Unit& u, int wr, int wc, int fr, int fq) const {
#pragma unroll
        for (int ai = 0; ai < 2; ++ai)
#pragma unroll
            for (int m = 0; m < 4; ++m) {
                const int row = u.pm * 256 + 128 * ai + 64 * wr + 16 * m + fr;
                const float rs = row_rs<16>(hpin + (size_t)row * 16, 1.0f / 1024.0f);
                float ss = 0.f;
#pragma unroll
                for (int bj = 0; bj < 2; ++bj) {
                    const size_t off = (size_t)row * 1024 + u.pn * 256 + 128 * bj + 32 * wc + 8 * fq;
                    const u32x4 pw = *(const u32x4*)(pp + off);
                    f32x4 v0 = *(const f32x4*)(h + off), v1 = *(const f32x4*)(h + off + 4);
#pragma unroll
                    for (int e = 0; e < 2; ++e) {
                        v0[2 * e] += sigmoidf_fast(acc[ai][bj][m][0][2 * e] * rs) * __builtin_bit_cast(float, pw[e] << 16);
                        v0[2 * e + 1] += sigmoidf_fast(acc[ai][bj][m][0][2 * e + 1] * rs) * __builtin_bit_cast(float, pw[e] & 0xffff0000u);
                        v1[2 * e] += sigmoidf_fast(acc[ai][bj][m][1][2 * e] * rs) * __builtin_bit_cast(float, pw[2 + e] << 16);
                        v1[2 * e + 1] += sigmoidf_fast(acc[ai][bj][m][1][2 * e + 1] * rs) * __builtin_bit_cast(float, pw[2 + e] & 0xffff0000u);
                    }
                    *(f32x4*)(h + off) = v0; *(f32x4*)(h + off + 4) = v1; *(u32x4*)(hb2 + off) = pack8(v0, v1);
                    ss += dot4(v0) + dot4(v1);
                }
                ss += __shfl_xor(ss, 16); ss += __shfl_xor(ss, 32);
                if (fq == 0) hp[(size_t)row * 16 + u.pn * 4 + wc] = ss;
                asm volatile("" ::: "memory");
            }
    }
};
__device__ __forceinline__ u32x2 pack4(f32x4 a) { u32x2 w = {cvtpk(a[0], a[1]), cvtpk(a[2], a[3])}; return w; }
struct EpiDqkv {
    const float* hp; const float* cosB; const float* sinB; bf16_t* cq; bf16_t* ckv; bf16_t* krope; float* cqp; float* kvp;
    __device__ __forceinline__ void operator()(const f32x4 (&acc)[2][2][4][2], const Unit& u, int wr, int wc, int fr, int fq) const {
#pragma unroll
        for (int ai = 0; ai < 2; ++ai)
#pragma unroll
            for (int m = 0; m < 4; ++m) {
                const int row = u.pm * 256 + 128 * ai + 64 * wr + 16 * m + fr, s = row & (NS - 1);
                const float rs = row_rs<16>(hp + (size_t)row * 16, 1.0f / 1024.0f);
                if (u.pn < 2) {
                    float ss = 0.f;
#pragma unroll
                    for (int bj = 0; bj < 2; ++bj) { const f32x4 v0 = acc[ai][bj][m][0] * rs, v1 = acc[ai][bj][m][1] * rs; ss += dot4(v0) + dot4(v1);
                        const int c = 128 * bj + 32 * wc + 8 * fq;
                        if (u.pn == 0) *(u32x4*)(cq + (size_t)row * 384 + c) = pack8(v0, v1); else *(u32x4*)(ckv + (size_t)row * 256 + c) = pack8(v0, v1); }
                    ss += __shfl_xor(ss, 16); ss += __shfl_xor(ss, 32);
                    if (fq == 0) { if (u.pn == 0) cqp[(size_t)row * 8 + wc] = ss; else kvp[(size_t)row * 4 + wc] = ss; }
                } else {
                    const f32x4 v0 = acc[ai][0][m][0] * rs, v1 = acc[ai][0][m][1] * rs;
                    float ss = dot4(v0) + dot4(v1);
                    *(u32x4*)(cq + (size_t)row * 384 + 256 + 32 * wc + 8 * fq) = pack8(v0, v1);
                    ss += __shfl_xor(ss, 16); ss += __shfl_xor(ss, 32);
                    if (fq == 0) cqp[(size_t)row * 8 + 4 + wc] = ss;
                    if (wc < 2) {
                        const int j = 16 * wc + 4 * fq;
                        const f32x4 cs = *(const f32x4*)(cosB + (size_t)s * 32 + j), sn = *(const f32x4*)(sinB + (size_t)s * 32 + j);
                        const f32x4 x1 = acc[ai][1][m][0] * rs, x2 = acc[ai][1][m][1] * rs;
                        *(u32x2*)(krope + (size_t)row * 64 + j) = pack4(x1 * cs - x2 * sn);
                        *(u32x2*)(krope + (size_t)row * 64 + 32 + j) = pack4(x1 * sn + x2 * cs);
                    }
                }
            }
    }
};
struct EpiUq {
    const float* cqp; const float* cosB; const float* sinB; bf16_t* q;
    __device__ __forceinline__ void operator()(const f32x4 (&acc)[2][2][4][2], const Unit& u, int wr, int wc, int fr, int fq) const {
        const int bb = u.pm >> 5;
#pragma unroll
        for (int ai = 0; ai < 2; ++ai)
#pragma unroll
            for (int m = 0; m < 4; ++m) {
                const int row = u.pm * 256 + 128 * ai + 64 * wr + 16 * m + fr, s = row & (NS - 1);
                const float rs = row_rs<8>(cqp + (size_t)row * 8, 1.0f / 384.0f);
#pragma unroll
                for (int bj = 0; bj < 2; ++bj) {
                    if (u.pn < 4) {
                        const int hh = 2 * u.pn + bj;
                        *(u32x4*)(q + ((size_t)(bb * NH + hh) * NS + s) * 192 + 32 * wc + 8 * fq) = pack8(acc[ai][bj][m][0] * rs, acc[ai][bj][m][1] * rs);
                    } else {
                        const int gidx = bj * 4 + wc, hh = 4 * (u.pn - 4) + (gidx >> 1), j = 16 * (gidx & 1) + 4 * fq;
                        const f32x4 cs = *(const f32x4*)(cosB + (size_t)s * 32 + j), sn = *(const f32x4*)(sinB + (size_t)s * 32 + j);
                        const f32x4 x1 = acc[ai][bj][m][0] * rs, x2 = acc[ai][bj][m][1] * rs;
                        bf16_t* d = q + ((size_t)(bb * NH + hh) * NS + s) * 192 + 128 + j;
                        *(u32x2*)d = pack4(x1 * cs - x2 * sn); *(u32x2*)(d + 32) = pack4(x1 * sn + x2 * cs);
                    }
                }
            }
    }
};
struct EpiUkv {
    const float* kvp; bf16_t* kn; bf16_t* v;
    __device__ __forceinline__ void operator()(const f32x4 (&acc)[2][2][4][2], const Unit& u, int wr, int wc, int fr, int fq) const {
        const int bb = u.pm >> 5;
#pragma unroll
        for (int ai = 0; ai < 2; ++ai)
#pragma unroll
            for (int m = 0; m < 4; ++m) {
                const int row = u.pm * 256 + 128 * ai + 64 * wr + 16 * m + fr, s = row & (NS - 1);
                const float rs = row_rs<4>(kvp + (size_t)row * 4, 1.0f / 256.0f);
                const size_t o = ((size_t)(bb * NH + u.pn) * NS + s) * 128 + 32 * wc + 8 * fq;
                *(u32x4*)(kn + o) = pack8(acc[ai][0][m][0] * rs, acc[ai][0][m][1] * rs);
                *(u32x4*)(v + o) = pack8(acc[ai][1][m][0] * rs, acc[ai][1][m][1] * rs);
            }
    }
};

struct WConv { const float* src0; const float* src1; const float* gain; bf16_t* dst; int N0, N1, K, Nout, kind; };
__device__ __forceinline__ int colmap(int kind, int n) {
    switch (kind) {
    case 1: {
        const int pn = n >> 8; if (pn >= 8) return n;
        const int t = pn >> 2, bj = (n >> 7) & 1, r = n & 127, hh = 2 * (pn & 3) + (r >> 6), d = 64 * bj + (r & 63);
        return t * 1024 + hh * 128 + d; }
    case 2: {
        if (n < 256) return n;
        if (n < 512) return 384 + (n - 256);
        if (n < 640) return 256 + (n - 512);
        const int r = n - 640, wc = r >> 5, fq = (r >> 3) & 3, nn = (r >> 2) & 1, i = r & 3;
        if (wc >= 2) return -1;
        return 384 + 256 + 32 * nn + 16 * wc + 4 * fq + i; }
    case 3: {
        if (n < 1024) return (n >> 7) * 192 + (n & 127);
        const int m = n - 1024, pn4 = m >> 8, gidx = (m >> 5) & 7, fq = (m >> 3) & 3, nn = (m >> 2) & 1, i = m & 3;
        const int hh = 4 * pn4 + (gidx >> 1), j = 16 * (gidx & 1) + 4 * fq + i;
        return hh * 192 + 128 + 32 * nn + j; }
    case 4: {
        const int q = n >> 8, bj = (n >> 7) & 1, r = n & 127;
        return bj * 256 + 128 * q + r; }
    default: return n;
    }
}
__device__ __forceinline__ void conv_item(const WConv& w, LAS float* scr, int item, int lane) {
    const int nblk = w.Nout / 32, kb = item / nblk, nb = item % nblk, k0 = 64 * kb, n0 = 32 * nb;
    const int s = colmap(w.kind, n0 + (lane & 31));
    const bool z = s < 0, first = s < w.N0;
    const float* sp = first ? w.src0 + s : w.src1 + (s - w.N0);
    const int ld = first ? w.N0 : w.N1;
#pragma unroll 8
    for (int i = 0; i < 32; ++i) { const int kk = 2 * i + (lane >> 5);
        float v = 0.f; if (!z) { v = sp[(size_t)(k0 + kk) * ld]; if (w.gain) v *= w.gain[k0 + kk]; }
        scr[kk * 33 + (lane & 31)] = v; }
    asm volatile("s_waitcnt lgkmcnt(0)" ::: "memory");
    const int c = lane & 7;
#pragma unroll
    for (int j = 0; j < 4; ++j) { const int n = (lane >> 3) + 8 * j; const LAS float* sv = scr + (8 * c) * 33 + n;
        u32x4 o; o.x = cvtpk(sv[0 * 33], sv[1 * 33]); o.y = cvtpk(sv[2 * 33], sv[3 * 33]); o.z = cvtpk(sv[4 * 33], sv[5 * 33]); o.w = cvtpk(sv[6 * 33], sv[7 * 33]);
        *(u32x4*)(w.dst + (size_t)(n0 + n) * w.K + k0 + 8 * c) = o; }
    asm volatile("s_waitcnt lgkmcnt(0)" ::: "memory");
}
__device__ __forceinline__ bool get_conv(int mi, const Args& a, WConv& w) {
    unsigned char* ws = a.ws;
    w.src1 = nullptr; w.N1 = 0; w.gain = nullptr; w.kind = 0;
    if (mi == 0) { w.src0 = a.in[6]; w.N0 = 3072; w.K = 1024; w.Nout = 3072; w.kind = 1; w.gain = a.in[2]; w.dst = (bf16_t*)(ws + WS_WQKV0); return true; }
    if (mi == 1) { w.src0 = a.in[7]; w.N0 = 1024; w.K = 1024; w.Nout = 1024; w.dst = (bf16_t*)(ws + WS_WO0); return true; }
    if (mi == 2) { w.src0 = a.in[8]; w.N0 = 384; w.src1 = a.in[11]; w.N1 = 320; w.K = 1024; w.Nout = 768; w.kind = 2; w.gain = a.in[2] + 1024; w.dst = (bf16_t*)(ws + WS_WDQKV); return true; }
    if (mi == 3) { w.src0 = a.in[10]; w.N0 = 1536; w.K = 384; w.Nout = 1536; w.kind = 3; w.gain = a.in[9]; w.dst = (bf16_t*)(ws + WS_WUQ); return true; }
    if (mi == 4) { w.src0 = a.in[13]; w.N0 = 2048; w.K = 256; w.Nout = 2048; w.gain = a.in[12]; w.dst = (bf16_t*)(ws + WS_WUKV); return true; }
    if (mi == 5) { w.src0 = a.in[14]; w.N0 = 1024; w.K = 1024; w.Nout = 1024; w.dst = (bf16_t*)(ws + WS_WO1); return true; }
    if (mi < 38) { const int le = mi - 6, l = le >> 4;
        w.src0 = a.in[17] + (size_t)le * 1024 * 256; w.N0 = 256; w.src1 = a.in[18] + (size_t)le * 1024 * 256; w.N1 = 256; w.K = 1024; w.Nout = 512; w.kind = 4;
        w.gain = a.in[3] + l * 1024; w.dst = (bf16_t*)(ws + WS_WGU) + (size_t)le * 512 * 1024; return true; }
    if (mi < 70) { const int le = mi - 38;
        w.src0 = a.in[19] + (size_t)le * 256 * 1024; w.N0 = 1024; w.K = 256; w.Nout = 1024; w.dst = (bf16_t*)(ws + WS_WD) + (size_t)le * 1024 * 256; return true; }
    if (mi < 72) { const int l = mi - 70;
        w.src0 = a.in[20] + (size_t)l * 1024 * 1024; w.N0 = 1024; w.K = 1024; w.Nout = 1024; w.gain = a.in[4] + l * 1024; w.dst = (bf16_t*)(ws + WS_WPG) + (size_t)l * 1024 * 1024; return true; }
    if (mi < 74) { const int l = mi - 72;
        w.src0 = a.in[21] + (size_t)l * 256 * 1024; w.N0 = 1024; w.K = 256; w.Nout = 1024; w.dst = (bf16_t*)(ws + WS_WPP) + (size_t)l * 1024 * 256; return true; }
    return false;
}

__device__ __forceinline__ void p_prologue(const Args& a, LAS unsigned char* lds, int vcu, int G) {
    int tid = threadIdx.x; asm volatile("" : "+v"(tid));
    const int lane = tid & 63, wave = __builtin_amdgcn_readfirstlane(tid >> 6);
    const int gw = vcu * NWAVES + wave, NGW = G * NWAVES;
    unsigned char* ws = a.ws;
    LAS float* scr = (LAS float*)(lds + wave * 16384);
    int base = 0;
    for (int mi = 0; mi < 74; ++mi) {
        WConv w; get_conv(mi, a, w);
        const int n = (w.K / 64) * (w.Nout / 32);
        int it = (gw - (base % NGW) + NGW) % NGW;
        for (; it < n; it += NGW) conv_item(w, scr, it, lane);
        base += n;
    }
    {   const float* x = a.in[0]; bf16_t* hb = (bf16_t*)(ws + WS_HB); float* hpx = (float*)(ws + WS_HPX);
        for (int m = gw; m < NT; m += NGW) {
            const f32x4* xr = (const f32x4*)(x + (size_t)m * 1024) + lane;
            f32x4 v[4]; float s = 0.f;
#pragma unroll
            for (int j = 0; j < 4; ++j) { v[j] = xr[64 * j]; s += dot4(v[j]); }
            s = wave_sum(s);
            u32x2* o8 = (u32x2*)(hb + (size_t)m * 1024) + lane;
#pragma unroll
            for (int j = 0; j < 4; ++j) { u32x2 o; o.x = cvtpk(v[j][0], v[j][1]); o.y = cvtpk(v[j][2], v[j][3]); o8[64 * j] = o; }
            if (lane < 16) hpx[(size_t)m * 16 + lane] = (lane == 0) ? s : 0.f;
        } }
    {   const int gt = (vcu * NTHR) + tid, NGT = G * NTHR;
        float* cosA = (float*)(ws + WS_COSA); float* sinA = (float*)(ws + WS_SINA); float* cosB = (float*)(ws + WS_COSB); float* sinB = (float*)(ws + WS_SINB);
        for (int i = gt; i < NS * 64; i += NGT) { const int s = i >> 6, j = i & 63; const float inv = powf(10000.0f, -(float)j / 64.0f); float sn, cs; sincosf((float)s * inv, &sn, &cs); cosA[i] = cs; sinA[i] = sn; }
        for (int i = gt; i < NS * 32; i += NGT) { const int s = i >> 5, j = i & 31; const float inv = powf(10000.0f, -(float)j / 32.0f); float sn, cs; sincosf((float)s * inv, &sn, &cs); cosB[i] = cs; sinB[i] = sn; }
        float* km = (float*)(ws + WS_KMEAN);
        for (int i = gt; i < NB * NH * 32 * 128; i += NGT) km[i] = 0.f;
        float* wrt = (float*)(ws + WS_WRT);
        for (int i = gt; i < 2 * 1024 * 20; i += NGT) { const int l = i / 20480, r = i % 20480, k = r / 20, c = r % 20;
            const float g = a.in[3][l * 1024 + k];
            wrt[i] = g * (c < 4 ? a.in[15][(size_t)(l * 1024 + k) * 4 + c] : a.in[16][(size_t)(l * 1024 + k) * 16 + (c - 4)]); }
    }
}

template <int DQK, int MODE>
__device__ __forceinline__ void p_attention(const Args& a, unsigned char* ldsg) {
    unsigned char* ws = a.ws;
    for (int L = blockIdx.x; L < 512; L += gridDim.x) {
        const int xcd = L & 7, k = L >> 3, bh = xcd + 8 * (k >> 4), x = k & 15, b = bh >> 3, h = bh & 7;
        for (int pass = 0; pass < 2; ++pass) {
            const int qb = pass ? x : 31 - x, P0 = qb * 256;
            bf16_t* Op = (bf16_t*)(ws + WS_O) + ((size_t)(b * NS + P0) * 1024 + h * 128);
            if (MODE == 1) {
                const bf16_t* Q = (const bf16_t*)(ws + WS_Q) + (size_t)bh * NS * 128;
                const bf16_t* Kp = (const bf16_t*)(ws + WS_K0) + (size_t)bh * NS * 128;
                const bf16_t* Vp = (const bf16_t*)(ws + WS_V0) + (size_t)bh * NS * 128;
                at::attn_unit<DQK, MODE>((char*)ldsg, Q + (size_t)P0 * 128, Kp, nullptr, Vp, Op, P0, (const float*)(ws + WS_KMEAN) + (size_t)bh * 32 * 128);
            } else {
                const bf16_t* Q = (const bf16_t*)(ws + WS_Q) + (size_t)bh * NS * 192;
                const bf16_t* Kp = (const bf16_t*)(ws + WS_KN1) + (size_t)bh * NS * 128;
                const bf16_t* Kr = (const bf16_t*)(ws + WS_KROPE) + (size_t)b * NS * 64;
                const bf16_t* Vp = (const bf16_t*)(ws + WS_V1) + (size_t)bh * NS * 128;
                at::attn_unit<DQK, MODE>((char*)ldsg, Q + (size_t)P0 * 192, Kp, Kr, Vp, Op, P0, nullptr);
            }
        }
    }
}

__global__ void __launch_bounds__(NTHR, 2) mega(Args a) {
    extern __shared__ __attribute__((aligned(16))) unsigned char lds_g[];
    LAS unsigned char* lds = (LAS unsigned char*)lds_g;
    const int tid = threadIdx.x;
    const int G = gridDim.x, bx = blockIdx.x, vcu = (G % 8 == 0) ? (bx % 8) * (G / 8) + bx / 8 : bx;
    unsigned char* ws = a.ws;
    volatile LAS unsigned* MISC = (volatile LAS unsigned*)(lds + LDS_MISC);
    for (int u = tid; u < 256; u += NTHR) MISC[u] = 0u;
    __syncthreads();
    XcdBarrier bar = xcd_barrier_post((unsigned*)(ws + WS_CTL) + CW_BAR, MISC);
    const int lo = a.ph_lo, hi = a.ph_hi;
#ifndef DBG_ONLY
#define DBG_EN(k) true
#else
#define DBG_EN(k) ((k) == DBG_ONLY)
#endif
#define IN(k) (DBG_EN(k) && lo <= (k) && (k) < hi)
#define SEAM(k) do { if (IN(k) && IN((k) + 1)) xcd_barrier(bar); } while (0)
    if (IN(0)) { p_prologue(a, lds, vcu, G); }
    SEAM(0);
    if (IN(1)) {
        g8::DenseP P{(const char*)(ws + WS_HB), (const char*)(ws + WS_WQKV0), 1024, 1024, 1024, NT / 256, 3072 / 256, G, bx};
        EpiQKV E{(const float*)(ws + WS_HPX), (const float*)(ws + WS_COSA), (const float*)(ws + WS_SINA), (bf16_t*)(ws + WS_Q), (bf16_t*)(ws + WS_K0), (bf16_t*)(ws + WS_V0), (float*)(ws + WS_KMEAN)};
        g8::gemm_phase(lds, P, E);
    }
    SEAM(1);
    if (IN(2)) { p_attention<128, 1>(a, lds_g); }
    SEAM(2);
    if (IN(3)) {
        g8::DenseP P{(const char*)(ws + WS_O), (const char*)(ws + WS_WO0), 1024, 1024, 1024, NT / 256, 4, G, bx};
        EpiResid E{a.in[0], a.out, (bf16_t*)(ws + WS_HB), (float*)(ws + WS_HP0)};
        g8::gemm_phase(lds, P, E);
    }
    SEAM(3);
#define MOE_PLE(PB, layer) \
    if (IN((PB) + 0)) { p_route(a, lds, (layer), vcu, G); } \
    SEAM((PB) + 0); \
    if (IN((PB) + 1)) { \
        const int NRT = moe_prefix(a, lds, (layer)); \
        const unsigned* cnt = (const unsigned*)(ws + WS_CTL) + CW_CNT + (layer) * 24 * 16; \
        MoeUnits U{(LAS const int*)(lds + LDS_TB), NRT, G, bx}; \
        MoeGuP P{(const char*)(ws + WS_HB), (const char*)(ws + WS_WGU) + (size_t)(layer) * 16 * 512 * 1024 * 2, (const int*)(ws + WS_LIST), cnt, U, 1024, 1024}; \
        EpiGateUp E{(const float*)(ws + WS_HP0), (const float*)(ws + WS_TOKW), (const int*)(ws + WS_LIST), cnt, (LAS const int*)(lds + LDS_TB), (bf16_t*)(ws + WS_ACT)}; \
        g8::gemm_phase(lds, P, E); \
        g8::DenseP P2{(const char*)(ws + WS_PB), (const char*)(ws + WS_WPP) + (size_t)(layer) * 1024 * 256 * 2, 256, 256, 256, NT / 256, 4, G, bx}; \
        EpiStore E2{(bf16_t*)(ws + WS_PP), 1024}; \
        g8::gemm_phase(lds, P2, E2); \
    } \
    SEAM((PB) + 1); \
    if (IN((PB) + 2)) { \
        const int NRT = moe_prefix(a, lds, (layer)); \
        const unsigned* cnt = (const unsigned*)(ws + WS_CTL) + CW_CNT + (layer) * 24 * 16; \
        MoeUnits U{(LAS const int*)(lds + LDS_TB), NRT, G, bx}; \
        MoeDownP P{(const char*)(ws + WS_ACT), (const char*)(ws + WS_WD) + (size_t)(layer) * 16 * 1024 * 256 * 2, U, 256, 512}; \
        EpiDown E{a.out, (bf16_t*)(ws + WS_HB), (float*)(ws + WS_HP1), (const int*)(ws + WS_LIST), cnt, (LAS const int*)(lds + LDS_TB)}; \
        g8::gemm_phase(lds, P, E); \
    } \
    SEAM((PB) + 2); \
    if (IN((PB) + 3)) { \
        g8::DenseP P{(const char*)(ws + WS_HB), (const char*)(ws + WS_WPG) + (size_t)(layer) * 1024 * 1024 * 2, 1024, 1024, 1024, NT / 256, 4, G, bx}; \
        EpiPle E{(const float*)(ws + WS_HP1), (const bf16_t*)(ws + WS_PP), a.out, (bf16_t*)(ws + WS_O), (float*)(ws + WS_HP2)}; \
        g8::gemm_phase(lds, P, E); \
    } \
    SEAM((PB) + 3);
    MOE_PLE(4, 0)
    if (IN(8)) {
        g8::DenseP P{(const char*)(ws + WS_O), (const char*)(ws + WS_WDQKV), 1024, 1024, 1024, NT / 256, 3, G, bx};
        EpiDqkv E{(const float*)(ws + WS_HP2), (const float*)(ws + WS_COSB), (const float*)(ws + WS_SINB), (bf16_t*)(ws + WS_CQ), (bf16_t*)(ws + WS_CKV), (bf16_t*)(ws + WS_KROPE), (float*)(ws + WS_CQP), (float*)(ws + WS_KVP)};
        g8::gemm_phase(lds, P, E);
    }
    SEAM(8);
    if (IN(9)) {
        g8::DenseP P{(const char*)(ws + WS_CQ), (const char*)(ws + WS_WUQ), 384, 384, 384, NT / 256, 6, G, bx};
        EpiUq E{(const float*)(ws + WS_CQP), (const float*)(ws + WS_COSB), (const float*)(ws + WS_SINB), (bf16_t*)(ws + WS_Q)};
        g8::gemm_phase(lds, P, E);
        g8::DenseP P2{(const char*)(ws + WS_CKV), (const char*)(ws + WS_WUKV), 256, 256, 256, NT / 256, 8, G, bx};
        EpiUkv E2{(const float*)(ws + WS_KVP), (bf16_t*)(ws + WS_KN1), (bf16_t*)(ws + WS_V1)};
        g8::gemm_phase(lds, P2, E2);
    }
    SEAM(9);
    if (IN(10)) { p_attention<192, 0>(a, lds_g); }
    SEAM(10);
    if (IN(11)) {
        g8::DenseP P{(const char*)(ws + WS_O), (const char*)(ws + WS_WO1), 1024, 1024, 1024, NT / 256, 4, G, bx};
        EpiResid E{a.out, a.out, (bf16_t*)(ws + WS_HB), (float*)(ws + WS_HP0)};
        g8::gemm_phase(lds, P, E);
    }
    SEAM(11);
    MOE_PLE(12, 1)
    if (IN(16)) {
        int t2 = threadIdx.x; asm volatile("" : "+v"(t2)); const int lane = t2 & 63, wave = t2 >> 6; const float* fg = a.in[5];
        for (int mrow = vcu * NWAVES + wave; mrow < NT; mrow += G * NWAVES) {
            f32x4* xr = (f32x4*)(a.out + (size_t)mrow * 1024) + lane;
            f32x4 v[4]; float s = 0.f;
#pragma unroll
            for (int j = 0; j < 4; ++j) { v[j] = xr[64 * j]; s += dot4(v[j]); }
            s = wave_sum(s);
            const float r = rsqrtf(s * (1.0f / 1024.0f) + EPS);
#pragma unroll
            for (int j = 0; j < 4; ++j) xr[64 * j] = v[j] * r * *((const f32x4*)fg + lane + 64 * j);
        }
    }
#undef IN
#undef SEAM
}

constexpr int N_PHASES = 17;
static int g_grid = 0;
static bool setup() {
    if (g_grid) return g_grid > 0;
    int dev = 0, cus = 0;
    if (hipGetDevice(&dev) != hipSuccess || hipDeviceGetAttribute(&cus, hipDeviceAttributeMultiprocessorCount, dev) != hipSuccess) { g_grid = -1; return false; }
    if (hipFuncSetAttribute((const void*)mega, hipFuncAttributeMaxDynamicSharedMemorySize, LDS_BYTES) != hipSuccess) { fprintf(stderr, "hipFuncSetAttribute failed\n"); g_grid = -1; return false; }
    int per_cu = 0;
    if (hipOccupancyMaxActiveBlocksPerMultiprocessor(&per_cu, (const void*)mega, NTHR, LDS_BYTES) != hipSuccess || per_cu < 1) { fprintf(stderr, "occupancy query: %d\n", per_cu); }
    (void)hipGetLastError();
    g_grid = cus;
    return true;
}
static void run_phases(const Args& base, int lo, int hi, bool one_launch, hipStream_t st) {
    if (one_launch) { Args a = base; a.ph_lo = lo; a.ph_hi = hi; hipLaunchKernelGGL(mega, dim3(g_grid), dim3(NTHR), LDS_BYTES, st, a); }
    else for (int p = lo; p < hi; ++p) { Args a = base; a.ph_lo = p; a.ph_hi = p + 1; hipLaunchKernelGGL(mega, dim3(g_grid), dim3(NTHR), LDS_BYTES, st, a); }
}
}
#ifndef ONE_LAUNCH
#define ONE_LAUNCH 1
#endif
extern "C" void kernel_launch(void* const* d_in, const int* in_sizes, int n_in, void* d_out, int out_size, void* d_ws, size_t ws_size, hipStream_t stream) {
    (void)in_sizes; (void)out_size;
    if (n_in != 22) { fprintf(stderr, "kernel_launch: expected 22 inputs, got %d\n", n_in); return; }
    if (ws_size < fk::WS_END) { fprintf(stderr, "kernel_launch: workspace too small (%zu)\n", ws_size); return; }
    if (!fk::setup()) return;
    (void)hipMemsetAsync((char*)d_ws + fk::WS_CTL, 0, fk::CTL_ZERO_BYTES, stream);
    fk::Args a{};
    for (int i = 0; i < 22; ++i) a.in[i] = (const float*)d_in[i];
    a.out = (float*)d_out; a.ws = (unsigned char*)d_ws;
    fk::run_phases(a, 0, fk::N_PHASES, ONE_LAUNCH != 0, stream);
}
```

```cpp
#include <hip/hip_runtime.h>
#include <cstdio>
#include <cstdint>
#include <cmath>
namespace fk {
#define LAS __attribute__((address_space(3)))
#define GAS __attribute__((address_space(1)))
typedef unsigned short bf16_t;
typedef short bf16x8 __attribute__((ext_vector_type(8)));
typedef short s16x4 __attribute__((ext_vector_type(4)));
typedef float f32x4 __attribute__((ext_vector_type(4)));
typedef float f32x16 __attribute__((ext_vector_type(16)));
typedef unsigned u32x4 __attribute__((ext_vector_type(4)));
typedef unsigned u32x2 __attribute__((ext_vector_type(2)));
typedef float f32x2_t __attribute__((ext_vector_type(2)));
typedef __bf16 bf16x2_t __attribute__((ext_vector_type(2)));

constexpr int NB = 4, NS = 8192, ND = 1024, NT = NB * NS, NH = 8;
constexpr float EPS = 1e-6f;
constexpr int NWAVES = 8, NTHR = 512;

constexpr size_t MiB = 1u << 20;
constexpr size_t WS_CTL = 0, CTL_ZERO_BYTES = 1 * MiB;
constexpr size_t WS_COSA = 1 * MiB, WS_SINA = 3 * MiB, WS_COSB = 5 * MiB, WS_SINB = 6 * MiB;
constexpr size_t WS_KMEAN = 7 * MiB;
constexpr size_t WS_WRT = 7 * MiB + 512 * 1024;
constexpr size_t WS_HPX = 8 * MiB, WS_HP0 = 10 * MiB, WS_HP1 = 12 * MiB, WS_HP2 = 14 * MiB;
constexpr size_t WS_CQP = 16 * MiB, WS_KVP = 17 * MiB;
constexpr size_t WS_TOKW = 18 * MiB;
constexpr size_t WS_LIST = 19 * MiB;
constexpr size_t WS_WQKV0 = 24 * MiB, WS_WO0 = 30 * MiB, WS_WDQKV = 32 * MiB, WS_WUQ = 34 * MiB, WS_WUKV = 36 * MiB, WS_WO1 = 37 * MiB;
constexpr size_t WS_WGU = 40 * MiB;
constexpr size_t WS_WD = 72 * MiB;
constexpr size_t WS_WPG = 88 * MiB;
constexpr size_t WS_WPP = 92 * MiB;
constexpr size_t WS_HB = 94 * MiB;
constexpr size_t WS_CQ = WS_HB, WS_CKV = WS_HB + 24 * MiB, WS_KROPE = WS_HB + 40 * MiB;
constexpr size_t WS_O = 158 * MiB;
constexpr size_t WS_R = 222 * MiB;
constexpr size_t WS_Q = WS_R, WS_K0 = WS_R + 64 * MiB, WS_V0 = WS_R + 128 * MiB;
constexpr size_t WS_KN1 = WS_R + 96 * MiB, WS_V1 = WS_R + 160 * MiB;
constexpr size_t WS_ACT = WS_R, WS_PB = WS_R + 40 * MiB, WS_PP = WS_R + 64 * MiB;
constexpr size_t WS_END = WS_R + 224 * MiB;
constexpr int CW_CNT = 1024;
constexpr int CW_BAR = 4096;

constexpr int RING_BYTES = 131072;
constexpr int LDS_MISC = RING_BYTES;
constexpr int LDS_BYTES = 147456;

struct Args { const float* in[22]; float* out; unsigned char* ws; int ph_lo, ph_hi; };

__device__ __forceinline__ unsigned cvtpk(float lo, float hi) { f32x2_t v = {lo, hi}; bf16x2_t b = __builtin_convertvector(v, bf16x2_t); return __builtin_bit_cast(unsigned, b); }
__device__ __forceinline__ float bf2f(unsigned short b) { return __builtin_bit_cast(float, (unsigned)b << 16); }
__device__ __forceinline__ u32x4 pack8(f32x4 a, f32x4 b) { u32x4 w = {cvtpk(a[0], a[1]), cvtpk(a[2], a[3]), cvtpk(b[0], b[1]), cvtpk(b[2], b[3])}; return w; }
__device__ __forceinline__ float wave_sum(float v) {
#pragma unroll
    for (int o = 1; o < 64; o <<= 1) v += __shfl_xor(v, o);
    return v;
}
__device__ __forceinline__ float dot4(f32x4 a) { return (a[0] * a[0] + a[1] * a[1]) + (a[2] * a[2] + a[3] * a[3]); }
template <int NP> __device__ __forceinline__ float row_rs(const float* hp, float invd) {
    float s = 0.f;
#pragma unroll
    for (int i = 0; i < NP / 4; ++i) { const f32x4 a = *(const f32x4*)(hp + 4 * i); s += (a[0] + a[1]) + (a[2] + a[3]); }
    return rsqrtf(s * invd + EPS);
}

#define XB_TMO      128
#define XB_XCNT(j)  (256  + 64 * (j))
#define XB_XSUB(j)  (1280 + 64 * (j))
#define XB_XGEN(j)  (2304 + 64 * (j))
#define XB_TOP      3328
#define XB_TOPGEN   3392
#define XCD_BAR_WORDS 3456
#define XB_SPIN_CAP (1u << 18)
__device__ __forceinline__ unsigned xb_ld(unsigned* p)              { return __hip_atomic_load(p, __ATOMIC_RELAXED, __HIP_MEMORY_SCOPE_AGENT); }
__device__ __forceinline__ unsigned xb_add(unsigned* p, unsigned v) { return __hip_atomic_fetch_add(p, v, __ATOMIC_RELAXED, __HIP_MEMORY_SCOPE_AGENT); }
__device__ __forceinline__ unsigned xb_xcc_id() { return (unsigned)__builtin_amdgcn_s_getreg((3 << 11) | 20) & 0xFu; }
#define XB_SPIN(cond, bar) do { unsigned _sp = 0; while (cond) { __builtin_amdgcn_s_sleep(1); \
    if ((++_sp & 255u) == 0u) { if (xb_ld(&(bar)[XB_TMO])) break; if (_sp > XB_SPIN_CAP) { atomicAdd(&(bar)[XB_TMO], 1u); break; } } } } while (0)
struct XcdBarrier { unsigned* bar; unsigned x; volatile LAS unsigned* st; };
__device__ __forceinline__ XcdBarrier xcd_barrier_post(unsigned* bar, volatile LAS unsigned* st) {
    XcdBarrier b; b.bar = bar; b.x = xb_xcc_id(); b.st = st;
    if (threadIdx.x == 0) (void)xb_add(&bar[XB_XCNT(b.x)], 1u);
    return b;
}
__device__ __forceinline__ void xcd_barrier_complete(unsigned* bar, unsigned x, unsigned& nloc, unsigned& nx) {
    const unsigned G = gridDim.x * gridDim.y * gridDim.z;
    unsigned sum, cnt, mine, sp = 0u;
    for (;;) {
        sum = 0u; cnt = 0u; mine = 0u;
#pragma unroll
        for (unsigned j = 0; j < 16; ++j) { const unsigned c = xb_ld(&bar[XB_XCNT(j)]); sum += c; cnt += (c > 0u) ? 1u : 0u; mine = (j == x) ? c : mine; }
        if (sum == G) break;
        __builtin_amdgcn_s_sleep(1);
        if ((++sp & 255u) == 0u) { if (xb_ld(&bar[XB_TMO])) break; if (sp > XB_SPIN_CAP) { atomicAdd(&bar[XB_TMO], 1u); break; } }
    }
    nloc = mine > 0u ? mine : 1u; nx = cnt > 0u ? cnt : 1u;
}
__device__ __forceinline__ void xcd_barrier(const XcdBarrier& b) {
    asm volatile("s_waitcnt vmcnt(0)" ::: "memory");
    __syncthreads();
    if (threadIdx.x == 0) {
        unsigned* bar = b.bar;
        __builtin_amdgcn_s_waitcnt(0);
        unsigned nloc = b.st[0], nx = b.st[1];
        if (nloc == 0u) { xcd_barrier_complete(bar, b.x, nloc, nx); b.st[0] = nloc; b.st[1] = nx; }
        const unsigned old = xb_add(&bar[XB_XSUB(b.x)], 1u);
        const unsigned gen = old / nloc;
        if (old + 1u == (gen + 1u) * nloc) {
            __builtin_amdgcn_fence(__ATOMIC_RELEASE, "agent");
            asm volatile("s_waitcnt vmcnt(0)" ::: "memory");
            const unsigned og = xb_add(&bar[XB_TOP], 1u);
            const unsigned tg = og / nx;
            if (og + 1u == (tg + 1u) * nx) xb_add(&bar[XB_TOPGEN], 1u);
            else XB_SPIN(xb_ld(&bar[XB_TOPGEN]) == tg, bar);
            __builtin_amdgcn_fence(__ATOMIC_ACQUIRE, "agent");
            xb_add(&bar[XB_XGEN(b.x)], 1u);
            asm volatile("s_waitcnt vmcnt(0)" ::: "memory");
        } else {
            XB_SPIN(xb_ld(&bar[XB_XGEN(b.x)]) == gen, bar);
            __builtin_amdgcn_fence(__ATOMIC_ACQUIRE, "agent");
            asm volatile("s_waitcnt vmcnt(0)" ::: "memory");
        }
    }
    __syncthreads();
}

namespace g8 {
constexpr int BM = 256, BK = 64, HALF = 128, HTB = HALF * BK * 2, STAGE_BYTES = 8 * HTB, NXCD = 8, WGM = 8;
__device__ __forceinline__ int lds_byte(int r, int c) { const int st = (r >> 4) * 2 + (c >> 5), rr = r & 15, cc = c & 31, ob = rr * 64 + cc * 2; return st * 1024 + (ob ^ (((ob >> 9) & 1) << 5)); }
__device__ __forceinline__ void stage_rc(int b, int& R, int& C) { const int st = b / 1024, sb = b % 1024, swz = sb ^ (((sb >> 9) & 1) << 5); R = (st >> 1) * 16 + swz / 64; C = (st & 1) * 32 + (swz % 64) / 2; }
__device__ __forceinline__ int perm32(int rho) { const int n = rho >> 4, i = rho & 15; return 8 * (i >> 2) + 4 * n + (i & 3); }
struct Unit { int pm, pn, aux; };
struct AOff { unsigned o[2][2]; };

__device__ __forceinline__ bool static_order(int i, int G, int c, int nM, int nN, int& pm, int& pn) {
    const int nwg = nM * nN; const long L = (long)i * G + c; if (L >= nwg) return false;
    int wgid = (int)L; { const int q = nwg / NXCD, r = nwg % NXCD, xcd = wgid % NXCD, off = wgid / NXCD; wgid = (xcd < r ? xcd * (q + 1) : r * (q + 1) + (xcd - r) * q) + off; }
    const int nig = WGM * nN, gid = wgid / nig, fm = gid * WGM, gsz = (nM - fm) < WGM ? (nM - fm) : WGM;
    pm = fm + ((wgid % nig) % gsz); pn = (wgid % nig) / gsz; return true;
}
struct DenseP {
    const char* A; const char* B; int lda, ldb, K, nM, nN, G, c;
    __device__ __forceinline__ bool next(int i, Unit& u) const { u.aux = 0; return static_order(i, G, c, nM, nN, u.pm, u.pn); }
    __device__ __forceinline__ void aoff(const Unit& u, const int (&R)[2], const int (&C)[2], AOff& o) const {
#pragma unroll
        for (int h = 0; h < 2; ++h)
#pragma unroll
            for (int i = 0; i < 2; ++i) o.o[h][i] = (unsigned)(((u.pm * BM + h * HALF + R[i]) * lda + C[i]) * 2);
    }
    __device__ __forceinline__ const char* bbase(const Unit& u, int kt) const { return B + ((size_t)u.pn * BM * ldb + (size_t)kt * BK) * 2; }
};

template <class Prov, class Epi>
__device__ __forceinline__ void gemm_phase(LAS unsigned char* lds, const Prov& P, const Epi& E) {
    int tid = threadIdx.x; asm volatile("" : "+v"(tid));
    const int wid = __builtin_amdgcn_readfirstlane(tid >> 6), lane = tid & 63, wr = wid >> 2, wc = wid & 3, fr = lane & 15, fq = lane >> 4;
    const int K = P.K, nt = K / BK;
    int R[2], C[2]; unsigned voffB[2];
#pragma unroll
    for (int i = 0; i < 2; ++i) { stage_rc(tid * 16 + i * 8192, R[i], C[i]); const int Rb = (R[i] & ~31) + perm32(R[i] & 31); voffB[i] = (unsigned)(Rb * P.ldb + C[i]) * 2u; }
    const size_t hstepB = (size_t)HALF * P.ldb * 2;
    const unsigned ldsw = (unsigned)wid * 1024u;
    const int aoff = lds_byte(wr * 64 + fr, fq * 8), boff = lds_byte(wc * 32 + fr, fq * 8);
#define G8_SA(b, h) (((b) * 2 + (h)) * HTB)
#define G8_SB(b, h) ((4 + (b) * 2 + (h)) * HTB)
#define G8_STAGE_A(bufoff, h, AO, kb) do { _Pragma("unroll") for (int _i = 0; _i < 2; ++_i) \
        __builtin_amdgcn_global_load_lds((const unsigned*)(P.A + (size_t)((AO).o[h][_i] + (kb))), (LAS unsigned*)(lds + (bufoff) + ldsw + _i * 8192), 16, 0, 0); } while (0)
#define G8_STAGE_B(bufoff, bp) do { _Pragma("unroll") for (int _i = 0; _i < 2; ++_i) \
        __builtin_amdgcn_global_load_lds((const unsigned*)((bp) + voffB[_i]), (LAS unsigned*)(lds + (bufoff) + ldsw + _i * 8192), 16, 0, 0); } while (0)
#define G8_LDA(dst, b, h) do { _Pragma("unroll") for (int m = 0; m < 4; ++m) _Pragma("unroll") for (int k = 0; k < 2; ++k) dst[m][k] = *(const LAS bf16x8*)(lds + G8_SA(b, h) + aoff + m * 2048 + k * 1024); } while (0)
#define G8_LDB(dst, b, h) do { _Pragma("unroll") for (int n = 0; n < 2; ++n) _Pragma("unroll") for (int k = 0; k < 2; ++k) dst[n][k] = *(const LAS bf16x8*)(lds + G8_SB(b, h) + boff + n * 2048 + k * 1024); } while (0)
#define G8_MMA(ai, bj, At, Bt) do { __builtin_amdgcn_s_setprio(1); _Pragma("unroll") for (int m = 0; m < 4; ++m) _Pragma("unroll") for (int n = 0; n < 2; ++n) _Pragma("unroll") for (int k = 0; k < 2; ++k) \
        acc[ai][bj][m][n] = __builtin_amdgcn_mfma_f32_16x16x32_bf16(Bt[n][k], At[m][k], acc[ai][bj][m][n], 0, 0, 0); __builtin_amdgcn_s_setprio(0); } while (0)
#define G8_WAIT_V(n) asm volatile("s_waitcnt vmcnt(" #n ")" ::: "memory")
#define G8_WAIT_L(n) asm volatile("s_waitcnt lgkmcnt(" #n ")" ::: "memory")
#define G8_BAR __builtin_amdgcn_s_barrier()
#define G8_SCHED __builtin_amdgcn_sched_barrier(0)
    Unit cur, nxt; int ui = 0;
    if (!P.next(0, cur)) return;
    f32x4 acc[2][2][4][2];
#pragma unroll
    for (int a = 0; a < 2; ++a)
#pragma unroll
        for (int b = 0; b < 2; ++b)
#pragma unroll
            for (int m = 0; m < 4; ++m)
#pragma unroll
                for (int n = 0; n < 2; ++n) acc[a][b][m][n] = (f32x4){0.f, 0.f, 0.f, 0.f};
    bf16x8 At[4][2], B0[2][2], B1[2][2];
    AOff cA, nA;
    P.aoff(cur, R, C, cA);
    {   const char* b0 = P.bbase(cur, 0); const char* b1 = P.bbase(cur, 1);
        G8_STAGE_B(G8_SB(0, 0), b0); G8_STAGE_B(G8_SB(0, 1), b0 + hstepB); G8_STAGE_A(G8_SA(0, 0), 0, cA, 0u); G8_STAGE_A(G8_SA(0, 1), 1, cA, 0u);
        if (wr == 1) G8_BAR;
        G8_WAIT_V(2); G8_BAR;
        G8_STAGE_B(G8_SB(1, 0), b1); G8_STAGE_A(G8_SA(1, 0), 0, cA, 128u); G8_STAGE_B(G8_SB(1, 1), b1 + hstepB);
        G8_WAIT_V(6); G8_BAR; }
    for (;;) {
        const bool has_next = P.next(ui + 1, nxt);
        if (has_next) P.aoff(nxt, R, C, nA); else { nA = cA; nxt = cur; }
        for (int t = 0; t < nt; t += 2) {
            const bool last = (t == nt - 2);
            const unsigned kb1 = (unsigned)(t + 1) * 128u;
            const unsigned kb2 = last ? 0u : (unsigned)(t + 2) * 128u, kb3 = kb2 + 128u;
            AOff s;
#pragma unroll
            for (int h = 0; h < 2; ++h)
#pragma unroll
                for (int i = 0; i < 2; ++i) s.o[h][i] = last ? nA.o[h][i] : cA.o[h][i];
            const char* b2 = last ? P.bbase(nxt, 0) : P.bbase(cur, t + 2);
            const char* b3 = last ? P.bbase(nxt, 1) : P.bbase(cur, t + 3);
            G8_LDB(B0, 0, 0); G8_LDB(B1, 0, 1); G8_SCHED; G8_LDA(At, 0, 0); G8_STAGE_A(G8_SA(1, 1), 1, cA, kb1);
            G8_WAIT_V(8); G8_WAIT_L(0); G8_BAR; G8_MMA(0, 0, At, B0); G8_MMA(0, 1, At, B1); G8_BAR; G8_SCHED;
            G8_LDA(At, 0, 1); G8_STAGE_B(G8_SB(0, 0), b2); G8_STAGE_B(G8_SB(0, 1), b2 + hstepB); G8_STAGE_A(G8_SA(0, 0), 0, s, kb2);
            G8_WAIT_V(8); G8_WAIT_L(0); G8_BAR; G8_MMA(1, 0, At, B0); G8_MMA(1, 1, At, B1); G8_BAR; G8_SCHED;
            G8_LDB(B0, 1, 0); G8_LDB(B1, 1, 1); G8_SCHED; G8_LDA(At, 1, 0); G8_STAGE_A(G8_SA(0, 1), 1, s, kb2);
            G8_WAIT_V(8); G8_WAIT_L(0); G8_BAR; G8_MMA(0, 0, At, B0); G8_MMA(0, 1, At, B1); G8_BAR; G8_SCHED;
            G8_LDA(At, 1, 1); G8_STAGE_B(G8_SB(1, 0), b3); G8_STAGE_B(G8_SB(1, 1), b3 + hstepB); G8_STAGE_A(G8_SA(1, 0), 0, s, kb3);
            G8_WAIT_V(8); G8_WAIT_L(0); G8_BAR; G8_MMA(1, 0, At, B0); G8_MMA(1, 1, At, B1); G8_BAR; G8_SCHED;
        }
        if (wr == 0) G8_BAR;
        E(acc, cur, wr, wc, fr, fq);
        if (!has_next) break;
#pragma unroll
        for (int a = 0; a < 2; ++a)
#pragma unroll
            for (int b = 0; b < 2; ++b)
#pragma unroll
                for (int m = 0; m < 4; ++m)
#pragma unroll
                    for (int n = 0; n < 2; ++n) acc[a][b][m][n] = (f32x4){0.f, 0.f, 0.f, 0.f};
        cur = nxt; cA = nA; ++ui;
        if (wr == 1) G8_BAR;
    }
    G8_WAIT_V(0);
    G8_BAR;
#undef G8_SA
#undef G8_SB
#undef G8_STAGE_A
#undef G8_STAGE_B
#undef G8_LDA
#undef G8_LDB
#undef G8_MMA
#undef G8_WAIT_V
#undef G8_WAIT_L
#undef G8_BAR
#undef G8_SCHED
}
}
using g8::Unit;


struct EpiQKV {
    const float* hpx; const float* cosA; const float* sinA; bf16_t* Q; bf16_t* Kk; bf16_t* V; float* kmean;
    __device__ __forceinline__ void operator()(const f32x4 (&acc)[2][2][4][2], const Unit& u, int wr, int wc, int fr, int fq) const {
        const int t = u.pn >> 2;
        const int bb = u.pm >> 5;
        if (t < 2) {
            const int hh = 2 * (u.pn & 3) + (wc >> 1), j0 = 32 * (wc & 1) + 8 * fq;
            bf16_t* dst0 = (t == 0 ? Q : Kk) + ((size_t)(bb * NH + hh) * NS) * 128;
            f32x4 ks[2][2] = {{{0.f, 0.f, 0.f, 0.f}, {0.f, 0.f, 0.f, 0.f}}, {{0.f, 0.f, 0.f, 0.f}, {0.f, 0.f, 0.f, 0.f}}};
#pragma unroll
            for (int ai = 0; ai < 2; ++ai)
#pragma unroll
                for (int m = 0; m < 4; ++m) {
                    const int row = u.pm * 256 + 128 * ai + 64 * wr + 16 * m + fr, s = row & (NS - 1);
                    const float rs = row_rs<16>(hpx + (size_t)row * 16, 1.0f / 1024.0f);
                    f32x4 o1[2], o2[2];
#pragma unroll
                    for (int n = 0; n < 2; ++n) {
                        const f32x4 cs = *(const f32x4*)(cosA + (size_t)s * 64 + j0 + 4 * n), sn = *(const f32x4*)(sinA + (size_t)s * 64 + j0 + 4 * n);
                        const f32x4 x1 = acc[ai][0][m][n] * rs, x2 = acc[ai][1][m][n] * rs;
                        o1[n] = x1 * cs - x2 * sn; o2[n] = x1 * sn + x2 * cs;
                        ks[0][n] += o1[n]; ks[1][n] += o2[n];
                    }
                    bf16_t* d = dst0 + (size_t)s * 128 + j0;
                    *(u32x4*)d = pack8(o1[0], o1[1]); *(u32x4*)(d + 64) = pack8(o2[0], o2[1]);
                }
            if (t == 1) {
#pragma unroll
                for (int q = 0; q < 2; ++q)
#pragma unroll
                    for (int n = 0; n < 2; ++n)
#pragma unroll
                        for (int e = 0; e < 4; ++e) { float v = ks[q][n][e]; v += __shfl_xor(v, 1); v += __shfl_xor(v, 2); v += __shfl_xor(v, 4); v += __shfl_xor(v, 8); ks[q][n][e] = v; }
                if (fr == 0) {
                    float* km = kmean + ((size_t)(bb * NH + hh) * 32 + (u.pm & 31)) * 128 + j0;
#pragma unroll
                    for (int q = 0; q < 2; ++q)
#pragma unroll
                        for (int n = 0; n < 2; ++n)
#pragma unroll
                            for (int e = 0; e < 4; ++e) atomicAdd(km + 64 * q + 4 * n + e, ks[q][n][e]);
                }
            }
        } else {
            const int d0 = 32 * wc + 8 * fq;
#pragma unroll
            for (int ai = 0; ai < 2; ++ai)
#pragma unroll
                for (int m = 0; m < 4; ++m) {
                    const int row = u.pm * 256 + 128 * ai + 64 * wr + 16 * m + fr, s = row & (NS - 1);
                    const float rs = row_rs<16>(hpx + (size_t)row * 16, 1.0f / 1024.0f);
#pragma unroll
                    for (int bj = 0; bj < 2; ++bj) {
                        const int hh = 2 * (u.pn - 8) + bj;
                        bf16_t* d = V + ((size_t)(bb * NH + hh) * NS + s) * 128 + d0;
                        *(u32x4*)d = pack8(acc[ai][bj][m][0] * rs, acc[ai][bj][m][1] * rs);
                    }
                }
        }
    }
};

struct EpiResid {
    const float* base; float* h; bf16_t* hb; float* hp;
    __device__ __forceinline__ void operator()(const f32x4 (&acc)[2][2][4][2], const Unit& u, int wr, int wc, int fr, int fq) const {
#pragma unroll
        for (int ai = 0; ai < 2; ++ai)
#pragma unroll
            for (int m = 0; m < 4; ++m) {
                const int row = u.pm * 256 + 128 * ai + 64 * wr + 16 * m + fr;
                float ss = 0.f;
#pragma unroll
                for (int bj = 0; bj < 2; ++bj) {
                    const size_t off = (size_t)row * 1024 + u.pn * 256 + 128 * bj + 32 * wc + 8 * fq;
                    const f32x4 v0 = acc[ai][bj][m][0] + *(const f32x4*)(base + off), v1 = acc[ai][bj][m][1] + *(const f32x4*)(base + off + 4);
                    *(f32x4*)(h + off) = v0; *(f32x4*)(h + off + 4) = v1;
                    *(u32x4*)(hb + off) = pack8(v0, v1);
                    ss += dot4(v0) + dot4(v1);
                }
                ss += __shfl_xor(ss, 16); ss += __shfl_xor(ss, 32);
                if (fq == 0) hp[(size_t)row * 16 + u.pn * 4 + wc] = ss;
                asm volatile("" ::: "memory");
            }
    }
};
namespace at {
constexpr int KVBLK = 64, SHM_V = KVBLK * 128 * 2;
constexpr float THR = 8.f;
#define AT_SBAR() __builtin_amdgcn_sched_barrier(0)
__device__ __forceinline__ int v_st(int k, int c) { const int kk = (k & ~0xC) | ((k & 4) << 1) | ((k & 8) >> 1); return ((kk >> 3) * 4 + (c >> 5)) * 512 + ((kk & 7) * 32 + (c & 31)) * 2; }
__device__ __forceinline__ int v_rd_base(int lane) { return ((lane & 3) << 3) | (((lane >> 2) & 3) << 6) | (((lane >> 4) & 1) << 5) | (((lane >> 5) & 1) << 8); }
constexpr int v_rd_off(int d0, int ks, int half) { return d0 * 512 + ks * 4096 + half * 2048; }
__device__ __forceinline__ int crow(int r, int hi) { return (r & 3) + 8 * (r >> 2) + 4 * hi; }

template <int DQK> __device__ __forceinline__ int kswz(int row, int colB) { return row * (DQK * 2) + (colB ^ ((row & 7) << 4)); }

__device__ __forceinline__ void mask_causal(f32x16& p0, f32x16& p1, int dq) {
    const float NEG = -__builtin_inff();
#pragma unroll
    for (int r = 0; r < 16; ++r) {
        const int c = (r & 3) + 8 * (r >> 2);
        if (dq - c < 0) p0[r] = NEG;
        if (dq - c - 32 < 0) p1[r] = NEG;
    }
}
__device__ __forceinline__ void mask_all(f32x16& p0, f32x16& p1, bool keep) {
    const float NEG = -__builtin_inff();
#pragma unroll
    for (int r = 0; r < 16; ++r) { p0[r] = keep ? p0[r] : NEG; p1[r] = keep ? p1[r] : NEG; }
}
__device__ __forceinline__ void partialSM(f32x16& p0, f32x16& p1, float& m_reg, float& mn, float& alpha, const float SC, const float C2) {
    float pmax = p0[0];
#pragma unroll
    for (int r = 1; r < 16; ++r) pmax = fmaxf(pmax, p0[r]);
#pragma unroll
    for (int r = 0; r < 16; ++r) pmax = fmaxf(pmax, p1[r]);
    { auto rr = __builtin_amdgcn_permlane32_swap(__float_as_uint(pmax), __float_as_uint(pmax), false, false);
      pmax = fmaxf(__uint_as_float(rr[0]), __uint_as_float(rr[1])); }
    if (__builtin_expect(__all((pmax - m_reg) * SC <= THR), 1)) { mn = m_reg; alpha = 1.f; }
    else { mn = fmaxf(m_reg, pmax); alpha = __builtin_amdgcn_exp2f((m_reg - mn) * C2); m_reg = mn; }
    const float mnL = -mn * C2;
#pragma unroll
    for (int r = 0; r < 16; ++r) p0[r] = fmaf(p0[r], C2, mnL);
#pragma unroll
    for (int r = 0; r < 16; ++r) p1[r] = fmaf(p1[r], C2, mnL);
#pragma unroll
    for (int r = 0; r < 16; ++r) p0[r] = __builtin_amdgcn_exp2f(p0[r]);
}
__device__ __forceinline__ void finishSM(f32x16& p0, f32x16& p1, float alpha, float& l_reg, bf16x8& pa0, bf16x8& pa1, bf16x8& pa2, bf16x8& pa3) {
#pragma unroll
    for (int r = 0; r < 16; ++r) p1[r] = __builtin_amdgcn_exp2f(p1[r]);
    float ps = 0;
#pragma unroll
    for (int r = 0; r < 16; ++r) ps += p0[r];
#pragma unroll
    for (int r = 0; r < 16; ++r) ps += p1[r];
    { auto rr = __builtin_amdgcn_permlane32_swap(__float_as_uint(ps), __float_as_uint(ps), false, false);
      ps = __uint_as_float(rr[0]) + __uint_as_float(rr[1]); }
    l_reg = l_reg * alpha + ps;
#define AT_PK4(P, B_, OUT) do { unsigned a0 = cvtpk(P[B_+0], P[B_+1]), a1 = cvtpk(P[B_+2], P[B_+3]);                          \
        unsigned b0 = cvtpk(P[B_+4], P[B_+5]), b1 = cvtpk(P[B_+6], P[B_+7]);                                             \
        auto r0 = __builtin_amdgcn_permlane32_swap(a0, b0, false, false); auto r1 = __builtin_amdgcn_permlane32_swap(a1, b1, false, false); \
        u32x4 w = {r0[0], r1[0], r0[1], r1[1]}; OUT = __builtin_bit_cast(bf16x8, w); } while (0)
    AT_PK4(p0, 0, pa0); AT_PK4(p0, 8, pa1); AT_PK4(p1, 0, pa2); AT_PK4(p1, 8, pa3);
#undef AT_PK4
}
template <int DQK>
__device__ __forceinline__ void qkt(f32x16& p0, f32x16& p1, const char* Kt, int r32, int hi, const bf16x8* qr, bool act) {
    if (!act) { const float NEG = -__builtin_inff();
#pragma unroll
        for (int r = 0; r < 16; ++r) { p0[r] = NEG; p1[r] = NEG; } return; }
    p0 = f32x16{}; p1 = f32x16{};
    const char* kb[4];
#pragma unroll
    for (int dd = 0; dd < 4; ++dd) kb[dd] = Kt + kswz<DQK>(r32, (dd * 16 + hi * 8) * 2);
#pragma unroll
    for (int d0 = 0; d0 < DQK / 16; ++d0) { const char* a = kb[d0 & 3] + (d0 >> 2) * 128;
        bf16x8 b0 = *reinterpret_cast<const bf16x8*>(a);
        bf16x8 b1 = *reinterpret_cast<const bf16x8*>(a + 32 * DQK * 2);
        p0 = __builtin_amdgcn_mfma_f32_32x32x16_bf16(b0, qr[d0], p0, 0, 0, 0);
        p1 = __builtin_amdgcn_mfma_f32_32x32x16_bf16(b1, qr[d0], p1, 0, 0, 0); }
}
template <int VB>
__device__ __forceinline__ void pv_tile(f32x16* o, int vb0, bf16x8 pa0, bf16x8 pa1, bf16x8 pa2, bf16x8 pa3, bool act) {
    if (!act) return;
#define AT_TRRD(dst, off) asm volatile("ds_read_b64_tr_b16 %0, %1 offset:%2" : "=&v"(dst) : "v"(vb0), "i"(off) : "memory")
#define AT_PV_D0(d0) do { s16x4 l0, l1, l2, l3, h0, h1, h2, h3; constexpr int b_ = VB * SHM_V + v_rd_off(d0, 0, 0); \
        AT_TRRD(l0, b_); AT_TRRD(h0, b_ + 2048); AT_TRRD(l1, b_ + 4096); AT_TRRD(h1, b_ + 6144); AT_TRRD(l2, b_ + 8192); AT_TRRD(h2, b_ + 10240); AT_TRRD(l3, b_ + 12288); AT_TRRD(h3, b_ + 14336); \
        asm volatile("s_waitcnt lgkmcnt(0)" ::: "memory"); AT_SBAR();   \
        o[d0] = __builtin_amdgcn_mfma_f32_32x32x16_bf16(pa0, (bf16x8){l0[0], l0[1], l0[2], l0[3], h0[0], h0[1], h0[2], h0[3]}, o[d0], 0, 0, 0);   \
        o[d0] = __builtin_amdgcn_mfma_f32_32x32x16_bf16(pa1, (bf16x8){l1[0], l1[1], l1[2], l1[3], h1[0], h1[1], h1[2], h1[3]}, o[d0], 0, 0, 0);   \
        o[d0] = __builtin_amdgcn_mfma_f32_32x32x16_bf16(pa2, (bf16x8){l2[0], l2[1], l2[2], l2[3], h2[0], h2[1], h2[2], h2[3]}, o[d0], 0, 0, 0);   \
        o[d0] = __builtin_amdgcn_mfma_f32_32x32x16_bf16(pa3, (bf16x8){l3[0], l3[1], l3[2], l3[3], h3[0], h3[1], h3[2], h3[3]}, o[d0], 0, 0, 0); } while (0)
    AT_PV_D0(0); AT_PV_D0(1); AT_PV_D0(2); AT_PV_D0(3);
#undef AT_PV_D0
#undef AT_TRRD
}

template <int DQK> struct Lds { static constexpr int SHM_K = KVBLK * DQK * 2, K_OFF = 2 * SHM_V, WS_OFF = K_OFF + 2 * SHM_K, BYTES = WS_OFF + NWAVES * 64 * 4; };

template <int DQK, int MODE>
__device__ __forceinline__ void attn_unit(char* lds, const bf16_t* Qp, const bf16_t* Kn, const bf16_t* Kr, const bf16_t* Vp, bf16_t* Op, int P0, const float* kms) {
    typedef Lds<DQK> L;
    constexpr int SHM_K = L::SHM_K;
    constexpr float SC = (DQK == 128) ? 0.08838834764831845f : 0.07216878364870323f;
    constexpr float C2 = 1.4426950408889634f * SC;
    constexpr int ND0 = DQK / 16;
    int tid = threadIdx.x; asm volatile("" : "+v"(tid));
    const int wid = __builtin_amdgcn_readfirstlane(tid >> 6), lane = tid & 63, r32 = lane & 31, hi = lane >> 5;
    const int NT = (P0 + 256) / KVBLK;
    const int qlo = P0 + wid * 32, qm = qlo + r32 - 4 * hi;
    char* V_lds = lds; char* K_lds = lds + L::K_OFF;
    float* ws = (float*)(lds + L::WS_OFF) + wid * 64; float* li_l = ws, * al_l = ws + 32;
    float m_reg = -1e30f, l_reg = 0; f32x16 o[4] = {};
    const int sr = tid >> 4, sc = (tid & 15) * 8, vst0 = v_st(sr, sc), vst1 = v_st(32 + sr, sc), kws = kswz<DQK>(sr, sc * 2);
    const int rr_ = tid >> 3, rc_ = (tid & 7) * 8, kws_r = kswz<DQK>(rr_, 256 + rc_ * 2);
    const int vb0 = (int)(uintptr_t)V_lds + v_rd_base(lane);
    bf16x8 qr[ND0];
    {   const unsigned qo = (unsigned)(((wid * 32 + r32) * DQK + hi * 8) * 2);
#pragma unroll
        for (int d0 = 0; d0 < ND0; ++d0) qr[d0] = *(const bf16x8*)((const char*)Qp + qo + d0 * 32); }
    unsigned selmask = 0u; const int own = P0 >> 8;
    if (MODE == 1) {
        {   unsigned ko = (unsigned)((sr * 128 + sc) * 4); asm volatile("" : "+v"(ko));
            const f32x4 a = *(const f32x4*)((const char*)kms + ko) * (1.0f / 256.0f), b = *(const f32x4*)((const char*)kms + ko + 16) * (1.0f / 256.0f);
            const u32x4 h8 = pack8(a, b);
            f32x4 ha, hb_;
#pragma unroll
            for (int e = 0; e < 2; ++e) { ha[2 * e] = __builtin_bit_cast(float, h8[e] << 16); ha[2 * e + 1] = __builtin_bit_cast(float, h8[e] & 0xffff0000u);
                                          hb_[2 * e] = __builtin_bit_cast(float, h8[2 + e] << 16); hb_[2 * e + 1] = __builtin_bit_cast(float, h8[2 + e] & 0xffff0000u); }
            const u32x4 l8 = pack8(a - ha, b - hb_);
            *(u32x4*)(K_lds + kws) = h8; *(u32x4*)(K_lds + SHM_K + kws) = l8; }
        __syncthreads();
        f32x16 g = f32x16{};
        {   const char* kb[4];
#pragma unroll
            for (int dd = 0; dd < 4; ++dd) kb[dd] = K_lds + kswz<DQK>(r32, (dd * 16 + hi * 8) * 2);
#pragma unroll
            for (int d0 = 0; d0 < 8; ++d0) { const char* a = kb[d0 & 3] + (d0 >> 2) * 128;
                g = __builtin_amdgcn_mfma_f32_32x32x16_bf16(*reinterpret_cast<const bf16x8*>(a), qr[d0], g, 0, 0, 0);
                g = __builtin_amdgcn_mfma_f32_32x32x16_bf16(*reinterpret_cast<const bf16x8*>(a + SHM_K), qr[d0], g, 0, 0, 0); } }
        const float NINF = -__builtin_inff();
        float v1 = NINF, v2 = NINF, v3 = NINF; int i1 = 64, i2 = 65, i3 = 66;
        const int ownl = own - 4 * hi;
#pragma unroll
        for (int r = 0; r < 16; ++r) {
            const int idx = (r & 3) + 8 * (r >> 2); const float val = (idx < ownl) ? g[r] : NINF;
            const bool c1 = val > v1, c2 = val > v2, c3 = val > v3;
            v3 = c2 ? v2 : (c3 ? val : v3); i3 = c2 ? i2 : (c3 ? idx : i3);
            v2 = c1 ? v1 : (c2 ? val : v2); i2 = c1 ? i1 : (c2 ? idx : i2);
            v1 = c1 ? val : v1;             i1 = c1 ? idx : i1;
        }
        i1 += 4 * hi; i2 += 4 * hi; i3 += 4 * hi;
        float pv_[3]; int pi_[3];
        pv_[0] = __shfl_xor(v1, 32); pv_[1] = __shfl_xor(v2, 32); pv_[2] = __shfl_xor(v3, 32);
        pi_[0] = __shfl_xor(i1, 32); pi_[1] = __shfl_xor(i2, 32); pi_[2] = __shfl_xor(i3, 32);
#pragma unroll
        for (int c = 0; c < 3; ++c) {
            const float val = pv_[c]; const int idx = pi_[c];
            const bool c1 = (val > v1) || (val == v1 && idx < i1), c2 = (val > v2) || (val == v2 && idx < i2), c3 = (val > v3) || (val == v3 && idx < i3);
            v3 = c2 ? v2 : (c3 ? val : v3); i3 = c2 ? i2 : (c3 ? idx : i3);
            v2 = c1 ? v1 : (c2 ? val : v2); i2 = c1 ? i1 : (c2 ? idx : i2);
            v1 = c1 ? val : v1;             i1 = c1 ? idx : i1;
        }
        selmask = (i1 < 32 ? (1u << i1) : 0u) | (i2 < 32 ? (1u << i2) : 0u) | (i3 < 32 ? (1u << i3) : 0u);
        __syncthreads();
    }
    bf16x8 st_v0, st_v1, st_k0, st_k1, st_k2;
    const unsigned lo_a = (unsigned)((sr * 128 + sc) * 2), lo_r = (unsigned)((rr_ * 64 + rc_) * 2);
#define AT_VMW() asm volatile("s_waitcnt vmcnt(0)" ::: "memory")
    const __amdgpu_buffer_rsrc_t rsV = __builtin_amdgcn_make_buffer_rsrc((void*)Vp, 0, NS * 256, 0x00020000), rsK = __builtin_amdgcn_make_buffer_rsrc((void*)Kn, 0, NS * 256, 0x00020000);
    const __amdgpu_buffer_rsrc_t rsR = __builtin_amdgcn_make_buffer_rsrc((void*)(DQK == 192 ? Kr : Kn), 0, NS * 128, 0x00020000);
#define AT_BL(rs, vo, so) __builtin_bit_cast(bf16x8, __builtin_amdgcn_raw_buffer_load_b128(rs, (int)(vo), (int)(so), 0))
#define AT_SLOAD(k0) do { const int so_ = (k0) * 256; \
                          st_v0 = AT_BL(rsV, lo_a, so_); st_v1 = AT_BL(rsV, lo_a, so_ + 8192); \
                          st_k0 = AT_BL(rsK, lo_a, so_); st_k1 = AT_BL(rsK, lo_a, so_ + 8192); \
                          if (DQK == 192) { st_k2 = AT_BL(rsR, lo_r, (k0) * 128); } } while (0)
#define AT_SWRITE(bf) do { *(bf16x8*)(V_lds + (bf) * SHM_V + vst0) = st_v0; *(bf16x8*)(V_lds + (bf) * SHM_V + vst1) = st_v1; \
                           *(bf16x8*)(K_lds + (bf) * SHM_K + kws) = st_k0; *(bf16x8*)(K_lds + (bf) * SHM_K + kws + 32 * DQK * 2) = st_k1; \
                           if (DQK == 192) *(bf16x8*)(K_lds + (bf) * SHM_K + kws_r) = st_k2; } while (0)
#define AT_RESC(a) do { if (__any((a) < 1.f)) { if (hi == 0) al_l[r32] = (a); asm volatile("s_waitcnt lgkmcnt(0)" ::: "memory");              \
                     _Pragma("unroll") for (int d_ = 0; d_ < 4; ++d_) _Pragma("unroll") for (int r = 0; r < 16; ++r) o[d_][r] *= al_l[crow(r, hi)]; } } while (0)
#define AT_KBASE(t) ((t) * KVBLK)
#define AT_ACT(t) (MODE == 0 ? (AT_KBASE(t) <= qlo + 31) : ((((t) >> 2) < own) ? (__any((selmask >> ((t) >> 2)) & 1u) != 0) : (AT_KBASE(t) <= qlo + 31)))
#define AT_MASKT(P0_, P1_, t) do { const int kb_ = AT_KBASE(t); \
        if (MODE == 1 && ((t) >> 2) < own) { mask_all(P0_, P1_, ((selmask >> ((t) >> 2)) & 1u) != 0u); } \
        else if (kb_ + KVBLK - 1 > qlo && kb_ <= qlo + 31) mask_causal(P0_, P1_, qm - kb_); } while (0)
    f32x16 pA0, pA1, pB0, pB1; float mnA, mnB, alA, alB; bf16x8 pa0, pa1, pa2, pa3;
    AT_SLOAD(AT_KBASE(0)); AT_VMW(); AT_SWRITE(0);
    __syncthreads();
    AT_SLOAD(AT_KBASE(1));
    AT_SBAR(); qkt<DQK>(pA0, pA1, K_lds, r32, hi, qr, AT_ACT(0));
    AT_MASKT(pA0, pA1, 0); partialSM(pA0, pA1, m_reg, mnA, alA, SC, C2);
    AT_VMW(); AT_SWRITE(1);
    __syncthreads();
#define AT_HALF_STEP(PX0, PX1, mnX, alX, PY0, PY1, alY, t, KB, VB, SB) do {                                                      \
        AT_SBAR(); qkt<DQK>(PX0, PX1, K_lds + (KB) * SHM_K, r32, hi, qr, AT_ACT(t));                                             \
        finishSM(PY0, PY1, alY, l_reg, pa0, pa1, pa2, pa3); AT_SBAR();                                                           \
        if ((t) + 1 < NT) { AT_SLOAD(AT_KBASE((t) + 1)); AT_SBAR(); }                                                            \
        pv_tile<VB>(o, vb0, pa0, pa1, pa2, pa3, AT_ACT((t) - 1)); AT_MASKT(PX0, PX1, (t)); partialSM(PX0, PX1, m_reg, mnX, alX, SC, C2); \
        __syncthreads();                                                                                                      \
        if ((t) + 1 < NT) { AT_VMW(); AT_SWRITE(SB); }                                                                           \
        AT_RESC(alX); __syncthreads(); } while (0)
    for (int t = 1; t + 1 < NT; t += 2) {
        AT_HALF_STEP(pB0, pB1, mnB, alB, pA0, pA1, alA, t, 1, 0, 0);
        AT_HALF_STEP(pA0, pA1, mnA, alA, pB0, pB1, alB, t + 1, 0, 1, 1);
    }
    AT_SBAR(); qkt<DQK>(pB0, pB1, K_lds + SHM_K, r32, hi, qr, AT_ACT(NT - 1)); AT_SBAR();
    finishSM(pA0, pA1, alA, l_reg, pa0, pa1, pa2, pa3); AT_SBAR();
    pv_tile<0>(o, vb0, pa0, pa1, pa2, pa3, AT_ACT(NT - 2));
    AT_MASKT(pB0, pB1, NT - 1); partialSM(pB0, pB1, m_reg, mnB, alB, SC, C2); AT_RESC(alB);
    finishSM(pB0, pB1, alB, l_reg, pa0, pa1, pa2, pa3); AT_SBAR(); pv_tile<1>(o, vb0, pa0, pa1, pa2, pa3, AT_ACT(NT - 1));
    if (hi == 0) li_l[r32] = l_reg; asm volatile("s_waitcnt lgkmcnt(0)" ::: "memory");
    float rli[16];
#pragma unroll
    for (int r = 0; r < 16; ++r) rli[r] = __builtin_amdgcn_rcpf(li_l[crow(r, hi)]);
    unsigned lofs = (unsigned)((wid * 32 + 4 * hi) * 1024 + r32);
    asm volatile("" : "+v"(lofs));
    lofs *= 2u;
#pragma unroll
    for (int r = 0; r < 16; ++r) { const int orow = (r & 3) + 8 * (r >> 2);
#pragma unroll
        for (int d0 = 0; d0 < 4; ++d0) { const float v = o[d0][r] * rli[r];
            const float vn = __shfl_xor(v, 1);
            if ((r32 & 1) == 0) *(unsigned*)((char*)Op + (size_t)(orow * 2048 + d0 * 64) + lofs) = cvtpk(v, vn); } }
    __syncthreads();
#undef AT_VMW
#undef AT_SLOAD
#undef AT_BL
#undef AT_SWRITE
#undef AT_RESC
#undef AT_KBASE
#undef AT_ACT
#undef AT_MASKT
#undef AT_HALF_STEP
}
}
__device__ __forceinline__ int pair_lo(int p) { return p < 3 ? 0 : (p < 5 ? 1 : 2); }
__device__ __forceinline__ int pair_hi(int p) { return p < 3 ? p + 1 : (p < 5 ? p - 1 : 3); }
constexpr int LDS_TB = LDS_MISC + 64;

__device__ __forceinline__ void p_route(const Args& a, LAS unsigned char* lds, int layer, int vcu, int G) {
    int tid = threadIdx.x; asm volatile("" : "+v"(tid));
    const int lane = tid & 63, wave = __builtin_amdgcn_readfirstlane(tid >> 6), i32 = lane & 31, kk = lane >> 5;
    unsigned char* ws = a.ws;
    LAS float* wl = (LAS float*)lds;
    {   const float* wrt = (const float*)(ws + WS_WRT) + (size_t)layer * 20480;
        for (int i = tid; i < 20480; i += NTHR) { const int k = i / 20, c = i % 20; wl[c * 1024 + k] = wrt[i]; } }
    __syncthreads();
    const float* h = a.out;
    float* tokw = (float*)(ws + WS_TOKW); int* list = (int*)(ws + WS_LIST);
    unsigned* cnt = (unsigned*)(ws + WS_CTL) + CW_CNT + layer * 24 * 16;
    const int gw = vcu * NWAVES + wave, NGW = G * NWAVES;
    const int lrow = i32 < 4 ? i32 : (i32 < 8 ? 12 + i32 : ((i32 & 4) ? -1 : ((i32 >> 3) == 1 ? i32 - 4 : ((i32 >> 3) == 2 ? i32 - 8 : i32 - 12))));
    const LAS float* wrow = wl + (lrow < 0 ? 0 : lrow) * 1024 + 4 * kk;
    const float wmask = lrow < 0 ? 0.f : 1.f;
    for (int task = gw; task < NT / 32; task += NGW) {
        const int t = task * 32 + i32;
        const float* hrow = h + (size_t)t * 1024 + 4 * kk;
        f32x16 c = f32x16{}; float ssp = 0.f;
#pragma unroll 4
        for (int it = 0; it < 128; ++it) {
            const f32x4 hv = *(const f32x4*)(hrow + 8 * it);
            const f32x4 wv = *(const LAS f32x4*)(wrow + 8 * it) * wmask;
            ssp += dot4(hv);
#pragma unroll
            for (int e = 0; e < 4; ++e) c = __builtin_amdgcn_mfma_f32_32x32x2f32(wv[e], hv[e], c, 0, 0, 0);
        }
        const float ss = ssp + __shfl_xor(ssp, 32);
        float ex[4];
#pragma unroll
        for (int e = 0; e < 4; ++e) ex[e] = __shfl_xor(c[e], 32);
        const float rs = rsqrtf(ss * (1.0f / 1024.0f) + EPS);
        float lg[20];
#pragma unroll
        for (int e = 0; e < 16; ++e) lg[e] = c[e] * rs;
#pragma unroll
        for (int e = 0; e < 4; ++e) lg[16 + e] = ex[e] * rs;
        int gs = 0; float gm = lg[0];
#pragma unroll
        for (int i = 1; i < 4; ++i) if (lg[i] > gm) { gm = lg[i]; gs = i; }
        float den = 0.f;
#pragma unroll
        for (int i = 0; i < 4; ++i) den += __expf(lg[i] - gm);
        const float gwt = 1.0f / den;
        float ein[4];
#pragma unroll
        for (int i = 0; i < 4; ++i) ein[i] = gs == 0 ? lg[4 + i] : (gs == 1 ? lg[8 + i] : (gs == 2 ? lg[12 + i] : lg[16 + i]));
        int i1 = 0; float e1 = ein[0];
#pragma unroll
        for (int i = 1; i < 4; ++i) if (ein[i] > e1) { e1 = ein[i]; i1 = i; }
        int i2 = -1; float e2 = 0.f;
#pragma unroll
        for (int i = 0; i < 4; ++i) if (i != i1 && (i2 < 0 || ein[i] > e2)) { e2 = ein[i]; i2 = i; }
        const float x2 = __expf(e2 - e1), w1 = gwt / (1.0f + x2), w2 = gwt * x2 / (1.0f + x2);
        const int lo = i1 < i2 ? i1 : i2, hi = i1 < i2 ? i2 : i1;
        const int pidx = lo == 0 ? hi - 1 : (lo == 1 ? hi + 1 : 5);
        const int bucket = gs * 6 + pidx;
        if (kk == 0) {
            f32x2_t wv2 = {(i1 == lo) ? w1 : w2, (i1 == lo) ? w2 : w1};
            *(f32x2_t*)(tokw + (size_t)t * 2) = wv2;
            const unsigned pos = __hip_atomic_fetch_add(cnt + bucket * 16, 1u, __ATOMIC_RELAXED, __HIP_MEMORY_SCOPE_AGENT);
            list[(size_t)bucket * NT + pos] = t;
        }
    }
    {   const float* p = a.in[1] + (size_t)layer * NT * 256; bf16_t* pb = (bf16_t*)(ws + WS_PB);
        const int gt = vcu * NTHR + tid, NGT = G * NTHR;
        for (int i = gt; i < NT * 256 / 8; i += NGT) { const f32x4 x0 = *(const f32x4*)(p + (size_t)i * 8), x1 = *(const f32x4*)(p + (size_t)i * 8 + 4); *(u32x4*)(pb + (size_t)i * 8) = pack8(x0, x1); } }
    __syncthreads();
}

__device__ __forceinline__ int moe_prefix(const Args& a, LAS unsigned char* lds, int layer) {
    LAS int* tb = (LAS int*)(lds + LDS_TB);
    if (threadIdx.x == 0) { const unsigned* cnt = (const unsigned*)(a.ws + WS_CTL) + CW_CNT + layer * 24 * 16; int s = 0;
        for (int b = 0; b < 24; ++b) { tb[b] = s; s += (int)((__hip_atomic_load(cnt + b * 16, __ATOMIC_RELAXED, __HIP_MEMORY_SCOPE_AGENT) + 255u) >> 8); }
        tb[24] = s; }
    __syncthreads();
    return __builtin_amdgcn_readfirstlane(tb[24]);
}
struct MoeUnits {
    LAS const int* tb; int NRT, G, c;
    __device__ __forceinline__ bool next(int i, Unit& u) const {
        const int L = i * G + c, rt = L >> 2; if (rt >= NRT) return false;
        int b = 0;
        for (int q = 1; q < 24; ++q) b = (tb[q] <= rt) ? q : b;
        u.pm = rt; u.pn = L & 3; u.aux = __builtin_amdgcn_readfirstlane(b); return true;
    }
};
struct MoeGuP {
    const char* A; const char* W; const int* list; const unsigned* cnt; MoeUnits U; int ldb, K;
    __device__ __forceinline__ bool next(int i, Unit& u) const { return U.next(i, u); }
    __device__ __forceinline__ void aoff(const Unit& u, const int (&R)[2], const int (&C)[2], g8::AOff& o) const {
        const int n = (int)cnt[u.aux * 16], p0 = (u.pm - __builtin_amdgcn_readfirstlane(U.tb[u.aux])) * 256;
#pragma unroll
        for (int h = 0; h < 2; ++h)
#pragma unroll
            for (int i = 0; i < 2; ++i) { int pos = p0 + h * 128 + R[i]; pos = pos < n ? pos : n - 1; const int tok = list[(size_t)u.aux * NT + pos]; o.o[h][i] = (unsigned)((tok * 1024 + C[i]) * 2); }
    }
    __device__ __forceinline__ const char* bbase(const Unit& u, int kt) const {
        const int g = u.aux / 6, pi = u.aux % 6, e = g * 4 + ((u.pn < 2) ? pair_lo(pi) : pair_hi(pi));
        return W + ((size_t)(e * 512 + (u.pn & 1) * 256) * 1024 + (size_t)kt * 64) * 2;
    }
};
struct MoeDownP {
    const char* A; const char* W; MoeUnits U; int ldb, K;
    __device__ __forceinline__ bool next(int i, Unit& u) const { return U.next(i, u); }
    __device__ __forceinline__ void aoff(const Unit& u, const int (&R)[2], const int (&C)[2], g8::AOff& o) const {
#pragma unroll
        for (int h = 0; h < 2; ++h)
#pragma unroll
            for (int i = 0; i < 2; ++i) o.o[h][i] = (unsigned)(((u.pm * 256 + h * 128 + R[i]) * 512 + C[i]) * 2);
    }
    __device__ __forceinline__ const char* bbase(const Unit& u, int kt) const {
        const int g = u.aux / 6, pi = u.aux % 6, e = g * 4 + ((kt < 4) ? pair_lo(pi) : pair_hi(pi));
        return W + ((size_t)(e * 1024 + u.pn * 256) * 256 + (size_t)(kt & 3) * 64) * 2;
    }
};
__device__ __forceinline__ float sigmoidf_fast(float x) { return __builtin_amdgcn_rcpf(1.0f + __builtin_amdgcn_exp2f(-1.4426950408889634f * x)); }

struct EpiGateUp {
    const float* hp; const float* tokw; const int* list; const unsigned* cnt; LAS const int* tb; bf16_t* act;
    __device__ __forceinline__ void operator()(const f32x4 (&acc)[2][2][4][2], const Unit& u, int wr, int wc, int fr, int fq) const {
        const int n = (int)cnt[u.aux * 16], p0 = (u.pm - __builtin_amdgcn_readfirstlane(tb[u.aux])) * 256, half = u.pn >> 1;
#pragma unroll
        for (int ai = 0; ai < 2; ++ai)
#pragma unroll
            for (int m = 0; m < 4; ++m) {
                const int r = 128 * ai + 64 * wr + 16 * m + fr; int pos = p0 + r; pos = pos < n ? pos : n - 1;
                const int tok = list[(size_t)u.aux * NT + pos];
                const float rs = row_rs<16>(hp + (size_t)tok * 16, 1.0f / 1024.0f), w = tokw[(size_t)tok * 2 + half];
                f32x4 o[2];
#pragma unroll
                for (int nn = 0; nn < 2; ++nn)
#pragma unroll
                    for (int e = 0; e < 4; ++e) { const float g = acc[ai][0][m][nn][e] * rs, up = acc[ai][1][m][nn][e] * rs; o[nn][e] = g * sigmoidf_fast(g) * up * w; }
                *(u32x4*)(act + (size_t)(u.pm * 256 + r) * 512 + half * 256 + (u.pn & 1) * 128 + 32 * wc + 8 * fq) = pack8(o[0], o[1]);
            }
    }
};
struct EpiDown {
    float* h; bf16_t* hb; float* hp; const int* list; const unsigned* cnt; LAS const int* tb;
    __device__ __forceinline__ void operator()(const f32x4 (&acc)[2][2][4][2], const Unit& u, int wr, int wc, int fr, int fq) const {
        const int n = (int)cnt[u.aux * 16], p0 = (u.pm - __builtin_amdgcn_readfirstlane(tb[u.aux])) * 256;
#pragma unroll
        for (int ai = 0; ai < 2; ++ai)
#pragma unroll
            for (int m = 0; m < 4; ++m) {
                const int r = 128 * ai + 64 * wr + 16 * m + fr, pos = p0 + r; const bool valid = pos < n;
                const int tok = list[(size_t)u.aux * NT + (valid ? pos : n - 1)];
                float ss = 0.f;
#pragma unroll
                for (int bj = 0; bj < 2; ++bj) {
                    const size_t off = (size_t)tok * 1024 + u.pn * 256 + 128 * bj + 32 * wc + 8 * fq;
                    const f32x4 v0 = acc[ai][bj][m][0] + *(const f32x4*)(h + off), v1 = acc[ai][bj][m][1] + *(const f32x4*)(h + off + 4);
                    if (valid) { *(f32x4*)(h + off) = v0; *(f32x4*)(h + off + 4) = v1; *(u32x4*)(hb + off) = pack8(v0, v1); }
                    ss += dot4(v0) + dot4(v1);
                }
                ss += __shfl_xor(ss, 16); ss += __shfl_xor(ss, 32);
                if (fq == 0 && valid) hp[(size_t)tok * 16 + u.pn * 4 + wc] = ss;
                asm volatile("" ::: "memory");
            }
    }
};
struct EpiStore {
    bf16_t* O; int ldc;
    __device__ __forceinline__ void operator()(const f32x4 (&acc)[2][2][4][2], const Unit& u, int wr, int wc, int fr, int fq) const {
#pragma unroll
        for (int ai = 0; ai < 2; ++ai)
#pragma unroll
            for (int m = 0; m < 4; ++m) { const int row = u.pm * 256 + 128 * ai + 64 * wr + 16 * m + fr;
#pragma unroll
                for (int bj = 0; bj < 2; ++bj) *(u32x4*)(O + (size_t)row * ldc + u.pn * 256 + 128 * bj + 32 * wc + 8 * fq) = pack8(acc[ai][bj][m][0], acc[ai][bj][m][1]); }
    }
};
struct EpiPle {
    const float* hpin; const bf16_t* pp; float* h; bf16_t* hb2; float* hp;
    __device__ __forceinline__ void operator()(const f32x4 (&acc)[2][2][4][2], const Unit& u, int wr, int wc, int fr, int fq) const {
#pragma unroll
        for (int ai = 0; ai < 2; ++ai)
#pragma unroll
            for (int m = 0; m < 4; ++m) {
                const int row = u.pm * 256 + 128 * ai + 64 * wr + 16 * m + fr;
                const float rs = row_rs<16>(hpin + (size_t)row * 16, 1.0f / 1024.0f);
                float ss = 0.f;
#pragma unroll
                for (int bj = 0; bj < 2; ++bj) {
                    const size_t off = (size_t)row * 1024 + u.pn * 256 + 128 * bj + 32 * wc + 8 * fq;
                    const u32x4 pw = *(const u32x4*)(pp + off);
                    f32x4 v0 = *(const f32x4*)(h + off), v1 = *(const f32x4*)(h + off + 4);
#pragma unroll
                    for (int e = 0; e < 2; ++e) {
                        v0[2 * e] += sigmoidf_fast(acc[ai][bj][m][0][2 * e] * rs) * __builtin_bit_cast(float, pw[e] << 16);
                        v0[2 * e + 1] += sigmoidf_fast(acc[ai][bj][m][0][2 * e + 1] * rs) * __builtin_bit_cast(float, pw[e] & 0xffff0000u);
                        v1[2 * e] += sigmoidf_fast(acc[ai][bj][m][1][2 * e] * rs) * __builtin_bit_cast(float, pw[2 + e] << 16);
                        v1[2 * e + 1] += sigmoidf_fast(acc[ai][bj][m][1][2 * e + 1] * rs) * __builtin_bit_cast(float, pw[2 + e] & 0xffff0000u);
                    }
                    *(f32x4*)(h + off) = v0; *(f32x4*)(h + off + 4) = v1; *(u32x4*)(hb2 + off) = pack8(v0, v1);
                    ss += dot4(v0) + dot4(v1);
                }
                ss += __shfl_xor(ss, 16); ss += __shfl_xor(ss, 32);
                if (fq == 0) hp[(size_t)row * 16 + u.pn * 4 + wc] = ss;
                asm volatile("" ::: "memory");
            }
    }
};
__device__ __forceinline__ u32x2 pack4(f32x4 a) { u32x2 w = {cvtpk(a[0], a[1]), cvtpk(a[2], a[3])}; return w; }
struct EpiDqkv {
    const float* hp; const float* cosB; const float* sinB; bf16_t* cq; bf16_t* ckv; bf16_t* krope; float* cqp; float* kvp;
    __device__ __forceinline__ void operator()(const f32x4 (&acc)[2][2][4][2], const Unit& u, int wr, int wc, int fr, int fq) const {
#pragma unroll
        for (int ai = 0; ai < 2; ++ai)
#pragma unroll
            for (int m = 0; m < 4; ++m) {
                const int row = u.pm * 256 + 128 * ai + 64 * wr + 16 * m + fr, s = row & (NS - 1);
                const float rs = row_rs<16>(hp + (size_t)row * 16, 1.0f / 1024.0f);
                if (u.pn < 2) {
                    float ss = 0.f;
#pragma unroll
                    for (int bj = 0; bj < 2; ++bj) { const f32x4 v0 = acc[ai][bj][m][0] * rs, v1 = acc[ai][bj][m][1] * rs; ss += dot4(v0) + dot4(v1);
                        const int c = 128 * bj + 32 * wc + 8 * fq;
                        if (u.pn == 0) *(u32x4*)(cq + (size_t)row * 384 + c) = pack8(v0, v1); else *(u32x4*)(ckv + (size_t)row * 256 + c) = pack8(v0, v1); }
                    ss += __shfl_xor(ss, 16); ss += __shfl_xor(ss, 32);
                    if (fq == 0) { if (u.pn == 0) cqp[(size_t)row * 8 + wc] = ss; else kvp[(size_t)row * 4 + wc] = ss; }
                } else {
                    const f32x4 v0 = acc[ai][0][m][0] * rs, v1 = acc[ai][0][m][1] * rs;
                    float ss = dot4(v0) + dot4(v1);
                    *(u32x4*)(cq + (size_t)row * 384 + 256 + 32 * wc + 8 * fq) = pack8(v0, v1);
                    ss += __shfl_xor(ss, 16); ss += __shfl_xor(ss, 32);
                    if (fq == 0) cqp[(size_t)row * 8 + 4 + wc] = ss;
                    if (wc < 2) {
                        const int j = 16 * wc + 4 * fq;
                        const f32x4 cs = *(const f32x4*)(cosB + (size_t)s * 32 + j), sn = *(const f32x4*)(sinB + (size_t)s * 32 + j);
                        const f32x4 x1 = acc[ai][1][m][0] * rs, x2 = acc[ai][1][m][1] * rs;
                        *(u32x2*)(krope + (size_t)row * 64 + j) = pack4(x1 * cs - x2 * sn);
                        *(u32x2*)(krope + (size_t)row * 64 + 32 + j) = pack4(x1 * sn + x2 * cs);
                    }
                }
            }
    }
};
struct EpiUq {
    const float* cqp; const float* cosB; const float* sinB; bf16_t* q;
    __device__ __forceinline__ void operator()(const f32x4 (&acc)[2][2][4][2], const Unit& u, int wr, int wc, int fr, int fq) const {
        const int bb = u.pm >> 5;
#pragma unroll
        for (int ai = 0; ai < 2; ++ai)
#pragma unroll
            for (int m = 0; m < 4; ++m) {
                const int row = u.pm * 256 + 128 * ai + 64 * wr + 16 * m + fr, s = row & (NS - 1);
                const float rs = row_rs<8>(cqp + (size_t)row * 8, 1.0f / 384.0f);
#pragma unroll
                for (int bj = 0; bj < 2; ++bj) {
                    if (u.pn < 4) {
                        const int hh = 2 * u.pn + bj;
                        *(u32x4*)(q + ((size_t)(bb * NH + hh) * NS + s) * 192 + 32 * wc + 8 * fq) = pack8(acc[ai][bj][m][0] * rs, acc[ai][bj][m][1] * rs);
                    } else {
                        const int gidx = bj * 4 + wc, hh = 4 * (u.pn - 4) + (gidx >> 1), j = 16 * (gidx & 1) + 4 * fq;
                        const f32x4 cs = *(const f32x4*)(cosB + (size_t)s * 32 + j), sn = *(const f32x4*)(sinB + (size_t)s * 32 + j);
                        const f32x4 x1 = acc[ai][bj][m][0] * rs, x2 = acc[ai][bj][m][1] * rs;
                        bf16_t* d = q + ((size_t)(bb * NH + hh) * NS + s) * 192 + 128 + j;
                        *(u32x2*)d = pack4(x1 * cs - x2 * sn); *(u32x2*)(d + 32) = pack4(x1 * sn + x2 * cs);
                    }
                }
            }
    }
};
struct EpiUkv {
    const float* kvp; bf16_t* kn; bf16_t* v;
    __device__ __forceinline__ void operator()(const f32x4 (&acc)[2][2][4][2], const Unit& u, int wr, int wc, int fr, int fq) const {
        const int bb = u.pm >> 5;
#pragma unroll
        for (int ai = 0; ai < 2; ++ai)
#pragma unroll
            for (int m = 0; m < 4; ++m) {
                const int row = u.pm * 256 + 128 * ai + 64 * wr + 16 * m + fr, s = row & (NS - 1);
                const float rs = row_rs<4>(kvp + (size_t)row * 4, 1.0f / 256.0f);
                const size_t o = ((size_t)(bb * NH + u.pn) * NS + s) * 128 + 32 * wc + 8 * fq;
                *(u32x4*)(kn + o) = pack8(acc[ai][0][m][0] * rs, acc[ai][0][m][1] * rs);
                *(u32x4*)(v + o) = pack8(acc[ai][1][m][0] * rs, acc[ai][1][m][1] * rs);
            }
    }
};

struct WConv { const float* src0; const float* src1; const float* gain; bf16_t* dst; int N0, N1, K, Nout, kind; };
__device__ __forceinline__ int colmap(int kind, int n) {
    switch (kind) {
    case 1: {
        const int pn = n >> 8; if (pn >= 8) return n;
        const int t = pn >> 2, bj = (n >> 7) & 1, r = n & 127, hh = 2 * (pn & 3) + (r >> 6), d = 64 * bj + (r & 63);
        return t * 1024 + hh * 128 + d; }
    case 2: {
        if (n < 256) return n;
        if (n < 512) return 384 + (n - 256);
        if (n < 640) return 256 + (n - 512);
        const int r = n - 640, wc = r >> 5, fq = (r >> 3) & 3, nn = (r >> 2) & 1, i = r & 3;
        if (wc >= 2) return -1;
        return 384 + 256 + 32 * nn + 16 * wc + 4 * fq + i; }
    case 3: {
        if (n < 1024) return (n >> 7) * 192 + (n & 127);
        const int m = n - 1024, pn4 = m >> 8, gidx = (m >> 5) & 7, fq = (m >> 3) & 3, nn = (m >> 2) & 1, i = m & 3;
        const int hh = 4 * pn4 + (gidx >> 1), j = 16 * (gidx & 1) + 4 * fq + i;
        return hh * 192 + 128 + 32 * nn + j; }
    case 4: {
        const int q = n >> 8, bj = (n >> 7) & 1, r = n & 127;
        return bj * 256 + 128 * q + r; }
    default: return n;
    }
}
__device__ __forceinline__ void conv_item(const WConv& w, LAS float* scr, int item, int lane) {
    const int nblk = w.Nout / 32, kb = item / nblk, nb = item % nblk, k0 = 64 * kb, n0 = 32 * nb;
    const int n4 = lane & 7, ks = lane >> 3;
    const int s = colmap(w.kind, n0 + 4 * n4);
    const bool z = s < 0, first = s < w.N0;
    const float* sp = first ? w.src0 + s : w.src1 + (s - w.N0);
    const int ld = first ? w.N0 : w.N1;
    f32x4 v[8];
#pragma unroll
    for (int it = 0; it < 8; ++it) { const int k = it * 8 + ks; v[it] = z ? (f32x4){0.f, 0.f, 0.f, 0.f} : *(const f32x4*)(sp + (size_t)(k0 + k) * ld); }
#pragma unroll
    for (int it = 0; it < 8; ++it) { const int k = it * 8 + ks; const float g = w.gain ? w.gain[k0 + k] : 1.0f;
#pragma unroll
        for (int e = 0; e < 4; ++e) scr[k * 33 + 4 * n4 + e] = v[it][e] * g; }
    asm volatile("s_waitcnt lgkmcnt(0)" ::: "memory");
    const int c = lane & 7;
#pragma unroll
    for (int j = 0; j < 4; ++j) { const int n = (lane >> 3) + 8 * j; const LAS float* sv = scr + (8 * c) * 33 + n;
        u32x4 o; o.x = cvtpk(sv[0 * 33], sv[1 * 33]); o.y = cvtpk(sv[2 * 33], sv[3 * 33]); o.z = cvtpk(sv[4 * 33], sv[5 * 33]); o.w = cvtpk(sv[6 * 33], sv[7 * 33]);
        *(u32x4*)(w.dst + (size_t)(n0 + n) * w.K + k0 + 8 * c) = o; }
    asm volatile("s_waitcnt lgkmcnt(0)" ::: "memory");
}
__device__ __forceinline__ bool get_conv(int mi, const Args& a, WConv& w) {
    unsigned char* ws = a.ws;
    w.src1 = nullptr; w.N1 = 0; w.gain = nullptr; w.kind = 0;
    if (mi == 0) { w.src0 = a.in[6]; w.N0 = 3072; w.K = 1024; w.Nout = 3072; w.kind = 1; w.gain = a.in[2]; w.dst = (bf16_t*)(ws + WS_WQKV0); return true; }
    if (mi == 1) { w.src0 = a.in[7]; w.N0 = 1024; w.K = 1024; w.Nout = 1024; w.dst = (bf16_t*)(ws + WS_WO0); return true; }
    if (mi == 2) { w.src0 = a.in[8]; w.N0 = 384; w.src1 = a.in[11]; w.N1 = 320; w.K = 1024; w.Nout = 768; w.kind = 2; w.gain = a.in[2] + 1024; w.dst = (bf16_t*)(ws + WS_WDQKV); return true; }
    if (mi == 3) { w.src0 = a.in[10]; w.N0 = 1536; w.K = 384; w.Nout = 1536; w.kind = 3; w.gain = a.in[9]; w.dst = (bf16_t*)(ws + WS_WUQ); return true; }
    if (mi == 4) { w.src0 = a.in[13]; w.N0 = 2048; w.K = 256; w.Nout = 2048; w.gain = a.in[12]; w.dst = (bf16_t*)(ws + WS_WUKV); return true; }
    if (mi == 5) { w.src0 = a.in[14]; w.N0 = 1024; w.K = 1024; w.Nout = 1024; w.dst = (bf16_t*)(ws + WS_WO1); return true; }
    if (mi < 38) { const int le = mi - 6, l = le >> 4;
        w.src0 = a.in[17] + (size_t)le * 1024 * 256; w.N0 = 256; w.src1 = a.in[18] + (size_t)le * 1024 * 256; w.N1 = 256; w.K = 1024; w.Nout = 512; w.kind = 4;
        w.gain = a.in[3] + l * 1024; w.dst = (bf16_t*)(ws + WS_WGU) + (size_t)le * 512 * 1024; return true; }
    if (mi < 70) { const int le = mi - 38;
        w.src0 = a.in[19] + (size_t)le * 256 * 1024; w.N0 = 1024; w.K = 256; w.Nout = 1024; w.dst = (bf16_t*)(ws + WS_WD) + (size_t)le * 1024 * 256; return true; }
    if (mi < 72) { const int l = mi - 70;
        w.src0 = a.in[20] + (size_t)l * 1024 * 1024; w.N0 = 1024; w.K = 1024; w.Nout = 1024; w.gain = a.in[4] + l * 1024; w.dst = (bf16_t*)(ws + WS_WPG) + (size_t)l * 1024 * 1024; return true; }
    if (mi < 74) { const int l = mi - 72;
        w.src0 = a.in[21] + (size_t)l * 256 * 1024; w.N0 = 1024; w.K = 256; w.Nout = 1024; w.dst = (bf16_t*)(ws + WS_WPP) + (size_t)l * 1024 * 256; return true; }
    return false;
}

__device__ __forceinline__ void p_prologue(const Args& a, LAS unsigned char* lds, int vcu, int G) {
    int tid = threadIdx.x; asm volatile("" : "+v"(tid));
    const int lane = tid & 63, wave = __builtin_amdgcn_readfirstlane(tid >> 6);
    const int gw = vcu * NWAVES + wave, NGW = G * NWAVES;
    unsigned char* ws = a.ws;
    LAS float* scr = (LAS float*)(lds + wave * 16384);
    int base = 0;
    for (int mi = 0; mi < 74; ++mi) {
        WConv w; get_conv(mi, a, w);
        const int n = (w.K / 64) * (w.Nout / 32);
        int it = (gw - (base % NGW) + NGW) % NGW;
        for (; it < n; it += NGW) conv_item(w, scr, it, lane);
        base += n;
    }
    {   const float* x = a.in[0]; bf16_t* hb = (bf16_t*)(ws + WS_HB); float* hpx = (float*)(ws + WS_HPX);
        for (int m = gw; m < NT; m += 2 * NGW) {
            const int m2 = (m + NGW < NT) ? m + NGW : m;
            const f32x4* xr = (const f32x4*)(x + (size_t)m * 1024) + lane; const f32x4* xr2 = (const f32x4*)(x + (size_t)m2 * 1024) + lane;
            f32x4 v[4], v2[4]; float s = 0.f, s2 = 0.f;
#pragma unroll
            for (int j = 0; j < 4; ++j) { v[j] = xr[64 * j]; v2[j] = xr2[64 * j]; }
#pragma unroll
            for (int j = 0; j < 4; ++j) { s += dot4(v[j]); s2 += dot4(v2[j]); }
            s = wave_sum(s); s2 = wave_sum(s2);
            u32x2* o8 = (u32x2*)(hb + (size_t)m * 1024) + lane; u32x2* o82 = (u32x2*)(hb + (size_t)m2 * 1024) + lane;
#pragma unroll
            for (int j = 0; j < 4; ++j) { u32x2 o; o.x = cvtpk(v[j][0], v[j][1]); o.y = cvtpk(v[j][2], v[j][3]); o8[64 * j] = o;
                                          u32x2 o2; o2.x = cvtpk(v2[j][0], v2[j][1]); o2.y = cvtpk(v2[j][2], v2[j][3]); o82[64 * j] = o2; }
            if (lane < 16) { hpx[(size_t)m * 16 + lane] = (lane == 0) ? s : 0.f; hpx[(size_t)m2 * 16 + lane] = (lane == 0) ? s2 : 0.f; }
        } }
    {   const int gt = (vcu * NTHR) + tid, NGT = G * NTHR;
        float* cosA = (float*)(ws + WS_COSA); float* sinA = (float*)(ws + WS_SINA); float* cosB = (float*)(ws + WS_COSB); float* sinB = (float*)(ws + WS_SINB);
        for (int i = gt; i < NS * 64; i += NGT) { const int s = i >> 6, j = i & 63; const float inv = powf(10000.0f, -(float)j / 64.0f); float sn, cs; sincosf((float)s * inv, &sn, &cs); cosA[i] = cs; sinA[i] = sn; }
        for (int i = gt; i < NS * 32; i += NGT) { const int s = i >> 5, j = i & 31; const float inv = powf(10000.0f, -(float)j / 32.0f); float sn, cs; sincosf((float)s * inv, &sn, &cs); cosB[i] = cs; sinB[i] = sn; }
        float* km = (float*)(ws + WS_KMEAN);
        for (int i = gt; i < NB * NH * 32 * 128; i += NGT) km[i] = 0.f;
        float* wrt = (float*)(ws + WS_WRT);
        for (int i = gt; i < 2 * 1024 * 20; i += NGT) { const int l = i / 20480, r = i % 20480, k = r / 20, c = r % 20;
            const float g = a.in[3][l * 1024 + k];
            wrt[i] = g * (c < 4 ? a.in[15][(size_t)(l * 1024 + k) * 4 + c] : a.in[16][(size_t)(l * 1024 + k) * 16 + (c - 4)]); }
    }
}

template <int DQK, int MODE>
__device__ __forceinline__ void p_attention(const Args& a, unsigned char* ldsg) {
    unsigned char* ws = a.ws;
    for (int L = blockIdx.x; L < 512; L += gridDim.x) {
        const int xcd = L & 7, k = L >> 3, bh = xcd + 8 * (k >> 4), x = k & 15, b = bh >> 3, h = bh & 7;
        for (int pass = 0; pass < 2; ++pass) {
            const int qb = pass ? x : 31 - x, P0 = qb * 256;
            bf16_t* Op = (bf16_t*)(ws + WS_O) + ((size_t)(b * NS + P0) * 1024 + h * 128);
            if (MODE == 1) {
                const bf16_t* Q = (const bf16_t*)(ws + WS_Q) + (size_t)bh * NS * 128;
                const bf16_t* Kp = (const bf16_t*)(ws + WS_K0) + (size_t)bh * NS * 128;
                const bf16_t* Vp = (const bf16_t*)(ws + WS_V0) + (size_t)bh * NS * 128;
                at::attn_unit<DQK, MODE>((char*)ldsg, Q + (size_t)P0 * 128, Kp, nullptr, Vp, Op, P0, (const float*)(ws + WS_KMEAN) + (size_t)bh * 32 * 128);
            } else {
                const bf16_t* Q = (const bf16_t*)(ws + WS_Q) + (size_t)bh * NS * 192;
                const bf16_t* Kp = (const bf16_t*)(ws + WS_KN1) + (size_t)bh * NS * 128;
                const bf16_t* Kr = (const bf16_t*)(ws + WS_KROPE) + (size_t)b * NS * 64;
                const bf16_t* Vp = (const bf16_t*)(ws + WS_V1) + (size_t)bh * NS * 128;
                at::attn_unit<DQK, MODE>((char*)ldsg, Q + (size_t)P0 * 192, Kp, Kr, Vp, Op, P0, nullptr);
            }
        }
    }
}

__global__ void __launch_bounds__(NTHR, 2) mega(Args a) {
    extern __shared__ __attribute__((aligned(16))) unsigned char lds_g[];
    LAS unsigned char* lds = (LAS unsigned char*)lds_g;
    const int tid = threadIdx.x;
    const int G = gridDim.x, bx = blockIdx.x, vcu = (G % 8 == 0) ? (bx % 8) * (G / 8) + bx / 8 : bx;
    unsigned char* ws = a.ws;
    volatile LAS unsigned* MISC = (volatile LAS unsigned*)(lds + LDS_MISC);
    for (int u = tid; u < 256; u += NTHR) MISC[u] = 0u;
    __syncthreads();
    XcdBarrier bar = xcd_barrier_post((unsigned*)(ws + WS_CTL) + CW_BAR, MISC);
    const int lo = a.ph_lo, hi = a.ph_hi;
#ifndef DBG_ONLY
#define DBG_EN(k) true
#else
#define DBG_EN(k) ((k) == DBG_ONLY)
#endif
#define IN(k) (DBG_EN(k) && lo <= (k) && (k) < hi)
#define SEAM(k) do { if (IN(k) && IN((k) + 1)) xcd_barrier(bar); } while (0)
    if (IN(0)) { p_prologue(a, lds, vcu, G); }
    SEAM(0);
    if (IN(1)) {
        g8::DenseP P{(const char*)(ws + WS_HB), (const char*)(ws + WS_WQKV0), 1024, 1024, 1024, NT / 256, 3072 / 256, G, bx};
        EpiQKV E{(const float*)(ws + WS_HPX), (const float*)(ws + WS_COSA), (const float*)(ws + WS_SINA), (bf16_t*)(ws + WS_Q), (bf16_t*)(ws + WS_K0), (bf16_t*)(ws + WS_V0), (float*)(ws + WS_KMEAN)};
        g8::gemm_phase(lds, P, E);
    }
    SEAM(1);
    if (IN(2)) { p_attention<128, 1>(a, lds_g); }
    SEAM(2);
    if (IN(3)) {
        g8::DenseP P{(const char*)(ws + WS_O), (const char*)(ws + WS_WO0), 1024, 1024, 1024, NT / 256, 4, G, bx};
        EpiResid E{a.in[0], a.out, (bf16_t*)(ws + WS_HB), (float*)(ws + WS_HP0)};
        g8::gemm_phase(lds, P, E);
    }
    SEAM(3);
#define MOE_PLE(PB, layer) \
    if (IN((PB) + 0)) { p_route(a, lds, (layer), vcu, G); } \
    SEAM((PB) + 0); \
    if (IN((PB) + 1)) { \
        const int NRT = moe_prefix(a, lds, (layer)); \
        const unsigned* cnt = (const unsigned*)(ws + WS_CTL) + CW_CNT + (layer) * 24 * 16; \
        MoeUnits U{(LAS const int*)(lds + LDS_TB), NRT, G, bx}; \
        MoeGuP P{(const char*)(ws + WS_HB), (const char*)(ws + WS_WGU) + (size_t)(layer) * 16 * 512 * 1024 * 2, (const int*)(ws + WS_LIST), cnt, U, 1024, 1024}; \
        EpiGateUp E{(const float*)(ws + WS_HP0), (const float*)(ws + WS_TOKW), (const int*)(ws + WS_LIST), cnt, (LAS const int*)(lds + LDS_TB), (bf16_t*)(ws + WS_ACT)}; \
        g8::gemm_phase(lds, P, E); \
        g8::DenseP P2{(const char*)(ws + WS_PB), (const char*)(ws + WS_WPP) + (size_t)(layer) * 1024 * 256 * 2, 256, 256, 256, NT / 256, 4, G, bx}; \
        EpiStore E2{(bf16_t*)(ws + WS_PP), 1024}; \
        g8::gemm_phase(lds, P2, E2); \
    } \
    SEAM((PB) + 1); \
    if (IN((PB) + 2)) { \
        const int NRT = moe_prefix(a, lds, (layer)); \
        const unsigned* cnt = (const unsigned*)(ws + WS_CTL) + CW_CNT + (layer) * 24 * 16; \
        MoeUnits U{(LAS const int*)(lds + LDS_TB), NRT, G, bx}; \
        MoeDownP P{(const char*)(ws + WS_ACT), (const char*)(ws + WS_WD) + (size_t)(layer) * 16 * 1024 * 256 * 2, U, 256, 512}; \
        EpiDown E{a.out, (bf16_t*)(ws + WS_HB), (float*)(ws + WS_HP1), (const int*)(ws + WS_LIST), cnt, (LAS const int*)(lds + LDS_TB)}; \
        g8::gemm_phase(lds, P, E); \
    } \
    SEAM((PB) + 2); \
    if (IN((PB) + 3)) { \
        g8::DenseP P{(const char*)(ws + WS_HB), (const char*)(ws + WS_WPG) + (size_t)(layer) * 1024 * 1024 * 2, 1024, 1024, 1024, NT / 256, 4, G, bx}; \
        EpiPle E{(const float*)(ws + WS_HP1), (const bf16_t*)(ws + WS_PP), a.out, (bf16_t*)(ws + WS_O), (float*)(ws + WS_HP2)}; \
        g8::gemm_phase(lds, P, E); \
    } \
    SEAM((PB) + 3);
    MOE_PLE(4, 0)
    if (IN(8)) {
        g8::DenseP P{(const char*)(ws + WS_O), (const char*)(ws + WS_WDQKV), 1024, 1024, 1024, NT / 256, 3, G, bx};
        EpiDqkv E{(const float*)(ws + WS_HP2), (const float*)(ws + WS_COSB), (const float*)(ws + WS_SINB), (bf16_t*)(ws + WS_CQ), (bf16_t*)(ws + WS_CKV), (bf16_t*)(ws + WS_KROPE), (float*)(ws + WS_CQP), (float*)(ws + WS_KVP)};
        g8::gemm_phase(lds, P, E);
    }
    SEAM(8);
    if (IN(9)) {
        g8::DenseP P{(const char*)(ws + WS_CQ), (const char*)(ws + WS_WUQ), 384, 384, 384, NT / 256, 6, G, bx};
        EpiUq E{(const float*)(ws + WS_CQP), (const float*)(ws + WS_COSB), (const float*)(ws + WS_SINB), (bf16_t*)(ws + WS_Q)};
        g8::gemm_phase(lds, P, E);
        g8::DenseP P2{(const char*)(ws + WS_CKV), (const char*)(ws + WS_WUKV), 256, 256, 256, NT / 256, 8, G, bx};
        EpiUkv E2{(const float*)(ws + WS_KVP), (bf16_t*)(ws + WS_KN1), (bf16_t*)(ws + WS_V1)};
        g8::gemm_phase(lds, P2, E2);
    }
    SEAM(9);
    if (IN(10)) { p_attention<192, 0>(a, lds_g); }
    SEAM(10);
    if (IN(11)) {
        g8::DenseP P{(const char*)(ws + WS_O), (const char*)(ws + WS_WO1), 1024, 1024, 1024, NT / 256, 4, G, bx};
        EpiResid E{a.out, a.out, (bf16_t*)(ws + WS_HB), (float*)(ws + WS_HP0)};
        g8::gemm_phase(lds, P, E);
    }
    SEAM(11);
    MOE_PLE(12, 1)
    if (IN(16)) {
        int t2 = threadIdx.x; asm volatile("" : "+v"(t2)); const int lane = t2 & 63, wave = t2 >> 6; const float* fg = a.in[5];
        for (int mrow = vcu * NWAVES + wave; mrow < NT; mrow += G * NWAVES) {
            f32x4* xr = (f32x4*)(a.out + (size_t)mrow * 1024) + lane;
            f32x4 v[4]; float s = 0.f;
#pragma unroll
            for (int j = 0; j < 4; ++j) { v[j] = xr[64 * j]; s += dot4(v[j]); }
            s = wave_sum(s);
            const float r = rsqrtf(s * (1.0f / 1024.0f) + EPS);
#pragma unroll
            for (int j = 0; j < 4; ++j) xr[64 * j] = v[j] * r * *((const f32x4*)fg + lane + 64 * j);
        }
    }
#undef IN
#undef SEAM
}

constexpr int N_PHASES = 17;
static int g_grid = 0;
static bool setup() {
    if (g_grid) return g_grid > 0;
    int dev = 0, cus = 0;
    if (hipGetDevice(&dev) != hipSuccess || hipDeviceGetAttribute(&cus, hipDeviceAttributeMultiprocessorCount, dev) != hipSuccess) { g_grid = -1; return false; }
    if (hipFuncSetAttribute((const void*)mega, hipFuncAttributeMaxDynamicSharedMemorySize, LDS_BYTES) != hipSuccess) { fprintf(stderr, "hipFuncSetAttribute failed\n"); g_grid = -1; return false; }
    int per_cu = 0;
    if (hipOccupancyMaxActiveBlocksPerMultiprocessor(&per_cu, (const void*)mega, NTHR, LDS_BYTES) != hipSuccess || per_cu < 1) { fprintf(stderr, "occupancy query: %d\n", per_cu); }
    (void)hipGetLastError();
    g_grid = cus;
    return true;
}
static void run_phases(const Args& base, int lo, int hi, bool one_launch, hipStream_t st) {
    if (one_launch) { Args a = base; a.ph_lo = lo; a.ph_hi = hi; hipLaunchKernelGGL(mega, dim3(g_grid), dim3(NTHR), LDS_BYTES, st, a); }
    else for (int p = lo; p < hi; ++p) { Args a = base; a.ph_lo = p; a.ph_hi = p + 1;
#ifdef PROBE_ROUTE
        if (p == 4) { Args b = base; b.ph_lo = 12; b.ph_hi = 13; hipLaunchKernelGGL(mega, dim3(g_grid), dim3(NTHR), LDS_BYTES, st, b); }
        if (p == 12) (void)hipMemsetAsync(base.ws + WS_CTL + (CW_CNT + 24 * 16) * 4, 0, 24 * 16 * 4, st);
#endif
        hipLaunchKernelGGL(mega, dim3(g_grid), dim3(NTHR), LDS_BYTES, st, a);
#ifdef DOUBLE_PHASE
        if (p == DOUBLE_PHASE) hipLaunchKernelGGL(mega, dim3(g_grid), dim3(NTHR), LDS_BYTES, st, a);
#endif
    }
}
}
#ifndef ONE_LAUNCH
#define ONE_LAUNCH 1
#endif
extern "C" void kernel_launch(void* const* d_in, const int* in_sizes, int n_in, void* d_out, int out_size, void* d_ws, size_t ws_size, hipStream_t stream) {
    (void)in_sizes; (void)out_size;
    if (n_in != 22) { fprintf(stderr, "kernel_launch: expected 22 inputs, got %d\n", n_in); return; }
    if (ws_size < fk::WS_END) { fprintf(stderr, "kernel_launch: workspace too small (%zu)\n", ws_size); return; }
    if (!fk::setup()) return;
    (void)hipMemsetAsync((char*)d_ws + fk::WS_CTL, 0, fk::CTL_ZERO_BYTES, stream);
    fk::Args a{};
    for (int i = 0; i < 22; ++i) a.in[i] = (const float*)d_in[i];
    a.out = (float*)d_out; a.ws = (unsigned char*)d_ws;
    fk::run_phases(a, 0, fk::N_PHASES, ONE_LAUNCH != 0, stream);
}
```

```cpp
#include <hip/hip_runtime.h>
#include <cstdio>
#include <cstdint>
#include <cmath>
namespace fk {
#define LAS __attribute__((address_space(3)))
#define GAS __attribute__((address_space(1)))
typedef unsigned short bf16_t;
typedef short bf16x8 __attribute__((ext_vector_type(8)));
typedef short s16x4 __attribute__((ext_vector_type(4)));
typedef float f32x4 __attribute__((ext_vector_type(4)));
typedef float f32x16 __attribute__((ext_vector_type(16)));
typedef unsigned u32x4 __attribute__((ext_vector_type(4)));
typedef unsigned u32x2 __attribute__((ext_vector_type(2)));
typedef float f32x2_t __attribute__((ext_vector_type(2)));
typedef __bf16 bf16x2_t __attribute__((ext_vector_type(2)));

constexpr int NB = 4, NS = 8192, ND = 1024, NT = NB * NS, NH = 8;
constexpr float EPS = 1e-6f;
constexpr int NWAVES = 8, NTHR = 512;

constexpr size_t MiB = 1u << 20;
constexpr size_t WS_CTL = 0, CTL_ZERO_BYTES = 1 * MiB;
constexpr size_t WS_COSA = 1 * MiB, WS_SINA = 3 * MiB, WS_COSB = 5 * MiB, WS_SINB = 6 * MiB;
constexpr size_t WS_KMEAN = 7 * MiB;
constexpr size_t WS_WRT = 7 * MiB + 512 * 1024;
constexpr size_t WS_HPX = 8 * MiB, WS_HP0 = 10 * MiB, WS_HP1 = 12 * MiB, WS_HP2 = 14 * MiB;
constexpr size_t WS_CQP = 16 * MiB, WS_KVP = 17 * MiB;
constexpr size_t WS_TOKW = 18 * MiB;
constexpr size_t WS_LIST = 19 * MiB;
constexpr size_t WS_WQKV0 = 24 * MiB, WS_WO0 = 30 * MiB, WS_WDQKV = 32 * MiB, WS_WUQ = 34 * MiB, WS_WUKV = 36 * MiB, WS_WO1 = 37 * MiB;
constexpr size_t WS_WGU = 40 * MiB;
constexpr size_t WS_WD = 72 * MiB;
constexpr size_t WS_WPG = 88 * MiB;
constexpr size_t WS_WPP = 92 * MiB;
constexpr size_t WS_HB = 94 * MiB;
constexpr size_t WS_CQ = WS_HB, WS_CKV = WS_HB + 24 * MiB, WS_KROPE = WS_HB + 40 * MiB;
constexpr size_t WS_O = 158 * MiB;
constexpr size_t WS_R = 222 * MiB;
constexpr size_t WS_Q = WS_R, WS_K0 = WS_R + 64 * MiB, WS_V0 = WS_R + 128 * MiB;
constexpr size_t WS_KN1 = WS_R + 96 * MiB, WS_V1 = WS_R + 160 * MiB;
constexpr size_t WS_ACT = WS_R, WS_PB = WS_R + 40 * MiB, WS_PP = WS_R + 64 * MiB;
constexpr size_t WS_END = WS_R + 224 * MiB;
constexpr int CW_CNT = 1024;
constexpr int CW_BAR = 4096;

constexpr int RING_BYTES = 131072;
constexpr int LDS_MISC = RING_BYTES;
constexpr int LDS_BYTES = 147456;

struct Args { const float* in[22]; float* out; unsigned char* ws; int ph_lo, ph_hi; };

__device__ __forceinline__ unsigned cvtpk(float lo, float hi) { f32x2_t v = {lo, hi}; bf16x2_t b = __builtin_convertvector(v, bf16x2_t); return __builtin_bit_cast(unsigned, b); }
__device__ __forceinline__ float bf2f(unsigned short b) { return __builtin_bit_cast(float, (unsigned)b << 16); }
__device__ __forceinline__ u32x4 pack8(f32x4 a, f32x4 b) { u32x4 w = {cvtpk(a[0], a[1]), cvtpk(a[2], a[3]), cvtpk(b[0], b[1]), cvtpk(b[2], b[3])}; return w; }
__device__ __forceinline__ float wave_sum(float v) {
#pragma unroll
    for (int o = 1; o < 64; o <<= 1) v += __shfl_xor(v, o);
    return v;
}
__device__ __forceinline__ float dot4(f32x4 a) { return (a[0] * a[0] + a[1] * a[1]) + (a[2] * a[2] + a[3] * a[3]); }
template <int NP> __device__ __forceinline__ float row_rs(const float* hp, float invd) {
    float s = 0.f;
#pragma unroll
    for (int i = 0; i < NP / 4; ++i) { const f32x4 a = *(const f32x4*)(hp + 4 * i); s += (a[0] + a[1]) + (a[2] + a[3]); }
    return rsqrtf(s * invd + EPS);
}

#define XB_TMO      128
#define XB_XCNT(j)  (256  + 64 * (j))
#define XB_XSUB(j)  (1280 + 64 * (j))
#define XB_XGEN(j)  (2304 + 64 * (j))
#define XB_TOP      3328
#define XB_TOPGEN   3392
#define XCD_BAR_WORDS 3456
#define XB_SPIN_CAP (1u << 18)
__device__ __forceinline__ unsigned xb_ld(unsigned* p)              { return __hip_atomic_load(p, __ATOMIC_RELAXED, __HIP_MEMORY_SCOPE_AGENT); }
__device__ __forceinline__ unsigned xb_add(unsigned* p, unsigned v) { return __hip_atomic_fetch_add(p, v, __ATOMIC_RELAXED, __HIP_MEMORY_SCOPE_AGENT); }
__device__ __forceinline__ unsigned xb_xcc_id() { return (unsigned)__builtin_amdgcn_s_getreg((3 << 11) | 20) & 0xFu; }
#define XB_SPIN(cond, bar) do { unsigned _sp = 0; while (cond) { __builtin_amdgcn_s_sleep(1); \
    if ((++_sp & 255u) == 0u) { if (xb_ld(&(bar)[XB_TMO])) break; if (_sp > XB_SPIN_CAP) { atomicAdd(&(bar)[XB_TMO], 1u); break; } } } } while (0)
struct XcdBarrier { unsigned* bar; unsigned x; volatile LAS unsigned* st; };
__device__ __forceinline__ XcdBarrier xcd_barrier_post(unsigned* bar, volatile LAS unsigned* st) {
    XcdBarrier b; b.bar = bar; b.x = xb_xcc_id(); b.st = st;
    if (threadIdx.x == 0) (void)xb_add(&bar[XB_XCNT(b.x)], 1u);
    return b;
}
__device__ __forceinline__ void xcd_barrier_complete(unsigned* bar, unsigned x, unsigned& nloc, unsigned& nx) {
    const unsigned G = gridDim.x * gridDim.y * gridDim.z;
    unsigned sum, cnt, mine, sp = 0u;
    for (;;) {
        sum = 0u; cnt = 0u; mine = 0u;
#pragma unroll
        for (unsigned j = 0; j < 16; ++j) { const unsigned c = xb_ld(&bar[XB_XCNT(j)]); sum += c; cnt += (c > 0u) ? 1u : 0u; mine = (j == x) ? c : mine; }
        if (sum == G) break;
        __builtin_amdgcn_s_sleep(1);
        if ((++sp & 255u) == 0u) { if (xb_ld(&bar[XB_TMO])) break; if (sp > XB_SPIN_CAP) { atomicAdd(&bar[XB_TMO], 1u); break; } }
    }
    nloc = mine > 0u ? mine : 1u; nx = cnt > 0u ? cnt : 1u;
}
__device__ __forceinline__ void xcd_barrier(const XcdBarrier& b) {
    asm volatile("s_waitcnt vmcnt(0)" ::: "memory");
    __syncthreads();
    if (threadIdx.x == 0) {
        unsigned* bar = b.bar;
        __builtin_amdgcn_s_waitcnt(0);
        unsigned nloc = b.st[0], nx = b.st[1];
        if (nloc == 0u) { xcd_barrier_complete(bar, b.x, nloc, nx); b.st[0] = nloc; b.st[1] = nx; }
        const unsigned old = xb_add(&bar[XB_XSUB(b.x)], 1u);
        const unsigned gen = old / nloc;
        if (old + 1u == (gen + 1u) * nloc) {
            __builtin_amdgcn_fence(__ATOMIC_RELEASE, "agent");
            asm volatile("s_waitcnt vmcnt(0)" ::: "memory");
            const unsigned og = xb_add(&bar[XB_TOP], 1u);
            const unsigned tg = og / nx;
            if (og + 1u == (tg + 1u) * nx) xb_add(&bar[XB_TOPGEN], 1u);
            else XB_SPIN(xb_ld(&bar[XB_TOPGEN]) == tg, bar);
            __builtin_amdgcn_fence(__ATOMIC_ACQUIRE, "agent");
            xb_add(&bar[XB_XGEN(b.x)], 1u);
            asm volatile("s_waitcnt vmcnt(0)" ::: "memory");
        } else {
            XB_SPIN(xb_ld(&bar[XB_XGEN(b.x)]) == gen, bar);
            __builtin_amdgcn_fence(__ATOMIC_ACQUIRE, "agent");
            asm volatile("s_waitcnt vmcnt(0)" ::: "memory");
        }
    }
    __syncthreads();
}

namespace g8 {
constexpr int BM = 256, BK = 64, HALF = 128, HTB = HALF * BK * 2, STAGE_BYTES = 8 * HTB, NXCD = 8, WGM = 8;
__device__ __forceinline__ int lds_byte(int r, int c) { const int st = (r >> 4) * 2 + (c >> 5), rr = r & 15, cc = c & 31, ob = rr * 64 + cc * 2; return st * 1024 + (ob ^ (((ob >> 9) & 1) << 5)); }
__device__ __forceinline__ void stage_rc(int b, int& R, int& C) { const int st = b / 1024, sb = b % 1024, swz = sb ^ (((sb >> 9) & 1) << 5); R = (st >> 1) * 16 + swz / 64; C = (st & 1) * 32 + (swz % 64) / 2; }
__device__ __forceinline__ int perm32(int rho) { const int n = rho >> 4, i = rho & 15; return 8 * (i >> 2) + 4 * n + (i & 3); }
struct Unit { int pm, pn, aux; };
struct AOff { unsigned o[2][2]; };

__device__ __forceinline__ bool static_order(int i, int G, int c, int nM, int nN, int& pm, int& pn) {
    const int nwg = nM * nN; const long L = (long)i * G + c; if (L >= nwg) return false;
    int wgid = (int)L; { const int q = nwg / NXCD, r = nwg % NXCD, xcd = wgid % NXCD, off = wgid / NXCD; wgid = (xcd < r ? xcd * (q + 1) : r * (q + 1) + (xcd - r) * q) + off; }
    const int nig = WGM * nN, gid = wgid / nig, fm = gid * WGM, gsz = (nM - fm) < WGM ? (nM - fm) : WGM;
    pm = fm + ((wgid % nig) % gsz); pn = (wgid % nig) / gsz; return true;
}
struct DenseP {
    const char* A; const char* B; int lda, ldb, K, nM, nN, G, c;
    __device__ __forceinline__ bool next(int i, Unit& u) const { u.aux = 0; return static_order(i, G, c, nM, nN, u.pm, u.pn); }
    __device__ __forceinline__ void aoff(const Unit& u, const int (&R)[2], const int (&C)[2], AOff& o) const {
#pragma unroll
        for (int h = 0; h < 2; ++h)
#pragma unroll
            for (int i = 0; i < 2; ++i) o.o[h][i] = (unsigned)(((u.pm * BM + h * HALF + R[i]) * lda + C[i]) * 2);
    }
    __device__ __forceinline__ const char* bbase(const Unit& u, int kt) const { return B + ((size_t)u.pn * BM * ldb + (size_t)kt * BK) * 2; }
};

template <class Prov, class Epi>
__device__ __forceinline__ void gemm_phase(LAS unsigned char* lds, const Prov& P, const Epi& E) {
    int tid = threadIdx.x; asm volatile("" : "+v"(tid));
    const int wid = __builtin_amdgcn_readfirstlane(tid >> 6), lane = tid & 63, wr = wid >> 2, wc = wid & 3, fr = lane & 15, fq = lane >> 4;
    const int K = P.K, nt = K / BK;
    int R[2], C[2]; unsigned voffB[2];
#pragma unroll
    for (int i = 0; i < 2; ++i) { stage_rc(tid * 16 + i * 8192, R[i], C[i]); const int Rb = (R[i] & ~31) + perm32(R[i] & 31); voffB[i] = (unsigned)(Rb * P.ldb + C[i]) * 2u; }
    const size_t hstepB = (size_t)HALF * P.ldb * 2;
    const unsigned ldsw = (unsigned)wid * 1024u;
    const int aoff = lds_byte(wr * 64 + fr, fq * 8), boff = lds_byte(wc * 32 + fr, fq * 8);
#define G8_SA(b, h) (((b) * 2 + (h)) * HTB)
#define G8_SB(b, h) ((4 + (b) * 2 + (h)) * HTB)
#define G8_STAGE_A(bufoff, h, AO, kb) do { _Pragma("unroll") for (int _i = 0; _i < 2; ++_i) \
        __builtin_amdgcn_global_load_lds((const unsigned*)(P.A + (size_t)((AO).o[h][_i] + (kb))), (LAS unsigned*)(lds + (bufoff) + ldsw + _i * 8192), 16, 0, 0); } while (0)
#define G8_STAGE_B(bufoff, bp) do { _Pragma("unroll") for (int _i = 0; _i < 2; ++_i) \
        __builtin_amdgcn_global_load_lds((const unsigned*)((bp) + voffB[_i]), (LAS unsigned*)(lds + (bufoff) + ldsw + _i * 8192), 16, 0, 0); } while (0)
#define G8_LDA(dst, b, h) do { _Pragma("unroll") for (int m = 0; m < 4; ++m) _Pragma("unroll") for (int k = 0; k < 2; ++k) dst[m][k] = *(const LAS bf16x8*)(lds + G8_SA(b, h) + aoff + m * 2048 + k * 1024); } while (0)
#define G8_LDB(dst, b, h) do { _Pragma("unroll") for (int n = 0; n < 2; ++n) _Pragma("unroll") for (int k = 0; k < 2; ++k) dst[n][k] = *(const LAS bf16x8*)(lds + G8_SB(b, h) + boff + n * 2048 + k * 1024); } while (0)
#define G8_MMA(ai, bj, At, Bt) do { __builtin_amdgcn_s_setprio(1); _Pragma("unroll") for (int m = 0; m < 4; ++m) _Pragma("unroll") for (int n = 0; n < 2; ++n) _Pragma("unroll") for (int k = 0; k < 2; ++k) \
        acc[ai][bj][m][n] = __builtin_amdgcn_mfma_f32_16x16x32_bf16(Bt[n][k], At[m][k], acc[ai][bj][m][n], 0, 0, 0); __builtin_amdgcn_s_setprio(0); } while (0)
#define G8_WAIT_V(n) asm volatile("s_waitcnt vmcnt(" #n ")" ::: "memory")
#define G8_WAIT_L(n) asm volatile("s_waitcnt lgkmcnt(" #n ")" ::: "memory")
#define G8_BAR __builtin_amdgcn_s_barrier()
#define G8_SCHED __builtin_amdgcn_sched_barrier(0)
    Unit cur, nxt; int ui = 0;
    if (!P.next(0, cur)) return;
    f32x4 acc[2][2][4][2];
#pragma unroll
    for (int a = 0; a < 2; ++a)
#pragma unroll
        for (int b = 0; b < 2; ++b)
#pragma unroll
            for (int m = 0; m < 4; ++m)
#pragma unroll
                for (int n = 0; n < 2; ++n) acc[a][b][m][n] = (f32x4){0.f, 0.f, 0.f, 0.f};
    bf16x8 At[4][2], B0[2][2], B1[2][2];
    AOff cA, nA;
    P.aoff(cur, R, C, cA);
    {   const char* b0 = P.bbase(cur, 0); const char* b1 = P.bbase(cur, 1);
        G8_STAGE_B(G8_SB(0, 0), b0); G8_STAGE_B(G8_SB(0, 1), b0 + hstepB); G8_STAGE_A(G8_SA(0, 0), 0, cA, 0u); G8_STAGE_A(G8_SA(0, 1), 1, cA, 0u);
        if (wr == 1) G8_BAR;
        G8_WAIT_V(2); G8_BAR;
        G8_STAGE_B(G8_SB(1, 0), b1); G8_STAGE_A(G8_SA(1, 0), 0, cA, 128u); G8_STAGE_B(G8_SB(1, 1), b1 + hstepB);
        G8_WAIT_V(6); G8_BAR; }
    for (;;) {
        const bool has_next = P.next(ui + 1, nxt);
        if (has_next) P.aoff(nxt, R, C, nA); else { nA = cA; nxt = cur; }
        for (int t = 0; t < nt; t += 2) {
            const bool last = (t == nt - 2);
            const unsigned kb1 = (unsigned)(t + 1) * 128u;
            const unsigned kb2 = last ? 0u : (unsigned)(t + 2) * 128u, kb3 = kb2 + 128u;
            AOff s;
#pragma unroll
            for (int h = 0; h < 2; ++h)
#pragma unroll
                for (int i = 0; i < 2; ++i) s.o[h][i] = last ? nA.o[h][i] : cA.o[h][i];
            const char* b2 = last ? P.bbase(nxt, 0) : P.bbase(cur, t + 2);
            const char* b3 = last ? P.bbase(nxt, 1) : P.bbase(cur, t + 3);
            G8_LDB(B0, 0, 0); G8_LDB(B1, 0, 1); G8_SCHED; G8_LDA(At, 0, 0); G8_STAGE_A(G8_SA(1, 1), 1, cA, kb1);
            G8_WAIT_V(8); G8_WAIT_L(0); G8_BAR; G8_MMA(0, 0, At, B0); G8_MMA(0, 1, At, B1); G8_BAR; G8_SCHED;
            G8_LDA(At, 0, 1); G8_STAGE_B(G8_SB(0, 0), b2); G8_STAGE_B(G8_SB(0, 1), b2 + hstepB); G8_STAGE_A(G8_SA(0, 0), 0, s, kb2);
            G8_WAIT_V(8); G8_WAIT_L(0); G8_BAR; G8_MMA(1, 0, At, B0); G8_MMA(1, 1, At, B1); G8_BAR; G8_SCHED;
            G8_LDB(B0, 1, 0); G8_LDB(B1, 1, 1); G8_SCHED; G8_LDA(At, 1, 0); G8_STAGE_A(G8_SA(0, 1), 1, s, kb2);
            G8_WAIT_V(8); G8_WAIT_L(0); G8_BAR; G8_MMA(0, 0, At, B0); G8_MMA(0, 1, At, B1); G8_BAR; G8_SCHED;
            G8_LDA(At, 1, 1); G8_STAGE_B(G8_SB(1, 0), b3); G8_STAGE_B(G8_SB(1, 1), b3 + hstepB); G8_STAGE_A(G8_SA(1, 0), 0, s, kb3);
            G8_WAIT_V(8); G8_WAIT_L(0); G8_BAR; G8_MMA(1, 0, At, B0); G8_MMA(1, 1, At, B1); G8_BAR; G8_SCHED;
        }
        if (wr == 0) G8_BAR;
        E(acc, cur, wr, wc, fr, fq);
        if (!has_next) break;
#pragma unroll
        for (int a = 0; a < 2; ++a)
#pragma unroll
            for (int b = 0; b < 2; ++b)
#pragma unroll
                for (int m = 0; m < 4; ++m)
#pragma unroll
                    for (int n = 0; n < 2; ++n) acc[a][b][m][n] = (f32x4){0.f, 0.f, 0.f, 0.f};
        cur = nxt; cA = nA; ++ui;
        if (wr == 1) G8_BAR;
    }
    G8_WAIT_V(0);
    G8_BAR;
#undef G8_SA
#undef G8_SB
#undef G8_STAGE_A
#undef G8_STAGE_B
#undef G8_LDA
#undef G8_LDB
#undef G8_MMA
#undef G8_WAIT_V
#undef G8_WAIT_L
#undef G8_BAR
#undef G8_SCHED
}
}
using g8::Unit;


struct EpiQKV {
    const float* hpx; const float* cosA; const float* sinA; bf16_t* Q; bf16_t* Kk; bf16_t* V; float* kmean;
    __device__ __forceinline__ void operator()(const f32x4 (&acc)[2][2][4][2], const Unit& u, int wr, int wc, int fr, int fq) const {
        const int t = u.pn >> 2;
        const int bb = u.pm >> 5;
        if (t < 2) {
            const int hh = 2 * (u.pn & 3) + (wc >> 1), j0 = 32 * (wc & 1) + 8 * fq;
            bf16_t* dst0 = (t == 0 ? Q : Kk) + ((size_t)(bb * NH + hh) * NS) * 128;
            f32x4 ks[2][2] = {{{0.f, 0.f, 0.f, 0.f}, {0.f, 0.f, 0.f, 0.f}}, {{0.f, 0.f, 0.f, 0.f}, {0.f, 0.f, 0.f, 0.f}}};
#pragma unroll
            for (int ai = 0; ai < 2; ++ai)
#pragma unroll
                for (int m = 0; m < 4; ++m) {
                    const int row = u.pm * 256 + 128 * ai + 64 * wr + 16 * m + fr, s = row & (NS - 1);
                    const float rs = row_rs<16>(hpx + (size_t)row * 16, 1.0f / 1024.0f);
                    f32x4 o1[2], o2[2];
#pragma unroll
                    for (int n = 0; n < 2; ++n) {
                        const f32x4 cs = *(const f32x4*)(cosA + (size_t)s * 64 + j0 + 4 * n), sn = *(const f32x4*)(sinA + (size_t)s * 64 + j0 + 4 * n);
                        const f32x4 x1 = acc[ai][0][m][n] * rs, x2 = acc[ai][1][m][n] * rs;
                        o1[n] = x1 * cs - x2 * sn; o2[n] = x1 * sn + x2 * cs;
                        ks[0][n] += o1[n]; ks[1][n] += o2[n];
                    }
                    bf16_t* d = dst0 + (size_t)s * 128 + j0;
                    *(u32x4*)d = pack8(o1[0], o1[1]); *(u32x4*)(d + 64) = pack8(o2[0], o2[1]);
                }
            if (t == 1) {
#pragma unroll
                for (int q = 0; q < 2; ++q)
#pragma unroll
                    for (int n = 0; n < 2; ++n)
#pragma unroll
                        for (int e = 0; e < 4; ++e) { float v = ks[q][n][e]; v += __shfl_xor(v, 1); v += __shfl_xor(v, 2); v += __shfl_xor(v, 4); v += __shfl_xor(v, 8); ks[q][n][e] = v; }
                if (fr == 0) {
                    float* km = kmean + ((size_t)(bb * NH + hh) * 32 + (u.pm & 31)) * 128 + j0;
#pragma unroll
                    for (int q = 0; q < 2; ++q)
#pragma unroll
                        for (int n = 0; n < 2; ++n)
#pragma unroll
                            for (int e = 0; e < 4; ++e) atomicAdd(km + 64 * q + 4 * n + e, ks[q][n][e]);
                }
            }
        } else {
            const int d0 = 32 * wc + 8 * fq;
#pragma unroll
            for (int ai = 0; ai < 2; ++ai)
#pragma unroll
                for (int m = 0; m < 4; ++m) {
                    const int row = u.pm * 256 + 128 * ai + 64 * wr + 16 * m + fr, s = row & (NS - 1);
                    const float rs = row_rs<16>(hpx + (size_t)row * 16, 1.0f / 1024.0f);
#pragma unroll
                    for (int bj = 0; bj < 2; ++bj) {
                        const int hh = 2 * (u.pn - 8) + bj;
                        bf16_t* d = V + ((size_t)(bb * NH + hh) * NS + s) * 128 + d0;
                        *(u32x4*)d = pack8(acc[ai][bj][m][0] * rs, acc[ai][bj][m][1] * rs);
                    }
                }
        }
    }
};

__device__ __forceinline__ void unpack8(u32x4 w, f32x4& a, f32x4& b) {
#pragma unroll
    for (int e = 0; e < 2; ++e) { a[2 * e] = __builtin_bit_cast(float, w[e] << 16); a[2 * e + 1] = __builtin_bit_cast(float, w[e] & 0xffff0000u);
                                  b[2 * e] = __builtin_bit_cast(float, w[2 + e] << 16); b[2 * e + 1] = __builtin_bit_cast(float, w[2 + e] & 0xffff0000u); }
}
struct EpiResid {
    const bf16_t* base; bf16_t* hb; float* hp;
    __device__ __forceinline__ void operator()(const f32x4 (&acc)[2][2][4][2], const Unit& u, int wr, int wc, int fr, int fq) const {
#pragma unroll
        for (int ai = 0; ai < 2; ++ai)
#pragma unroll
            for (int m = 0; m < 4; ++m) {
                const int row = u.pm * 256 + 128 * ai + 64 * wr + 16 * m + fr;
                float ss = 0.f;
#pragma unroll
                for (int bj = 0; bj < 2; ++bj) {
                    const size_t off = (size_t)row * 1024 + u.pn * 256 + 128 * bj + 32 * wc + 8 * fq;
                    f32x4 b0, b1; unpack8(*(const u32x4*)(base + off), b0, b1);
                    const f32x4 v0 = acc[ai][bj][m][0] + b0, v1 = acc[ai][bj][m][1] + b1;
                    *(u32x4*)(hb + off) = pack8(v0, v1);
                    ss += dot4(v0) + dot4(v1);
                }
                ss += __shfl_xor(ss, 16); ss += __shfl_xor(ss, 32);
                if (fq == 0) hp[(size_t)row * 16 + u.pn * 4 + wc] = ss;
                if (m & 1) asm volatile("" ::: "memory");
            }
    }
};
namespace at {
constexpr int KVBLK = 64, SHM_V = KVBLK * 128 * 2;
constexpr float THR = 8.f;
#define AT_SBAR() __builtin_amdgcn_sched_barrier(0)
__device__ __forceinline__ int v_st(int k, int c) { const int kk = (k & ~0xC) | ((k & 4) << 1) | ((k & 8) >> 1); return ((kk >> 3) * 4 + (c >> 5)) * 512 + ((kk & 7) * 32 + (c & 31)) * 2; }
__device__ __forceinline__ int v_rd_base(int lane) { return ((lane & 3) << 3) | (((lane >> 2) & 3) << 6) | (((lane >> 4) & 1) << 5) | (((lane >> 5) & 1) << 8); }
constexpr int v_rd_off(int d0, int ks, int half) { return d0 * 512 + ks * 4096 + half * 2048; }
__device__ __forceinline__ int crow(int r, int hi) { return (r & 3) + 8 * (r >> 2) + 4 * hi; }

template <int DQK> __device__ __forceinline__ int kswz(int row, int colB) { return row * (DQK * 2) + (colB ^ ((row & 7) << 4)); }

__device__ __forceinline__ void mask_causal(f32x16& p0, f32x16& p1, int dq) {
    const float NEG = -__builtin_inff();
#pragma unroll
    for (int r = 0; r < 16; ++r) {
        const int c = (r & 3) + 8 * (r >> 2);
        if (dq - c < 0) p0[r] = NEG;
        if (dq - c - 32 < 0) p1[r] = NEG;
    }
}
__device__ __forceinline__ void mask_all(f32x16& p0, f32x16& p1, bool keep) {
    const float NEG = -__builtin_inff();
#pragma unroll
    for (int r = 0; r < 16; ++r) { p0[r] = keep ? p0[r] : NEG; p1[r] = keep ? p1[r] : NEG; }
}
__device__ __forceinline__ void partialSM(f32x16& p0, f32x16& p1, float& m_reg, float& mn, float& alpha, const float SC, const float C2) {
    float pmax = p0[0];
#pragma unroll
    for (int r = 1; r < 16; ++r) pmax = fmaxf(pmax, p0[r]);
#pragma unroll
    for (int r = 0; r < 16; ++r) pmax = fmaxf(pmax, p1[r]);
    { auto rr = __builtin_amdgcn_permlane32_swap(__float_as_uint(pmax), __float_as_uint(pmax), false, false);
      pmax = fmaxf(__uint_as_float(rr[0]), __uint_as_float(rr[1])); }
    if (__builtin_expect(__all((pmax - m_reg) * SC <= THR), 1)) { mn = m_reg; alpha = 1.f; }
    else { mn = fmaxf(m_reg, pmax); alpha = __builtin_amdgcn_exp2f((m_reg - mn) * C2); m_reg = mn; }
    const float mnL = -mn * C2;
#pragma unroll
    for (int r = 0; r < 16; ++r) p0[r] = fmaf(p0[r], C2, mnL);
#pragma unroll
    for (int r = 0; r < 16; ++r) p1[r] = fmaf(p1[r], C2, mnL);
#pragma unroll
    for (int r = 0; r < 16; ++r) p0[r] = __builtin_amdgcn_exp2f(p0[r]);
}
__device__ __forceinline__ void finishSM(f32x16& p0, f32x16& p1, float alpha, float& l_reg, bf16x8& pa0, bf16x8& pa1, bf16x8& pa2, bf16x8& pa3) {
#pragma unroll
    for (int r = 0; r < 16; ++r) p1[r] = __builtin_amdgcn_exp2f(p1[r]);
    float ps = 0;
#pragma unroll
    for (int r = 0; r < 16; ++r) ps += p0[r];
#pragma unroll
    for (int r = 0; r < 16; ++r) ps += p1[r];
    { auto rr = __builtin_amdgcn_permlane32_swap(__float_as_uint(ps), __float_as_uint(ps), false, false);
      ps = __uint_as_float(rr[0]) + __uint_as_float(rr[1]); }
    l_reg = l_reg * alpha + ps;
#define AT_PK4(P, B_, OUT) do { unsigned a0 = cvtpk(P[B_+0], P[B_+1]), a1 = cvtpk(P[B_+2], P[B_+3]);                          \
        unsigned b0 = cvtpk(P[B_+4], P[B_+5]), b1 = cvtpk(P[B_+6], P[B_+7]);                                             \
        auto r0 = __builtin_amdgcn_permlane32_swap(a0, b0, false, false); auto r1 = __builtin_amdgcn_permlane32_swap(a1, b1, false, false); \
        u32x4 w = {r0[0], r1[0], r0[1], r1[1]}; OUT = __builtin_bit_cast(bf16x8, w); } while (0)
    AT_PK4(p0, 0, pa0); AT_PK4(p0, 8, pa1); AT_PK4(p1, 0, pa2); AT_PK4(p1, 8, pa3);
#undef AT_PK4
}
template <int DQK>
__device__ __forceinline__ void qkt(f32x16& p0, f32x16& p1, const char* Kt, int r32, int hi, const bf16x8* qr, bool act) {
    if (!act) { const float NEG = -__builtin_inff();
#pragma unroll
        for (int r = 0; r < 16; ++r) { p0[r] = NEG; p1[r] = NEG; } return; }
    p0 = f32x16{}; p1 = f32x16{};
    const char* kb[4];
#pragma unroll
    for (int dd = 0; dd < 4; ++dd) kb[dd] = Kt + kswz<DQK>(r32, (dd * 16 + hi * 8) * 2);
#pragma unroll
    for (int d0 = 0; d0 < DQK / 16; ++d0) { const char* a = kb[d0 & 3] + (d0 >> 2) * 128;
        bf16x8 b0 = *reinterpret_cast<const bf16x8*>(a);
        bf16x8 b1 = *reinterpret_cast<const bf16x8*>(a + 32 * DQK * 2);
        p0 = __builtin_amdgcn_mfma_f32_32x32x16_bf16(b0, qr[d0], p0, 0, 0, 0);
        p1 = __builtin_amdgcn_mfma_f32_32x32x16_bf16(b1, qr[d0], p1, 0, 0, 0); }
}
template <int VB>
__device__ __forceinline__ void pv_tile(f32x16* o, int vb0, bf16x8 pa0, bf16x8 pa1, bf16x8 pa2, bf16x8 pa3, bool act) {
    if (!act) return;
#define AT_TRRD(dst, off) asm volatile("ds_read_b64_tr_b16 %0, %1 offset:%2" : "=&v"(dst) : "v"(vb0), "i"(off) : "memory")
#define AT_PV_D0(d0) do { s16x4 l0, l1, l2, l3, h0, h1, h2, h3; constexpr int b_ = VB * SHM_V + v_rd_off(d0, 0, 0); \
        AT_TRRD(l0, b_); AT_TRRD(h0, b_ + 2048); AT_TRRD(l1, b_ + 4096); AT_TRRD(h1, b_ + 6144); AT_TRRD(l2, b_ + 8192); AT_TRRD(h2, b_ + 10240); AT_TRRD(l3, b_ + 12288); AT_TRRD(h3, b_ + 14336); \
        asm volatile("s_waitcnt lgkmcnt(0)" ::: "memory"); AT_SBAR();   \
        o[d0] = __builtin_amdgcn_mfma_f32_32x32x16_bf16(pa0, (bf16x8){l0[0], l0[1], l0[2], l0[3], h0[0], h0[1], h0[2], h0[3]}, o[d0], 0, 0, 0);   \
        o[d0] = __builtin_amdgcn_mfma_f32_32x32x16_bf16(pa1, (bf16x8){l1[0], l1[1], l1[2], l1[3], h1[0], h1[1], h1[2], h1[3]}, o[d0], 0, 0, 0);   \
        o[d0] = __builtin_amdgcn_mfma_f32_32x32x16_bf16(pa2, (bf16x8){l2[0], l2[1], l2[2], l2[3], h2[0], h2[1], h2[2], h2[3]}, o[d0], 0, 0, 0);   \
        o[d0] = __builtin_amdgcn_mfma_f32_32x32x16_bf16(pa3, (bf16x8){l3[0], l3[1], l3[2], l3[3], h3[0], h3[1], h3[2], h3[3]}, o[d0], 0, 0, 0); } while (0)
    AT_PV_D0(0); AT_PV_D0(1); AT_PV_D0(2); AT_PV_D0(3);
#undef AT_PV_D0
#undef AT_TRRD
}

template <int DQK> struct Lds { static constexpr int SHM_K = KVBLK * DQK * 2, K_OFF = 2 * SHM_V, WS_OFF = K_OFF + 2 * SHM_K, BYTES = WS_OFF + NWAVES * 64 * 4; };

template <int DQK, int MODE>
__device__ __forceinline__ void attn_unit(char* lds, const bf16_t* Qp, const bf16_t* Kn, const bf16_t* Kr, const bf16_t* Vp, bf16_t* Op, int P0, const float* kms) {
    typedef Lds<DQK> L;
    constexpr int SHM_K = L::SHM_K;
    constexpr float SC = (DQK == 128) ? 0.08838834764831845f : 0.07216878364870323f;
    constexpr float C2 = 1.4426950408889634f * SC;
    constexpr int ND0 = DQK / 16;
    int tid = threadIdx.x; asm volatile("" : "+v"(tid));
    const int wid = __builtin_amdgcn_readfirstlane(tid >> 6), lane = tid & 63, r32 = lane & 31, hi = lane >> 5;
    const int NT = (P0 + 256) / KVBLK;
    const int qlo = P0 + wid * 32, qm = qlo + r32 - 4 * hi;
    char* V_lds = lds; char* K_lds = lds + L::K_OFF;
    float* ws = (float*)(lds + L::WS_OFF) + wid * 64; float* li_l = ws, * al_l = ws + 32;
    float m_reg = -1e30f, l_reg = 0; f32x16 o[4] = {};
    const int sr = tid >> 4, sc = (tid & 15) * 8, vst0 = v_st(sr, sc), vst1 = v_st(32 + sr, sc), kws = kswz<DQK>(sr, sc * 2);
    const int rr_ = tid >> 3, rc_ = (tid & 7) * 8, kws_r = kswz<DQK>(rr_, 256 + rc_ * 2);
    const int vb0 = (int)(uintptr_t)V_lds + v_rd_base(lane);
    bf16x8 qr[ND0];
    {   const unsigned qo = (unsigned)(((wid * 32 + r32) * DQK + hi * 8) * 2);
#pragma unroll
        for (int d0 = 0; d0 < ND0; ++d0) qr[d0] = *(const bf16x8*)((const char*)Qp + qo + d0 * 32); }
    unsigned selmask = 0u; const int own = P0 >> 8;
    if (MODE == 1) {
        {   unsigned ko = (unsigned)((sr * 128 + sc) * 4); asm volatile("" : "+v"(ko));
            const f32x4 a = *(const f32x4*)((const char*)kms + ko) * (1.0f / 256.0f), b = *(const f32x4*)((const char*)kms + ko + 16) * (1.0f / 256.0f);
            const u32x4 h8 = pack8(a, b);
            f32x4 ha, hb_;
#pragma unroll
            for (int e = 0; e < 2; ++e) { ha[2 * e] = __builtin_bit_cast(float, h8[e] << 16); ha[2 * e + 1] = __builtin_bit_cast(float, h8[e] & 0xffff0000u);
                                          hb_[2 * e] = __builtin_bit_cast(float, h8[2 + e] << 16); hb_[2 * e + 1] = __builtin_bit_cast(float, h8[2 + e] & 0xffff0000u); }
            const u32x4 l8 = pack8(a - ha, b - hb_);
            *(u32x4*)(K_lds + kws) = h8; *(u32x4*)(K_lds + SHM_K + kws) = l8; }
        __syncthreads();
        f32x16 g = f32x16{};
        {   const char* kb[4];
#pragma unroll
            for (int dd = 0; dd < 4; ++dd) kb[dd] = K_lds + kswz<DQK>(r32, (dd * 16 + hi * 8) * 2);
#pragma unroll
            for (int d0 = 0; d0 < 8; ++d0) { const char* a = kb[d0 & 3] + (d0 >> 2) * 128;
                g = __builtin_amdgcn_mfma_f32_32x32x16_bf16(*reinterpret_cast<const bf16x8*>(a), qr[d0], g, 0, 0, 0);
                g = __builtin_amdgcn_mfma_f32_32x32x16_bf16(*reinterpret_cast<const bf16x8*>(a + SHM_K), qr[d0], g, 0, 0, 0); } }
        const float NINF = -__builtin_inff();
        float v1 = NINF, v2 = NINF, v3 = NINF; int i1 = 64, i2 = 65, i3 = 66;
        const int ownl = own - 4 * hi;
#pragma unroll
        for (int r = 0; r < 16; ++r) {
            const int idx = (r & 3) + 8 * (r >> 2); const float val = (idx < ownl) ? g[r] : NINF;
            const bool c1 = val > v1, c2 = val > v2, c3 = val > v3;
            v3 = c2 ? v2 : (c3 ? val : v3); i3 = c2 ? i2 : (c3 ? idx : i3);
            v2 = c1 ? v1 : (c2 ? val : v2); i2 = c1 ? i1 : (c2 ? idx : i2);
            v1 = c1 ? val : v1;             i1 = c1 ? idx : i1;
        }
        i1 += 4 * hi; i2 += 4 * hi; i3 += 4 * hi;
        float pv_[3]; int pi_[3];
        pv_[0] = __shfl_xor(v1, 32); pv_[1] = __shfl_xor(v2, 32); pv_[2] = __shfl_xor(v3, 32);
        pi_[0] = __shfl_xor(i1, 32); pi_[1] = __shfl_xor(i2, 32); pi_[2] = __shfl_xor(i3, 32);
#pragma unroll
        for (int c = 0; c < 3; ++c) {
            const float val = pv_[c]; const int idx = pi_[c];
            const bool c1 = (val > v1) || (val == v1 && idx < i1), c2 = (val > v2) || (val == v2 && idx < i2), c3 = (val > v3) || (val == v3 && idx < i3);
            v3 = c2 ? v2 : (c3 ? val : v3); i3 = c2 ? i2 : (c3 ? idx : i3);
            v2 = c1 ? v1 : (c2 ? val : v2); i2 = c1 ? i1 : (c2 ? idx : i2);
            v1 = c1 ? val : v1;             i1 = c1 ? idx : i1;
        }
        selmask = (i1 < 32 ? (1u << i1) : 0u) | (i2 < 32 ? (1u << i2) : 0u) | (i3 < 32 ? (1u << i3) : 0u);
        __syncthreads();
    }
    bf16x8 st_v0, st_v1, st_k0, st_k1, st_k2;
    const unsigned lo_a = (unsigned)((sr * 128 + sc) * 2), lo_r = (unsigned)((rr_ * 64 + rc_) * 2);
#define AT_VMW() asm volatile("s_waitcnt vmcnt(0)" ::: "memory")
    const __amdgpu_buffer_rsrc_t rsV = __builtin_amdgcn_make_buffer_rsrc((void*)Vp, 0, NS * 256, 0x00020000), rsK = __builtin_amdgcn_make_buffer_rsrc((void*)Kn, 0, NS * 256, 0x00020000);
    const __amdgpu_buffer_rsrc_t rsR = __builtin_amdgcn_make_buffer_rsrc((void*)(DQK == 192 ? Kr : Kn), 0, NS * 128, 0x00020000);
#define AT_BL(rs, vo, so) __builtin_bit_cast(bf16x8, __builtin_amdgcn_raw_buffer_load_b128(rs, (int)(vo), (int)(so), 0))
#define AT_SLOAD(k0) do { const int so_ = (k0) * 256; \
                          st_v0 = AT_BL(rsV, lo_a, so_); st_v1 = AT_BL(rsV, lo_a, so_ + 8192); \
                          st_k0 = AT_BL(rsK, lo_a, so_); st_k1 = AT_BL(rsK, lo_a, so_ + 8192); \
                          if (DQK == 192) { st_k2 = AT_BL(rsR, lo_r, (k0) * 128); } } while (0)
#define AT_SWRITE(bf) do { *(bf16x8*)(V_lds + (bf) * SHM_V + vst0) = st_v0; *(bf16x8*)(V_lds + (bf) * SHM_V + vst1) = st_v1; \
                           *(bf16x8*)(K_lds + (bf) * SHM_K + kws) = st_k0; *(bf16x8*)(K_lds + (bf) * SHM_K + kws + 32 * DQK * 2) = st_k1; \
                           if (DQK == 192) *(bf16x8*)(K_lds + (bf) * SHM_K + kws_r) = st_k2; } while (0)
#define AT_RESC(a) do { if (__any((a) < 1.f)) { if (hi == 0) al_l[r32] = (a); asm volatile("s_waitcnt lgkmcnt(0)" ::: "memory");              \
                     _Pragma("unroll") for (int d_ = 0; d_ < 4; ++d_) _Pragma("unroll") for (int r = 0; r < 16; ++r) o[d_][r] *= al_l[crow(r, hi)]; } } while (0)
#define AT_KBASE(t) ((t) * KVBLK)
#define AT_ACT(t) (MODE == 0 ? (AT_KBASE(t) <= qlo + 31) : ((((t) >> 2) < own) ? (__any((selmask >> ((t) >> 2)) & 1u) != 0) : (AT_KBASE(t) <= qlo + 31)))
#define AT_MASKT(P0_, P1_, t) do { const int kb_ = AT_KBASE(t); \
        if (MODE == 1 && ((t) >> 2) < own) { mask_all(P0_, P1_, ((selmask >> ((t) >> 2)) & 1u) != 0u); } \
        else if (kb_ + KVBLK - 1 > qlo && kb_ <= qlo + 31) mask_causal(P0_, P1_, qm - kb_); } while (0)
    f32x16 pA0, pA1, pB0, pB1; float mnA, mnB, alA, alB; bf16x8 pa0, pa1, pa2, pa3;
    AT_SLOAD(AT_KBASE(0)); AT_VMW(); AT_SWRITE(0);
    __syncthreads();
    AT_SLOAD(AT_KBASE(1));
    AT_SBAR(); qkt<DQK>(pA0, pA1, K_lds, r32, hi, qr, AT_ACT(0));
    AT_MASKT(pA0, pA1, 0); partialSM(pA0, pA1, m_reg, mnA, alA, SC, C2);
    AT_VMW(); AT_SWRITE(1);
    __syncthreads();
#define AT_HALF_STEP(PX0, PX1, mnX, alX, PY0, PY1, alY, t, KB, VB, SB) do {                                                      \
        AT_SBAR(); qkt<DQK>(PX0, PX1, K_lds + (KB) * SHM_K, r32, hi, qr, AT_ACT(t));                                             \
        finishSM(PY0, PY1, alY, l_reg, pa0, pa1, pa2, pa3); AT_SBAR();                                                           \
        if ((t) + 1 < NT) { AT_SLOAD(AT_KBASE((t) + 1)); AT_SBAR(); }                                                            \
        pv_tile<VB>(o, vb0, pa0, pa1, pa2, pa3, AT_ACT((t) - 1)); AT_MASKT(PX0, PX1, (t)); partialSM(PX0, PX1, m_reg, mnX, alX, SC, C2); \
        __syncthreads();                                                                                                      \
        if ((t) + 1 < NT) { AT_VMW(); AT_SWRITE(SB); }                                                                           \
        AT_RESC(alX); __syncthreads(); } while (0)
    for (int t = 1; t + 1 < NT; t += 2) {
        AT_HALF_STEP(pB0, pB1, mnB, alB, pA0, pA1, alA, t, 1, 0, 0);
        AT_HALF_STEP(pA0, pA1, mnA, alA, pB0, pB1, alB, t + 1, 0, 1, 1);
    }
    AT_SBAR(); qkt<DQK>(pB0, pB1, K_lds + SHM_K, r32, hi, qr, AT_ACT(NT - 1)); AT_SBAR();
    finishSM(pA0, pA1, alA, l_reg, pa0, pa1, pa2, pa3); AT_SBAR();
    pv_tile<0>(o, vb0, pa0, pa1, pa2, pa3, AT_ACT(NT - 2));
    AT_MASKT(pB0, pB1, NT - 1); partialSM(pB0, pB1, m_reg, mnB, alB, SC, C2); AT_RESC(alB);
    finishSM(pB0, pB1, alB, l_reg, pa0, pa1, pa2, pa3); AT_SBAR(); pv_tile<1>(o, vb0, pa0, pa1, pa2, pa3, AT_ACT(NT - 1));
    if (hi == 0) li_l[r32] = l_reg; asm volatile("s_waitcnt lgkmcnt(0)" ::: "memory");
    float rli[16];
#pragma unroll
    for (int r = 0; r < 16; ++r) rli[r] = __builtin_amdgcn_rcpf(li_l[crow(r, hi)]);
    unsigned lofs = (unsigned)((wid * 32 + 4 * hi) * 1024 + r32);
    asm volatile("" : "+v"(lofs));
    lofs *= 2u;
#pragma unroll
    for (int r = 0; r < 16; ++r) { const int orow = (r & 3) + 8 * (r >> 2);
#pragma unroll
        for (int d0 = 0; d0 < 4; ++d0) { const float v = o[d0][r] * rli[r];
            const float vn = __shfl_xor(v, 1);
            if ((r32 & 1) == 0) *(unsigned*)((char*)Op + (size_t)(orow * 2048 + d0 * 64) + lofs) = cvtpk(v, vn); } }
    __syncthreads();
#undef AT_VMW
#undef AT_SLOAD
#undef AT_BL
#undef AT_SWRITE
#undef AT_RESC
#undef AT_KBASE
#undef AT_ACT
#undef AT_MASKT
#undef AT_HALF_STEP
}
}
__device__ __forceinline__ int pair_lo(int p) { return p < 3 ? 0 : (p < 5 ? 1 : 2); }
__device__ __forceinline__ int pair_hi(int p) { return p < 3 ? p + 1 : (p < 5 ? p - 1 : 3); }
constexpr int LDS_TB = LDS_MISC + 64;

__device__ __forceinline__ void p_route(const Args& a, LAS unsigned char* lds, int layer, const bf16_t* h, int vcu, int G) {
    int tid = threadIdx.x; asm volatile("" : "+v"(tid));
    const int lane = tid & 63, wave = __builtin_amdgcn_readfirstlane(tid >> 6), i32 = lane & 31, kk = lane >> 5;
    unsigned char* ws = a.ws;
    LAS float* wl = (LAS float*)lds;
    {   const float* wrt = (const float*)(ws + WS_WRT) + (size_t)layer * 20480;
        for (int i = tid; i < 20480; i += NTHR) { const int k = i / 20, c = i % 20; wl[c * 1024 + k] = wrt[i]; } }
    __syncthreads();
    float* tokw = (float*)(ws + WS_TOKW); int* list = (int*)(ws + WS_LIST);
    unsigned* cnt = (unsigned*)(ws + WS_CTL) + CW_CNT + layer * 24 * 16;
    const int gw = vcu * NWAVES + wave, NGW = G * NWAVES;
    const int lrow = i32 < 4 ? i32 : (i32 < 8 ? 12 + i32 : ((i32 & 4) ? -1 : ((i32 >> 3) == 1 ? i32 - 4 : ((i32 >> 3) == 2 ? i32 - 8 : i32 - 12))));
    const LAS float* wrow = wl + (lrow < 0 ? 0 : lrow) * 1024 + 8 * kk;
    const float wmask = lrow < 0 ? 0.f : 1.f;
    for (int task = gw; task < NT / 32; task += NGW) {
        const int t = task * 32 + i32;
        const bf16_t* hrow = h + (size_t)t * 1024 + 8 * kk;
        f32x16 c = f32x16{}; float ssp = 0.f;
#pragma unroll 4
        for (int it = 0; it < 64; ++it) {
            f32x4 h0, h1; unpack8(*(const u32x4*)(hrow + 16 * it), h0, h1);
            const f32x4 w0 = *(const LAS f32x4*)(wrow + 16 * it) * wmask, w1 = *(const LAS f32x4*)(wrow + 16 * it + 4) * wmask;
            ssp += dot4(h0) + dot4(h1);
#pragma unroll
            for (int e = 0; e < 4; ++e) c = __builtin_amdgcn_mfma_f32_32x32x2f32(w0[e], h0[e], c, 0, 0, 0);
#pragma unroll
            for (int e = 0; e < 4; ++e) c = __builtin_amdgcn_mfma_f32_32x32x2f32(w1[e], h1[e], c, 0, 0, 0);
        }
        const float ss = ssp + __shfl_xor(ssp, 32);
        float ex[4];
#pragma unroll
        for (int e = 0; e < 4; ++e) ex[e] = __shfl_xor(c[e], 32);
        const float rs = rsqrtf(ss * (1.0f / 1024.0f) + EPS);
        float lg[20];
#pragma unroll
        for (int e = 0; e < 16; ++e) lg[e] = c[e] * rs;
#pragma unroll
        for (int e = 0; e < 4; ++e) lg[16 + e] = ex[e] * rs;
        int gs = 0; float gm = lg[0];
#pragma unroll
        for (int i = 1; i < 4; ++i) if (lg[i] > gm) { gm = lg[i]; gs = i; }
        float den = 0.f;
#pragma unroll
        for (int i = 0; i < 4; ++i) den += __expf(lg[i] - gm);
        const float gwt = 1.0f / den;
        float ein[4];
#pragma unroll
        for (int i = 0; i < 4; ++i) ein[i] = gs == 0 ? lg[4 + i] : (gs == 1 ? lg[8 + i] : (gs == 2 ? lg[12 + i] : lg[16 + i]));
        int i1 = 0; float e1 = ein[0];
#pragma unroll
        for (int i = 1; i < 4; ++i) if (ein[i] > e1) { e1 = ein[i]; i1 = i; }
        int i2 = -1; float e2 = 0.f;
#pragma unroll
        for (int i = 0; i < 4; ++i) if (i != i1 && (i2 < 0 || ein[i] > e2)) { e2 = ein[i]; i2 = i; }
        const float x2 = __expf(e2 - e1), w1 = gwt / (1.0f + x2), w2 = gwt * x2 / (1.0f + x2);
        const int lo = i1 < i2 ? i1 : i2, hi = i1 < i2 ? i2 : i1;
        const int pidx = lo == 0 ? hi - 1 : (lo == 1 ? hi + 1 : 5);
        const int bucket = gs * 6 + pidx;
        if (kk == 0) {
            f32x2_t wv2 = {(i1 == lo) ? w1 : w2, (i1 == lo) ? w2 : w1};
            *(f32x2_t*)(tokw + (size_t)t * 2) = wv2;
            const unsigned pos = __hip_atomic_fetch_add(cnt + bucket * 16, 1u, __ATOMIC_RELAXED, __HIP_MEMORY_SCOPE_AGENT);
            list[(size_t)bucket * NT + pos] = t;
        }
    }
    {   const float* p = a.in[1] + (size_t)layer * NT * 256; bf16_t* pb = (bf16_t*)(ws + WS_PB);
        const int gt = vcu * NTHR + tid, NGT = G * NTHR;
        for (int i = gt; i < NT * 256 / 8; i += NGT) { const f32x4 x0 = *(const f32x4*)(p + (size_t)i * 8), x1 = *(const f32x4*)(p + (size_t)i * 8 + 4); *(u32x4*)(pb + (size_t)i * 8) = pack8(x0, x1); } }
    __syncthreads();
}

__device__ __forceinline__ int moe_prefix(const Args& a, LAS unsigned char* lds, int layer) {
    LAS int* tb = (LAS int*)(lds + LDS_TB);
    if (threadIdx.x == 0) { const unsigned* cnt = (const unsigned*)(a.ws + WS_CTL) + CW_CNT + layer * 24 * 16; int s = 0;
        for (int b = 0; b < 24; ++b) { tb[b] = s; s += (int)((__hip_atomic_load(cnt + b * 16, __ATOMIC_RELAXED, __HIP_MEMORY_SCOPE_AGENT) + 255u) >> 8); }
        tb[24] = s; }
    __syncthreads();
    return __builtin_amdgcn_readfirstlane(tb[24]);
}
struct MoeUnits {
    LAS const int* tb; int NRT, G, c;
    __device__ __forceinline__ bool next(int i, Unit& u) const {
        const int L = i * G + c, rt = L >> 2; if (rt >= NRT) return false;
        int b = 0;
        for (int q = 1; q < 24; ++q) b = (tb[q] <= rt) ? q : b;
        u.pm = rt; u.pn = L & 3; u.aux = __builtin_amdgcn_readfirstlane(b); return true;
    }
};
struct MoeGuP {
    const char* A; const char* W; const int* list; const unsigned* cnt; MoeUnits U; int ldb, K;
    __device__ __forceinline__ bool next(int i, Unit& u) const { return U.next(i, u); }
    __device__ __forceinline__ void aoff(const Unit& u, const int (&R)[2], const int (&C)[2], g8::AOff& o) const {
        const int n = (int)cnt[u.aux * 16], p0 = (u.pm - __builtin_amdgcn_readfirstlane(U.tb[u.aux])) * 256;
#pragma unroll
        for (int h = 0; h < 2; ++h)
#pragma unroll
            for (int i = 0; i < 2; ++i) { int pos = p0 + h * 128 + R[i]; pos = pos < n ? pos : n - 1; const int tok = list[(size_t)u.aux * NT + pos]; o.o[h][i] = (unsigned)((tok * 1024 + C[i]) * 2); }
    }
    __device__ __forceinline__ const char* bbase(const Unit& u, int kt) const {
        const int g = u.aux / 6, pi = u.aux % 6, e = g * 4 + ((u.pn < 2) ? pair_lo(pi) : pair_hi(pi));
        return W + ((size_t)(e * 512 + (u.pn & 1) * 256) * 1024 + (size_t)kt * 64) * 2;
    }
};
struct MoeDownP {
    const char* A; const char* W; MoeUnits U; int ldb, K;
    __device__ __forceinline__ bool next(int i, Unit& u) const { return U.next(i, u); }
    __device__ __forceinline__ void aoff(const Unit& u, const int (&R)[2], const int (&C)[2], g8::AOff& o) const {
#pragma unroll
        for (int h = 0; h < 2; ++h)
#pragma unroll
            for (int i = 0; i < 2; ++i) o.o[h][i] = (unsigned)(((u.pm * 256 + h * 128 + R[i]) * 512 + C[i]) * 2);
    }
    __device__ __forceinline__ const char* bbase(const Unit& u, int kt) const {
        const int g = u.aux / 6, pi = u.aux % 6, e = g * 4 + ((kt < 4) ? pair_lo(pi) : pair_hi(pi));
        return W + ((size_t)(e * 1024 + u.pn * 256) * 256 + (size_t)(kt & 3) * 64) * 2;
    }
};
__device__ __forceinline__ float sigmoidf_fast(float x) { return __builtin_amdgcn_rcpf(1.0f + __builtin_amdgcn_exp2f(-1.4426950408889634f * x)); }

struct EpiGateUp {
    const float* hp; const float* tokw; const int* list; const unsigned* cnt; LAS const int* tb; bf16_t* act;
    __device__ __forceinline__ void operator()(const f32x4 (&acc)[2][2][4][2], const Unit& u, int wr, int wc, int fr, int fq) const {
        const int n = (int)cnt[u.aux * 16], p0 = (u.pm - __builtin_amdgcn_readfirstlane(tb[u.aux])) * 256, half = u.pn >> 1;
#pragma unroll
        for (int ai = 0; ai < 2; ++ai)
#pragma unroll
            for (int m = 0; m < 4; ++m) {
                const int r = 128 * ai + 64 * wr + 16 * m + fr; int pos = p0 + r; pos = pos < n ? pos : n - 1;
                const int tok = list[(size_t)u.aux * NT + pos];
                const float rs = row_rs<16>(hp + (size_t)tok * 16, 1.0f / 1024.0f), w = tokw[(size_t)tok * 2 + half];
                f32x4 o[2];
#pragma unroll
                for (int nn = 0; nn < 2; ++nn)
#pragma unroll
                    for (int e = 0; e < 4; ++e) { const float g = acc[ai][0][m][nn][e] * rs, up = acc[ai][1][m][nn][e] * rs; o[nn][e] = g * sigmoidf_fast(g) * up * w; }
                *(u32x4*)(act + (size_t)(u.pm * 256 + r) * 512 + half * 256 + (u.pn & 1) * 128 + 32 * wc + 8 * fq) = pack8(o[0], o[1]);
            }
    }
};
struct EpiDown {
    bf16_t* hb; float* hp; const int* list; const unsigned* cnt; LAS const int* tb;
    __device__ __forceinline__ void operator()(const f32x4 (&acc)[2][2][4][2], const Unit& u, int wr, int wc, int fr, int fq) const {
        const int n = (int)cnt[u.aux * 16], p0 = (u.pm - __builtin_amdgcn_readfirstlane(tb[u.aux])) * 256;
#pragma unroll
        for (int ai = 0; ai < 2; ++ai)
#pragma unroll
            for (int m = 0; m < 4; ++m) {
                const int r = 128 * ai + 64 * wr + 16 * m + fr, pos = p0 + r; const bool valid = pos < n;
                const int tok = list[(size_t)u.aux * NT + (valid ? pos : n - 1)];
                float ss = 0.f;
#pragma unroll
                for (int bj = 0; bj < 2; ++bj) {
                    const size_t off = (size_t)tok * 1024 + u.pn * 256 + 128 * bj + 32 * wc + 8 * fq;
                    f32x4 b0, b1; unpack8(*(const u32x4*)(hb + off), b0, b1);
                    const f32x4 v0 = acc[ai][bj][m][0] + b0, v1 = acc[ai][bj][m][1] + b1;
                    if (valid) *(u32x4*)(hb + off) = pack8(v0, v1);
                    ss += dot4(v0) + dot4(v1);
                }
                ss += __shfl_xor(ss, 16); ss += __shfl_xor(ss, 32);
                if (fq == 0 && valid) hp[(size_t)tok * 16 + u.pn * 4 + wc] = ss;
                if (m & 1) asm volatile("" ::: "memory");
            }
    }
};
struct EpiStore {
    bf16_t* O; int ldc;
    __device__ __forceinline__ void operator()(const f32x4 (&acc)[2][2][4][2], const Unit& u, int wr, int wc, int fr, int fq) const {
#pragma unroll
        for (int ai = 0; ai < 2; ++ai)
#pragma unroll
            for (int m = 0; m < 4; ++m) { const int row = u.pm * 256 + 128 * ai + 64 * wr + 16 * m + fr;
#pragma unroll
                for (int bj = 0; bj < 2; ++bj) *(u32x4*)(O + (size_t)row * ldc + u.pn * 256 + 128 * bj + 32 * wc + 8 * fq) = pack8(acc[ai][bj][m][0], acc[ai][bj][m][1]); }
    }
};
struct EpiPle {
    const float* hpin; const bf16_t* pp; const bf16_t* hbi; bf16_t* hbo; float* hp;
    __device__ __forceinline__ void operator()(const f32x4 (&acc)[2][2][4][2], const Unit& u, int wr, int wc, int fr, int fq) const {
#pragma unroll
        for (int ai = 0; ai < 2; ++ai)
#pragma unroll
            for (int m = 0; m < 4; ++m) {
                const int row = u.pm * 256 + 128 * ai + 64 * wr + 16 * m + fr;
                const float rs = row_rs<16>(hpin + (size_t)row * 16, 1.0f / 1024.0f);
                float ss = 0.f;
#pragma unroll
                for (int bj = 0; bj < 2; ++bj) {
                    const size_t off = (size_t)row * 1024 + u.pn * 256 + 128 * bj + 32 * wc + 8 * fq;
                    f32x4 p0, p1, v0, v1; unpack8(*(const u32x4*)(pp + off), p0, p1); unpack8(*(const u32x4*)(hbi + off), v0, v1);
#pragma unroll
                    for (int e = 0; e < 4; ++e) { v0[e] += sigmoidf_fast(acc[ai][bj][m][0][e] * rs) * p0[e]; v1[e] += sigmoidf_fast(acc[ai][bj][m][1][e] * rs) * p1[e]; }
                    *(u32x4*)(hbo + off) = pack8(v0, v1);
                    ss += dot4(v0) + dot4(v1);
                }
                ss += __shfl_xor(ss, 16); ss += __shfl_xor(ss, 32);
                if (fq == 0) hp[(size_t)row * 16 + u.pn * 4 + wc] = ss;
                if (m & 1) asm volatile("" ::: "memory");
            }
    }
};
__device__ __forceinline__ u32x2 pack4(f32x4 a) { u32x2 w = {cvtpk(a[0], a[1]), cvtpk(a[2], a[3])}; return w; }
struct EpiDqkv {
    const float* hp; const float* cosB; const float* sinB; bf16_t* cq; bf16_t* ckv; bf16_t* krope; float* cqp; float* kvp;
    __device__ __forceinline__ void operator()(const f32x4 (&acc)[2][2][4][2], const Unit& u, int wr, int wc, int fr, int fq) const {
#pragma unroll
        for (int ai = 0; ai < 2; ++ai)
#pragma unroll
            for (int m = 0; m < 4; ++m) {
                const int row = u.pm * 256 + 128 * ai + 64 * wr + 16 * m + fr, s = row & (NS - 1);
                const float rs = row_rs<16>(hp + (size_t)row * 16, 1.0f / 1024.0f);
                if (u.pn < 2) {
                    float ss = 0.f;
#pragma unroll
                    for (int bj = 0; bj < 2; ++bj) { const f32x4 v0 = acc[ai][bj][m][0] * rs, v1 = acc[ai][bj][m][1] * rs; ss += dot4(v0) + dot4(v1);
                        const int c = 128 * bj + 32 * wc + 8 * fq;
                        if (u.pn == 0) *(u32x4*)(cq + (size_t)row * 384 + c) = pack8(v0, v1); else *(u32x4*)(ckv + (size_t)row * 256 + c) = pack8(v0, v1); }
                    ss += __shfl_xor(ss, 16); ss += __shfl_xor(ss, 32);
                    if (fq == 0) { if (u.pn == 0) cqp[(size_t)row * 8 + wc] = ss; else kvp[(size_t)row * 4 + wc] = ss; }
                } else {
                    const f32x4 v0 = acc[ai][0][m][0] * rs, v1 = acc[ai][0][m][1] * rs;
                    float ss = dot4(v0) + dot4(v1);
                    *(u32x4*)(cq + (size_t)row * 384 + 256 + 32 * wc + 8 * fq) = pack8(v0, v1);
                    ss += __shfl_xor(ss, 16); ss += __shfl_xor(ss, 32);
                    if (fq == 0) cqp[(size_t)row * 8 + 4 + wc] = ss;
                    if (wc < 2) {
                        const int j = 16 * wc + 4 * fq;
                        const f32x4 cs = *(const f32x4*)(cosB + (size_t)s * 32 + j), sn = *(const f32x4*)(sinB + (size_t)s * 32 + j);
                        const f32x4 x1 = acc[ai][1][m][0] * rs, x2 = acc[ai][1][m][1] * rs;
                        *(u32x2*)(krope + (size_t)row * 64 + j) = pack4(x1 * cs - x2 * sn);
                        *(u32x2*)(krope + (size_t)row * 64 + 32 + j) = pack4(x1 * sn + x2 * cs);
                    }
                }
            }
    }
};
struct EpiUq {
    const float* cqp; const float* cosB; const float* sinB; bf16_t* q;
    __device__ __forceinline__ void operator()(const f32x4 (&acc)[2][2][4][2], const Unit& u, int wr, int wc, int fr, int fq) const {
        const int bb = u.pm >> 5;
#pragma unroll
        for (int ai = 0; ai < 2; ++ai)
#pragma unroll
            for (int m = 0; m < 4; ++m) {
                const int row = u.pm * 256 + 128 * ai + 64 * wr + 16 * m + fr, s = row & (NS - 1);
                const float rs = row_rs<8>(cqp + (size_t)row * 8, 1.0f / 384.0f);
#pragma unroll
                for (int bj = 0; bj < 2; ++bj) {
                    if (u.pn < 4) {
                        const int hh = 2 * u.pn + bj;
                        *(u32x4*)(q + ((size_t)(bb * NH + hh) * NS + s) * 192 + 32 * wc + 8 * fq) = pack8(acc[ai][bj][m][0] * rs, acc[ai][bj][m][1] * rs);
                    } else {
                        const int gidx = bj * 4 + wc, hh = 4 * (u.pn - 4) + (gidx >> 1), j = 16 * (gidx & 1) + 4 * fq;
                        const f32x4 cs = *(const f32x4*)(cosB + (size_t)s * 32 + j), sn = *(const f32x4*)(sinB + (size_t)s * 32 + j);
                        const f32x4 x1 = acc[ai][bj][m][0] * rs, x2 = acc[ai][bj][m][1] * rs;
                        bf16_t* d = q + ((size_t)(bb * NH + hh) * NS + s) * 192 + 128 + j;
                        *(u32x2*)d = pack4(x1 * cs - x2 * sn); *(u32x2*)(d + 32) = pack4(x1 * sn + x2 * cs);
                    }
                }
            }
    }
};
struct EpiUkv {
    const float* kvp; bf16_t* kn; bf16_t* v;
    __device__ __forceinline__ void operator()(const f32x4 (&acc)[2][2][4][2], const Unit& u, int wr, int wc, int fr, int fq) const {
        const int bb = u.pm >> 5;
#pragma unroll
        for (int ai = 0; ai < 2; ++ai)
#pragma unroll
            for (int m = 0; m < 4; ++m) {
                const int row = u.pm * 256 + 128 * ai + 64 * wr + 16 * m + fr, s = row & (NS - 1);
                const float rs = row_rs<4>(kvp + (size_t)row * 4, 1.0f / 256.0f);
                const size_t o = ((size_t)(bb * NH + u.pn) * NS + s) * 128 + 32 * wc + 8 * fq;
                *(u32x4*)(kn + o) = pack8(acc[ai][0][m][0] * rs, acc[ai][0][m][1] * rs);
                *(u32x4*)(v + o) = pack8(acc[ai][1][m][0] * rs, acc[ai][1][m][1] * rs);
            }
    }
};

struct WConv { const float* src0; const float* src1; const float* gain; bf16_t* dst; int N0, N1, K, Nout, kind; };
__device__ __forceinline__ int colmap(int kind, int n) {
    switch (kind) {
    case 1: {
        const int pn = n >> 8; if (pn >= 8) return n;
        const int t = pn >> 2, bj = (n >> 7) & 1, r = n & 127, hh = 2 * (pn & 3) + (r >> 6), d = 64 * bj + (r & 63);
        return t * 1024 + hh * 128 + d; }
    case 2: {
        if (n < 256) return n;
        if (n < 512) return 384 + (n - 256);
        if (n < 640) return 256 + (n - 512);
        const int r = n - 640, wc = r >> 5, fq = (r >> 3) & 3, nn = (r >> 2) & 1, i = r & 3;
        if (wc >= 2) return -1;
        return 384 + 256 + 32 * nn + 16 * wc + 4 * fq + i; }
    case 3: {
        if (n < 1024) return (n >> 7) * 192 + (n & 127);
        const int m = n - 1024, pn4 = m >> 8, gidx = (m >> 5) & 7, fq = (m >> 3) & 3, nn = (m >> 2) & 1, i = m & 3;
        const int hh = 4 * pn4 + (gidx >> 1), j = 16 * (gidx & 1) + 4 * fq + i;
        return hh * 192 + 128 + 32 * nn + j; }
    case 4: {
        const int q = n >> 8, bj = (n >> 7) & 1, r = n & 127;
        return bj * 256 + 128 * q + r; }
    default: return n;
    }
}
__device__ __forceinline__ void conv_item(const WConv& w, LAS float* scr, int item, int lane) {
    const int nblk = w.Nout / 32, kb = item / nblk, nb = item % nblk, k0 = 64 * kb, n0 = 32 * nb;
    const int n4 = lane & 7, ks = lane >> 3;
    const int s = colmap(w.kind, n0 + 4 * n4);
    const bool z = s < 0, first = s < w.N0;
    const float* sp = first ? w.src0 + s : w.src1 + (s - w.N0);
    const int ld = first ? w.N0 : w.N1;
    f32x4 v[8];
#pragma unroll
    for (int it = 0; it < 8; ++it) { const int k = it * 8 + ks; v[it] = z ? (f32x4){0.f, 0.f, 0.f, 0.f} : *(const f32x4*)(sp + (size_t)(k0 + k) * ld); }
#pragma unroll
    for (int it = 0; it < 8; ++it) { const int k = it * 8 + ks; const float g = w.gain ? w.gain[k0 + k] : 1.0f;
#pragma unroll
        for (int e = 0; e < 4; ++e) scr[k * 33 + 4 * n4 + e] = v[it][e] * g; }
    asm volatile("s_waitcnt lgkmcnt(0)" ::: "memory");
    const int c = lane & 7;
#pragma unroll
    for (int j = 0; j < 4; ++j) { const int n = (lane >> 3) + 8 * j; const LAS float* sv = scr + (8 * c) * 33 + n;
        u32x4 o; o.x = cvtpk(sv[0 * 33], sv[1 * 33]); o.y = cvtpk(sv[2 * 33], sv[3 * 33]); o.z = cvtpk(sv[4 * 33], sv[5 * 33]); o.w = cvtpk(sv[6 * 33], sv[7 * 33]);
        *(u32x4*)(w.dst + (size_t)(n0 + n) * w.K + k0 + 8 * c) = o; }
    asm volatile("s_waitcnt lgkmcnt(0)" ::: "memory");
}
__device__ __forceinline__ bool get_conv(int mi, const Args& a, WConv& w) {
    unsigned char* ws = a.ws;
    w.src1 = nullptr; w.N1 = 0; w.gain = nullptr; w.kind = 0;
    if (mi == 0) { w.src0 = a.in[6]; w.N0 = 3072; w.K = 1024; w.Nout = 3072; w.kind = 1; w.gain = a.in[2]; w.dst = (bf16_t*)(ws + WS_WQKV0); return true; }
    if (mi == 1) { w.src0 = a.in[7]; w.N0 = 1024; w.K = 1024; w.Nout = 1024; w.dst = (bf16_t*)(ws + WS_WO0); return true; }
    if (mi == 2) { w.src0 = a.in[8]; w.N0 = 384; w.src1 = a.in[11]; w.N1 = 320; w.K = 1024; w.Nout = 768; w.kind = 2; w.gain = a.in[2] + 1024; w.dst = (bf16_t*)(ws + WS_WDQKV); return true; }
    if (mi == 3) { w.src0 = a.in[10]; w.N0 = 1536; w.K = 384; w.Nout = 1536; w.kind = 3; w.gain = a.in[9]; w.dst = (bf16_t*)(ws + WS_WUQ); return true; }
    if (mi == 4) { w.src0 = a.in[13]; w.N0 = 2048; w.K = 256; w.Nout = 2048; w.gain = a.in[12]; w.dst = (bf16_t*)(ws + WS_WUKV); return true; }
    if (mi == 5) { w.src0 = a.in[14]; w.N0 = 1024; w.K = 1024; w.Nout = 1024; w.dst = (bf16_t*)(ws + WS_WO1); return true; }
    if (mi < 38) { const int le = mi - 6, l = le >> 4;
        w.src0 = a.in[17] + (size_t)le * 1024 * 256; w.N0 = 256; w.src1 = a.in[18] + (size_t)le * 1024 * 256; w.N1 = 256; w.K = 1024; w.Nout = 512; w.kind = 4;
        w.gain = a.in[3] + l * 1024; w.dst = (bf16_t*)(ws + WS_WGU) + (size_t)le * 512 * 1024; return true; }
    if (mi < 70) { const int le = mi - 38;
        w.src0 = a.in[19] + (size_t)le * 256 * 1024; w.N0 = 1024; w.K = 256; w.Nout = 1024; w.dst = (bf16_t*)(ws + WS_WD) + (size_t)le * 1024 * 256; return true; }
    if (mi < 72) { const int l = mi - 70;
        w.src0 = a.in[20] + (size_t)l * 1024 * 1024; w.N0 = 1024; w.K = 1024; w.Nout = 1024; w.gain = a.in[4] + l * 1024; w.dst = (bf16_t*)(ws + WS_WPG) + (size_t)l * 1024 * 1024; return true; }
    if (mi < 74) { const int l = mi - 72;
        w.src0 = a.in[21] + (size_t)l * 256 * 1024; w.N0 = 1024; w.K = 256; w.Nout = 1024; w.dst = (bf16_t*)(ws + WS_WPP) + (size_t)l * 1024 * 256; return true; }
    return false;
}

__device__ __forceinline__ void p_prologue(const Args& a, LAS unsigned char* lds, int vcu, int G) {
    int tid = threadIdx.x; asm volatile("" : "+v"(tid));
    const int lane = tid & 63, wave = __builtin_amdgcn_readfirstlane(tid >> 6);
    const int gw = vcu * NWAVES + wave, NGW = G * NWAVES;
    unsigned char* ws = a.ws;
    LAS float* scr = (LAS float*)(lds + wave * 16384);
    int base = 0;
    for (int mi = 0; mi < 74; ++mi) {
        WConv w; get_conv(mi, a, w);
        const int n = (w.K / 64) * (w.Nout / 32);
        int it = (gw - (base % NGW) + NGW) % NGW;
        for (; it < n; it += NGW) conv_item(w, scr, it, lane);
        base += n;
    }
    {   const float* x = a.in[0]; bf16_t* hb = (bf16_t*)(ws + WS_HB); float* hpx = (float*)(ws + WS_HPX);
        for (int m = gw; m < NT; m += 2 * NGW) {
            const int m2 = (m + NGW < NT) ? m + NGW : m;
            const f32x4* xr = (const f32x4*)(x + (size_t)m * 1024) + lane; const f32x4* xr2 = (const f32x4*)(x + (size_t)m2 * 1024) + lane;
            f32x4 v[4], v2[4]; float s = 0.f, s2 = 0.f;
#pragma unroll
            for (int j = 0; j < 4; ++j) { v[j] = xr[64 * j]; v2[j] = xr2[64 * j]; }
#pragma unroll
            for (int j = 0; j < 4; ++j) { s += dot4(v[j]); s2 += dot4(v2[j]); }
            s = wave_sum(s); s2 = wave_sum(s2);
            u32x2* o8 = (u32x2*)(hb + (size_t)m * 1024) + lane; u32x2* o82 = (u32x2*)(hb + (size_t)m2 * 1024) + lane;
#pragma unroll
            for (int j = 0; j < 4; ++j) { u32x2 o; o.x = cvtpk(v[j][0], v[j][1]); o.y = cvtpk(v[j][2], v[j][3]); o8[64 * j] = o;
                                          u32x2 o2; o2.x = cvtpk(v2[j][0], v2[j][1]); o2.y = cvtpk(v2[j][2], v2[j][3]); o82[64 * j] = o2; }
            if (lane < 16) { hpx[(size_t)m * 16 + lane] = (lane == 0) ? s : 0.f; hpx[(size_t)m2 * 16 + lane] = (lane == 0) ? s2 : 0.f; }
        } }
    {   const int gt = (vcu * NTHR) + tid, NGT = G * NTHR;
        float* cosA = (float*)(ws + WS_COSA); float* sinA = (float*)(ws + WS_SINA); float* cosB = (float*)(ws + WS_COSB); float* sinB = (float*)(ws + WS_SINB);
        for (int i = gt; i < NS * 64; i += NGT) { const int s = i >> 6, j = i & 63; const float inv = powf(10000.0f, -(float)j / 64.0f); float sn, cs; sincosf((float)s * inv, &sn, &cs); cosA[i] = cs; sinA[i] = sn; }
        for (int i = gt; i < NS * 32; i += NGT) { const int s = i >> 5, j = i & 31; const float inv = powf(10000.0f, -(float)j / 32.0f); float sn, cs; sincosf((float)s * inv, &sn, &cs); cosB[i] = cs; sinB[i] = sn; }
        float* km = (float*)(ws + WS_KMEAN);
        for (int i = gt; i < NB * NH * 32 * 128; i += NGT) km[i] = 0.f;
        float* wrt = (float*)(ws + WS_WRT);
        for (int i = gt; i < 2 * 1024 * 20; i += NGT) { const int l = i / 20480, r = i % 20480, k = r / 20, c = r % 20;
            const float g = a.in[3][l * 1024 + k];
            wrt[i] = g * (c < 4 ? a.in[15][(size_t)(l * 1024 + k) * 4 + c] : a.in[16][(size_t)(l * 1024 + k) * 16 + (c - 4)]); }
    }
}

template <int DQK, int MODE>
__device__ __forceinline__ void p_attention(const Args& a, unsigned char* ldsg) {
    unsigned char* ws = a.ws;
    for (int L = blockIdx.x; L < 512; L += gridDim.x) {
        const int xcd = L & 7, k = L >> 3, bh = xcd + 8 * (k >> 4), x = k & 15, b = bh >> 3, h = bh & 7;
        for (int pass = 0; pass < 2; ++pass) {
            const int qb = pass ? x : 31 - x, P0 = qb * 256;
            bf16_t* Op = (bf16_t*)(ws + WS_O) + ((size_t)(b * NS + P0) * 1024 + h * 128);
            if (MODE == 1) {
                const bf16_t* Q = (const bf16_t*)(ws + WS_Q) + (size_t)bh * NS * 128;
                const bf16_t* Kp = (const bf16_t*)(ws + WS_K0) + (size_t)bh * NS * 128;
                const bf16_t* Vp = (const bf16_t*)(ws + WS_V0) + (size_t)bh * NS * 128;
                at::attn_unit<DQK, MODE>((char*)ldsg, Q + (size_t)P0 * 128, Kp, nullptr, Vp, Op, P0, (const float*)(ws + WS_KMEAN) + (size_t)bh * 32 * 128);
            } else {
                const bf16_t* Q = (const bf16_t*)(ws + WS_Q) + (size_t)bh * NS * 192;
                const bf16_t* Kp = (const bf16_t*)(ws + WS_KN1) + (size_t)bh * NS * 128;
                const bf16_t* Kr = (const bf16_t*)(ws + WS_KROPE) + (size_t)b * NS * 64;
                const bf16_t* Vp = (const bf16_t*)(ws + WS_V1) + (size_t)bh * NS * 128;
                at::attn_unit<DQK, MODE>((char*)ldsg, Q + (size_t)P0 * 192, Kp, Kr, Vp, Op, P0, nullptr);
            }
        }
    }
}

__global__ void __launch_bounds__(NTHR, 2) mega(Args a) {
    extern __shared__ __attribute__((aligned(16))) unsigned char lds_g[];
    LAS unsigned char* lds = (LAS unsigned char*)lds_g;
    const int tid = threadIdx.x;
    const int G = gridDim.x, bx = blockIdx.x, vcu = (G % 8 == 0) ? (bx % 8) * (G / 8) + bx / 8 : bx;
    unsigned char* ws = a.ws;
    volatile LAS unsigned* MISC = (volatile LAS unsigned*)(lds + LDS_MISC);
    for (int u = tid; u < 256; u += NTHR) MISC[u] = 0u;
    __syncthreads();
    XcdBarrier bar = xcd_barrier_post((unsigned*)(ws + WS_CTL) + CW_BAR, MISC);
    const int lo = a.ph_lo, hi = a.ph_hi;
#ifndef DBG_ONLY
#define DBG_EN(k) true
#else
#define DBG_EN(k) ((k) == DBG_ONLY)
#endif
#define IN(k) (DBG_EN(k) && lo <= (k) && (k) < hi)
#define SEAM(k) do { if (IN(k) && IN((k) + 1)) xcd_barrier(bar); } while (0)
    if (IN(0)) { p_prologue(a, lds, vcu, G); }
    SEAM(0);
    if (IN(1)) {
        g8::DenseP P{(const char*)(ws + WS_HB), (const char*)(ws + WS_WQKV0), 1024, 1024, 1024, NT / 256, 3072 / 256, G, bx};
        EpiQKV E{(const float*)(ws + WS_HPX), (const float*)(ws + WS_COSA), (const float*)(ws + WS_SINA), (bf16_t*)(ws + WS_Q), (bf16_t*)(ws + WS_K0), (bf16_t*)(ws + WS_V0), (float*)(ws + WS_KMEAN)};
        g8::gemm_phase(lds, P, E);
    }
    SEAM(1);
    if (IN(2)) { p_attention<128, 1>(a, lds_g); }
    SEAM(2);
    if (IN(3)) {
        g8::DenseP P{(const char*)(ws + WS_O), (const char*)(ws + WS_WO0), 1024, 1024, 1024, NT / 256, 4, G, bx};
        EpiResid E{(const bf16_t*)(ws + WS_HB), (bf16_t*)(ws + WS_HB), (float*)(ws + WS_HP0)};
        g8::gemm_phase(lds, P, E);
    }
    SEAM(3);
#define MOE_PLE(PB, layer, HBC, HBN) \
    if (IN((PB) + 0)) { p_route(a, lds, (layer), (const bf16_t*)(HBC), vcu, G); } \
    SEAM((PB) + 0); \
    if (IN((PB) + 1)) { \
        const int NRT = moe_prefix(a, lds, (layer)); \
        const unsigned* cnt = (const unsigned*)(ws + WS_CTL) + CW_CNT + (layer) * 24 * 16; \
        MoeUnits U{(LAS const int*)(lds + LDS_TB), NRT, G, bx}; \
        MoeGuP P{(const char*)(HBC), (const char*)(ws + WS_WGU) + (size_t)(layer) * 16 * 512 * 1024 * 2, (const int*)(ws + WS_LIST), cnt, U, 1024, 1024}; \
        EpiGateUp E{(const float*)(ws + WS_HP0), (const float*)(ws + WS_TOKW), (const int*)(ws + WS_LIST), cnt, (LAS const int*)(lds + LDS_TB), (bf16_t*)(ws + WS_ACT)}; \
        g8::gemm_phase(lds, P, E); \
        g8::DenseP P2{(const char*)(ws + WS_PB), (const char*)(ws + WS_WPP) + (size_t)(layer) * 1024 * 256 * 2, 256, 256, 256, NT / 256, 4, G, bx}; \
        EpiStore E2{(bf16_t*)(ws + WS_PP), 1024}; \
        g8::gemm_phase(lds, P2, E2); \
    } \
    SEAM((PB) + 1); \
    if (IN((PB) + 2)) { \
        const int NRT = moe_prefix(a, lds, (layer)); \
        const unsigned* cnt = (const unsigned*)(ws + WS_CTL) + CW_CNT + (layer) * 24 * 16; \
        MoeUnits U{(LAS const int*)(lds + LDS_TB), NRT, G, bx}; \
        MoeDownP P{(const char*)(ws + WS_ACT), (const char*)(ws + WS_WD) + (size_t)(layer) * 16 * 1024 * 256 * 2, U, 256, 512}; \
        EpiDown E{(bf16_t*)(HBC), (float*)(ws + WS_HP1), (const int*)(ws + WS_LIST), cnt, (LAS const int*)(lds + LDS_TB)}; \
        g8::gemm_phase(lds, P, E); \
    } \
    SEAM((PB) + 2); \
    if (IN((PB) + 3)) { \
        g8::DenseP P{(const char*)(HBC), (const char*)(ws + WS_WPG) + (size_t)(layer) * 1024 * 1024 * 2, 1024, 1024, 1024, NT / 256, 4, G, bx}; \
        EpiPle E{(const float*)(ws + WS_HP1), (const bf16_t*)(ws + WS_PP), (const bf16_t*)(HBC), (bf16_t*)(HBN), (float*)(ws + WS_HP2)}; \
        g8::gemm_phase(lds, P, E); \
    } \
    SEAM((PB) + 3);
    MOE_PLE(4, 0, ws + WS_HB, a.out)
    if (IN(8)) {
        g8::DenseP P{(const char*)a.out, (const char*)(ws + WS_WDQKV), 1024, 1024, 1024, NT / 256, 3, G, bx};
        EpiDqkv E{(const float*)(ws + WS_HP2), (const float*)(ws + WS_COSB), (const float*)(ws + WS_SINB), (bf16_t*)(ws + WS_CQ), (bf16_t*)(ws + WS_CKV), (bf16_t*)(ws + WS_KROPE), (float*)(ws + WS_CQP), (float*)(ws + WS_KVP)};
        g8::gemm_phase(lds, P, E);
    }
    SEAM(8);
    if (IN(9)) {
        g8::DenseP P{(const char*)(ws + WS_CQ), (const char*)(ws + WS_WUQ), 384, 384, 384, NT / 256, 6, G, bx};
        EpiUq E{(const float*)(ws + WS_CQP), (const float*)(ws + WS_COSB), (const float*)(ws + WS_SINB), (bf16_t*)(ws + WS_Q)};
        g8::gemm_phase(lds, P, E);
        g8::DenseP P2{(const char*)(ws + WS_CKV), (const char*)(ws + WS_WUKV), 256, 256, 256, NT / 256, 8, G, bx};
        EpiUkv E2{(const float*)(ws + WS_KVP), (bf16_t*)(ws + WS_KN1), (bf16_t*)(ws + WS_V1)};
        g8::gemm_phase(lds, P2, E2);
    }
    SEAM(9);
    if (IN(10)) { p_attention<192, 0>(a, lds_g); }
    SEAM(10);
    if (IN(11)) {
        g8::DenseP P{(const char*)(ws + WS_O), (const char*)(ws + WS_WO1), 1024, 1024, 1024, NT / 256, 4, G, bx};
        EpiResid E{(const bf16_t*)a.out, (bf16_t*)a.out, (float*)(ws + WS_HP0)};
        g8::gemm_phase(lds, P, E);
    }
    SEAM(11);
    MOE_PLE(12, 1, a.out, ws + WS_HB)
    if (IN(16)) {
        int t2 = threadIdx.x; asm volatile("" : "+v"(t2)); const int lane = t2 & 63, wave = t2 >> 6; const float* fg = a.in[5];
        const bf16_t* hfin = (const bf16_t*)(ws + WS_HB);
        for (int mrow = vcu * NWAVES + wave; mrow < NT; mrow += G * NWAVES) {
            f32x4 v[4]; float s = 0.f;
#pragma unroll
            for (int j = 0; j < 2; ++j) { unpack8(*((const u32x4*)(hfin + (size_t)mrow * 1024) + lane + 64 * j), v[2 * j], v[2 * j + 1]); s += dot4(v[2 * j]) + dot4(v[2 * j + 1]); }
            s = wave_sum(s);
            const float r = rsqrtf(s * (1.0f / 1024.0f) + EPS);
            f32x4* xr = (f32x4*)(a.out + (size_t)mrow * 1024);
#pragma unroll
            for (int j = 0; j < 2; ++j) { const int c4 = 2 * (lane + 64 * j);
                xr[c4] = v[2 * j] * r * *((const f32x4*)fg + c4); xr[c4 + 1] = v[2 * j + 1] * r * *((const f32x4*)fg + c4 + 1); }
        }
    }
#undef IN
#undef SEAM
}

constexpr int N_PHASES = 17;
static int g_grid = 0;
static bool setup() {
    if (g_grid) return g_grid > 0;
    int dev = 0, cus = 0;
    if (hipGetDevice(&dev) != hipSuccess || hipDeviceGetAttribute(&cus, hipDeviceAttributeMultiprocessorCount, dev) != hipSuccess) { g_grid = -1; return false; }
    if (hipFuncSetAttribute((const void*)mega, hipFuncAttributeMaxDynamicSharedMemorySize, LDS_BYTES) != hipSuccess) { fprintf(stderr, "hipFuncSetAttribute failed\n"); g_grid = -1; return false; }
    int per_cu = 0;
    if (hipOccupancyMaxActiveBlocksPerMultiprocessor(&per_cu, (const void*)mega, NTHR, LDS_BYTES) != hipSuccess || per_cu < 1) { fprintf(stderr, "occupancy query: %d\n", per_cu); }
    (void)hipGetLastError();
    g_grid = cus;
    return true;
}
static void run_phases(const Args& base, int lo, int hi, bool one_launch, hipStream_t st) {
    if (one_launch) { Args a = base; a.ph_lo = lo; a.ph_hi = hi; hipLaunchKernelGGL(mega, dim3(g_grid), dim3(NTHR), LDS_BYTES, st, a); }
    else for (int p = lo; p < hi; ++p) { Args a = base; a.ph_lo = p; a.ph_hi = p + 1;
#ifdef PROBE_ROUTE
        if (p == 4) { Args b = base; b.ph_lo = 12; b.ph_hi = 13; hipLaunchKernelGGL(mega, dim3(g_grid), dim3(NTHR), LDS_BYTES, st, b); }
        if (p == 12) (void)hipMemsetAsync(base.ws + WS_CTL + (CW_CNT + 24 * 16) * 4, 0, 24 * 16 * 4, st);
#endif
        hipLaunchKernelGGL(mega, dim3(g_grid), dim3(NTHR), LDS_BYTES, st, a);
#ifdef DOUBLE_PHASE
        if (p == DOUBLE_PHASE) hipLaunchKernelGGL(mega, dim3(g_grid), dim3(NTHR), LDS_BYTES, st, a);
#endif
    }
}
}
#ifndef ONE_LAUNCH
#define ONE_LAUNCH 1
#endif
extern "C" void kernel_launch(void* const* d_in, const int* in_sizes, int n_in, void* d_out, int out_size, void* d_ws, size_t ws_size, hipStream_t stream) {
    (void)in_sizes; (void)out_size;
    if (n_in != 22) { fprintf(stderr, "kernel_launch: expected 22 inputs, got %d\n", n_in); return; }
    if (ws_size < fk::WS_END) { fprintf(stderr, "kernel_launch: workspace too small (%zu)\n", ws_size); return; }
    if (!fk::setup()) return;
    (void)hipMemsetAsync((char*)d_ws + fk::WS_CTL, 0, fk::CTL_ZERO_BYTES, stream);
    fk::Args a{};
    for (int i = 0; i < 22; ++i) a.in[i] = (const float*)d_in[i];
    a.out = (float*)d_out; a.ws = (unsigned char*)d_ws;
    fk::run_phases(a, 0, fk::N_PHASES, ONE_LAUNCH != 0, stream);
}
```

```cpp
#include <hip/hip_runtime.h>
#include <cstdio>
#include <cstdint>
#include <cmath>
namespace fk {
#define LAS __attribute__((address_space(3)))
#define GAS __attribute__((address_space(1)))
typedef unsigned short bf16_t;
typedef short bf16x8 __attribute__((ext_vector_type(8)));
typedef short s16x4 __attribute__((ext_vector_type(4)));
typedef float f32x4 __attribute__((ext_vector_type(4)));
typedef float f32x16 __attribute__((ext_vector_type(16)));
typedef unsigned u32x4 __attribute__((ext_vector_type(4)));
typedef unsigned u32x2 __attribute__((ext_vector_type(2)));
typedef float f32x2_t __attribute__((ext_vector_type(2)));
typedef __bf16 bf16x2_t __attribute__((ext_vector_type(2)));

constexpr int NB = 4, NS = 8192, ND = 1024, NT = NB * NS, NH = 8;
constexpr float EPS = 1e-6f;
constexpr int NWAVES = 8, NTHR = 512;

constexpr size_t MiB = 1u << 20;
constexpr size_t WS_CTL = 0, CTL_ZERO_BYTES = 1 * MiB;
constexpr size_t WS_COSA = 1 * MiB, WS_SINA = 3 * MiB, WS_COSB = 5 * MiB, WS_SINB = 6 * MiB;
constexpr size_t WS_KMEAN = 7 * MiB;
constexpr size_t WS_WRT = 7 * MiB + 512 * 1024;
constexpr size_t WS_HPX = 8 * MiB, WS_HP0 = 10 * MiB, WS_HP1 = 12 * MiB, WS_HP2 = 14 * MiB;
constexpr size_t WS_CQP = 16 * MiB, WS_KVP = 17 * MiB;
constexpr size_t WS_TOKW = 18 * MiB;
constexpr size_t WS_LIST = 19 * MiB;
constexpr size_t WS_WQKV0 = 24 * MiB, WS_WO0 = 30 * MiB, WS_WDQKV = 32 * MiB, WS_WUQ = 34 * MiB, WS_WUKV = 36 * MiB, WS_WO1 = 37 * MiB;
constexpr size_t WS_WGU = 40 * MiB;
constexpr size_t WS_WD = 72 * MiB;
constexpr size_t WS_WPG = 88 * MiB;
constexpr size_t WS_WPP = 92 * MiB;
constexpr size_t WS_HB = 94 * MiB;
constexpr size_t WS_CQ = WS_HB, WS_CKV = WS_HB + 24 * MiB, WS_KROPE = WS_HB + 40 * MiB;
constexpr size_t WS_O = 158 * MiB;
constexpr size_t WS_R = 222 * MiB;
constexpr size_t WS_Q = WS_R, WS_K0 = WS_R + 64 * MiB, WS_V0 = WS_R + 128 * MiB;
constexpr size_t WS_KN1 = WS_R + 96 * MiB, WS_V1 = WS_R + 160 * MiB;
constexpr size_t WS_ACT = WS_R, WS_PB = WS_R + 40 * MiB, WS_PP = WS_R + 64 * MiB;
constexpr size_t WS_PART2 = WS_R + 224 * MiB;
constexpr size_t WS_END = WS_PART2 + 64 * MiB;
constexpr int CW_CNT = 1024;
constexpr int CW_BAR = 4096;
constexpr int CW_LCNT = 8192;

constexpr int RING_BYTES = 131072;
constexpr int LDS_MISC = RING_BYTES;
constexpr int LDS_BYTES = 147456;

struct Args { const float* in[22]; float* out; unsigned char* ws; int ph_lo, ph_hi; };

__device__ __forceinline__ unsigned cvtpk(float lo, float hi) { f32x2_t v = {lo, hi}; bf16x2_t b = __builtin_convertvector(v, bf16x2_t); return __builtin_bit_cast(unsigned, b); }
__device__ __forceinline__ float bf2f(unsigned short b) { return __builtin_bit_cast(float, (unsigned)b << 16); }
__device__ __forceinline__ u32x4 pack8(f32x4 a, f32x4 b) { u32x4 w = {cvtpk(a[0], a[1]), cvtpk(a[2], a[3]), cvtpk(b[0], b[1]), cvtpk(b[2], b[3])}; return w; }
__device__ __forceinline__ float wave_sum(float v) {
#pragma unroll
    for (int o = 1; o < 64; o <<= 1) v += __shfl_xor(v, o);
    return v;
}
__device__ __forceinline__ float dot4(f32x4 a) { return (a[0] * a[0] + a[1] * a[1]) + (a[2] * a[2] + a[3] * a[3]); }
template <int NP> __device__ __forceinline__ float row_rs(const float* hp, float invd) {
    float s = 0.f;
#pragma unroll
    for (int i = 0; i < NP / 4; ++i) { const f32x4 a = *(const f32x4*)(hp + 4 * i); s += (a[0] + a[1]) + (a[2] + a[3]); }
    return rsqrtf(s * invd + EPS);
}

#define XB_TMO      128
#define XB_XCNT(j)  (256  + 64 * (j))
#define XB_XSUB(j)  (1280 + 64 * (j))
#define XB_XGEN(j)  (2304 + 64 * (j))
#define XB_TOP      3328
#define XB_TOPGEN   3392
#define XCD_BAR_WORDS 3456
#define XB_SPIN_CAP (1u << 18)
__device__ __forceinline__ unsigned xb_ld(unsigned* p)              { return __hip_atomic_load(p, __ATOMIC_RELAXED, __HIP_MEMORY_SCOPE_AGENT); }
__device__ __forceinline__ unsigned xb_add(unsigned* p, unsigned v) { return __hip_atomic_fetch_add(p, v, __ATOMIC_RELAXED, __HIP_MEMORY_SCOPE_AGENT); }
__device__ __forceinline__ unsigned xb_xcc_id() { return (unsigned)__builtin_amdgcn_s_getreg((3 << 11) | 20) & 0xFu; }
#define XB_SPIN(cond, bar) do { unsigned _sp = 0; while (cond) { __builtin_amdgcn_s_sleep(1); \
    if ((++_sp & 255u) == 0u) { if (xb_ld(&(bar)[XB_TMO])) break; if (_sp > XB_SPIN_CAP) { atomicAdd(&(bar)[XB_TMO], 1u); break; } } } } while (0)
struct XcdBarrier { unsigned* bar; unsigned x; volatile LAS unsigned* st; };
__device__ __forceinline__ XcdBarrier xcd_barrier_post(unsigned* bar, volatile LAS unsigned* st) {
    XcdBarrier b; b.bar = bar; b.x = xb_xcc_id(); b.st = st;
    if (threadIdx.x == 0) (void)xb_add(&bar[XB_XCNT(b.x)], 1u);
    return b;
}
__device__ __forceinline__ void xcd_barrier_complete(unsigned* bar, unsigned x, unsigned& nloc, unsigned& nx) {
    const unsigned G = gridDim.x * gridDim.y * gridDim.z;
    unsigned sum, cnt, mine, sp = 0u;
    for (;;) {
        sum = 0u; cnt = 0u; mine = 0u;
#pragma unroll
        for (unsigned j = 0; j < 16; ++j) { const unsigned c = xb_ld(&bar[XB_XCNT(j)]); sum += c; cnt += (c > 0u) ? 1u : 0u; mine = (j == x) ? c : mine; }
        if (sum == G) break;
        __builtin_amdgcn_s_sleep(1);
        if ((++sp & 255u) == 0u) { if (xb_ld(&bar[XB_TMO])) break; if (sp > XB_SPIN_CAP) { atomicAdd(&bar[XB_TMO], 1u); break; } }
    }
    nloc = mine > 0u ? mine : 1u; nx = cnt > 0u ? cnt : 1u;
}
__device__ __forceinline__ void xcd_barrier(const XcdBarrier& b) {
    asm volatile("s_waitcnt vmcnt(0)" ::: "memory");
    __syncthreads();
    if (threadIdx.x == 0) {
        unsigned* bar = b.bar;
        __builtin_amdgcn_s_waitcnt(0);
        unsigned nloc = b.st[0], nx = b.st[1];
        if (nloc == 0u) { xcd_barrier_complete(bar, b.x, nloc, nx); b.st[0] = nloc; b.st[1] = nx; }
        const unsigned old = xb_add(&bar[XB_XSUB(b.x)], 1u);
        const unsigned gen = old / nloc;
        if (old + 1u == (gen + 1u) * nloc) {
            __builtin_amdgcn_fence(__ATOMIC_RELEASE, "agent");
            asm volatile("s_waitcnt vmcnt(0)" ::: "memory");
            const unsigned og = xb_add(&bar[XB_TOP], 1u);
            const unsigned tg = og / nx;
            if (og + 1u == (tg + 1u) * nx) xb_add(&bar[XB_TOPGEN], 1u);
            else XB_SPIN(xb_ld(&bar[XB_TOPGEN]) == tg, bar);
            __builtin_amdgcn_fence(__ATOMIC_ACQUIRE, "agent");
            xb_add(&bar[XB_XGEN(b.x)], 1u);
            asm volatile("s_waitcnt vmcnt(0)" ::: "memory");
        } else {
            XB_SPIN(xb_ld(&bar[XB_XGEN(b.x)]) == gen, bar);
            __builtin_amdgcn_fence(__ATOMIC_ACQUIRE, "agent");
            asm volatile("s_waitcnt vmcnt(0)" ::: "memory");
        }
    }
    __syncthreads();
}

namespace g8 {
constexpr int BM = 256, BK = 64, HALF = 128, HTB = HALF * BK * 2, STAGE_BYTES = 8 * HTB, NXCD = 8, WGM = 8;
__device__ __forceinline__ int lds_byte(int r, int c) { const int st = (r >> 4) * 2 + (c >> 5), rr = r & 15, cc = c & 31, ob = rr * 64 + cc * 2; return st * 1024 + (ob ^ (((ob >> 9) & 1) << 5)); }
__device__ __forceinline__ void stage_rc(int b, int& R, int& C) { const int st = b / 1024, sb = b % 1024, swz = sb ^ (((sb >> 9) & 1) << 5); R = (st >> 1) * 16 + swz / 64; C = (st & 1) * 32 + (swz % 64) / 2; }
__device__ __forceinline__ int perm32(int rho) { const int n = rho >> 4, i = rho & 15; return 8 * (i >> 2) + 4 * n + (i & 3); }
struct Unit { int pm, pn, aux; };
struct AOff { unsigned o[2][2]; };

__device__ __forceinline__ bool static_order(int i, int G, int c, int nM, int nN, int& pm, int& pn) {
    const int nwg = nM * nN; const long L = (long)i * G + c; if (L >= nwg) return false;
    int wgid = (int)L; { const int q = nwg / NXCD, r = nwg % NXCD, xcd = wgid % NXCD, off = wgid / NXCD; wgid = (xcd < r ? xcd * (q + 1) : r * (q + 1) + (xcd - r) * q) + off; }
    const int nig = WGM * nN, gid = wgid / nig, fm = gid * WGM, gsz = (nM - fm) < WGM ? (nM - fm) : WGM;
    pm = fm + ((wgid % nig) % gsz); pn = (wgid % nig) / gsz; return true;
}
struct DenseP {
    const char* A; const char* B; int lda, ldb, K, nM, nN, G, c;
    __device__ __forceinline__ bool next(int i, Unit& u) const { u.aux = 0; return static_order(i, G, c, nM, nN, u.pm, u.pn); }
    __device__ __forceinline__ void aoff(const Unit& u, const int (&R)[2], const int (&C)[2], AOff& o) const {
#pragma unroll
        for (int h = 0; h < 2; ++h)
#pragma unroll
            for (int i = 0; i < 2; ++i) o.o[h][i] = (unsigned)(((u.pm * BM + h * HALF + R[i]) * lda + C[i]) * 2);
    }
    __device__ __forceinline__ const char* bbase(const Unit& u, int kt) const { return B + ((size_t)u.pn * BM * ldb + (size_t)kt * BK) * 2; }
};

template <class Prov, class Epi>
__device__ __forceinline__ void gemm_phase(LAS unsigned char* lds, const Prov& P, const Epi& E) {
    int tid = threadIdx.x; asm volatile("" : "+v"(tid));
    const int wid = __builtin_amdgcn_readfirstlane(tid >> 6), lane = tid & 63, wr = wid >> 2, wc = wid & 3, fr = lane & 15, fq = lane >> 4;
    const int K = P.K, nt = K / BK;
    int R[2], C[2]; unsigned voffB[2];
#pragma unroll
    for (int i = 0; i < 2; ++i) { stage_rc(tid * 16 + i * 8192, R[i], C[i]); const int Rb = (R[i] & ~31) + perm32(R[i] & 31); voffB[i] = (unsigned)(Rb * P.ldb + C[i]) * 2u; }
    const size_t hstepB = (size_t)HALF * P.ldb * 2;
    const unsigned ldsw = (unsigned)wid * 1024u;
    const int aoff = lds_byte(wr * 64 + fr, fq * 8), boff = lds_byte(wc * 32 + fr, fq * 8);
#define G8_SA(b, h) (((b) * 2 + (h)) * HTB)
#define G8_SB(b, h) ((4 + (b) * 2 + (h)) * HTB)
#define G8_STAGE_A(bufoff, h, AO, kb) do { _Pragma("unroll") for (int _i = 0; _i < 2; ++_i) \
        __builtin_amdgcn_global_load_lds((const unsigned*)(P.A + (size_t)((AO).o[h][_i] + (kb))), (LAS unsigned*)(lds + (bufoff) + ldsw + _i * 8192), 16, 0, 0); } while (0)
#define G8_STAGE_B(bufoff, bp) do { _Pragma("unroll") for (int _i = 0; _i < 2; ++_i) \
        __builtin_amdgcn_global_load_lds((const unsigned*)((bp) + voffB[_i]), (LAS unsigned*)(lds + (bufoff) + ldsw + _i * 8192), 16, 0, 0); } while (0)
#define G8_LDA(dst, b, h) do { _Pragma("unroll") for (int m = 0; m < 4; ++m) _Pragma("unroll") for (int k = 0; k < 2; ++k) dst[m][k] = *(const LAS bf16x8*)(lds + G8_SA(b, h) + aoff + m * 2048 + k * 1024); } while (0)
#define G8_LDB(dst, b, h) do { _Pragma("unroll") for (int n = 0; n < 2; ++n) _Pragma("unroll") for (int k = 0; k < 2; ++k) dst[n][k] = *(const LAS bf16x8*)(lds + G8_SB(b, h) + boff + n * 2048 + k * 1024); } while (0)
#define G8_MMA(ai, bj, At, Bt) do { __builtin_amdgcn_s_setprio(1); _Pragma("unroll") for (int m = 0; m < 4; ++m) _Pragma("unroll") for (int n = 0; n < 2; ++n) _Pragma("unroll") for (int k = 0; k < 2; ++k) \
        acc[ai][bj][m][n] = __builtin_amdgcn_mfma_f32_16x16x32_bf16(Bt[n][k], At[m][k], acc[ai][bj][m][n], 0, 0, 0); __builtin_amdgcn_s_setprio(0); } while (0)
#define G8_WAIT_V(n) asm volatile("s_waitcnt vmcnt(" #n ")" ::: "memory")
#define G8_WAIT_L(n) asm volatile("s_waitcnt lgkmcnt(" #n ")" ::: "memory")
#define G8_BAR __builtin_amdgcn_s_barrier()
#define G8_SCHED __builtin_amdgcn_sched_barrier(0)
    Unit cur, nxt; int ui = 0;
    if (!P.next(0, cur)) return;
    f32x4 acc[2][2][4][2];
#pragma unroll
    for (int a = 0; a < 2; ++a)
#pragma unroll
        for (int b = 0; b < 2; ++b)
#pragma unroll
            for (int m = 0; m < 4; ++m)
#pragma unroll
                for (int n = 0; n < 2; ++n) acc[a][b][m][n] = (f32x4){0.f, 0.f, 0.f, 0.f};
    bf16x8 At[4][2], B0[2][2], B1[2][2];
    AOff cA, nA;
    P.aoff(cur, R, C, cA);
    {   const char* b0 = P.bbase(cur, 0); const char* b1 = P.bbase(cur, 1);
        G8_STAGE_B(G8_SB(0, 0), b0); G8_STAGE_B(G8_SB(0, 1), b0 + hstepB); G8_STAGE_A(G8_SA(0, 0), 0, cA, 0u); G8_STAGE_A(G8_SA(0, 1), 1, cA, 0u);
        if (wr == 1) G8_BAR;
        G8_WAIT_V(2); G8_BAR;
        G8_STAGE_B(G8_SB(1, 0), b1); G8_STAGE_A(G8_SA(1, 0), 0, cA, 128u); G8_STAGE_B(G8_SB(1, 1), b1 + hstepB);
        G8_WAIT_V(6); G8_BAR; }
    for (;;) {
        const bool has_next = P.next(ui + 1, nxt);
        if (has_next) P.aoff(nxt, R, C, nA); else { nA = cA; nxt = cur; }
        for (int t = 0; t < nt; t += 2) {
            const bool last = (t == nt - 2);
            const unsigned kb1 = (unsigned)(t + 1) * 128u;
            const unsigned kb2 = last ? 0u : (unsigned)(t + 2) * 128u, kb3 = kb2 + 128u;
            AOff s;
#pragma unroll
            for (int h = 0; h < 2; ++h)
#pragma unroll
                for (int i = 0; i < 2; ++i) s.o[h][i] = last ? nA.o[h][i] : cA.o[h][i];
            const char* b2 = last ? P.bbase(nxt, 0) : P.bbase(cur, t + 2);
            const char* b3 = last ? P.bbase(nxt, 1) : P.bbase(cur, t + 3);
            G8_LDB(B0, 0, 0); G8_LDB(B1, 0, 1); G8_SCHED; G8_LDA(At, 0, 0); G8_STAGE_A(G8_SA(1, 1), 1, cA, kb1);
            G8_WAIT_V(8); G8_WAIT_L(0); G8_BAR; G8_MMA(0, 0, At, B0); G8_MMA(0, 1, At, B1); G8_BAR; G8_SCHED;
            G8_LDA(At, 0, 1); G8_STAGE_B(G8_SB(0, 0), b2); G8_STAGE_B(G8_SB(0, 1), b2 + hstepB); G8_STAGE_A(G8_SA(0, 0), 0, s, kb2);
            G8_WAIT_V(8); G8_WAIT_L(0); G8_BAR; G8_MMA(1, 0, At, B0); G8_MMA(1, 1, At, B1); G8_BAR; G8_SCHED;
            G8_LDB(B0, 1, 0); G8_LDB(B1, 1, 1); G8_SCHED; G8_LDA(At, 1, 0); G8_STAGE_A(G8_SA(0, 1), 1, s, kb2);
            G8_WAIT_V(8); G8_WAIT_L(0); G8_BAR; G8_MMA(0, 0, At, B0); G8_MMA(0, 1, At, B1); G8_BAR; G8_SCHED;
            G8_LDA(At, 1, 1); G8_STAGE_B(G8_SB(1, 0), b3); G8_STAGE_B(G8_SB(1, 1), b3 + hstepB); G8_STAGE_A(G8_SA(1, 0), 0, s, kb3);
            G8_WAIT_V(8); G8_WAIT_L(0); G8_BAR; G8_MMA(1, 0, At, B0); G8_MMA(1, 1, At, B1); G8_BAR; G8_SCHED;
        }
        if (wr == 0) G8_BAR;
        E(acc, cur, wr, wc, fr, fq);
        if (!has_next) break;
#pragma unroll
        for (int a = 0; a < 2; ++a)
#pragma unroll
            for (int b = 0; b < 2; ++b)
#pragma unroll
                for (int m = 0; m < 4; ++m)
#pragma unroll
                    for (int n = 0; n < 2; ++n) acc[a][b][m][n] = (f32x4){0.f, 0.f, 0.f, 0.f};
        cur = nxt; cA = nA; ++ui;
        if (wr == 1) G8_BAR;
    }
    G8_WAIT_V(0);
    G8_BAR;
#undef G8_SA
#undef G8_SB
#undef G8_STAGE_A
#undef G8_STAGE_B
#undef G8_LDA
#undef G8_LDB
#undef G8_MMA
#undef G8_WAIT_V
#undef G8_WAIT_L
#undef G8_BAR
#undef G8_SCHED
}
}
using g8::Unit;


struct EpiQKV {
    const float* hpx; const float* cosA; const float* sinA; bf16_t* Q; bf16_t* Kk; bf16_t* V; float* kmean;
    __device__ __forceinline__ void operator()(const f32x4 (&acc)[2][2][4][2], const Unit& u, int wr, int wc, int fr, int fq) const {
        const int t = u.pn >> 2;
        const int bb = u.pm >> 5;
        if (t < 2) {
            const int hh = 2 * (u.pn & 3) + (wc >> 1), j0 = 32 * (wc & 1) + 8 * fq;
            bf16_t* dst0 = (t == 0 ? Q : Kk) + ((size_t)(bb * NH + hh) * NS) * 128;
            f32x4 ks[2][2] = {{{0.f, 0.f, 0.f, 0.f}, {0.f, 0.f, 0.f, 0.f}}, {{0.f, 0.f, 0.f, 0.f}, {0.f, 0.f, 0.f, 0.f}}};
#pragma unroll
            for (int ai = 0; ai < 2; ++ai)
#pragma unroll
                for (int m = 0; m < 4; ++m) {
                    const int row = u.pm * 256 + 128 * ai + 64 * wr + 16 * m + fr, s = row & (NS - 1);
                    const float rs = row_rs<16>(hpx + (size_t)row * 16, 1.0f / 1024.0f);
                    f32x4 o1[2], o2[2];
#pragma unroll
                    for (int n = 0; n < 2; ++n) {
                        const f32x4 cs = *(const f32x4*)(cosA + (size_t)s * 64 + j0 + 4 * n), sn = *(const f32x4*)(sinA + (size_t)s * 64 + j0 + 4 * n);
                        const f32x4 x1 = acc[ai][0][m][n] * rs, x2 = acc[ai][1][m][n] * rs;
                        o1[n] = x1 * cs - x2 * sn; o2[n] = x1 * sn + x2 * cs;
                        ks[0][n] += o1[n]; ks[1][n] += o2[n];
                    }
                    bf16_t* d = dst0 + (size_t)s * 128 + j0;
                    *(u32x4*)d = pack8(o1[0], o1[1]); *(u32x4*)(d + 64) = pack8(o2[0], o2[1]);
                }
            if (t == 1) {
#pragma unroll
                for (int q = 0; q < 2; ++q)
#pragma unroll
                    for (int n = 0; n < 2; ++n)
#pragma unroll
                        for (int e = 0; e < 4; ++e) { float v = ks[q][n][e]; v += __shfl_xor(v, 1); v += __shfl_xor(v, 2); v += __shfl_xor(v, 4); v += __shfl_xor(v, 8); ks[q][n][e] = v; }
                if (fr == 0) {
                    float* km = kmean + ((size_t)(bb * NH + hh) * 32 + (u.pm & 31)) * 128 + j0;
#pragma unroll
                    for (int q = 0; q < 2; ++q)
#pragma unroll
                        for (int n = 0; n < 2; ++n)
#pragma unroll
                            for (int e = 0; e < 4; ++e) atomicAdd(km + 64 * q + 4 * n + e, ks[q][n][e]);
                }
            }
        } else {
            const int d0 = 32 * wc + 8 * fq;
#pragma unroll
            for (int ai = 0; ai < 2; ++ai)
#pragma unroll
                for (int m = 0; m < 4; ++m) {
                    const int row = u.pm * 256 + 128 * ai + 64 * wr + 16 * m + fr, s = row & (NS - 1);
                    const float rs = row_rs<16>(hpx + (size_t)row * 16, 1.0f / 1024.0f);
#pragma unroll
                    for (int bj = 0; bj < 2; ++bj) {
                        const int hh = 2 * (u.pn - 8) + bj;
                        bf16_t* d = V + ((size_t)(bb * NH + hh) * NS + s) * 128 + d0;
                        *(u32x4*)d = pack8(acc[ai][bj][m][0] * rs, acc[ai][bj][m][1] * rs);
                    }
                }
        }
    }
};

__device__ __forceinline__ void unpack8(u32x4 w, f32x4& a, f32x4& b) {
#pragma unroll
    for (int e = 0; e < 2; ++e) { a[2 * e] = __builtin_bit_cast(float, w[e] << 16); a[2 * e + 1] = __builtin_bit_cast(float, w[e] & 0xffff0000u);
                                  b[2 * e] = __builtin_bit_cast(float, w[2 + e] << 16); b[2 * e + 1] = __builtin_bit_cast(float, w[2 + e] & 0xffff0000u); }
}
struct EpiResid {
    const bf16_t* base; bf16_t* hb; float* hp;
    __device__ __forceinline__ void operator()(const f32x4 (&acc)[2][2][4][2], const Unit& u, int wr, int wc, int fr, int fq) const {
#pragma unroll
        for (int ai = 0; ai < 2; ++ai)
#pragma unroll
            for (int m = 0; m < 4; ++m) {
                const int row = u.pm * 256 + 128 * ai + 64 * wr + 16 * m + fr;
                float ss = 0.f;
#pragma unroll
                for (int bj = 0; bj < 2; ++bj) {
                    const size_t off = (size_t)row * 1024 + u.pn * 256 + 128 * bj + 32 * wc + 8 * fq;
                    f32x4 b0, b1; unpack8(*(const u32x4*)(base + off), b0, b1);
                    const f32x4 v0 = acc[ai][bj][m][0] + b0, v1 = acc[ai][bj][m][1] + b1;
                    *(u32x4*)(hb + off) = pack8(v0, v1);
                    ss += dot4(v0) + dot4(v1);
                }
                ss += __shfl_xor(ss, 16); ss += __shfl_xor(ss, 32);
                if (fq == 0) hp[(size_t)row * 16 + u.pn * 4 + wc] = ss;
                if (m & 1) asm volatile("" ::: "memory");
            }
    }
};
namespace at {
constexpr int KVBLK = 64, SHM_V = KVBLK * 128 * 2;
constexpr float THR = 8.f;
#define AT_SBAR() __builtin_amdgcn_sched_barrier(0)
__device__ __forceinline__ int v_st(int k, int c) { const int kk = (k & ~0xC) | ((k & 4) << 1) | ((k & 8) >> 1); return ((kk >> 3) * 4 + (c >> 5)) * 512 + ((kk & 7) * 32 + (c & 31)) * 2; }
__device__ __forceinline__ int v_rd_base(int lane) { return ((lane & 3) << 3) | (((lane >> 2) & 3) << 6) | (((lane >> 4) & 1) << 5) | (((lane >> 5) & 1) << 8); }
constexpr int v_rd_off(int d0, int ks, int half) { return d0 * 512 + ks * 4096 + half * 2048; }
__device__ __forceinline__ int crow(int r, int hi) { return (r & 3) + 8 * (r >> 2) + 4 * hi; }

template <int DQK> __device__ __forceinline__ int kswz(int row, int colB) { return row * (DQK * 2) + (colB ^ ((row & 7) << 4)); }

__device__ __forceinline__ void mask_causal(f32x16& p0, f32x16& p1, int dq) {
    const float NEG = -__builtin_inff();
#pragma unroll
    for (int r = 0; r < 16; ++r) {
        const int c = (r & 3) + 8 * (r >> 2);
        if (dq - c < 0) p0[r] = NEG;
        if (dq - c - 32 < 0) p1[r] = NEG;
    }
}
__device__ __forceinline__ void mask_all(f32x16& p0, f32x16& p1, bool keep) {
    const float NEG = -__builtin_inff();
#pragma unroll
    for (int r = 0; r < 16; ++r) { p0[r] = keep ? p0[r] : NEG; p1[r] = keep ? p1[r] : NEG; }
}
__device__ __forceinline__ void partialSM(f32x16& p0, f32x16& p1, float& m_reg, float& mn, float& alpha, const float SC, const float C2) {
    float pmax = p0[0];
#pragma unroll
    for (int r = 1; r < 16; ++r) pmax = fmaxf(pmax, p0[r]);
#pragma unroll
    for (int r = 0; r < 16; ++r) pmax = fmaxf(pmax, p1[r]);
    { auto rr = __builtin_amdgcn_permlane32_swap(__float_as_uint(pmax), __float_as_uint(pmax), false, false);
      pmax = fmaxf(__uint_as_float(rr[0]), __uint_as_float(rr[1])); }
    if (__builtin_expect(__all((pmax - m_reg) * SC <= THR), 1)) { mn = m_reg; alpha = 1.f; }
    else { mn = fmaxf(m_reg, pmax); alpha = __builtin_amdgcn_exp2f((m_reg - mn) * C2); m_reg = mn; }
    const float mnL = -mn * C2;
#pragma unroll
    for (int r = 0; r < 16; ++r) p0[r] = fmaf(p0[r], C2, mnL);
#pragma unroll
    for (int r = 0; r < 16; ++r) p1[r] = fmaf(p1[r], C2, mnL);
#pragma unroll
    for (int r = 0; r < 16; ++r) p0[r] = __builtin_amdgcn_exp2f(p0[r]);
}
__device__ __forceinline__ void finishSM(f32x16& p0, f32x16& p1, float alpha, float& l_reg, bf16x8& pa0, bf16x8& pa1, bf16x8& pa2, bf16x8& pa3) {
#pragma unroll
    for (int r = 0; r < 16; ++r) p1[r] = __builtin_amdgcn_exp2f(p1[r]);
    float ps = 0;
#pragma unroll
    for (int r = 0; r < 16; ++r) ps += p0[r];
#pragma unroll
    for (int r = 0; r < 16; ++r) ps += p1[r];
    { auto rr = __builtin_amdgcn_permlane32_swap(__float_as_uint(ps), __float_as_uint(ps), false, false);
      ps = __uint_as_float(rr[0]) + __uint_as_float(rr[1]); }
    l_reg = l_reg * alpha + ps;
#define AT_PK4(P, B_, OUT) do { unsigned a0 = cvtpk(P[B_+0], P[B_+1]), a1 = cvtpk(P[B_+2], P[B_+3]);                          \
        unsigned b0 = cvtpk(P[B_+4], P[B_+5]), b1 = cvtpk(P[B_+6], P[B_+7]);                                             \
        auto r0 = __builtin_amdgcn_permlane32_swap(a0, b0, false, false); auto r1 = __builtin_amdgcn_permlane32_swap(a1, b1, false, false); \
        u32x4 w = {r0[0], r1[0], r0[1], r1[1]}; OUT = __builtin_bit_cast(bf16x8, w); } while (0)
    AT_PK4(p0, 0, pa0); AT_PK4(p0, 8, pa1); AT_PK4(p1, 0, pa2); AT_PK4(p1, 8, pa3);
#undef AT_PK4
}
template <int DQK>
__device__ __forceinline__ void qkt(f32x16& p0, f32x16& p1, const char* Kt, int r32, int hi, const bf16x8* qr, bool act) {
    if (!act) { const float NEG = -__builtin_inff();
#pragma unroll
        for (int r = 0; r < 16; ++r) { p0[r] = NEG; p1[r] = NEG; } return; }
    p0 = f32x16{}; p1 = f32x16{};
    const char* kb[4];
#pragma unroll
    for (int dd = 0; dd < 4; ++dd) kb[dd] = Kt + kswz<DQK>(r32, (dd * 16 + hi * 8) * 2);
#pragma unroll
    for (int d0 = 0; d0 < DQK / 16; ++d0) { const char* a = kb[d0 & 3] + (d0 >> 2) * 128;
        bf16x8 b0 = *reinterpret_cast<const bf16x8*>(a);
        bf16x8 b1 = *reinterpret_cast<const bf16x8*>(a + 32 * DQK * 2);
        p0 = __builtin_amdgcn_mfma_f32_32x32x16_bf16(b0, qr[d0], p0, 0, 0, 0);
        p1 = __builtin_amdgcn_mfma_f32_32x32x16_bf16(b1, qr[d0], p1, 0, 0, 0); }
}
template <int VB>
__device__ __forceinline__ void pv_tile(f32x16* o, int vb0, bf16x8 pa0, bf16x8 pa1, bf16x8 pa2, bf16x8 pa3, bool act) {
    if (!act) return;
#define AT_TRRD(dst, off) asm volatile("ds_read_b64_tr_b16 %0, %1 offset:%2" : "=&v"(dst) : "v"(vb0), "i"(off) : "memory")
#define AT_PV_D0(d0) do { s16x4 l0, l1, l2, l3, h0, h1, h2, h3; constexpr int b_ = VB * SHM_V + v_rd_off(d0, 0, 0); \
        AT_TRRD(l0, b_); AT_TRRD(h0, b_ + 2048); AT_TRRD(l1, b_ + 4096); AT_TRRD(h1, b_ + 6144); AT_TRRD(l2, b_ + 8192); AT_TRRD(h2, b_ + 10240); AT_TRRD(l3, b_ + 12288); AT_TRRD(h3, b_ + 14336); \
        asm volatile("s_waitcnt lgkmcnt(0)" ::: "memory"); AT_SBAR();   \
        o[d0] = __builtin_amdgcn_mfma_f32_32x32x16_bf16(pa0, (bf16x8){l0[0], l0[1], l0[2], l0[3], h0[0], h0[1], h0[2], h0[3]}, o[d0], 0, 0, 0);   \
        o[d0] = __builtin_amdgcn_mfma_f32_32x32x16_bf16(pa1, (bf16x8){l1[0], l1[1], l1[2], l1[3], h1[0], h1[1], h1[2], h1[3]}, o[d0], 0, 0, 0);   \
        o[d0] = __builtin_amdgcn_mfma_f32_32x32x16_bf16(pa2, (bf16x8){l2[0], l2[1], l2[2], l2[3], h2[0], h2[1], h2[2], h2[3]}, o[d0], 0, 0, 0);   \
        o[d0] = __builtin_amdgcn_mfma_f32_32x32x16_bf16(pa3, (bf16x8){l3[0], l3[1], l3[2], l3[3], h3[0], h3[1], h3[2], h3[3]}, o[d0], 0, 0, 0); } while (0)
    AT_PV_D0(0); AT_PV_D0(1); AT_PV_D0(2); AT_PV_D0(3);
#undef AT_PV_D0
#undef AT_TRRD
}

template <int DQK> struct Lds { static constexpr int SHM_K = KVBLK * DQK * 2, K_OFF = 2 * SHM_V, WS_OFF = K_OFF + 2 * SHM_K, BYTES = WS_OFF + NWAVES * 64 * 4, F_OFF = BYTES; };

constexpr int LCAP = 256 * 496;
__device__ __forceinline__ int loff(int n) { return 256 * (31 * n - (n * (n - 1)) / 2); }
struct SparseBufs { unsigned short* lists; unsigned* lcnt; unsigned* selinfo; float* ml; unsigned char* part01; unsigned char* part2; };

struct AttnP { const bf16_t* Qp; const bf16_t* Kn; const bf16_t* Kr; const bf16_t* Vp; bf16_t* Op; int P0, t0, NT, bh, nent; const unsigned short* ents; };

template <int DQK, int MODE>
__device__ __forceinline__ void attn_unit(char* lds, const AttnP& A, const SparseBufs& SB) {
    typedef Lds<DQK> L;
    constexpr int SHM_K = L::SHM_K;
    constexpr float SC = (DQK == 128) ? 0.08838834764831845f : 0.07216878364870323f;
    constexpr float C2 = 1.4426950408889634f * SC;
    constexpr int ND0 = DQK / 16;
    int tid = threadIdx.x; asm volatile("" : "+v"(tid));
    const int wid = __builtin_amdgcn_readfirstlane(tid >> 6), lane = tid & 63, r32 = lane & 31, hi = lane >> 5;
    const int NT = A.NT, t0 = A.t0, P0 = A.P0;
    const int qlo = P0 + wid * 32, qm = qlo + r32 - 4 * hi;
    char* V_lds = lds; char* K_lds = lds + L::K_OFF;
    float* ws = (float*)(lds + L::WS_OFF) + wid * 64; float* li_l = ws, * al_l = ws + 32;
    float m_reg = -1e30f, l_reg = 0; f32x16 o[4] = {};
    const int sr = tid >> 4, sc = (tid & 15) * 8, vst0 = v_st(sr, sc), vst1 = v_st(32 + sr, sc), kws = kswz<DQK>(sr, sc * 2);
    const int rr_ = tid >> 3, rc_ = (tid & 7) * 8, kws_r = kswz<DQK>(rr_, 256 + rc_ * 2);
    const int vb0 = (int)(uintptr_t)V_lds + v_rd_base(lane);
    bf16x8 qr[ND0];
    int ent = -1;
    if (MODE == 2) {
        const int ri = wid * 32 + r32; const bool valid = ri < A.nent;
        const int e = (int)A.ents[valid ? ri : 0]; ent = valid ? e : -1;
        const __amdgpu_buffer_rsrc_t rsQ = __builtin_amdgcn_make_buffer_rsrc((void*)A.Qp, 0, NS * 256, 0x00020000);
        const unsigned qo = (unsigned)((e & 8191) * 256 + hi * 16);
#pragma unroll
        for (int d0 = 0; d0 < ND0; ++d0) qr[d0] = __builtin_bit_cast(bf16x8, __builtin_amdgcn_raw_buffer_load_b128(rsQ, (int)(qo + d0 * 32), 0, 0));
    } else {
        const unsigned qo = (unsigned)(((wid * 32 + r32) * DQK + hi * 8) * 2);
#pragma unroll
        for (int d0 = 0; d0 < ND0; ++d0) qr[d0] = *(const bf16x8*)((const char*)A.Qp + qo + d0 * 32);
    }
    bf16x8 st_v0, st_v1, st_k0, st_k1, st_k2;
    const unsigned lo_a = (unsigned)((sr * 128 + sc) * 2), lo_r = (unsigned)((rr_ * 64 + rc_) * 2);
#define AT_VMW() asm volatile("s_waitcnt vmcnt(0)" ::: "memory")
    const __amdgpu_buffer_rsrc_t rsV = __builtin_amdgcn_make_buffer_rsrc((void*)A.Vp, 0, NS * 256, 0x00020000), rsK = __builtin_amdgcn_make_buffer_rsrc((void*)A.Kn, 0, NS * 256, 0x00020000);
    const __amdgpu_buffer_rsrc_t rsR = __builtin_amdgcn_make_buffer_rsrc((void*)(DQK == 192 ? A.Kr : A.Kn), 0, NS * 128, 0x00020000);
#define AT_BL(rs, vo, so) __builtin_bit_cast(bf16x8, __builtin_amdgcn_raw_buffer_load_b128(rs, (int)(vo), (int)(so), 0))
#define AT_SLOAD(k0) do { const int so_ = (k0) * 256; \
                          st_v0 = AT_BL(rsV, lo_a, so_); st_v1 = AT_BL(rsV, lo_a, so_ + 8192); \
                          st_k0 = AT_BL(rsK, lo_a, so_); st_k1 = AT_BL(rsK, lo_a, so_ + 8192); \
                          if (DQK == 192) { st_k2 = AT_BL(rsR, lo_r, (k0) * 128); } } while (0)
#define AT_SWRITE(bf) do { *(bf16x8*)(V_lds + (bf) * SHM_V + vst0) = st_v0; *(bf16x8*)(V_lds + (bf) * SHM_V + vst1) = st_v1; \
                           *(bf16x8*)(K_lds + (bf) * SHM_K + kws) = st_k0; *(bf16x8*)(K_lds + (bf) * SHM_K + kws + 32 * DQK * 2) = st_k1; \
                           if (DQK == 192) *(bf16x8*)(K_lds + (bf) * SHM_K + kws_r) = st_k2; } while (0)
#define AT_RESC(a) do { if (__any((a) < 1.f)) { if (hi == 0) al_l[r32] = (a); asm volatile("s_waitcnt lgkmcnt(0)" ::: "memory");              \
                     _Pragma("unroll") for (int d_ = 0; d_ < 4; ++d_) _Pragma("unroll") for (int r = 0; r < 16; ++r) o[d_][r] *= al_l[crow(r, hi)]; } } while (0)
#define AT_KBASE(t) ((t0 + (t)) * KVBLK)
#define AT_ACT(t) (MODE == 2 ? true : (AT_KBASE(t) <= qlo + 31))
#define AT_MASKT(P0_, P1_, t) do { if (MODE != 2) { const int kb_ = AT_KBASE(t); \
        if (kb_ + KVBLK - 1 > qlo && kb_ <= qlo + 31) mask_causal(P0_, P1_, qm - kb_); } } while (0)
    f32x16 pA0, pA1, pB0, pB1; float mnA, mnB, alA, alB; bf16x8 pa0, pa1, pa2, pa3;
    AT_SLOAD(AT_KBASE(0)); AT_VMW(); AT_SWRITE(0);
    __syncthreads();
    AT_SLOAD(AT_KBASE(1));
    AT_SBAR(); qkt<DQK>(pA0, pA1, K_lds, r32, hi, qr, AT_ACT(0));
    AT_MASKT(pA0, pA1, 0); partialSM(pA0, pA1, m_reg, mnA, alA, SC, C2);
    AT_VMW(); AT_SWRITE(1);
    __syncthreads();
#define AT_HALF_STEP(PX0, PX1, mnX, alX, PY0, PY1, alY, t, KB, VB, SB_) do {                                                      \
        AT_SBAR(); qkt<DQK>(PX0, PX1, K_lds + (KB) * SHM_K, r32, hi, qr, AT_ACT(t));                                             \
        finishSM(PY0, PY1, alY, l_reg, pa0, pa1, pa2, pa3); AT_SBAR();                                                           \
        if ((t) + 1 < NT) { AT_SLOAD(AT_KBASE((t) + 1)); AT_SBAR(); }                                                            \
        pv_tile<VB>(o, vb0, pa0, pa1, pa2, pa3, AT_ACT((t) - 1)); AT_MASKT(PX0, PX1, (t)); partialSM(PX0, PX1, m_reg, mnX, alX, SC, C2); \
        __syncthreads();                                                                                                      \
        if ((t) + 1 < NT) { AT_VMW(); AT_SWRITE(SB_); }                                                                           \
        AT_RESC(alX); __syncthreads(); } while (0)
    for (int t = 1; t + 1 < NT; t += 2) {
        AT_HALF_STEP(pB0, pB1, mnB, alB, pA0, pA1, alA, t, 1, 0, 0);
        AT_HALF_STEP(pA0, pA1, mnA, alA, pB0, pB1, alB, t + 1, 0, 1, 1);
    }
    AT_SBAR(); qkt<DQK>(pB0, pB1, K_lds + SHM_K, r32, hi, qr, AT_ACT(NT - 1)); AT_SBAR();
    finishSM(pA0, pA1, alA, l_reg, pa0, pa1, pa2, pa3); AT_SBAR();
    pv_tile<0>(o, vb0, pa0, pa1, pa2, pa3, AT_ACT(NT - 2));
    AT_MASKT(pB0, pB1, NT - 1); partialSM(pB0, pB1, m_reg, mnB, alB, SC, C2); AT_RESC(alB);
    finishSM(pB0, pB1, alB, l_reg, pa0, pa1, pa2, pa3); AT_SBAR(); pv_tile<1>(o, vb0, pa0, pa1, pa2, pa3, AT_ACT(NT - 1));
    if (MODE == 0) {
        if (hi == 0) li_l[r32] = l_reg; asm volatile("s_waitcnt lgkmcnt(0)" ::: "memory");
        float rli[16];
#pragma unroll
        for (int r = 0; r < 16; ++r) rli[r] = __builtin_amdgcn_rcpf(li_l[crow(r, hi)]);
        unsigned lofs = (unsigned)((wid * 32 + 4 * hi) * 1024 + r32);
        asm volatile("" : "+v"(lofs));
        lofs *= 2u;
#pragma unroll
        for (int r = 0; r < 16; ++r) { const int orow = (r & 3) + 8 * (r >> 2);
#pragma unroll
            for (int d0 = 0; d0 < 4; ++d0) { const float v = o[d0][r] * rli[r];
                const float vn = __shfl_xor(v, 1);
                if ((r32 & 1) == 0) *(unsigned*)((char*)A.Op + (size_t)(orow * 2048 + d0 * 64) + lofs) = cvtpk(v, vn); } }
    } else if (MODE == 2) {
        int* en_l = (int*)al_l;
        if (hi == 0) { li_l[r32] = l_reg; en_l[r32] = ent;
            if (ent >= 0) { f32x2_t mlv = {m_reg, l_reg}; *(f32x2_t*)(SB.ml + ((size_t)(ent >> 13) * (NB * NH * NS) + (size_t)A.bh * NS + (ent & 8191)) * 2) = mlv; } }
        asm volatile("s_waitcnt lgkmcnt(0)" ::: "memory");
        unsigned colb = (unsigned)(r32 * 2); asm volatile("" : "+v"(colb));
#pragma unroll
        for (int r = 0; r < 16; ++r) { const int e = en_l[crow(r, hi)]; const float inv = __builtin_amdgcn_rcpf(li_l[crow(r, hi)]);
            const int slot = e >> 13;
            unsigned char* pb = (slot == 2) ? SB.part2 : SB.part01 + (size_t)slot * ((size_t)NB * NH * NS * 256);
            const unsigned po = (unsigned)((A.bh * NS + (e & 8191)) * 256) + colb;
#pragma unroll
            for (int d0 = 0; d0 < 4; ++d0) { const float v = o[d0][r] * inv; const float vn = __shfl_xor(v, 1);
                if ((r32 & 1) == 0 && e >= 0) *(unsigned*)(pb + po + d0 * 64) = cvtpk(v, vn); } }
    } else {
        float* F = (float*)(lds + L::F_OFF);
        {   float f_own = 0.f;
            if (hi == 0) {
                const int s = qlo + r32; const unsigned si = SB.selinfo[(size_t)A.bh * NS + s];
                float mk[3], lk[3]; float M = m_reg;
#pragma unroll
                for (int k = 0; k < 3; ++k) { const bool v = ((si >> (8 * k)) & 255u) < 32u; mk[k] = -1e30f; lk[k] = 0.f;
                    if (v) { const f32x2_t t = *(const f32x2_t*)(SB.ml + ((size_t)k * (NB * NH * NS) + (size_t)A.bh * NS + s) * 2); mk[k] = t[0]; lk[k] = t[1]; }
                    M = fmaxf(M, mk[k]); }
                const float w_own = __builtin_amdgcn_exp2f((m_reg - M) * C2);
                float den = w_own * l_reg, wk[3];
#pragma unroll
                for (int k = 0; k < 3; ++k) { wk[k] = lk[k] * __builtin_amdgcn_exp2f((mk[k] - M) * C2); den += wk[k]; }
                const float inv = __builtin_amdgcn_rcpf(den);
                f_own = w_own * inv;
                f32x4 fv = {wk[0] * inv, wk[1] * inv, wk[2] * inv, 0.f};
                *(f32x4*)(F + (wid * 32 + r32) * 4) = fv;
                al_l[r32] = f_own;
            }
        }
        __syncthreads();
        unsigned short* OT = (unsigned short*)lds;
        unsigned otb = (unsigned)((wid * 32 + 4 * hi) * 256 + r32 * 2); asm volatile("" : "+v"(otb));
#pragma unroll
        for (int r = 0; r < 16; ++r) { const int orow = (r & 3) + 8 * (r >> 2); const float f = al_l[crow(r, hi)];
#pragma unroll
            for (int d0 = 0; d0 < 4; ++d0) { const float v = o[d0][r] * f; const float vn = __shfl_xor(v, 1);
                if ((r32 & 1) == 0) *(unsigned*)((char*)OT + otb + orow * 256 + d0 * 64) = cvtpk(v, vn); } }
        __syncthreads();
        unsigned tq = (unsigned)tid; asm volatile("" : "+v"(tq));
#pragma unroll 2
        for (int i = 0; i < 8; ++i) { const unsigned q = tq + 512u * i, row = q >> 4, c8 = (q & 15u) * 8u;
            f32x4 a0, a1; unpack8(*(const u32x4*)((const char*)OT + row * 256 + c8 * 2), a0, a1);
            const f32x4 fv = *(const f32x4*)(F + row * 4);
            const unsigned po = (unsigned)((A.bh * NS + P0 + (int)row) * 256) + c8 * 2;
#pragma unroll
            for (int k = 0; k < 3; ++k) if (fv[k] != 0.f) { f32x4 b0, b1;
                const unsigned char* pb = (k == 2) ? SB.part2 : SB.part01 + (size_t)k * ((size_t)NB * NH * NS * 256);
                unpack8(*(const u32x4*)(pb + po), b0, b1); a0 += b0 * fv[k]; a1 += b1 * fv[k]; }
            *(u32x4*)((char*)A.Op + (size_t)row * 2048 + c8 * 2) = pack8(a0, a1); }
    }
    __syncthreads();
#undef AT_VMW
#undef AT_SLOAD
#undef AT_BL
#undef AT_SWRITE
#undef AT_RESC
#undef AT_KBASE
#undef AT_ACT
#undef AT_MASKT
#undef AT_HALF_STEP
}

__device__ __forceinline__ void gate_unit(char* lds, const bf16_t* Qp  , const float* kms, int bh, int qb, const SparseBufs& SB) {
    typedef Lds<128> L; constexpr int SHM_K = L::SHM_K;
    int tid = threadIdx.x; asm volatile("" : "+v"(tid));
    const int wid = __builtin_amdgcn_readfirstlane(tid >> 6), lane = tid & 63, r32 = lane & 31, hi = lane >> 5;
    char* K_lds = lds + L::K_OFF;
    int* hist = (int*)(lds + L::WS_OFF); int* base = hist + 32;
    const int sr = tid >> 4, sc = (tid & 15) * 8, kws = kswz<128>(sr, sc * 2);
    bf16x8 qr[8];
    {   const unsigned qo = (unsigned)(((wid * 32 + r32) * 128 + hi * 8) * 2);
#pragma unroll
        for (int d0 = 0; d0 < 8; ++d0) qr[d0] = *(const bf16x8*)((const char*)Qp + qo + d0 * 32); }
    {   unsigned ko = (unsigned)((sr * 128 + sc) * 4); asm volatile("" : "+v"(ko));
        const f32x4 a = *(const f32x4*)((const char*)kms + ko) * (1.0f / 256.0f), b = *(const f32x4*)((const char*)kms + ko + 16) * (1.0f / 256.0f);
        const u32x4 h8 = pack8(a, b);
        f32x4 ha, hb_; unpack8(h8, ha, hb_);
        const u32x4 l8 = pack8(a - ha, b - hb_);
        *(u32x4*)(K_lds + kws) = h8; *(u32x4*)(K_lds + SHM_K + kws) = l8; }
    if (tid < 64) hist[tid] = 0;
    __syncthreads();
    f32x16 g = f32x16{};
    {   const char* kb[4];
#pragma unroll
        for (int dd = 0; dd < 4; ++dd) kb[dd] = K_lds + kswz<128>(r32, (dd * 16 + hi * 8) * 2);
#pragma unroll
        for (int d0 = 0; d0 < 8; ++d0) { const char* a = kb[d0 & 3] + (d0 >> 2) * 128;
            g = __builtin_amdgcn_mfma_f32_32x32x16_bf16(*reinterpret_cast<const bf16x8*>(a), qr[d0], g, 0, 0, 0);
            g = __builtin_amdgcn_mfma_f32_32x32x16_bf16(*reinterpret_cast<const bf16x8*>(a + SHM_K), qr[d0], g, 0, 0, 0); } }
    const float NINF = -__builtin_inff();
    float v1 = NINF, v2 = NINF, v3 = NINF; int i1 = 64, i2 = 65, i3 = 66;
    const int ownl = qb - 4 * hi;
#pragma unroll
    for (int r = 0; r < 16; ++r) {
        const int idx = (r & 3) + 8 * (r >> 2); const float val = (idx < ownl) ? g[r] : NINF;
        const bool c1 = val > v1, c2 = val > v2, c3 = val > v3;
        v3 = c2 ? v2 : (c3 ? val : v3); i3 = c2 ? i2 : (c3 ? idx : i3);
        v2 = c1 ? v1 : (c2 ? val : v2); i2 = c1 ? i1 : (c2 ? idx : i2);
        v1 = c1 ? val : v1;             i1 = c1 ? idx : i1;
    }
    i1 += 4 * hi; i2 += 4 * hi; i3 += 4 * hi;
    float pv_[3]; int pi_[3];
    pv_[0] = __shfl_xor(v1, 32); pv_[1] = __shfl_xor(v2, 32); pv_[2] = __shfl_xor(v3, 32);
    pi_[0] = __shfl_xor(i1, 32); pi_[1] = __shfl_xor(i2, 32); pi_[2] = __shfl_xor(i3, 32);
#pragma unroll
    for (int c = 0; c < 3; ++c) {
        const float val = pv_[c]; const int idx = pi_[c];
        const bool c1 = (val > v1) || (val == v1 && idx < i1), c2 = (val > v2) || (val == v2 && idx < i2), c3 = (val > v3) || (val == v3 && idx < i3);
        v3 = c2 ? v2 : (c3 ? val : v3); i3 = c2 ? i2 : (c3 ? idx : i3);
        v2 = c1 ? v1 : (c2 ? val : v2); i2 = c1 ? i1 : (c2 ? idx : i2);
        v1 = c1 ? val : v1;             i1 = c1 ? idx : i1;
    }
    const int s = qb * 256 + wid * 32 + r32;
    int rk1 = 0, rk2 = 0, rk3 = 0;
    if (hi == 0) {
        SB.selinfo[(size_t)bh * NS + s] = (unsigned)(i1 < 32 ? i1 : 255) | ((unsigned)(i2 < 32 ? i2 : 255) << 8) | ((unsigned)(i3 < 32 ? i3 : 255) << 16);
        if (i1 < 32) rk1 = __hip_atomic_fetch_add(hist + i1, 1, __ATOMIC_RELAXED, __HIP_MEMORY_SCOPE_WORKGROUP);
        if (i2 < 32) rk2 = __hip_atomic_fetch_add(hist + i2, 1, __ATOMIC_RELAXED, __HIP_MEMORY_SCOPE_WORKGROUP);
        if (i3 < 32) rk3 = __hip_atomic_fetch_add(hist + i3, 1, __ATOMIC_RELAXED, __HIP_MEMORY_SCOPE_WORKGROUP);
    }
    __syncthreads();
    if (tid < 32) { const int c = hist[tid]; base[tid] = c > 0 ? (int)__hip_atomic_fetch_add(SB.lcnt + bh * 32 + tid, (unsigned)c, __ATOMIC_RELAXED, __HIP_MEMORY_SCOPE_AGENT) : 0; }
    __syncthreads();
    if (hi == 0) {
        unsigned short* lb = SB.lists + (size_t)bh * LCAP;
        if (i1 < 32) lb[loff(i1) + base[i1] + rk1] = (unsigned short)(s | (0 << 13));
        if (i2 < 32) lb[loff(i2) + base[i2] + rk2] = (unsigned short)(s | (1 << 13));
        if (i3 < 32) lb[loff(i3) + base[i3] + rk3] = (unsigned short)(s | (2 << 13));
    }
    __syncthreads();
}
}
__device__ __forceinline__ int pair_lo(int p) { return p < 3 ? 0 : (p < 5 ? 1 : 2); }
__device__ __forceinline__ int pair_hi(int p) { return p < 3 ? p + 1 : (p < 5 ? p - 1 : 3); }
constexpr int LDS_TB = LDS_MISC + 64;

__device__ __forceinline__ void p_route(const Args& a, LAS unsigned char* lds, int layer, const bf16_t* h, int vcu, int G) {
    int tid = threadIdx.x; asm volatile("" : "+v"(tid));
    const int lane = tid & 63, wave = __builtin_amdgcn_readfirstlane(tid >> 6), i32 = lane & 31, kk = lane >> 5;
    unsigned char* ws = a.ws;
    LAS float* wl = (LAS float*)lds;
    {   const float* wrt = (const float*)(ws + WS_WRT) + (size_t)layer * 20480;
        for (int i = tid; i < 20480; i += NTHR) { const int k = i / 20, c = i % 20; wl[c * 1024 + k] = wrt[i]; } }
    __syncthreads();
    float* tokw = (float*)(ws + WS_TOKW); int* list = (int*)(ws + WS_LIST);
    unsigned* cnt = (unsigned*)(ws + WS_CTL) + CW_CNT + layer * 24 * 16;
    const int gw = vcu * NWAVES + wave, NGW = G * NWAVES;
    const int lrow = i32 < 4 ? i32 : (i32 < 8 ? 12 + i32 : ((i32 & 4) ? -1 : ((i32 >> 3) == 1 ? i32 - 4 : ((i32 >> 3) == 2 ? i32 - 8 : i32 - 12))));
    const LAS float* wrow = wl + (lrow < 0 ? 0 : lrow) * 1024 + 8 * kk;
    const float wmask = lrow < 0 ? 0.f : 1.f;
    for (int task = gw; task < NT / 32; task += NGW) {
        const int t = task * 32 + i32;
        const bf16_t* hrow = h + (size_t)t * 1024 + 8 * kk;
        f32x16 c = f32x16{}; float ssp = 0.f;
#pragma unroll 4
        for (int it = 0; it < 64; ++it) {
            f32x4 h0, h1; unpack8(*(const u32x4*)(hrow + 16 * it), h0, h1);
            const f32x4 w0 = *(const LAS f32x4*)(wrow + 16 * it) * wmask, w1 = *(const LAS f32x4*)(wrow + 16 * it + 4) * wmask;
            ssp += dot4(h0) + dot4(h1);
#pragma unroll
            for (int e = 0; e < 4; ++e) c = __builtin_amdgcn_mfma_f32_32x32x2f32(w0[e], h0[e], c, 0, 0, 0);
#pragma unroll
            for (int e = 0; e < 4; ++e) c = __builtin_amdgcn_mfma_f32_32x32x2f32(w1[e], h1[e], c, 0, 0, 0);
        }
        const float ss = ssp + __shfl_xor(ssp, 32);
        float ex[4];
#pragma unroll
        for (int e = 0; e < 4; ++e) ex[e] = __shfl_xor(c[e], 32);
        const float rs = rsqrtf(ss * (1.0f / 1024.0f) + EPS);
        float lg[20];
#pragma unroll
        for (int e = 0; e < 16; ++e) lg[e] = c[e] * rs;
#pragma unroll
        for (int e = 0; e < 4; ++e) lg[16 + e] = ex[e] * rs;
        int gs = 0; float gm = lg[0];
#pragma unroll
        for (int i = 1; i < 4; ++i) if (lg[i] > gm) { gm = lg[i]; gs = i; }
        float den = 0.f;
#pragma unroll
        for (int i = 0; i < 4; ++i) den += __expf(lg[i] - gm);
        const float gwt = 1.0f / den;
        float ein[4];
#pragma unroll
        for (int i = 0; i < 4; ++i) ein[i] = gs == 0 ? lg[4 + i] : (gs == 1 ? lg[8 + i] : (gs == 2 ? lg[12 + i] : lg[16 + i]));
        int i1 = 0; float e1 = ein[0];
#pragma unroll
        for (int i = 1; i < 4; ++i) if (ein[i] > e1) { e1 = ein[i]; i1 = i; }
        int i2 = -1; float e2 = 0.f;
#pragma unroll
        for (int i = 0; i < 4; ++i) if (i != i1 && (i2 < 0 || ein[i] > e2)) { e2 = ein[i]; i2 = i; }
        const float x2 = __expf(e2 - e1), w1 = gwt / (1.0f + x2), w2 = gwt * x2 / (1.0f + x2);
        const int lo = i1 < i2 ? i1 : i2, hi = i1 < i2 ? i2 : i1;
        const int pidx = lo == 0 ? hi - 1 : (lo == 1 ? hi + 1 : 5);
        const int bucket = gs * 6 + pidx;
        if (kk == 0) {
            f32x2_t wv2 = {(i1 == lo) ? w1 : w2, (i1 == lo) ? w2 : w1};
            *(f32x2_t*)(tokw + (size_t)t * 2) = wv2;
            const unsigned pos = __hip_atomic_fetch_add(cnt + bucket * 16, 1u, __ATOMIC_RELAXED, __HIP_MEMORY_SCOPE_AGENT);
            list[(size_t)bucket * NT + pos] = t;
        }
    }
    {   const float* p = a.in[1] + (size_t)layer * NT * 256; bf16_t* pb = (bf16_t*)(ws + WS_PB);
        const int gt = vcu * NTHR + tid, NGT = G * NTHR;
        for (int i = gt; i < NT * 256 / 8; i += NGT) { const f32x4 x0 = *(const f32x4*)(p + (size_t)i * 8), x1 = *(const f32x4*)(p + (size_t)i * 8 + 4); *(u32x4*)(pb + (size_t)i * 8) = pack8(x0, x1); } }
    __syncthreads();
}

__device__ __forceinline__ int moe_prefix(const Args& a, LAS unsigned char* lds, int layer) {
    LAS int* tb = (LAS int*)(lds + LDS_TB);
    if (threadIdx.x == 0) { const unsigned* cnt = (const unsigned*)(a.ws + WS_CTL) + CW_CNT + layer * 24 * 16; int s = 0;
        for (int b = 0; b < 24; ++b) { tb[b] = s; s += (int)((__hip_atomic_load(cnt + b * 16, __ATOMIC_RELAXED, __HIP_MEMORY_SCOPE_AGENT) + 255u) >> 8); }
        tb[24] = s; }
    __syncthreads();
    return __builtin_amdgcn_readfirstlane(tb[24]);
}
struct MoeUnits {
    LAS const int* tb; int NRT, G, c;
    __device__ __forceinline__ bool next(int i, Unit& u) const {
        const int L = i * G + c, rt = L >> 2; if (rt >= NRT) return false;
        int b = 0;
        for (int q = 1; q < 24; ++q) b = (tb[q] <= rt) ? q : b;
        u.pm = rt; u.pn = L & 3; u.aux = __builtin_amdgcn_readfirstlane(b); return true;
    }
};
struct MoeGuP {
    const char* A; const char* W; const int* list; const unsigned* cnt; MoeUnits U; int ldb, K;
    __device__ __forceinline__ bool next(int i, Unit& u) const { return U.next(i, u); }
    __device__ __forceinline__ void aoff(const Unit& u, const int (&R)[2], const int (&C)[2], g8::AOff& o) const {
        const int n = (int)cnt[u.aux * 16], p0 = (u.pm - __builtin_amdgcn_readfirstlane(U.tb[u.aux])) * 256;
#pragma unroll
        for (int h = 0; h < 2; ++h)
#pragma unroll
            for (int i = 0; i < 2; ++i) { int pos = p0 + h * 128 + R[i]; pos = pos < n ? pos : n - 1; const int tok = list[(size_t)u.aux * NT + pos]; o.o[h][i] = (unsigned)((tok * 1024 + C[i]) * 2); }
    }
    __device__ __forceinline__ const char* bbase(const Unit& u, int kt) const {
        const int g = u.aux / 6, pi = u.aux % 6, e = g * 4 + ((u.pn < 2) ? pair_lo(pi) : pair_hi(pi));
        return W + ((size_t)(e * 512 + (u.pn & 1) * 256) * 1024 + (size_t)kt * 64) * 2;
    }
};
struct MoeDownP {
    const char* A; const char* W; MoeUnits U; int ldb, K;
    __device__ __forceinline__ bool next(int i, Unit& u) const { return U.next(i, u); }
    __device__ __forceinline__ void aoff(const Unit& u, const int (&R)[2], const int (&C)[2], g8::AOff& o) const {
#pragma unroll
        for (int h = 0; h < 2; ++h)
#pragma unroll
            for (int i = 0; i < 2; ++i) o.o[h][i] = (unsigned)(((u.pm * 256 + h * 128 + R[i]) * 512 + C[i]) * 2);
    }
    __device__ __forceinline__ const char* bbase(const Unit& u, int kt) const {
        const int g = u.aux / 6, pi = u.aux % 6, e = g * 4 + ((kt < 4) ? pair_lo(pi) : pair_hi(pi));
        return W + ((size_t)(e * 1024 + u.pn * 256) * 256 + (size_t)(kt & 3) * 64) * 2;
    }
};
__device__ __forceinline__ float sigmoidf_fast(float x) { return __builtin_amdgcn_rcpf(1.0f + __builtin_amdgcn_exp2f(-1.4426950408889634f * x)); }

struct EpiGateUp {
    const float* hp; const float* tokw; const int* list; const unsigned* cnt; LAS const int* tb; bf16_t* act;
    __device__ __forceinline__ void operator()(const f32x4 (&acc)[2][2][4][2], const Unit& u, int wr, int wc, int fr, int fq) const {
        const int n = (int)cnt[u.aux * 16], p0 = (u.pm - __builtin_amdgcn_readfirstlane(tb[u.aux])) * 256, half = u.pn >> 1;
#pragma unroll
        for (int ai = 0; ai < 2; ++ai)
#pragma unroll
            for (int m = 0; m < 4; ++m) {
                const int r = 128 * ai + 64 * wr + 16 * m + fr; int pos = p0 + r; pos = pos < n ? pos : n - 1;
                const int tok = list[(size_t)u.aux * NT + pos];
                const float rs = row_rs<16>(hp + (size_t)tok * 16, 1.0f / 1024.0f), w = tokw[(size_t)tok * 2 + half];
                f32x4 o[2];
#pragma unroll
                for (int nn = 0; nn < 2; ++nn)
#pragma unroll
                    for (int e = 0; e < 4; ++e) { const float g = acc[ai][0][m][nn][e] * rs, up = acc[ai][1][m][nn][e] * rs; o[nn][e] = g * sigmoidf_fast(g) * up * w; }
                *(u32x4*)(act + (size_t)(u.pm * 256 + r) * 512 + half * 256 + (u.pn & 1) * 128 + 32 * wc + 8 * fq) = pack8(o[0], o[1]);
            }
    }
};
struct EpiDown {
    bf16_t* hb; float* hp; const int* list; const unsigned* cnt; LAS const int* tb;
    __device__ __forceinline__ void operator()(const f32x4 (&acc)[2][2][4][2], const Unit& u, int wr, int wc, int fr, int fq) const {
        const int n = (int)cnt[u.aux * 16], p0 = (u.pm - __builtin_amdgcn_readfirstlane(tb[u.aux])) * 256;
#pragma unroll
        for (int ai = 0; ai < 2; ++ai)
#pragma unroll
            for (int m = 0; m < 4; ++m) {
                const int r = 128 * ai + 64 * wr + 16 * m + fr, pos = p0 + r; const bool valid = pos < n;
                const int tok = list[(size_t)u.aux * NT + (valid ? pos : n - 1)];
                float ss = 0.f;
#pragma unroll
                for (int bj = 0; bj < 2; ++bj) {
                    const size_t off = (size_t)tok * 1024 + u.pn * 256 + 128 * bj + 32 * wc + 8 * fq;
                    f32x4 b0, b1; unpack8(*(const u32x4*)(hb + off), b0, b1);
                    const f32x4 v0 = acc[ai][bj][m][0] + b0, v1 = acc[ai][bj][m][1] + b1;
                    if (valid) *(u32x4*)(hb + off) = pack8(v0, v1);
                    ss += dot4(v0) + dot4(v1);
                }
                ss += __shfl_xor(ss, 16); ss += __shfl_xor(ss, 32);
                if (fq == 0 && valid) hp[(size_t)tok * 16 + u.pn * 4 + wc] = ss;
                if (m & 1) asm volatile("" ::: "memory");
            }
    }
};
struct EpiStore {
    bf16_t* O; int ldc;
    __device__ __forceinline__ void operator()(const f32x4 (&acc)[2][2][4][2], const Unit& u, int wr, int wc, int fr, int fq) const {
#pragma unroll
        for (int ai = 0; ai < 2; ++ai)
#pragma unroll
            for (int m = 0; m < 4; ++m) { const int row = u.pm * 256 + 128 * ai + 64 * wr + 16 * m + fr;
#pragma unroll
                for (int bj = 0; bj < 2; ++bj) *(u32x4*)(O + (size_t)row * ldc + u.pn * 256 + 128 * bj + 32 * wc + 8 * fq) = pack8(acc[ai][bj][m][0], acc[ai][bj][m][1]); }
    }
};
struct EpiPle {
    const float* hpin; const bf16_t* pp; const bf16_t* hbi; bf16_t* hbo; float* hp;
    __device__ __forceinline__ void operator()(const f32x4 (&acc)[2][2][4][2], const Unit& u, int wr, int wc, int fr, int fq) const {
#pragma unroll
        for (int ai = 0; ai < 2; ++ai)
#pragma unroll
            for (int m = 0; m < 4; ++m) {
                const int row = u.pm * 256 + 128 * ai + 64 * wr + 16 * m + fr;
                const float rs = row_rs<16>(hpin + (size_t)row * 16, 1.0f / 1024.0f);
                float ss = 0.f;
#pragma unroll
                for (int bj = 0; bj < 2; ++bj) {
                    const size_t off = (size_t)row * 1024 + u.pn * 256 + 128 * bj + 32 * wc + 8 * fq;
                    f32x4 p0, p1, v0, v1; unpack8(*(const u32x4*)(pp + off), p0, p1); unpack8(*(const u32x4*)(hbi + off), v0, v1);
#pragma unroll
                    for (int e = 0; e < 4; ++e) { v0[e] += sigmoidf_fast(acc[ai][bj][m][0][e] * rs) * p0[e]; v1[e] += sigmoidf_fast(acc[ai][bj][m][1][e] * rs) * p1[e]; }
                    *(u32x4*)(hbo + off) = pack8(v0, v1);
                    ss += dot4(v0) + dot4(v1);
                }
                ss += __shfl_xor(ss, 16); ss += __shfl_xor(ss, 32);
                if (fq == 0) hp[(size_t)row * 16 + u.pn * 4 + wc] = ss;
                if (m & 1) asm volatile("" ::: "memory");
            }
    }
};
__device__ __forceinline__ u32x2 pack4(f32x4 a) { u32x2 w = {cvtpk(a[0], a[1]), cvtpk(a[2], a[3])}; return w; }
struct EpiDqkv {
    const float* hp; const float* cosB; const float* sinB; bf16_t* cq; bf16_t* ckv; bf16_t* krope; float* cqp; float* kvp;
    __device__ __forceinline__ void operator()(const f32x4 (&acc)[2][2][4][2], const Unit& u, int wr, int wc, int fr, int fq) const {
#pragma unroll
        for (int ai = 0; ai < 2; ++ai)
#pragma unroll
            for (int m = 0; m < 4; ++m) {
                const int row = u.pm * 256 + 128 * ai + 64 * wr + 16 * m + fr, s = row & (NS - 1);
                const float rs = row_rs<16>(hp + (size_t)row * 16, 1.0f / 1024.0f);
                if (u.pn < 2) {
                    float ss = 0.f;
#pragma unroll
                    for (int bj = 0; bj < 2; ++bj) { const f32x4 v0 = acc[ai][bj][m][0] * rs, v1 = acc[ai][bj][m][1] * rs; ss += dot4(v0) + dot4(v1);
                        const int c = 128 * bj + 32 * wc + 8 * fq;
                        if (u.pn == 0) *(u32x4*)(cq + (size_t)row * 384 + c) = pack8(v0, v1); else *(u32x4*)(ckv + (size_t)row * 256 + c) = pack8(v0, v1); }
                    ss += __shfl_xor(ss, 16); ss += __shfl_xor(ss, 32);
                    if (fq == 0) { if (u.pn == 0) cqp[(size_t)row * 8 + wc] = ss; else kvp[(size_t)row * 4 + wc] = ss; }
                } else {
                    const f32x4 v0 = acc[ai][0][m][0] * rs, v1 = acc[ai][0][m][1] * rs;
                    float ss = dot4(v0) + dot4(v1);
                    *(u32x4*)(cq + (size_t)row * 384 + 256 + 32 * wc + 8 * fq) = pack8(v0, v1);
                    ss += __shfl_xor(ss, 16); ss += __shfl_xor(ss, 32);
                    if (fq == 0) cqp[(size_t)row * 8 + 4 + wc] = ss;
                    if (wc < 2) {
                        const int j = 16 * wc + 4 * fq;
                        const f32x4 cs = *(const f32x4*)(cosB + (size_t)s * 32 + j), sn = *(const f32x4*)(sinB + (size_t)s * 32 + j);
                        const f32x4 x1 = acc[ai][1][m][0] * rs, x2 = acc[ai][1][m][1] * rs;
                        *(u32x2*)(krope + (size_t)row * 64 + j) = pack4(x1 * cs - x2 * sn);
                        *(u32x2*)(krope + (size_t)row * 64 + 32 + j) = pack4(x1 * sn + x2 * cs);
                    }
                }
            }
    }
};
struct EpiUq {
    const float* cqp; const float* cosB; const float* sinB; bf16_t* q;
    __device__ __forceinline__ void operator()(const f32x4 (&acc)[2][2][4][2], const Unit& u, int wr, int wc, int fr, int fq) const {
        const int bb = u.pm >> 5;
#pragma unroll
        for (int ai = 0; ai < 2; ++ai)
#pragma unroll
            for (int m = 0; m < 4; ++m) {
                const int row = u.pm * 256 + 128 * ai + 64 * wr + 16 * m + fr, s = row & (NS - 1);
                const float rs = row_rs<8>(cqp + (size_t)row * 8, 1.0f / 384.0f);
#pragma unroll
                for (int bj = 0; bj < 2; ++bj) {
                    if (u.pn < 4) {
                        const int hh = 2 * u.pn + bj;
                        *(u32x4*)(q + ((size_t)(bb * NH + hh) * NS + s) * 192 + 32 * wc + 8 * fq) = pack8(acc[ai][bj][m][0] * rs, acc[ai][bj][m][1] * rs);
                    } else {
                        const int gidx = bj * 4 + wc, hh = 4 * (u.pn - 4) + (gidx >> 1), j = 16 * (gidx & 1) + 4 * fq;
                        const f32x4 cs = *(const f32x4*)(cosB + (size_t)s * 32 + j), sn = *(const f32x4*)(sinB + (size_t)s * 32 + j);
                        const f32x4 x1 = acc[ai][bj][m][0] * rs, x2 = acc[ai][bj][m][1] * rs;
                        bf16_t* d = q + ((size_t)(bb * NH + hh) * NS + s) * 192 + 128 + j;
                        *(u32x2*)d = pack4(x1 * cs - x2 * sn); *(u32x2*)(d + 32) = pack4(x1 * sn + x2 * cs);
                    }
                }
            }
    }
};
struct EpiUkv {
    const float* kvp; bf16_t* kn; bf16_t* v;
    __device__ __forceinline__ void operator()(const f32x4 (&acc)[2][2][4][2], const Unit& u, int wr, int wc, int fr, int fq) const {
        const int bb = u.pm >> 5;
#pragma unroll
        for (int ai = 0; ai < 2; ++ai)
#pragma unroll
            for (int m = 0; m < 4; ++m) {
                const int row = u.pm * 256 + 128 * ai + 64 * wr + 16 * m + fr, s = row & (NS - 1);
                const float rs = row_rs<4>(kvp + (size_t)row * 4, 1.0f / 256.0f);
                const size_t o = ((size_t)(bb * NH + u.pn) * NS + s) * 128 + 32 * wc + 8 * fq;
                *(u32x4*)(kn + o) = pack8(acc[ai][0][m][0] * rs, acc[ai][0][m][1] * rs);
                *(u32x4*)(v + o) = pack8(acc[ai][1][m][0] * rs, acc[ai][1][m][1] * rs);
            }
    }
};

struct WConv { const float* src0; const float* src1; const float* gain; bf16_t* dst; int N0, N1, K, Nout, kind; };
__device__ __forceinline__ int colmap(int kind, int n) {
    switch (kind) {
    case 1: {
        const int pn = n >> 8; if (pn >= 8) return n;
        const int t = pn >> 2, bj = (n >> 7) & 1, r = n & 127, hh = 2 * (pn & 3) + (r >> 6), d = 64 * bj + (r & 63);
        return t * 1024 + hh * 128 + d; }
    case 2: {
        if (n < 256) return n;
        if (n < 512) return 384 + (n - 256);
        if (n < 640) return 256 + (n - 512);
        const int r = n - 640, wc = r >> 5, fq = (r >> 3) & 3, nn = (r >> 2) & 1, i = r & 3;
        if (wc >= 2) return -1;
        return 384 + 256 + 32 * nn + 16 * wc + 4 * fq + i; }
    case 3: {
        if (n < 1024) return (n >> 7) * 192 + (n & 127);
        const int m = n - 1024, pn4 = m >> 8, gidx = (m >> 5) & 7, fq = (m >> 3) & 3, nn = (m >> 2) & 1, i = m & 3;
        const int hh = 4 * pn4 + (gidx >> 1), j = 16 * (gidx & 1) + 4 * fq + i;
        return hh * 192 + 128 + 32 * nn + j; }
    case 4: {
        const int q = n >> 8, bj = (n >> 7) & 1, r = n & 127;
        return bj * 256 + 128 * q + r; }
    default: return n;
    }
}
__device__ __forceinline__ void conv_item(const WConv& w, LAS float* scr, int item, int lane) {
    const int nblk = w.Nout / 32, kb = item / nblk, nb = item % nblk, k0 = 64 * kb, n0 = 32 * nb;
    const int n4 = lane & 7, ks = lane >> 3;
    const int s = colmap(w.kind, n0 + 4 * n4);
    const bool z = s < 0, first = s < w.N0;
    const float* sp = first ? w.src0 + s : w.src1 + (s - w.N0);
    const int ld = first ? w.N0 : w.N1;
    f32x4 v[8];
#pragma unroll
    for (int it = 0; it < 8; ++it) { const int k = it * 8 + ks; v[it] = z ? (f32x4){0.f, 0.f, 0.f, 0.f} : *(const f32x4*)(sp + (size_t)(k0 + k) * ld); }
#pragma unroll
    for (int it = 0; it < 8; ++it) { const int k = it * 8 + ks; const float g = w.gain ? w.gain[k0 + k] : 1.0f;
#pragma unroll
        for (int e = 0; e < 4; ++e) scr[k * 33 + 4 * n4 + e] = v[it][e] * g; }
    asm volatile("s_waitcnt lgkmcnt(0)" ::: "memory");
    const int c = lane & 7;
#pragma unroll
    for (int j = 0; j < 4; ++j) { const int n = (lane >> 3) + 8 * j; const LAS float* sv = scr + (8 * c) * 33 + n;
        u32x4 o; o.x = cvtpk(sv[0 * 33], sv[1 * 33]); o.y = cvtpk(sv[2 * 33], sv[3 * 33]); o.z = cvtpk(sv[4 * 33], sv[5 * 33]); o.w = cvtpk(sv[6 * 33], sv[7 * 33]);
        *(u32x4*)(w.dst + (size_t)(n0 + n) * w.K + k0 + 8 * c) = o; }
    asm volatile("s_waitcnt lgkmcnt(0)" ::: "memory");
}
__device__ __forceinline__ bool get_conv(int mi, const Args& a, WConv& w) {
    unsigned char* ws = a.ws;
    w.src1 = nullptr; w.N1 = 0; w.gain = nullptr; w.kind = 0;
    if (mi == 0) { w.src0 = a.in[6]; w.N0 = 3072; w.K = 1024; w.Nout = 3072; w.kind = 1; w.gain = a.in[2]; w.dst = (bf16_t*)(ws + WS_WQKV0); return true; }
    if (mi == 1) { w.src0 = a.in[7]; w.N0 = 1024; w.K = 1024; w.Nout = 1024; w.dst = (bf16_t*)(ws + WS_WO0); return true; }
    if (mi == 2) { w.src0 = a.in[8]; w.N0 = 384; w.src1 = a.in[11]; w.N1 = 320; w.K = 1024; w.Nout = 768; w.kind = 2; w.gain = a.in[2] + 1024; w.dst = (bf16_t*)(ws + WS_WDQKV); return true; }
    if (mi == 3) { w.src0 = a.in[10]; w.N0 = 1536; w.K = 384; w.Nout = 1536; w.kind = 3; w.gain = a.in[9]; w.dst = (bf16_t*)(ws + WS_WUQ); return true; }
    if (mi == 4) { w.src0 = a.in[13]; w.N0 = 2048; w.K = 256; w.Nout = 2048; w.gain = a.in[12]; w.dst = (bf16_t*)(ws + WS_WUKV); return true; }
    if (mi == 5) { w.src0 = a.in[14]; w.N0 = 1024; w.K = 1024; w.Nout = 1024; w.dst = (bf16_t*)(ws + WS_WO1); return true; }
    if (mi < 38) { const int le = mi - 6, l = le >> 4;
        w.src0 = a.in[17] + (size_t)le * 1024 * 256; w.N0 = 256; w.src1 = a.in[18] + (size_t)le * 1024 * 256; w.N1 = 256; w.K = 1024; w.Nout = 512; w.kind = 4;
        w.gain = a.in[3] + l * 1024; w.dst = (bf16_t*)(ws + WS_WGU) + (size_t)le * 512 * 1024; return true; }
    if (mi < 70) { const int le = mi - 38;
        w.src0 = a.in[19] + (size_t)le * 256 * 1024; w.N0 = 1024; w.K = 256; w.Nout = 1024; w.dst = (bf16_t*)(ws + WS_WD) + (size_t)le * 1024 * 256; return true; }
    if (mi < 72) { const int l = mi - 70;
        w.src0 = a.in[20] + (size_t)l * 1024 * 1024; w.N0 = 1024; w.K = 1024; w.Nout = 1024; w.gain = a.in[4] + l * 1024; w.dst = (bf16_t*)(ws + WS_WPG) + (size_t)l * 1024 * 1024; return true; }
    if (mi < 74) { const int l = mi - 72;
        w.src0 = a.in[21] + (size_t)l * 256 * 1024; w.N0 = 1024; w.K = 256; w.Nout = 1024; w.dst = (bf16_t*)(ws + WS_WPP) + (size_t)l * 1024 * 256; return true; }
    return false;
}

__device__ __forceinline__ void p_prologue(const Args& a, LAS unsigned char* lds, int vcu, int G) {
    int tid = threadIdx.x; asm volatile("" : "+v"(tid));
    const int lane = tid & 63, wave = __builtin_amdgcn_readfirstlane(tid >> 6);
    const int gw = vcu * NWAVES + wave, NGW = G * NWAVES;
    unsigned char* ws = a.ws;
    LAS float* scr = (LAS float*)(lds + wave * 16384);
    int base = 0;
    for (int mi = 0; mi < 74; ++mi) {
        WConv w; get_conv(mi, a, w);
        const int n = (w.K / 64) * (w.Nout / 32);
        int it = (gw - (base % NGW) + NGW) % NGW;
        for (; it < n; it += NGW) conv_item(w, scr, it, lane);
        base += n;
    }
    {   const float* x = a.in[0]; bf16_t* hb = (bf16_t*)(ws + WS_HB); float* hpx = (float*)(ws + WS_HPX);
        for (int m = gw; m < NT; m += 2 * NGW) {
            const int m2 = (m + NGW < NT) ? m + NGW : m;
            const f32x4* xr = (const f32x4*)(x + (size_t)m * 1024) + lane; const f32x4* xr2 = (const f32x4*)(x + (size_t)m2 * 1024) + lane;
            f32x4 v[4], v2[4]; float s = 0.f, s2 = 0.f;
#pragma unroll
            for (int j = 0; j < 4; ++j) { v[j] = xr[64 * j]; v2[j] = xr2[64 * j]; }
#pragma unroll
            for (int j = 0; j < 4; ++j) { s += dot4(v[j]); s2 += dot4(v2[j]); }
            s = wave_sum(s); s2 = wave_sum(s2);
            u32x2* o8 = (u32x2*)(hb + (size_t)m * 1024) + lane; u32x2* o82 = (u32x2*)(hb + (size_t)m2 * 1024) + lane;
#pragma unroll
            for (int j = 0; j < 4; ++j) { u32x2 o; o.x = cvtpk(v[j][0], v[j][1]); o.y = cvtpk(v[j][2], v[j][3]); o8[64 * j] = o;
                                          u32x2 o2; o2.x = cvtpk(v2[j][0], v2[j][1]); o2.y = cvtpk(v2[j][2], v2[j][3]); o82[64 * j] = o2; }
            if (lane < 16) { hpx[(size_t)m * 16 + lane] = (lane == 0) ? s : 0.f; hpx[(size_t)m2 * 16 + lane] = (lane == 0) ? s2 : 0.f; }
        } }
    {   const int gt = (vcu * NTHR) + tid, NGT = G * NTHR;
        float* cosA = (float*)(ws + WS_COSA); float* sinA = (float*)(ws + WS_SINA); float* cosB = (float*)(ws + WS_COSB); float* sinB = (float*)(ws + WS_SINB);
        for (int i = gt; i < NS * 64; i += NGT) { const int s = i >> 6, j = i & 63; const float inv = powf(10000.0f, -(float)j / 64.0f); float sn, cs; sincosf((float)s * inv, &sn, &cs); cosA[i] = cs; sinA[i] = sn; }
        for (int i = gt; i < NS * 32; i += NGT) { const int s = i >> 5, j = i & 31; const float inv = powf(10000.0f, -(float)j / 32.0f); float sn, cs; sincosf((float)s * inv, &sn, &cs); cosB[i] = cs; sinB[i] = sn; }
        float* km = (float*)(ws + WS_KMEAN);
        for (int i = gt; i < NB * NH * 32 * 128; i += NGT) km[i] = 0.f;
        float* wrt = (float*)(ws + WS_WRT);
        for (int i = gt; i < 2 * 1024 * 20; i += NGT) { const int l = i / 20480, r = i % 20480, k = r / 20, c = r % 20;
            const float g = a.in[3][l * 1024 + k];
            wrt[i] = g * (c < 4 ? a.in[15][(size_t)(l * 1024 + k) * 4 + c] : a.in[16][(size_t)(l * 1024 + k) * 16 + (c - 4)]); }
    }
}

__device__ __forceinline__ at::SparseBufs sparse_bufs(const Args& a) {
    unsigned char* ws = a.ws;
    at::SparseBufs SB;
    SB.lists = (unsigned short*)(ws + WS_R + 200 * MiB); SB.lcnt = (unsigned*)(ws + WS_CTL) + CW_LCNT; SB.selinfo = (unsigned*)(ws + WS_R + 210 * MiB);
    SB.ml = (float*)(ws + WS_R + 192 * MiB); SB.part01 = (unsigned char*)a.out; SB.part2 = ws + WS_PART2;
    return SB;
}
__device__ __forceinline__ void p_attention_mla(const Args& a, unsigned char* ldsg) {
    unsigned char* ws = a.ws;
    const at::SparseBufs SB = sparse_bufs(a);
    for (int L = blockIdx.x; L < 512; L += gridDim.x) {
        const int xcd = L & 7, k = L >> 3, bh = xcd + 8 * (k >> 4), x = k & 15, b = bh >> 3, h = bh & 7;
        for (int pass = 0; pass < 2; ++pass) {
            const int qb = pass ? x : 31 - x, P0 = qb * 256;
            at::AttnP A;
            A.Qp = (const bf16_t*)(ws + WS_Q) + ((size_t)bh * NS + P0) * 192; A.Kn = (const bf16_t*)(ws + WS_KN1) + (size_t)bh * NS * 128;
            A.Kr = (const bf16_t*)(ws + WS_KROPE) + (size_t)b * NS * 64; A.Vp = (const bf16_t*)(ws + WS_V1) + (size_t)bh * NS * 128;
            A.Op = (bf16_t*)(ws + WS_O) + ((size_t)(b * NS + P0) * 1024 + h * 128); A.P0 = P0; A.t0 = 0; A.NT = (P0 + 256) / 64; A.bh = bh; A.nent = 0; A.ents = nullptr;
            at::attn_unit<192, 0>((char*)ldsg, A, SB);
        }
    }
}
__device__ __forceinline__ void p_moba_gate(const Args& a, unsigned char* ldsg) {
    unsigned char* ws = a.ws;
    const at::SparseBufs SB = sparse_bufs(a);
    for (int L = blockIdx.x; L < 1024; L += gridDim.x) {
        const int bh = L >> 5, qb = L & 31;
        at::gate_unit((char*)ldsg, (const bf16_t*)(ws + WS_Q) + ((size_t)bh * NS + qb * 256) * 128, (const float*)(ws + WS_KMEAN) + (size_t)bh * 32 * 128, bh, qb, SB);
    }
}
__device__ __forceinline__ void p_moba_gather(const Args& a, unsigned char* ldsg) {
    unsigned char* ws = a.ws;
    const at::SparseBufs SB = sparse_bufs(a);
    int tid = threadIdx.x; asm volatile("" : "+v"(tid));
    int* pre = (int*)(ldsg + 73728); int* seg = pre + 1032;
    if (tid < 32) { int s = 0; for (int j = 0; j < 32; ++j) s += (int)((SB.lcnt[tid * 32 + j] + 255u) >> 8); seg[tid] = s; }
    __syncthreads();
    if (tid < 32) { int s = 0; for (int j = 0; j < tid; ++j) s += seg[j];
        for (int j = 0; j < 32; ++j) { pre[tid * 32 + j] = s; s += (int)((SB.lcnt[tid * 32 + j] + 255u) >> 8); }
        if (tid == 31) pre[1024] = s; }
    __syncthreads();
    const int NU = __builtin_amdgcn_readfirstlane(pre[1024]);
    for (int u = blockIdx.x; u < NU; u += gridDim.x) {
        int lo = 0, hi = 1024;
        while (hi - lo > 1) { const int mid = (lo + hi) >> 1; if (pre[mid] <= u) lo = mid; else hi = mid; }
        const int li = __builtin_amdgcn_readfirstlane(lo), c = u - __builtin_amdgcn_readfirstlane(pre[lo]), bh = li >> 5, n = li & 31;
        const int cnt = (int)SB.lcnt[li];
        at::AttnP A;
        A.Qp = (const bf16_t*)(ws + WS_Q) + (size_t)bh * NS * 128; A.Kn = (const bf16_t*)(ws + WS_K0) + (size_t)bh * NS * 128; A.Kr = nullptr;
        A.Vp = (const bf16_t*)(ws + WS_V0) + (size_t)bh * NS * 128; A.Op = nullptr; A.P0 = 0; A.t0 = 4 * n; A.NT = 4; A.bh = bh;
        A.nent = (cnt - 256 * c) < 256 ? (cnt - 256 * c) : 256; A.ents = SB.lists + (size_t)bh * at::LCAP + at::loff(n) + 256 * c;
        at::attn_unit<128, 2>((char*)ldsg, A, SB);
    }
}
__device__ __forceinline__ void p_moba_own(const Args& a, unsigned char* ldsg) {
    unsigned char* ws = a.ws;
    const at::SparseBufs SB = sparse_bufs(a);
    for (int L = blockIdx.x; L < 1024; L += gridDim.x) {
        const int bh = L >> 5, qb = L & 31, b = bh >> 3, h = bh & 7, P0 = qb * 256;
        at::AttnP A;
        A.Qp = (const bf16_t*)(ws + WS_Q) + ((size_t)bh * NS + P0) * 128; A.Kn = (const bf16_t*)(ws + WS_K0) + (size_t)bh * NS * 128; A.Kr = nullptr;
        A.Vp = (const bf16_t*)(ws + WS_V0) + (size_t)bh * NS * 128; A.Op = (bf16_t*)(ws + WS_O) + ((size_t)(b * NS + P0) * 1024 + h * 128);
        A.P0 = P0; A.t0 = 4 * qb; A.NT = 4; A.bh = bh; A.nent = 0; A.ents = nullptr;
        at::attn_unit<128, 3>((char*)ldsg, A, SB);
    }
}

__global__ void __launch_bounds__(NTHR, 2) mega(Args a) {
    extern __shared__ __attribute__((aligned(16))) unsigned char lds_g[];
    LAS unsigned char* lds = (LAS unsigned char*)lds_g;
    const int tid = threadIdx.x;
    const int G = gridDim.x, bx = blockIdx.x, vcu = (G % 8 == 0) ? (bx % 8) * (G / 8) + bx / 8 : bx;
    unsigned char* ws = a.ws;
    volatile LAS unsigned* MISC = (volatile LAS unsigned*)(lds + LDS_MISC);
    for (int u = tid; u < 256; u += NTHR) MISC[u] = 0u;
    __syncthreads();
    XcdBarrier bar = xcd_barrier_post((unsigned*)(ws + WS_CTL) + CW_BAR, MISC);
    const int lo = a.ph_lo, hi = a.ph_hi;
#ifndef DBG_ONLY
#define DBG_EN(k) true
#else
#define DBG_EN(k) ((k) == DBG_ONLY)
#endif
#define IN(k) (DBG_EN(k) && lo <= (k) && (k) < hi)
#define SEAM(k) do { if (IN(k) && IN((k) + 1)) xcd_barrier(bar); } while (0)
    if (IN(0)) { p_prologue(a, lds, vcu, G); }
    SEAM(0);
    if (IN(1)) {
        g8::DenseP P{(const char*)(ws + WS_HB), (const char*)(ws + WS_WQKV0), 1024, 1024, 1024, NT / 256, 3072 / 256, G, bx};
        EpiQKV E{(const float*)(ws + WS_HPX), (const float*)(ws + WS_COSA), (const float*)(ws + WS_SINA), (bf16_t*)(ws + WS_Q), (bf16_t*)(ws + WS_K0), (bf16_t*)(ws + WS_V0), (float*)(ws + WS_KMEAN)};
        g8::gemm_phase(lds, P, E);
    }
    SEAM(1);
    if (IN(2)) { p_moba_gate(a, lds_g); }
    SEAM(2);
    if (IN(3)) { p_moba_gather(a, lds_g); }
    SEAM(3);
    if (IN(4)) { p_moba_own(a, lds_g); }
    SEAM(4);
    if (IN(5)) {
        g8::DenseP P{(const char*)(ws + WS_O), (const char*)(ws + WS_WO0), 1024, 1024, 1024, NT / 256, 4, G, bx};
        EpiResid E{(const bf16_t*)(ws + WS_HB), (bf16_t*)(ws + WS_HB), (float*)(ws + WS_HP0)};
        g8::gemm_phase(lds, P, E);
    }
    SEAM(5);
#define MOE_PLE(PB, layer, HBC, HBN) \
    if (IN((PB) + 0)) { p_route(a, lds, (layer), (const bf16_t*)(HBC), vcu, G); } \
    SEAM((PB) + 0); \
    if (IN((PB) + 1)) { \
        const int NRT = moe_prefix(a, lds, (layer)); \
        const unsigned* cnt = (const unsigned*)(ws + WS_CTL) + CW_CNT + (layer) * 24 * 16; \
        MoeUnits U{(LAS const int*)(lds + LDS_TB), NRT, G, bx}; \
        MoeGuP P{(const char*)(HBC), (const char*)(ws + WS_WGU) + (size_t)(layer) * 16 * 512 * 1024 * 2, (const int*)(ws + WS_LIST), cnt, U, 1024, 1024}; \
        EpiGateUp E{(const float*)(ws + WS_HP0), (const float*)(ws + WS_TOKW), (const int*)(ws + WS_LIST), cnt, (LAS const int*)(lds + LDS_TB), (bf16_t*)(ws + WS_ACT)}; \
        g8::gemm_phase(lds, P, E); \
        g8::DenseP P2{(const char*)(ws + WS_PB), (const char*)(ws + WS_WPP) + (size_t)(layer) * 1024 * 256 * 2, 256, 256, 256, NT / 256, 4, G, bx}; \
        EpiStore E2{(bf16_t*)(ws + WS_PP), 1024}; \
        g8::gemm_phase(lds, P2, E2); \
    } \
    SEAM((PB) + 1); \
    if (IN((PB) + 2)) { \
        const int NRT = moe_prefix(a, lds, (layer)); \
        const unsigned* cnt = (const unsigned*)(ws + WS_CTL) + CW_CNT + (layer) * 24 * 16; \
        MoeUnits U{(LAS const int*)(lds + LDS_TB), NRT, G, bx}; \
        MoeDownP P{(const char*)(ws + WS_ACT), (const char*)(ws + WS_WD) + (size_t)(layer) * 16 * 1024 * 256 * 2, U, 256, 512}; \
        EpiDown E{(bf16_t*)(HBC), (float*)(ws + WS_HP1), (const int*)(ws + WS_LIST), cnt, (LAS const int*)(lds + LDS_TB)}; \
        g8::gemm_phase(lds, P, E); \
    } \
    SEAM((PB) + 2); \
    if (IN((PB) + 3)) { \
        g8::DenseP P{(const char*)(HBC), (const char*)(ws + WS_WPG) + (size_t)(layer) * 1024 * 1024 * 2, 1024, 1024, 1024, NT / 256, 4, G, bx}; \
        EpiPle E{(const float*)(ws + WS_HP1), (const bf16_t*)(ws + WS_PP), (const bf16_t*)(HBC), (bf16_t*)(HBN), (float*)(ws + WS_HP2)}; \
        g8::gemm_phase(lds, P, E); \
    } \
    SEAM((PB) + 3);
    MOE_PLE(6, 0, ws + WS_HB, a.out)
    if (IN(10)) {
        g8::DenseP P{(const char*)a.out, (const char*)(ws + WS_WDQKV), 1024, 1024, 1024, NT / 256, 3, G, bx};
        EpiDqkv E{(const float*)(ws + WS_HP2), (const float*)(ws + WS_COSB), (const float*)(ws + WS_SINB), (bf16_t*)(ws + WS_CQ), (bf16_t*)(ws + WS_CKV), (bf16_t*)(ws + WS_KROPE), (float*)(ws + WS_CQP), (float*)(ws + WS_KVP)};
        g8::gemm_phase(lds, P, E);
    }
    SEAM(10);
    if (IN(11)) {
        g8::DenseP P{(const char*)(ws + WS_CQ), (const char*)(ws + WS_WUQ), 384, 384, 384, NT / 256, 6, G, bx};
        EpiUq E{(const float*)(ws + WS_CQP), (const float*)(ws + WS_COSB), (const float*)(ws + WS_SINB), (bf16_t*)(ws + WS_Q)};
        g8::gemm_phase(lds, P, E);
        g8::DenseP P2{(const char*)(ws + WS_CKV), (const char*)(ws + WS_WUKV), 256, 256, 256, NT / 256, 8, G, bx};
        EpiUkv E2{(const float*)(ws + WS_KVP), (bf16_t*)(ws + WS_KN1), (bf16_t*)(ws + WS_V1)};
        g8::gemm_phase(lds, P2, E2);
    }
    SEAM(11);
    if (IN(12)) { p_attention_mla(a, lds_g); }
    SEAM(12);
    if (IN(13)) {
        g8::DenseP P{(const char*)(ws + WS_O), (const char*)(ws + WS_WO1), 1024, 1024, 1024, NT / 256, 4, G, bx};
        EpiResid E{(const bf16_t*)a.out, (bf16_t*)a.out, (float*)(ws + WS_HP0)};
        g8::gemm_phase(lds, P, E);
    }
    SEAM(13);
    MOE_PLE(14, 1, a.out, ws + WS_HB)
    if (IN(18)) {
        int t2 = threadIdx.x; asm volatile("" : "+v"(t2)); const int lane = t2 & 63, wave = t2 >> 6; const float* fg = a.in[5];
        const bf16_t* hfin = (const bf16_t*)(ws + WS_HB);
        for (int mrow = vcu * NWAVES + wave; mrow < NT; mrow += G * NWAVES) {
            f32x4 v[4]; float s = 0.f;
#pragma unroll
            for (int j = 0; j < 2; ++j) { unpack8(*((const u32x4*)(hfin + (size_t)mrow * 1024) + lane + 64 * j), v[2 * j], v[2 * j + 1]); s += dot4(v[2 * j]) + dot4(v[2 * j + 1]); }
            s = wave_sum(s);
            const float r = rsqrtf(s * (1.0f / 1024.0f) + EPS);
            f32x4* xr = (f32x4*)(a.out + (size_t)mrow * 1024);
#pragma unroll
            for (int j = 0; j < 2; ++j) { const int c4 = 2 * (lane + 64 * j);
                xr[c4] = v[2 * j] * r * *((const f32x4*)fg + c4); xr[c4 + 1] = v[2 * j + 1] * r * *((const f32x4*)fg + c4 + 1); }
        }
    }
#undef IN
#undef SEAM
}

constexpr int N_PHASES = 19;
static int g_grid = 0;
static bool setup() {
    if (g_grid) return g_grid > 0;
    int dev = 0, cus = 0;
    if (hipGetDevice(&dev) != hipSuccess || hipDeviceGetAttribute(&cus, hipDeviceAttributeMultiprocessorCount, dev) != hipSuccess) { g_grid = -1; return false; }
    if (hipFuncSetAttribute((const void*)mega, hipFuncAttributeMaxDynamicSharedMemorySize, LDS_BYTES) != hipSuccess) { fprintf(stderr, "hipFuncSetAttribute failed\n"); g_grid = -1; return false; }
    int per_cu = 0;
    if (hipOccupancyMaxActiveBlocksPerMultiprocessor(&per_cu, (const void*)mega, NTHR, LDS_BYTES) != hipSuccess || per_cu < 1) { fprintf(stderr, "occupancy query: %d\n", per_cu); }
    (void)hipGetLastError();
    g_grid = cus;
    return true;
}
static void run_phases(const Args& base, int lo, int hi, bool one_launch, hipStream_t st) {
    if (one_launch) { Args a = base; a.ph_lo = lo; a.ph_hi = hi; hipLaunchKernelGGL(mega, dim3(g_grid), dim3(NTHR), LDS_BYTES, st, a); }
    else for (int p = lo; p < hi; ++p) { Args a = base; a.ph_lo = p; a.ph_hi = p + 1;
#ifdef PROBE_ROUTE
        if (p == 6) { Args b = base; b.ph_lo = 14; b.ph_hi = 15; hipLaunchKernelGGL(mega, dim3(g_grid), dim3(NTHR), LDS_BYTES, st, b); }
        if (p == 14) (void)hipMemsetAsync(base.ws + WS_CTL + (CW_CNT + 24 * 16) * 4, 0, 24 * 16 * 4, st);
#endif
        hipLaunchKernelGGL(mega, dim3(g_grid), dim3(NTHR), LDS_BYTES, st, a);
#ifdef DOUBLE_PHASE
        if (p == DOUBLE_PHASE) hipLaunchKernelGGL(mega, dim3(g_grid), dim3(NTHR), LDS_BYTES, st, a);
#endif
    }
}
}
#ifndef ONE_LAUNCH
#define ONE_LAUNCH 1
#endif
extern "C" void kernel_launch(void* const* d_in, const int* in_sizes, int n_in, void* d_out, int out_size, void* d_ws, size_t ws_size, hipStream_t stream) {
    (void)in_sizes; (void)out_size;
    if (n_in != 22) { fprintf(stderr, "kernel_launch: expected 22 inputs, got %d\n", n_in); return; }
    if (ws_size < fk::WS_END) { fprintf(stderr, "kernel_launch: workspace too small (%zu)\n", ws_size); return; }
    if (!fk::setup()) return;
    (void)hipMemsetAsync((char*)d_ws + fk::WS_CTL, 0, fk::CTL_ZERO_BYTES, stream);
    fk::Args a{};
    for (int i = 0; i < 22; ++i) a.in[i] = (const float*)d_in[i];
    a.out = (float*)d_out; a.ws = (unsigned char*)d_ws;
    fk::run_phases(a, 0, fk::N_PHASES, ONE_LAUNCH != 0, stream);
}
```

```cpp
#include <hip/hip_runtime.h>
#include <cstdio>
#include <cstdint>
#include <cmath>
namespace fk {
#define LAS __attribute__((address_space(3)))
#define GAS __attribute__((address_space(1)))
typedef unsigned short bf16_t;
typedef short bf16x8 __attribute__((ext_vector_type(8)));
typedef short s16x4 __attribute__((ext_vector_type(4)));
typedef float f32x4 __attribute__((ext_vector_type(4)));
typedef float f32x16 __attribute__((ext_vector_type(16)));
typedef unsigned u32x4 __attribute__((ext_vector_type(4)));
typedef unsigned u32x2 __attribute__((ext_vector_type(2)));
typedef float f32x2_t __attribute__((ext_vector_type(2)));
typedef __bf16 bf16x2_t __attribute__((ext_vector_type(2)));

constexpr int NB = 4, NS = 8192, ND = 1024, NT = NB * NS, NH = 8;
constexpr float EPS = 1e-6f;
constexpr int NWAVES = 8, NTHR = 512;

constexpr size_t MiB = 1u << 20;
constexpr size_t WS_CTL = 0, CTL_ZERO_BYTES = 1 * MiB;
constexpr size_t WS_COSA = 1 * MiB, WS_SINA = 3 * MiB, WS_COSB = 5 * MiB, WS_SINB = 6 * MiB;
constexpr size_t WS_KMEAN = 7 * MiB;
constexpr size_t WS_WRT = 7 * MiB + 512 * 1024;
constexpr size_t WS_HPX = 8 * MiB, WS_HP0 = 10 * MiB, WS_HP1 = 12 * MiB, WS_HP2 = 14 * MiB;
constexpr size_t WS_CQP = 16 * MiB, WS_KVP = 17 * MiB;
constexpr size_t WS_TOKW = 18 * MiB;
constexpr size_t WS_LIST = 19 * MiB;
constexpr size_t WS_WQKV0 = 24 * MiB, WS_WO0 = 30 * MiB, WS_WDQKV = 32 * MiB, WS_WUQ = 34 * MiB, WS_WUKV = 36 * MiB, WS_WO1 = 37 * MiB;
constexpr size_t WS_WGU = 40 * MiB;
constexpr size_t WS_WD = 72 * MiB;
constexpr size_t WS_WPG = 88 * MiB;
constexpr size_t WS_WPP = 92 * MiB;
constexpr size_t WS_HB = 94 * MiB;
constexpr size_t WS_CQ = WS_HB, WS_CKV = WS_HB + 24 * MiB, WS_KROPE = WS_HB + 40 * MiB;
constexpr size_t WS_O = 158 * MiB;
constexpr size_t WS_R = 222 * MiB;
constexpr size_t WS_Q = WS_R, WS_K0 = WS_R + 64 * MiB, WS_V0 = WS_R + 128 * MiB;
constexpr size_t WS_KN1 = WS_R + 96 * MiB, WS_V1 = WS_R + 160 * MiB;
constexpr size_t WS_ACT = WS_R, WS_PB = WS_R + 40 * MiB, WS_PP = WS_R + 64 * MiB;
constexpr size_t WS_PART2 = WS_R + 224 * MiB;
constexpr size_t WS_END = WS_PART2 + 64 * MiB;
constexpr int CW_CNT = 1024;
constexpr int CW_BAR = 4096;
constexpr int CW_LCNT = 8192;

constexpr int RING_BYTES = 131072;
constexpr int LDS_MISC = RING_BYTES;
constexpr int LDS_BYTES = 147456;

struct Args { const float* in[22]; float* out; unsigned char* ws; int ph_lo, ph_hi; };

__device__ __forceinline__ unsigned cvtpk(float lo, float hi) { f32x2_t v = {lo, hi}; bf16x2_t b = __builtin_convertvector(v, bf16x2_t); return __builtin_bit_cast(unsigned, b); }
__device__ __forceinline__ float bf2f(unsigned short b) { return __builtin_bit_cast(float, (unsigned)b << 16); }
__device__ __forceinline__ u32x4 pack8(f32x4 a, f32x4 b) { u32x4 w = {cvtpk(a[0], a[1]), cvtpk(a[2], a[3]), cvtpk(b[0], b[1]), cvtpk(b[2], b[3])}; return w; }
__device__ __forceinline__ float wave_sum(float v) {
#pragma unroll
    for (int o = 1; o < 64; o <<= 1) v += __shfl_xor(v, o);
    return v;
}
__device__ __forceinline__ float dot4(f32x4 a) { return (a[0] * a[0] + a[1] * a[1]) + (a[2] * a[2] + a[3] * a[3]); }
template <int NP> __device__ __forceinline__ float row_rs(const float* hp, float invd) {
    float s = 0.f;
#pragma unroll
    for (int i = 0; i < NP / 4; ++i) { const f32x4 a = *(const f32x4*)(hp + 4 * i); s += (a[0] + a[1]) + (a[2] + a[3]); }
    return rsqrtf(s * invd + EPS);
}

#define XB_TMO      128
#define XB_XCNT(j)  (256  + 64 * (j))
#define XB_XSUB(j)  (1280 + 64 * (j))
#define XB_XGEN(j)  (2304 + 64 * (j))
#define XB_TOP      3328
#define XB_TOPGEN   3392
#define XCD_BAR_WORDS 3456
#define XB_SPIN_CAP (1u << 18)
__device__ __forceinline__ unsigned xb_ld(unsigned* p)              { return __hip_atomic_load(p, __ATOMIC_RELAXED, __HIP_MEMORY_SCOPE_AGENT); }
__device__ __forceinline__ unsigned xb_add(unsigned* p, unsigned v) { return __hip_atomic_fetch_add(p, v, __ATOMIC_RELAXED, __HIP_MEMORY_SCOPE_AGENT); }
__device__ __forceinline__ unsigned xb_xcc_id() { return (unsigned)__builtin_amdgcn_s_getreg((3 << 11) | 20) & 0xFu; }
#define XB_SPIN(cond, bar) do { unsigned _sp = 0; while (cond) { __builtin_amdgcn_s_sleep(1); \
    if ((++_sp & 255u) == 0u) { if (xb_ld(&(bar)[XB_TMO])) break; if (_sp > XB_SPIN_CAP) { atomicAdd(&(bar)[XB_TMO], 1u); break; } } } } while (0)
struct XcdBarrier { unsigned* bar; unsigned x; volatile LAS unsigned* st; };
__device__ __forceinline__ XcdBarrier xcd_barrier_post(unsigned* bar, volatile LAS unsigned* st) {
    XcdBarrier b; b.bar = bar; b.x = xb_xcc_id(); b.st = st;
    if (threadIdx.x == 0) (void)xb_add(&bar[XB_XCNT(b.x)], 1u);
    return b;
}
__device__ __forceinline__ void xcd_barrier_complete(unsigned* bar, unsigned x, unsigned& nloc, unsigned& nx) {
    const unsigned G = gridDim.x * gridDim.y * gridDim.z;
    unsigned sum, cnt, mine, sp = 0u;
    for (;;) {
        sum = 0u; cnt = 0u; mine = 0u;
#pragma unroll
        for (unsigned j = 0; j < 16; ++j) { const unsigned c = xb_ld(&bar[XB_XCNT(j)]); sum += c; cnt += (c > 0u) ? 1u : 0u; mine = (j == x) ? c : mine; }
        if (sum == G) break;
        __builtin_amdgcn_s_sleep(1);
        if ((++sp & 255u) == 0u) { if (xb_ld(&bar[XB_TMO])) break; if (sp > XB_SPIN_CAP) { atomicAdd(&bar[XB_TMO], 1u); break; } }
    }
    nloc = mine > 0u ? mine : 1u; nx = cnt > 0u ? cnt : 1u;
}
__device__ __forceinline__ void xcd_barrier(const XcdBarrier& b) {
    asm volatile("s_waitcnt vmcnt(0)" ::: "memory");
    __syncthreads();
    if (threadIdx.x == 0) {
        unsigned* bar = b.bar;
        __builtin_amdgcn_s_waitcnt(0);
        unsigned nloc = b.st[0], nx = b.st[1];
        if (nloc == 0u) { xcd_barrier_complete(bar, b.x, nloc, nx); b.st[0] = nloc; b.st[1] = nx; }
        const unsigned old = xb_add(&bar[XB_XSUB(b.x)], 1u);
        const unsigned gen = old / nloc;
        if (old + 1u == (gen + 1u) * nloc) {
            __builtin_amdgcn_fence(__ATOMIC_RELEASE, "agent");
            asm volatile("s_waitcnt vmcnt(0)" ::: "memory");
            const unsigned og = xb_add(&bar[XB_TOP], 1u);
            const unsigned tg = og / nx;
            if (og + 1u == (tg + 1u) * nx) xb_add(&bar[XB_TOPGEN], 1u);
            else XB_SPIN(xb_ld(&bar[XB_TOPGEN]) == tg, bar);
            __builtin_amdgcn_fence(__ATOMIC_ACQUIRE, "agent");
            xb_add(&bar[XB_XGEN(b.x)], 1u);
            asm volatile("s_waitcnt vmcnt(0)" ::: "memory");
        } else {
            XB_SPIN(xb_ld(&bar[XB_XGEN(b.x)]) == gen, bar);
            __builtin_amdgcn_fence(__ATOMIC_ACQUIRE, "agent");
            asm volatile("s_waitcnt vmcnt(0)" ::: "memory");
        }
    }
    __syncthreads();
}

namespace g8 {
constexpr int BM = 256, BK = 64, HALF = 128, HTB = HALF * BK * 2, STAGE_BYTES = 8 * HTB, NXCD = 8, WGM = 8;
__device__ __forceinline__ int lds_byte(int r, int c) { const int st = (r >> 4) * 2 + (c >> 5), rr = r & 15, cc = c & 31, ob = rr * 64 + cc * 2; return st * 1024 + (ob ^ (((ob >> 9) & 1) << 5)); }
__device__ __forceinline__ void stage_rc(int b, int& R, int& C) { const int st = b / 1024, sb = b % 1024, swz = sb ^ (((sb >> 9) & 1) << 5); R = (st >> 1) * 16 + swz / 64; C = (st & 1) * 32 + (swz % 64) / 2; }
__device__ __forceinline__ int perm32(int rho) { const int n = rho >> 4, i = rho & 15; return 8 * (i >> 2) + 4 * n + (i & 3); }
struct Unit { int pm, pn, aux; };
struct AOff { unsigned o[2][2]; };

__device__ __forceinline__ bool static_order(int i, int G, int c, int nM, int nN, int& pm, int& pn) {
    const int nwg = nM * nN; const long L = (long)i * G + c; if (L >= nwg) return false;
    int wgid = (int)L; { const int q = nwg / NXCD, r = nwg % NXCD, xcd = wgid % NXCD, off = wgid / NXCD; wgid = (xcd < r ? xcd * (q + 1) : r * (q + 1) + (xcd - r) * q) + off; }
    const int nig = WGM * nN, gid = wgid / nig, fm = gid * WGM, gsz = (nM - fm) < WGM ? (nM - fm) : WGM;
    pm = fm + ((wgid % nig) % gsz); pn = (wgid % nig) / gsz; return true;
}
struct DenseP {
    const char* A; const char* B; int lda, ldb, K, nM, nN, G, c;
    __device__ __forceinline__ bool next(int i, Unit& u) const { u.aux = 0; return static_order(i, G, c, nM, nN, u.pm, u.pn); }
    __device__ __forceinline__ void aoff(const Unit& u, const int (&R)[2], const int (&C)[2], AOff& o) const {
#pragma unroll
        for (int h = 0; h < 2; ++h)
#pragma unroll
            for (int i = 0; i < 2; ++i) o.o[h][i] = (unsigned)(((u.pm * BM + h * HALF + R[i]) * lda + C[i]) * 2);
    }
    __device__ __forceinline__ const char* bbase(const Unit& u, int kt) const { return B + ((size_t)u.pn * BM * ldb + (size_t)kt * BK) * 2; }
};

template <class Prov, class Epi>
__device__ __forceinline__ void gemm_phase(LAS unsigned char* lds, const Prov& P, const Epi& E) {
    int tid = threadIdx.x; asm volatile("" : "+v"(tid));
    const int wid = __builtin_amdgcn_readfirstlane(tid >> 6), lane = tid & 63, wr = wid >> 2, wc = wid & 3, fr = lane & 15, fq = lane >> 4;
    const int K = P.K, nt = K / BK;
    int R[2], C[2]; unsigned voffB[2];
#pragma unroll
    for (int i = 0; i < 2; ++i) { stage_rc(tid * 16 + i * 8192, R[i], C[i]); const int Rb = (R[i] & ~31) + perm32(R[i] & 31); voffB[i] = (unsigned)(Rb * P.ldb + C[i]) * 2u; }
    const size_t hstepB = (size_t)HALF * P.ldb * 2;
    const unsigned ldsw = (unsigned)wid * 1024u;
    const int aoff = lds_byte(wr * 64 + fr, fq * 8), boff = lds_byte(wc * 32 + fr, fq * 8);
#define G8_SA(b, h) (((b) * 2 + (h)) * HTB)
#define G8_SB(b, h) ((4 + (b) * 2 + (h)) * HTB)
#define G8_STAGE_A(bufoff, h, AO, kb) do { _Pragma("unroll") for (int _i = 0; _i < 2; ++_i) \
        __builtin_amdgcn_global_load_lds((const unsigned*)(P.A + (size_t)((AO).o[h][_i] + (kb))), (LAS unsigned*)(lds + (bufoff) + ldsw + _i * 8192), 16, 0, 0); } while (0)
#define G8_STAGE_B(bufoff, bp) do { _Pragma("unroll") for (int _i = 0; _i < 2; ++_i) \
        __builtin_amdgcn_global_load_lds((const unsigned*)((bp) + voffB[_i]), (LAS unsigned*)(lds + (bufoff) + ldsw + _i * 8192), 16, 0, 0); } while (0)
#define G8_LDA(dst, b, h) do { _Pragma("unroll") for (int m = 0; m < 4; ++m) _Pragma("unroll") for (int k = 0; k < 2; ++k) dst[m][k] = *(const LAS bf16x8*)(lds + G8_SA(b, h) + aoff + m * 2048 + k * 1024); } while (0)
#define G8_LDB(dst, b, h) do { _Pragma("unroll") for (int n = 0; n < 2; ++n) _Pragma("unroll") for (int k = 0; k < 2; ++k) dst[n][k] = *(const LAS bf16x8*)(lds + G8_SB(b, h) + boff + n * 2048 + k * 1024); } while (0)
#define G8_MMA(ai, bj, At, Bt) do { __builtin_amdgcn_s_setprio(1); _Pragma("unroll") for (int m = 0; m < 4; ++m) _Pragma("unroll") for (int n = 0; n < 2; ++n) _Pragma("unroll") for (int k = 0; k < 2; ++k) \
        acc[ai][bj][m][n] = __builtin_amdgcn_mfma_f32_16x16x32_bf16(Bt[n][k], At[m][k], acc[ai][bj][m][n], 0, 0, 0); __builtin_amdgcn_s_setprio(0); } while (0)
#define G8_WAIT_V(n) asm volatile("s_waitcnt vmcnt(" #n ")" ::: "memory")
#define G8_WAIT_L(n) asm volatile("s_waitcnt lgkmcnt(" #n ")" ::: "memory")
#define G8_BAR __builtin_amdgcn_s_barrier()
#define G8_SCHED __builtin_amdgcn_sched_barrier(0)
    Unit cur, nxt; int ui = 0;
    if (!P.next(0, cur)) return;
    f32x4 acc[2][2][4][2];
#pragma unroll
    for (int a = 0; a < 2; ++a)
#pragma unroll
        for (int b = 0; b < 2; ++b)
#pragma unroll
            for (int m = 0; m < 4; ++m)
#pragma unroll
                for (int n = 0; n < 2; ++n) acc[a][b][m][n] = (f32x4){0.f, 0.f, 0.f, 0.f};
    bf16x8 At[4][2], B0[2][2], B1[2][2];
    AOff cA, nA;
    P.aoff(cur, R, C, cA);
    {   const char* b0 = P.bbase(cur, 0); const char* b1 = P.bbase(cur, 1);
        G8_STAGE_B(G8_SB(0, 0), b0); G8_STAGE_B(G8_SB(0, 1), b0 + hstepB); G8_STAGE_A(G8_SA(0, 0), 0, cA, 0u); G8_STAGE_A(G8_SA(0, 1), 1, cA, 0u);
        if (wr == 1) G8_BAR;
        G8_WAIT_V(2); G8_BAR;
        G8_STAGE_B(G8_SB(1, 0), b1); G8_STAGE_A(G8_SA(1, 0), 0, cA, 128u); G8_STAGE_B(G8_SB(1, 1), b1 + hstepB);
        G8_WAIT_V(6); G8_BAR; }
    for (;;) {
        const bool has_next = P.next(ui + 1, nxt);
        if (has_next) P.aoff(nxt, R, C, nA); else { nA = cA; nxt = cur; }
        for (int t = 0; t < nt; t += 2) {
            const bool last = (t == nt - 2);
            const unsigned kb1 = (unsigned)(t + 1) * 128u;
            const unsigned kb2 = last ? 0u : (unsigned)(t + 2) * 128u, kb3 = kb2 + 128u;
            AOff s;
#pragma unroll
            for (int h = 0; h < 2; ++h)
#pragma unroll
                for (int i = 0; i < 2; ++i) s.o[h][i] = last ? nA.o[h][i] : cA.o[h][i];
            const char* b2 = last ? P.bbase(nxt, 0) : P.bbase(cur, t + 2);
            const char* b3 = last ? P.bbase(nxt, 1) : P.bbase(cur, t + 3);
            G8_LDB(B0, 0, 0); G8_LDB(B1, 0, 1); G8_SCHED; G8_LDA(At, 0, 0); G8_STAGE_A(G8_SA(1, 1), 1, cA, kb1);
            G8_WAIT_V(8); G8_WAIT_L(0); G8_BAR; G8_MMA(0, 0, At, B0); G8_MMA(0, 1, At, B1); G8_BAR; G8_SCHED;
            G8_LDA(At, 0, 1); G8_STAGE_B(G8_SB(0, 0), b2); G8_STAGE_B(G8_SB(0, 1), b2 + hstepB); G8_STAGE_A(G8_SA(0, 0), 0, s, kb2);
            G8_WAIT_V(8); G8_WAIT_L(0); G8_BAR; G8_MMA(1, 0, At, B0); G8_MMA(1, 1, At, B1); G8_BAR; G8_SCHED;
            G8_LDB(B0, 1, 0); G8_LDB(B1, 1, 1); G8_SCHED; G8_LDA(At, 1, 0); G8_STAGE_A(G8_SA(0, 1), 1, s, kb2);
            G8_WAIT_V(8); G8_WAIT_L(0); G8_BAR; G8_MMA(0, 0, At, B0); G8_MMA(0, 1, At, B1); G8_BAR; G8_SCHED;
            G8_LDA(At, 1, 1); G8_STAGE_B(G8_SB(1, 0), b3); G8_STAGE_B(G8_SB(1, 1), b3 + hstepB); G8_STAGE_A(G8_SA(1, 0), 0, s, kb3);
            G8_WAIT_V(8); G8_WAIT_L(0); G8_BAR; G8_MMA(1, 0, At, B0); G8_MMA(1, 1, At, B1); G8_BAR; G8_SCHED;
        }
        if (wr == 0) G8_BAR;
        E(acc, cur, wr, wc, fr, fq);
        if (!has_next) break;
#pragma unroll
        for (int a = 0; a < 2; ++a)
#pragma unroll
            for (int b = 0; b < 2; ++b)
#pragma unroll
                for (int m = 0; m < 4; ++m)
#pragma unroll
                    for (int n = 0; n < 2; ++n) acc[a][b][m][n] = (f32x4){0.f, 0.f, 0.f, 0.f};
        cur = nxt; cA = nA; ++ui;
        if (wr == 1) G8_BAR;
    }
    G8_WAIT_V(0);
    G8_BAR;
#undef G8_SA
#undef G8_SB
#undef G8_STAGE_A
#undef G8_STAGE_B
#undef G8_LDA
#undef G8_LDB
#undef G8_MMA
#undef G8_WAIT_V
#undef G8_WAIT_L
#undef G8_BAR
#undef G8_SCHED
}
}
using g8::Unit;


struct EpiQKV {
    const float* hpx; const float* cosA; const float* sinA; bf16_t* Q; bf16_t* Kk; bf16_t* V; float* kmean;
    __device__ __forceinline__ void operator()(const f32x4 (&acc)[2][2][4][2], const Unit& u, int wr, int wc, int fr, int fq) const {
        const int t = u.pn >> 2;
        const int bb = u.pm >> 5;
        if (t < 2) {
            const int hh = 2 * (u.pn & 3) + (wc >> 1), j0 = 32 * (wc & 1) + 8 * fq;
            bf16_t* dst0 = (t == 0 ? Q : Kk) + ((size_t)(bb * NH + hh) * NS) * 128;
            f32x4 ks[2][2] = {{{0.f, 0.f, 0.f, 0.f}, {0.f, 0.f, 0.f, 0.f}}, {{0.f, 0.f, 0.f, 0.f}, {0.f, 0.f, 0.f, 0.f}}};
#pragma unroll
            for (int ai = 0; ai < 2; ++ai)
#pragma unroll
                for (int m = 0; m < 4; ++m) {
                    const int row = u.pm * 256 + 128 * ai + 64 * wr + 16 * m + fr, s = row & (NS - 1);
                    const float rs = row_rs<16>(hpx + (size_t)row * 16, 1.0f / 1024.0f);
                    f32x4 o1[2], o2[2];
#pragma unroll
                    for (int n = 0; n < 2; ++n) {
                        const f32x4 cs = *(const f32x4*)(cosA + (size_t)s * 64 + j0 + 4 * n), sn = *(const f32x4*)(sinA + (size_t)s * 64 + j0 + 4 * n);
                        const f32x4 x1 = acc[ai][0][m][n] * rs, x2 = acc[ai][1][m][n] * rs;
                        o1[n] = x1 * cs - x2 * sn; o2[n] = x1 * sn + x2 * cs;
                        ks[0][n] += o1[n]; ks[1][n] += o2[n];
                    }
                    bf16_t* d = dst0 + (size_t)s * 128 + j0;
                    *(u32x4*)d = pack8(o1[0], o1[1]); *(u32x4*)(d + 64) = pack8(o2[0], o2[1]);
                }
            if (t == 1) {
#pragma unroll
                for (int q = 0; q < 2; ++q)
#pragma unroll
                    for (int n = 0; n < 2; ++n)
#pragma unroll
                        for (int e = 0; e < 4; ++e) { float v = ks[q][n][e]; v += __shfl_xor(v, 1); v += __shfl_xor(v, 2); v += __shfl_xor(v, 4); v += __shfl_xor(v, 8); ks[q][n][e] = v; }
                if (fr == 0) {
                    float* km = kmean + ((size_t)(bb * NH + hh) * 32 + (u.pm & 31)) * 128 + j0;
#pragma unroll
                    for (int q = 0; q < 2; ++q)
#pragma unroll
                        for (int n = 0; n < 2; ++n)
#pragma unroll
                            for (int e = 0; e < 4; ++e) atomicAdd(km + 64 * q + 4 * n + e, ks[q][n][e]);
                }
            }
        } else {
            const int d0 = 32 * wc + 8 * fq;
#pragma unroll
            for (int ai = 0; ai < 2; ++ai)
#pragma unroll
                for (int m = 0; m < 4; ++m) {
                    const int row = u.pm * 256 + 128 * ai + 64 * wr + 16 * m + fr, s = row & (NS - 1);
                    const float rs = row_rs<16>(hpx + (size_t)row * 16, 1.0f / 1024.0f);
#pragma unroll
                    for (int bj = 0; bj < 2; ++bj) {
                        const int hh = 2 * (u.pn - 8) + bj;
                        bf16_t* d = V + ((size_t)(bb * NH + hh) * NS + s) * 128 + d0;
                        *(u32x4*)d = pack8(acc[ai][bj][m][0] * rs, acc[ai][bj][m][1] * rs);
                    }
                }
        }
    }
};

__device__ __forceinline__ void unpack8(u32x4 w, f32x4& a, f32x4& b) {
#pragma unroll
    for (int e = 0; e < 2; ++e) { a[2 * e] = __builtin_bit_cast(float, w[e] << 16); a[2 * e + 1] = __builtin_bit_cast(float, w[e] & 0xffff0000u);
                                  b[2 * e] = __builtin_bit_cast(float, w[2 + e] << 16); b[2 * e + 1] = __builtin_bit_cast(float, w[2 + e] & 0xffff0000u); }
}
struct EpiResid {
    const bf16_t* base; bf16_t* hb; float* hp;
    __device__ __forceinline__ void operator()(const f32x4 (&acc)[2][2][4][2], const Unit& u, int wr, int wc, int fr, int fq) const {
#pragma unroll
        for (int ai = 0; ai < 2; ++ai)
#pragma unroll
            for (int m = 0; m < 4; ++m) {
                const int row = u.pm * 256 + 128 * ai + 64 * wr + 16 * m + fr;
                float ss = 0.f;
#pragma unroll
                for (int bj = 0; bj < 2; ++bj) {
                    const size_t off = (size_t)row * 1024 + u.pn * 256 + 128 * bj + 32 * wc + 8 * fq;
                    f32x4 b0, b1; unpack8(*(const u32x4*)(base + off), b0, b1);
                    const f32x4 v0 = acc[ai][bj][m][0] + b0, v1 = acc[ai][bj][m][1] + b1;
                    *(u32x4*)(hb + off) = pack8(v0, v1);
                    ss += dot4(v0) + dot4(v1);
                }
                ss += __shfl_xor(ss, 16); ss += __shfl_xor(ss, 32);
                if (fq == 0) hp[(size_t)row * 16 + u.pn * 4 + wc] = ss;
                if (m & 1) asm volatile("" ::: "memory");
            }
    }
};
namespace at {
constexpr int KVBLK = 64, SHM_V = KVBLK * 128 * 2;
constexpr float THR = 8.f;
#define AT_SBAR() __builtin_amdgcn_sched_barrier(0)
__device__ __forceinline__ int v_st(int k, int c) { const int kk = (k & ~0xC) | ((k & 4) << 1) | ((k & 8) >> 1); return ((kk >> 3) * 4 + (c >> 5)) * 512 + ((kk & 7) * 32 + (c & 31)) * 2; }
__device__ __forceinline__ int v_rd_base(int lane) { return ((lane & 3) << 3) | (((lane >> 2) & 3) << 6) | (((lane >> 4) & 1) << 5) | (((lane >> 5) & 1) << 8); }
constexpr int v_rd_off(int d0, int ks, int half) { return d0 * 512 + ks * 4096 + half * 2048; }
__device__ __forceinline__ int crow(int r, int hi) { return (r & 3) + 8 * (r >> 2) + 4 * hi; }

template <int DQK> __device__ __forceinline__ int kswz(int row, int colB) { return row * (DQK * 2) + (colB ^ ((row & 7) << 4)); }

__device__ __forceinline__ void mask_causal(f32x16& p0, f32x16& p1, int dq) {
    const float NEG = -__builtin_inff();
#pragma unroll
    for (int r = 0; r < 16; ++r) {
        const int c = (r & 3) + 8 * (r >> 2);
        if (dq - c < 0) p0[r] = NEG;
        if (dq - c - 32 < 0) p1[r] = NEG;
    }
}
__device__ __forceinline__ void mask_all(f32x16& p0, f32x16& p1, bool keep) {
    const float NEG = -__builtin_inff();
#pragma unroll
    for (int r = 0; r < 16; ++r) { p0[r] = keep ? p0[r] : NEG; p1[r] = keep ? p1[r] : NEG; }
}
__device__ __forceinline__ void partialSM(f32x16& p0, f32x16& p1, float& m_reg, float& mn, float& alpha, const float SC, const float C2) {
    float pmax = p0[0];
#pragma unroll
    for (int r = 1; r < 16; ++r) pmax = fmaxf(pmax, p0[r]);
#pragma unroll
    for (int r = 0; r < 16; ++r) pmax = fmaxf(pmax, p1[r]);
    { auto rr = __builtin_amdgcn_permlane32_swap(__float_as_uint(pmax), __float_as_uint(pmax), false, false);
      pmax = fmaxf(__uint_as_float(rr[0]), __uint_as_float(rr[1])); }
    if (__builtin_expect(__all((pmax - m_reg) * SC <= THR), 1)) { mn = m_reg; alpha = 1.f; }
    else { mn = fmaxf(m_reg, pmax); alpha = __builtin_amdgcn_exp2f((m_reg - mn) * C2); m_reg = mn; }
    const float mnL = -mn * C2;
#pragma unroll
    for (int r = 0; r < 16; ++r) p0[r] = fmaf(p0[r], C2, mnL);
#pragma unroll
    for (int r = 0; r < 16; ++r) p1[r] = fmaf(p1[r], C2, mnL);
#pragma unroll
    for (int r = 0; r < 16; ++r) p0[r] = __builtin_amdgcn_exp2f(p0[r]);
}
__device__ __forceinline__ void finishSM(f32x16& p0, f32x16& p1, float alpha, float& l_reg, bf16x8& pa0, bf16x8& pa1, bf16x8& pa2, bf16x8& pa3) {
#pragma unroll
    for (int r = 0; r < 16; ++r) p1[r] = __builtin_amdgcn_exp2f(p1[r]);
    float ps = 0;
#pragma unroll
    for (int r = 0; r < 16; ++r) ps += p0[r];
#pragma unroll
    for (int r = 0; r < 16; ++r) ps += p1[r];
    { auto rr = __builtin_amdgcn_permlane32_swap(__float_as_uint(ps), __float_as_uint(ps), false, false);
      ps = __uint_as_float(rr[0]) + __uint_as_float(rr[1]); }
    l_reg = l_reg * alpha + ps;
#define AT_PK4(P, B_, OUT) do { unsigned a0 = cvtpk(P[B_+0], P[B_+1]), a1 = cvtpk(P[B_+2], P[B_+3]);                          \
        unsigned b0 = cvtpk(P[B_+4], P[B_+5]), b1 = cvtpk(P[B_+6], P[B_+7]);                                             \
        auto r0 = __builtin_amdgcn_permlane32_swap(a0, b0, false, false); auto r1 = __builtin_amdgcn_permlane32_swap(a1, b1, false, false); \
        u32x4 w = {r0[0], r1[0], r0[1], r1[1]}; OUT = __builtin_bit_cast(bf16x8, w); } while (0)
    AT_PK4(p0, 0, pa0); AT_PK4(p0, 8, pa1); AT_PK4(p1, 0, pa2); AT_PK4(p1, 8, pa3);
#undef AT_PK4
}
template <int DQK>
__device__ __forceinline__ void qkt(f32x16& p0, f32x16& p1, const char* Kt, int r32, int hi, const bf16x8* qr, bool act) {
    if (!act) { const float NEG = -__builtin_inff();
#pragma unroll
        for (int r = 0; r < 16; ++r) { p0[r] = NEG; p1[r] = NEG; } return; }
    p0 = f32x16{}; p1 = f32x16{};
    const char* kb[4];
#pragma unroll
    for (int dd = 0; dd < 4; ++dd) kb[dd] = Kt + kswz<DQK>(r32, (dd * 16 + hi * 8) * 2);
#pragma unroll
    for (int d0 = 0; d0 < DQK / 16; ++d0) { const char* a = kb[d0 & 3] + (d0 >> 2) * 128;
        bf16x8 b0 = *reinterpret_cast<const bf16x8*>(a);
        bf16x8 b1 = *reinterpret_cast<const bf16x8*>(a + 32 * DQK * 2);
        p0 = __builtin_amdgcn_mfma_f32_32x32x16_bf16(b0, qr[d0], p0, 0, 0, 0);
        p1 = __builtin_amdgcn_mfma_f32_32x32x16_bf16(b1, qr[d0], p1, 0, 0, 0); }
}
template <int VB>
__device__ __forceinline__ void pv_tile(f32x16* o, int vb0, bf16x8 pa0, bf16x8 pa1, bf16x8 pa2, bf16x8 pa3, bool act) {
    if (!act) return;
#define AT_TRRD(dst, off) asm volatile("ds_read_b64_tr_b16 %0, %1 offset:%2" : "=&v"(dst) : "v"(vb0), "i"(off) : "memory")
#define AT_PV_D0(d0) do { s16x4 l0, l1, l2, l3, h0, h1, h2, h3; constexpr int b_ = VB * SHM_V + v_rd_off(d0, 0, 0); \
        AT_TRRD(l0, b_); AT_TRRD(h0, b_ + 2048); AT_TRRD(l1, b_ + 4096); AT_TRRD(h1, b_ + 6144); AT_TRRD(l2, b_ + 8192); AT_TRRD(h2, b_ + 10240); AT_TRRD(l3, b_ + 12288); AT_TRRD(h3, b_ + 14336); \
        asm volatile("s_waitcnt lgkmcnt(0)" ::: "memory"); AT_SBAR();   \
        o[d0] = __builtin_amdgcn_mfma_f32_32x32x16_bf16((bf16x8){l0[0], l0[1], l0[2], l0[3], h0[0], h0[1], h0[2], h0[3]}, pa0, o[d0], 0, 0, 0);   \
        o[d0] = __builtin_amdgcn_mfma_f32_32x32x16_bf16((bf16x8){l1[0], l1[1], l1[2], l1[3], h1[0], h1[1], h1[2], h1[3]}, pa1, o[d0], 0, 0, 0);   \
        o[d0] = __builtin_amdgcn_mfma_f32_32x32x16_bf16((bf16x8){l2[0], l2[1], l2[2], l2[3], h2[0], h2[1], h2[2], h2[3]}, pa2, o[d0], 0, 0, 0);   \
        o[d0] = __builtin_amdgcn_mfma_f32_32x32x16_bf16((bf16x8){l3[0], l3[1], l3[2], l3[3], h3[0], h3[1], h3[2], h3[3]}, pa3, o[d0], 0, 0, 0); } while (0)
    AT_PV_D0(0); AT_PV_D0(1); AT_PV_D0(2); AT_PV_D0(3);
#undef AT_PV_D0
#undef AT_TRRD
}

__device__ __forceinline__ void ochunk(const f32x16 (&o)[4], int d0, int j, f32x4& c0, f32x4& c1) {
#pragma unroll
    for (int e = 0; e < 4; ++e) { auto rr = __builtin_amdgcn_permlane32_swap(__float_as_uint(o[d0][8 * j + e]), __float_as_uint(o[d0][8 * j + 4 + e]), false, false);
        c0[e] = __uint_as_float(rr[0]); c1[e] = __uint_as_float(rr[1]); }
}
template <int DQK> struct Lds { static constexpr int SHM_K = KVBLK * DQK * 2, K_OFF = 2 * SHM_V, WS_OFF = K_OFF + 2 * SHM_K, BYTES = WS_OFF + NWAVES * 64 * 4, F_OFF = BYTES; };

constexpr int LCAP = 256 * 496;
__device__ __forceinline__ int loff(int n) { return 256 * (31 * n - (n * (n - 1)) / 2); }
struct SparseBufs { unsigned short* lists; unsigned* lcnt; unsigned* selinfo; float* ml; unsigned char* part01; unsigned char* part2; };

struct AttnP { const bf16_t* Qp; const bf16_t* Kn; const bf16_t* Kr; const bf16_t* Vp; bf16_t* Op; int P0, t0, NT, bh, nent; const unsigned short* ents; };

template <int DQK, int MODE>
__device__ __forceinline__ void attn_unit(char* lds, const AttnP& A, const SparseBufs& SB) {
    typedef Lds<DQK> L;
    constexpr int SHM_K = L::SHM_K;
    constexpr float SC = (DQK == 128) ? 0.08838834764831845f : 0.07216878364870323f;
    constexpr float C2 = 1.4426950408889634f * SC;
    constexpr int ND0 = DQK / 16;
    int tid = threadIdx.x; asm volatile("" : "+v"(tid));
    const int wid = __builtin_amdgcn_readfirstlane(tid >> 6), lane = tid & 63, r32 = lane & 31, hi = lane >> 5;
    const int NT = A.NT, t0 = A.t0, P0 = A.P0;
    const int qlo = P0 + wid * 32, qm = qlo + r32 - 4 * hi;
    char* V_lds = lds; char* K_lds = lds + L::K_OFF;
    float* ws = (float*)(lds + L::WS_OFF) + wid * 64; float* li_l = ws, * al_l = ws + 32;
    float m_reg = -1e30f, l_reg = 0; f32x16 o[4] = {};
    const int sr = tid >> 4, sc = (tid & 15) * 8, vst0 = v_st(sr, sc), vst1 = v_st(32 + sr, sc), kws = kswz<DQK>(sr, sc * 2);
    const int rr_ = tid >> 3, rc_ = (tid & 7) * 8, kws_r = kswz<DQK>(rr_, 256 + rc_ * 2);
    const int vb0 = (int)(uintptr_t)V_lds + v_rd_base(lane);
    bf16x8 qr[ND0];
    int ent = -1;
    if (MODE == 2) {
        const int ri = wid * 32 + r32; const bool valid = ri < A.nent;
        const int e = (int)A.ents[valid ? ri : 0]; ent = valid ? e : -1;
        const __amdgpu_buffer_rsrc_t rsQ = __builtin_amdgcn_make_buffer_rsrc((void*)A.Qp, 0, NS * 256, 0x00020000);
        const unsigned qo = (unsigned)((e & 8191) * 256 + hi * 16);
#pragma unroll
        for (int d0 = 0; d0 < ND0; ++d0) qr[d0] = __builtin_bit_cast(bf16x8, __builtin_amdgcn_raw_buffer_load_b128(rsQ, (int)(qo + d0 * 32), 0, 0));
    } else {
        const unsigned qo = (unsigned)(((wid * 32 + r32) * DQK + hi * 8) * 2);
#pragma unroll
        for (int d0 = 0; d0 < ND0; ++d0) qr[d0] = *(const bf16x8*)((const char*)A.Qp + qo + d0 * 32);
    }
    bf16x8 st_v0, st_v1, st_k0, st_k1, st_k2;
    const unsigned lo_a = (unsigned)((sr * 128 + sc) * 2), lo_r = (unsigned)((rr_ * 64 + rc_) * 2);
#define AT_VMW() asm volatile("s_waitcnt vmcnt(0)" ::: "memory")
    const __amdgpu_buffer_rsrc_t rsV = __builtin_amdgcn_make_buffer_rsrc((void*)A.Vp, 0, NS * 256, 0x00020000), rsK = __builtin_amdgcn_make_buffer_rsrc((void*)A.Kn, 0, NS * 256, 0x00020000);
    const __amdgpu_buffer_rsrc_t rsR = __builtin_amdgcn_make_buffer_rsrc((void*)(DQK == 192 ? A.Kr : A.Kn), 0, NS * 128, 0x00020000);
#define AT_BL(rs, vo, so) __builtin_bit_cast(bf16x8, __builtin_amdgcn_raw_buffer_load_b128(rs, (int)(vo), (int)(so), 0))
#define AT_SLOAD(k0) do { const int so_ = (k0) * 256; \
                          st_v0 = AT_BL(rsV, lo_a, so_); st_v1 = AT_BL(rsV, lo_a, so_ + 8192); \
                          st_k0 = AT_BL(rsK, lo_a, so_); st_k1 = AT_BL(rsK, lo_a, so_ + 8192); \
                          if (DQK == 192) { st_k2 = AT_BL(rsR, lo_r, (k0) * 128); } } while (0)
#define AT_SWRITE(bf) do { *(bf16x8*)(V_lds + (bf) * SHM_V + vst0) = st_v0; *(bf16x8*)(V_lds + (bf) * SHM_V + vst1) = st_v1; \
                           *(bf16x8*)(K_lds + (bf) * SHM_K + kws) = st_k0; *(bf16x8*)(K_lds + (bf) * SHM_K + kws + 32 * DQK * 2) = st_k1; \
                           if (DQK == 192) *(bf16x8*)(K_lds + (bf) * SHM_K + kws_r) = st_k2; } while (0)
#define AT_RESC(a) do { if (__any((a) < 1.f)) { _Pragma("unroll") for (int d_ = 0; d_ < 4; ++d_) o[d_] *= (a); } } while (0)
#define AT_KBASE(t) ((t0 + (t)) * KVBLK)
#define AT_ACT(t) (MODE == 2 ? true : (AT_KBASE(t) <= qlo + 31))
#define AT_MASKT(P0_, P1_, t) do { if (MODE != 2) { const int kb_ = AT_KBASE(t); \
        if (kb_ + KVBLK - 1 > qlo && kb_ <= qlo + 31) mask_causal(P0_, P1_, qm - kb_); } } while (0)
    f32x16 pA0, pA1, pB0, pB1; float mnA, mnB, alA, alB; bf16x8 pa0, pa1, pa2, pa3;
    AT_SLOAD(AT_KBASE(0)); AT_VMW(); AT_SWRITE(0);
    __syncthreads();
    AT_SLOAD(AT_KBASE(1));
    AT_SBAR(); qkt<DQK>(pA0, pA1, K_lds, r32, hi, qr, AT_ACT(0));
    AT_MASKT(pA0, pA1, 0); partialSM(pA0, pA1, m_reg, mnA, alA, SC, C2);
    AT_VMW(); AT_SWRITE(1);
    __syncthreads();
#define AT_HALF_STEP(PX0, PX1, mnX, alX, PY0, PY1, alY, t, KB, VB, SB_) do {                                                      \
        AT_SBAR(); qkt<DQK>(PX0, PX1, K_lds + (KB) * SHM_K, r32, hi, qr, AT_ACT(t));                                             \
        finishSM(PY0, PY1, alY, l_reg, pa0, pa1, pa2, pa3); AT_SBAR();                                                           \
        if ((t) + 1 < NT) { AT_SLOAD(AT_KBASE((t) + 1)); AT_SBAR(); }                                                            \
        pv_tile<VB>(o, vb0, pa0, pa1, pa2, pa3, AT_ACT((t) - 1)); AT_MASKT(PX0, PX1, (t)); partialSM(PX0, PX1, m_reg, mnX, alX, SC, C2); \
        __syncthreads();                                                                                                      \
        if ((t) + 1 < NT) { AT_VMW(); AT_SWRITE(SB_); }                                                                           \
        AT_RESC(alX); __syncthreads(); } while (0)
    for (int t = 1; t + 1 < NT; t += 2) {
        AT_HALF_STEP(pB0, pB1, mnB, alB, pA0, pA1, alA, t, 1, 0, 0);
        AT_HALF_STEP(pA0, pA1, mnA, alA, pB0, pB1, alB, t + 1, 0, 1, 1);
    }
    AT_SBAR(); qkt<DQK>(pB0, pB1, K_lds + SHM_K, r32, hi, qr, AT_ACT(NT - 1)); AT_SBAR();
    finishSM(pA0, pA1, alA, l_reg, pa0, pa1, pa2, pa3); AT_SBAR();
    pv_tile<0>(o, vb0, pa0, pa1, pa2, pa3, AT_ACT(NT - 2));
    AT_MASKT(pB0, pB1, NT - 1); partialSM(pB0, pB1, m_reg, mnB, alB, SC, C2); AT_RESC(alB);
    finishSM(pB0, pB1, alB, l_reg, pa0, pa1, pa2, pa3); AT_SBAR(); pv_tile<1>(o, vb0, pa0, pa1, pa2, pa3, AT_ACT(NT - 1));
    if (MODE == 0) {
        const float il = __builtin_amdgcn_rcpf(l_reg);
        unsigned lofs = (unsigned)(((wid * 32 + r32) * 1024 + 8 * hi) * 2);
        asm volatile("" : "+v"(lofs));
#pragma unroll
        for (int d0 = 0; d0 < 4; ++d0)
#pragma unroll
            for (int j = 0; j < 2; ++j) { f32x4 c0, c1; ochunk(o, d0, j, c0, c1);
                *(u32x4*)((char*)A.Op + (size_t)((32 * d0 + 16 * j) * 2) + lofs) = pack8(c0 * il, c1 * il); }
    }
    __syncthreads();
#undef AT_VMW
#undef AT_SLOAD
#undef AT_BL
#undef AT_SWRITE
#undef AT_RESC
#undef AT_KBASE
#undef AT_ACT
#undef AT_MASKT
#undef AT_HALF_STEP
}

constexpr int RES_WS = 132096, RES_F = 134144;
__device__ __forceinline__ void moba_stage_kv(char* lds, const bf16_t* Kn, const bf16_t* Vp, int n) {
    int tid = threadIdx.x; asm volatile("" : "+v"(tid));
    const int sr = tid >> 4, sc = (tid & 15) * 8, vst0 = v_st(sr, sc), vst1 = v_st(32 + sr, sc), kws = kswz<128>(sr, sc * 2);
    const unsigned lo_a = (unsigned)((sr * 128 + sc) * 2);
    const __amdgpu_buffer_rsrc_t rsV = __builtin_amdgcn_make_buffer_rsrc((void*)Vp, 0, NS * 256, 0x00020000), rsK = __builtin_amdgcn_make_buffer_rsrc((void*)Kn, 0, NS * 256, 0x00020000);
    bf16x8 kv[4][4];
#pragma unroll
    for (int t = 0; t < 4; ++t) { const int so = (4 * n + t) * 64 * 256;
        kv[t][0] = __builtin_bit_cast(bf16x8, __builtin_amdgcn_raw_buffer_load_b128(rsV, (int)lo_a, so, 0)); kv[t][1] = __builtin_bit_cast(bf16x8, __builtin_amdgcn_raw_buffer_load_b128(rsV, (int)lo_a, so + 8192, 0));
        kv[t][2] = __builtin_bit_cast(bf16x8, __builtin_amdgcn_raw_buffer_load_b128(rsK, (int)lo_a, so, 0)); kv[t][3] = __builtin_bit_cast(bf16x8, __builtin_amdgcn_raw_buffer_load_b128(rsK, (int)lo_a, so + 8192, 0)); }
#pragma unroll
    for (int t = 0; t < 4; ++t) {
        *(bf16x8*)(lds + t * SHM_V + vst0) = kv[t][0]; *(bf16x8*)(lds + t * SHM_V + vst1) = kv[t][1];
        *(bf16x8*)(lds + 65536 + t * 16384 + kws) = kv[t][2]; *(bf16x8*)(lds + 65536 + t * 16384 + kws + 32 * 256) = kv[t][3]; }
    __syncthreads();
}
template <int MODE>
__device__ __forceinline__ void moba_rows(char* lds, const bf16_t* Qh  , bf16_t* Op  , int bh, const unsigned short* ents, int nvalid  , int qrow0  , int kb0, const SparseBufs& SB, int wid, int lane) {
    constexpr float SC = 0.08838834764831845f, C2 = 1.4426950408889634f * SC;
    const int r32 = lane & 31, hi = lane >> 5;
    char* V_lds = lds; char* K_lds = lds + 65536;
    float* ws = (float*)(lds + RES_WS) + wid * 64; float* li_l = ws, * al_l = ws + 32;
    const int vb0 = (int)(uintptr_t)V_lds + v_rd_base(lane);
    int ent = -1, srow;
    if (MODE == 2) { const bool valid = r32 < nvalid; const int e = (int)ents[valid ? r32 : 0]; ent = valid ? e : -1; srow = e & 8191; } else srow = qrow0 + r32;
    bf16x8 qr[8];
    {   const __amdgpu_buffer_rsrc_t rsQ = __builtin_amdgcn_make_buffer_rsrc((void*)Qh, 0, NS * 256, 0x00020000);
        const unsigned qo = (unsigned)(srow * 256 + hi * 16);
#pragma unroll
        for (int d0 = 0; d0 < 8; ++d0) qr[d0] = __builtin_bit_cast(bf16x8, __builtin_amdgcn_raw_buffer_load_b128(rsQ, (int)(qo + d0 * 32), 0, 0)); }
    float m_reg = -1e30f, l_reg = 0; f32x16 o[4] = {};
    const int qlo = qrow0, qm = qrow0 + r32 - 4 * hi;
#define MR_ACT(t) (MODE == 2 ? true : (kb0 + (t) * 64 <= qlo + 31))
#define MR_MASK(P0_, P1_, t) do { if (MODE == 3) { const int kb_ = kb0 + (t) * 64; if (kb_ + 63 > qlo && kb_ <= qlo + 31) mask_causal(P0_, P1_, qm - kb_); } } while (0)
#define MR_RESC(a) do { if (__any((a) < 1.f)) { _Pragma("unroll") for (int d_ = 0; d_ < 4; ++d_) o[d_] *= (a); } } while (0)
    f32x16 pA0, pA1, pB0, pB1; float mnA, mnB, alA, alB; bf16x8 pa0, pa1, pa2, pa3;
    qkt<128>(pA0, pA1, K_lds, r32, hi, qr, MR_ACT(0)); MR_MASK(pA0, pA1, 0); partialSM(pA0, pA1, m_reg, mnA, alA, SC, C2);
    AT_SBAR(); qkt<128>(pB0, pB1, K_lds + 16384, r32, hi, qr, MR_ACT(1)); finishSM(pA0, pA1, alA, l_reg, pa0, pa1, pa2, pa3); AT_SBAR();
    pv_tile<0>(o, vb0, pa0, pa1, pa2, pa3, MR_ACT(0)); MR_MASK(pB0, pB1, 1); partialSM(pB0, pB1, m_reg, mnB, alB, SC, C2); MR_RESC(alB);
    AT_SBAR(); qkt<128>(pA0, pA1, K_lds + 2 * 16384, r32, hi, qr, MR_ACT(2)); finishSM(pB0, pB1, alB, l_reg, pa0, pa1, pa2, pa3); AT_SBAR();
    pv_tile<1>(o, vb0, pa0, pa1, pa2, pa3, MR_ACT(1)); MR_MASK(pA0, pA1, 2); partialSM(pA0, pA1, m_reg, mnA, alA, SC, C2); MR_RESC(alA);
    AT_SBAR(); qkt<128>(pB0, pB1, K_lds + 3 * 16384, r32, hi, qr, MR_ACT(3)); finishSM(pA0, pA1, alA, l_reg, pa0, pa1, pa2, pa3); AT_SBAR();
    pv_tile<2>(o, vb0, pa0, pa1, pa2, pa3, MR_ACT(2)); MR_MASK(pB0, pB1, 3); partialSM(pB0, pB1, m_reg, mnB, alB, SC, C2); MR_RESC(alB);
    finishSM(pB0, pB1, alB, l_reg, pa0, pa1, pa2, pa3); AT_SBAR(); pv_tile<3>(o, vb0, pa0, pa1, pa2, pa3, MR_ACT(3));
#undef MR_ACT
#undef MR_MASK
#undef MR_RESC
    if (MODE == 2) {
        if (hi == 0 && ent >= 0) { f32x2_t mlv = {m_reg, l_reg}; *(f32x2_t*)(SB.ml + ((size_t)(ent >> 13) * (NB * NH * NS) + (size_t)bh * NS + srow) * 2) = mlv; }
        const float il = __builtin_amdgcn_rcpf(l_reg);
        const int slot = ent >> 13;
        unsigned char* pb = (slot == 2) ? SB.part2 : SB.part01 + (size_t)(slot & 1) * ((size_t)NB * NH * NS * 256);
        unsigned po = (unsigned)((bh * NS + srow) * 256 + 16 * hi); asm volatile("" : "+v"(po));
#pragma unroll
        for (int d0 = 0; d0 < 4; ++d0)
#pragma unroll
            for (int j = 0; j < 2; ++j) { f32x4 c0, c1; ochunk(o, d0, j, c0, c1);
                if (ent >= 0) *(u32x4*)(pb + po + (32 * d0 + 16 * j) * 2) = pack8(c0 * il, c1 * il); }
    } else {
        const int s = qrow0 + r32; const unsigned si = SB.selinfo[(size_t)bh * NS + s];
        float mk[3], lk[3]; float M = m_reg;
#pragma unroll
        for (int k = 0; k < 3; ++k) { const bool v = ((si >> (8 * k)) & 255u) < 32u; mk[k] = -1e30f; lk[k] = 0.f;
            if (v) { const f32x2_t t = *(const f32x2_t*)(SB.ml + ((size_t)k * (NB * NH * NS) + (size_t)bh * NS + s) * 2); mk[k] = t[0]; lk[k] = t[1]; }
            M = fmaxf(M, mk[k]); }
        const float w_own = __builtin_amdgcn_exp2f((m_reg - M) * C2);
        float den = w_own * l_reg, wk[3];
#pragma unroll
        for (int k = 0; k < 3; ++k) { wk[k] = lk[k] * __builtin_amdgcn_exp2f((mk[k] - M) * C2); den += wk[k]; }
        const float inv = __builtin_amdgcn_rcpf(den), f_own = w_own * inv;
#pragma unroll
        for (int k = 0; k < 3; ++k) wk[k] *= inv;
        unsigned po = (unsigned)((bh * NS + s) * 256 + 16 * hi); asm volatile("" : "+v"(po));
        const int b = bh >> 3, h = bh & 7;
        char* orow = (char*)Op + ((size_t)(b * NS + s) * 1024 + h * 128 + 8 * hi) * 2;
#pragma unroll
        for (int d0 = 0; d0 < 4; ++d0)
#pragma unroll
            for (int j = 0; j < 2; ++j) { f32x4 c0, c1; ochunk(o, d0, j, c0, c1); c0 *= f_own; c1 *= f_own;
                u32x4 pw[3];
#pragma unroll
                for (int k = 0; k < 3; ++k) { const unsigned char* pb = (k == 2) ? SB.part2 : SB.part01 + (size_t)k * ((size_t)NB * NH * NS * 256);
                    pw[k] = *(const u32x4*)(pb + po + (32 * d0 + 16 * j) * 2); }
#pragma unroll
                for (int k = 0; k < 3; ++k) { f32x4 b0, b1; const bool use = wk[k] != 0.f;
                    u32x4 w = pw[k]; w.x = use ? w.x : 0u; w.y = use ? w.y : 0u; w.z = use ? w.z : 0u; w.w = use ? w.w : 0u;
                    unpack8(w, b0, b1); c0 += b0 * wk[k]; c1 += b1 * wk[k]; }
                *(u32x4*)(orow + (32 * d0 + 16 * j) * 2) = pack8(c0, c1); }
    }
}
__device__ __forceinline__ void moba_own_unit(char* lds, const bf16_t* Qh, const bf16_t* Kn, const bf16_t* Vp, bf16_t* O, int bh, int qb, const SparseBufs& SB) {
    int tid = threadIdx.x; asm volatile("" : "+v"(tid));
    const int wid = __builtin_amdgcn_readfirstlane(tid >> 6), lane = tid & 63;
    moba_stage_kv(lds, Kn, Vp, qb);
    moba_rows<3>(lds, Qh, O, bh, nullptr, 0, qb * 256 + wid * 32, qb * 256, SB, wid, lane);
    __syncthreads();
}
__device__ __forceinline__ void moba_gather_unit(char* lds, const bf16_t* Qh, const bf16_t* Kn, const bf16_t* Vp, int bh, int n, const unsigned short* ents, int nrows, const SparseBufs& SB) {
    int tid = threadIdx.x; asm volatile("" : "+v"(tid));
    const int wid = __builtin_amdgcn_readfirstlane(tid >> 6), lane = tid & 63;
    moba_stage_kv(lds, Kn, Vp, n);
    const int ng = (nrows + 31) >> 5;
    for (int g = wid; g < ng; g += NWAVES) { const int nv = nrows - 32 * g; moba_rows<2>(lds, Qh, nullptr, bh, ents + 32 * g, nv < 32 ? nv : 32, 0, 0, SB, wid, lane); }
    __syncthreads();
}

__device__ __forceinline__ void gate_unit(char* lds, const bf16_t* Qp  , const float* kms, int bh, int qb, const SparseBufs& SB) {
    typedef Lds<128> L; constexpr int SHM_K = L::SHM_K;
    int tid = threadIdx.x; asm volatile("" : "+v"(tid));
    const int wid = __builtin_amdgcn_readfirstlane(tid >> 6), lane = tid & 63, r32 = lane & 31, hi = lane >> 5;
    char* K_lds = lds + L::K_OFF;
    int* hist = (int*)(lds + L::WS_OFF); int* base = hist + 32;
    const int sr = tid >> 4, sc = (tid & 15) * 8, kws = kswz<128>(sr, sc * 2);
    bf16x8 qr[8];
    {   const unsigned qo = (unsigned)(((wid * 32 + r32) * 128 + hi * 8) * 2);
#pragma unroll
        for (int d0 = 0; d0 < 8; ++d0) qr[d0] = *(const bf16x8*)((const char*)Qp + qo + d0 * 32); }
    {   unsigned ko = (unsigned)((sr * 128 + sc) * 4); asm volatile("" : "+v"(ko));
        const f32x4 a = *(const f32x4*)((const char*)kms + ko) * (1.0f / 256.0f), b = *(const f32x4*)((const char*)kms + ko + 16) * (1.0f / 256.0f);
        const u32x4 h8 = pack8(a, b);
        f32x4 ha, hb_; unpack8(h8, ha, hb_);
        const u32x4 l8 = pack8(a - ha, b - hb_);
        *(u32x4*)(K_lds + kws) = h8; *(u32x4*)(K_lds + SHM_K + kws) = l8; }
    if (tid < 64) hist[tid] = 0;
    __syncthreads();
    f32x16 g = f32x16{};
    {   const char* kb[4];
#pragma unroll
        for (int dd = 0; dd < 4; ++dd) kb[dd] = K_lds + kswz<128>(r32, (dd * 16 + hi * 8) * 2);
#pragma unroll
        for (int d0 = 0; d0 < 8; ++d0) { const char* a = kb[d0 & 3] + (d0 >> 2) * 128;
            g = __builtin_amdgcn_mfma_f32_32x32x16_bf16(*reinterpret_cast<const bf16x8*>(a), qr[d0], g, 0, 0, 0);
            g = __builtin_amdgcn_mfma_f32_32x32x16_bf16(*reinterpret_cast<const bf16x8*>(a + SHM_K), qr[d0], g, 0, 0, 0); } }
    const float NINF = -__builtin_inff();
    float v1 = NINF, v2 = NINF, v3 = NINF; int i1 = 64, i2 = 65, i3 = 66;
    const int ownl = qb - 4 * hi;
#pragma unroll
    for (int r = 0; r < 16; ++r) {
        const int idx = (r & 3) + 8 * (r >> 2); const float val = (idx < ownl) ? g[r] : NINF;
        const bool c1 = val > v1, c2 = val > v2, c3 = val > v3;
        v3 = c2 ? v2 : (c3 ? val : v3); i3 = c2 ? i2 : (c3 ? idx : i3);
        v2 = c1 ? v1 : (c2 ? val : v2); i2 = c1 ? i1 : (c2 ? idx : i2);
        v1 = c1 ? val : v1;             i1 = c1 ? idx : i1;
    }
    i1 += 4 * hi; i2 += 4 * hi; i3 += 4 * hi;
    float pv_[3]; int pi_[3];
    pv_[0] = __shfl_xor(v1, 32); pv_[1] = __shfl_xor(v2, 32); pv_[2] = __shfl_xor(v3, 32);
    pi_[0] = __shfl_xor(i1, 32); pi_[1] = __shfl_xor(i2, 32); pi_[2] = __shfl_xor(i3, 32);
#pragma unroll
    for (int c = 0; c < 3; ++c) {
        const float val = pv_[c]; const int idx = pi_[c];
        const bool c1 = (val > v1) || (val == v1 && idx < i1), c2 = (val > v2) || (val == v2 && idx < i2), c3 = (val > v3) || (val == v3 && idx < i3);
        v3 = c2 ? v2 : (c3 ? val : v3); i3 = c2 ? i2 : (c3 ? idx : i3);
        v2 = c1 ? v1 : (c2 ? val : v2); i2 = c1 ? i1 : (c2 ? idx : i2);
        v1 = c1 ? val : v1;             i1 = c1 ? idx : i1;
    }
    const int s = qb * 256 + wid * 32 + r32;
    int rk1 = 0, rk2 = 0, rk3 = 0;
    if (hi == 0) {
        SB.selinfo[(size_t)bh * NS + s] = (unsigned)(i1 < 32 ? i1 : 255) | ((unsigned)(i2 < 32 ? i2 : 255) << 8) | ((unsigned)(i3 < 32 ? i3 : 255) << 16);
        if (i1 < 32) rk1 = __hip_atomic_fetch_add(hist + i1, 1, __ATOMIC_RELAXED, __HIP_MEMORY_SCOPE_WORKGROUP);
        if (i2 < 32) rk2 = __hip_atomic_fetch_add(hist + i2, 1, __ATOMIC_RELAXED, __HIP_MEMORY_SCOPE_WORKGROUP);
        if (i3 < 32) rk3 = __hip_atomic_fetch_add(hist + i3, 1, __ATOMIC_RELAXED, __HIP_MEMORY_SCOPE_WORKGROUP);
    }
    __syncthreads();
    if (tid < 32) { const int c = hist[tid]; base[tid] = c > 0 ? (int)__hip_atomic_fetch_add(SB.lcnt + bh * 32 + tid, (unsigned)c, __ATOMIC_RELAXED, __HIP_MEMORY_SCOPE_AGENT) : 0; }
    __syncthreads();
    if (hi == 0) {
        unsigned short* lb = SB.lists + (size_t)bh * LCAP;
        if (i1 < 32) lb[loff(i1) + base[i1] + rk1] = (unsigned short)(s | (0 << 13));
        if (i2 < 32) lb[loff(i2) + base[i2] + rk2] = (unsigned short)(s | (1 << 13));
        if (i3 < 32) lb[loff(i3) + base[i3] + rk3] = (unsigned short)(s | (2 << 13));
    }
    __syncthreads();
}
}
__device__ __forceinline__ int pair_lo(int p) { return p < 3 ? 0 : (p < 5 ? 1 : 2); }
__device__ __forceinline__ int pair_hi(int p) { return p < 3 ? p + 1 : (p < 5 ? p - 1 : 3); }
constexpr int LDS_TB = LDS_MISC + 64;

__device__ __forceinline__ void p_route(const Args& a, LAS unsigned char* lds, int layer, const bf16_t* h, int vcu, int G) {
    int tid = threadIdx.x; asm volatile("" : "+v"(tid));
    const int lane = tid & 63, wave = __builtin_amdgcn_readfirstlane(tid >> 6), i32 = lane & 31, kk = lane >> 5;
    unsigned char* ws = a.ws;
    LAS float* wl = (LAS float*)lds;
    {   const float* wrt = (const float*)(ws + WS_WRT) + (size_t)layer * 20480;
        for (int i = tid; i < 20480; i += NTHR) { const int k = i / 20, c = i % 20; wl[c * 1024 + k] = wrt[i]; } }
    __syncthreads();
    float* tokw = (float*)(ws + WS_TOKW); int* list = (int*)(ws + WS_LIST);
    unsigned* cnt = (unsigned*)(ws + WS_CTL) + CW_CNT + layer * 24 * 16;
    const int gw = vcu * NWAVES + wave, NGW = G * NWAVES;
    const int lrow = i32 < 4 ? i32 : (i32 < 8 ? 12 + i32 : ((i32 & 4) ? -1 : ((i32 >> 3) == 1 ? i32 - 4 : ((i32 >> 3) == 2 ? i32 - 8 : i32 - 12))));
    const LAS float* wrow = wl + (lrow < 0 ? 0 : lrow) * 1024 + 8 * kk;
    const float wmask = lrow < 0 ? 0.f : 1.f;
    for (int task = gw; task < NT / 32; task += NGW) {
        const int t = task * 32 + i32;
        const bf16_t* hrow = h + (size_t)t * 1024 + 8 * kk;
        f32x16 c = f32x16{}; float ssp = 0.f;
#pragma unroll 4
        for (int it = 0; it < 64; ++it) {
            f32x4 h0, h1; unpack8(*(const u32x4*)(hrow + 16 * it), h0, h1);
            const f32x4 w0 = *(const LAS f32x4*)(wrow + 16 * it) * wmask, w1 = *(const LAS f32x4*)(wrow + 16 * it + 4) * wmask;
            ssp += dot4(h0) + dot4(h1);
#pragma unroll
            for (int e = 0; e < 4; ++e) c = __builtin_amdgcn_mfma_f32_32x32x2f32(w0[e], h0[e], c, 0, 0, 0);
#pragma unroll
            for (int e = 0; e < 4; ++e) c = __builtin_amdgcn_mfma_f32_32x32x2f32(w1[e], h1[e], c, 0, 0, 0);
        }
        const float ss = ssp + __shfl_xor(ssp, 32);
        float ex[4];
#pragma unroll
        for (int e = 0; e < 4; ++e) ex[e] = __shfl_xor(c[e], 32);
        const float rs = rsqrtf(ss * (1.0f / 1024.0f) + EPS);
        float lg[20];
#pragma unroll
        for (int e = 0; e < 16; ++e) lg[e] = c[e] * rs;
#pragma unroll
        for (int e = 0; e < 4; ++e) lg[16 + e] = ex[e] * rs;
        int gs = 0; float gm = lg[0];
#pragma unroll
        for (int i = 1; i < 4; ++i) if (lg[i] > gm) { gm = lg[i]; gs = i; }
        float den = 0.f;
#pragma unroll
        for (int i = 0; i < 4; ++i) den += __expf(lg[i] - gm);
        const float gwt = 1.0f / den;
        float ein[4];
#pragma unroll
        for (int i = 0; i < 4; ++i) ein[i] = gs == 0 ? lg[4 + i] : (gs == 1 ? lg[8 + i] : (gs == 2 ? lg[12 + i] : lg[16 + i]));
        int i1 = 0; float e1 = ein[0];
#pragma unroll
        for (int i = 1; i < 4; ++i) if (ein[i] > e1) { e1 = ein[i]; i1 = i; }
        int i2 = -1; float e2 = 0.f;
#pragma unroll
        for (int i = 0; i < 4; ++i) if (i != i1 && (i2 < 0 || ein[i] > e2)) { e2 = ein[i]; i2 = i; }
        const float x2 = __expf(e2 - e1), w1 = gwt / (1.0f + x2), w2 = gwt * x2 / (1.0f + x2);
        const int lo = i1 < i2 ? i1 : i2, hi = i1 < i2 ? i2 : i1;
        const int pidx = lo == 0 ? hi - 1 : (lo == 1 ? hi + 1 : 5);
        const int bucket = gs * 6 + pidx;
        if (kk == 0) {
            f32x2_t wv2 = {(i1 == lo) ? w1 : w2, (i1 == lo) ? w2 : w1};
            *(f32x2_t*)(tokw + (size_t)t * 2) = wv2;
            const unsigned pos = __hip_atomic_fetch_add(cnt + bucket * 16, 1u, __ATOMIC_RELAXED, __HIP_MEMORY_SCOPE_AGENT);
            list[(size_t)bucket * NT + pos] = t;
        }
    }
    {   const float* p = a.in[1] + (size_t)layer * NT * 256; bf16_t* pb = (bf16_t*)(ws + WS_PB);
        const int gt = vcu * NTHR + tid, NGT = G * NTHR;
        for (int i = gt; i < NT * 256 / 8; i += NGT) { const f32x4 x0 = *(const f32x4*)(p + (size_t)i * 8), x1 = *(const f32x4*)(p + (size_t)i * 8 + 4); *(u32x4*)(pb + (size_t)i * 8) = pack8(x0, x1); } }
    __syncthreads();
}

__device__ __forceinline__ int moe_prefix(const Args& a, LAS unsigned char* lds, int layer) {
    LAS int* tb = (LAS int*)(lds + LDS_TB);
    if (threadIdx.x == 0) { const unsigned* cnt = (const unsigned*)(a.ws + WS_CTL) + CW_CNT + layer * 24 * 16; int s = 0;
        for (int b = 0; b < 24; ++b) { tb[b] = s; s += (int)((__hip_atomic_load(cnt + b * 16, __ATOMIC_RELAXED, __HIP_MEMORY_SCOPE_AGENT) + 255u) >> 8); }
        tb[24] = s; }
    __syncthreads();
    return __builtin_amdgcn_readfirstlane(tb[24]);
}
struct MoeUnits {
    LAS const int* tb; int NRT, G, c;
    __device__ __forceinline__ bool next(int i, Unit& u) const {
        const int L = i * G + c, rt = L >> 2; if (rt >= NRT) return false;
        int b = 0;
        for (int q = 1; q < 24; ++q) b = (tb[q] <= rt) ? q : b;
        u.pm = rt; u.pn = L & 3; u.aux = __builtin_amdgcn_readfirstlane(b); return true;
    }
};
struct MoeGuP {
    const char* A; const char* W; const int* list; const unsigned* cnt; MoeUnits U; int ldb, K;
    __device__ __forceinline__ bool next(int i, Unit& u) const { return U.next(i, u); }
    __device__ __forceinline__ void aoff(const Unit& u, const int (&R)[2], const int (&C)[2], g8::AOff& o) const {
        const int n = (int)cnt[u.aux * 16], p0 = (u.pm - __builtin_amdgcn_readfirstlane(U.tb[u.aux])) * 256;
#pragma unroll
        for (int h = 0; h < 2; ++h)
#pragma unroll
            for (int i = 0; i < 2; ++i) { int pos = p0 + h * 128 + R[i]; pos = pos < n ? pos : n - 1; const int tok = list[(size_t)u.aux * NT + pos]; o.o[h][i] = (unsigned)((tok * 1024 + C[i]) * 2); }
    }
    __device__ __forceinline__ const char* bbase(const Unit& u, int kt) const {
        const int g = u.aux / 6, pi = u.aux % 6, e = g * 4 + ((u.pn < 2) ? pair_lo(pi) : pair_hi(pi));
        return W + ((size_t)(e * 512 + (u.pn & 1) * 256) * 1024 + (size_t)kt * 64) * 2;
    }
};
struct MoeDownP {
    const char* A; const char* W; MoeUnits U; int ldb, K;
    __device__ __forceinline__ bool next(int i, Unit& u) const { return U.next(i, u); }
    __device__ __forceinline__ void aoff(const Unit& u, const int (&R)[2], const int (&C)[2], g8::AOff& o) const {
#pragma unroll
        for (int h = 0; h < 2; ++h)
#pragma unroll
            for (int i = 0; i < 2; ++i) o.o[h][i] = (unsigned)(((u.pm * 256 + h * 128 + R[i]) * 512 + C[i]) * 2);
    }
    __device__ __forceinline__ const char* bbase(const Unit& u, int kt) const {
        const int g = u.aux / 6, pi = u.aux % 6, e = g * 4 + ((kt < 4) ? pair_lo(pi) : pair_hi(pi));
        return W + ((size_t)(e * 1024 + u.pn * 256) * 256 + (size_t)(kt & 3) * 64) * 2;
    }
};
__device__ __forceinline__ float sigmoidf_fast(float x) { return __builtin_amdgcn_rcpf(1.0f + __builtin_amdgcn_exp2f(-1.4426950408889634f * x)); }

struct EpiGateUp {
    const float* hp; const float* tokw; const int* list; const unsigned* cnt; LAS const int* tb; bf16_t* act;
    __device__ __forceinline__ void operator()(const f32x4 (&acc)[2][2][4][2], const Unit& u, int wr, int wc, int fr, int fq) const {
        const int n = (int)cnt[u.aux * 16], p0 = (u.pm - __builtin_amdgcn_readfirstlane(tb[u.aux])) * 256, half = u.pn >> 1;
#pragma unroll
        for (int ai = 0; ai < 2; ++ai)
#pragma unroll
            for (int m = 0; m < 4; ++m) {
                const int r = 128 * ai + 64 * wr + 16 * m + fr; int pos = p0 + r; pos = pos < n ? pos : n - 1;
                const int tok = list[(size_t)u.aux * NT + pos];
                const float rs = row_rs<16>(hp + (size_t)tok * 16, 1.0f / 1024.0f), w = tokw[(size_t)tok * 2 + half];
                f32x4 o[2];
#pragma unroll
                for (int nn = 0; nn < 2; ++nn)
#pragma unroll
                    for (int e = 0; e < 4; ++e) { const float g = acc[ai][0][m][nn][e] * rs, up = acc[ai][1][m][nn][e] * rs; o[nn][e] = g * sigmoidf_fast(g) * up * w; }
                *(u32x4*)(act + (size_t)(u.pm * 256 + r) * 512 + half * 256 + (u.pn & 1) * 128 + 32 * wc + 8 * fq) = pack8(o[0], o[1]);
            }
    }
};
struct EpiDown {
    bf16_t* hb; float* hp; const int* list; const unsigned* cnt; LAS const int* tb;
    __device__ __forceinline__ void operator()(const f32x4 (&acc)[2][2][4][2], const Unit& u, int wr, int wc, int fr, int fq) const {
        const int n = (int)cnt[u.aux * 16], p0 = (u.pm - __builtin_amdgcn_readfirstlane(tb[u.aux])) * 256;
#pragma unroll
        for (int ai = 0; ai < 2; ++ai)
#pragma unroll
            for (int m = 0; m < 4; ++m) {
                const int r = 128 * ai + 64 * wr + 16 * m + fr, pos = p0 + r; const bool valid = pos < n;
                const int tok = list[(size_t)u.aux * NT + (valid ? pos : n - 1)];
                float ss = 0.f;
#pragma unroll
                for (int bj = 0; bj < 2; ++bj) {
                    const size_t off = (size_t)tok * 1024 + u.pn * 256 + 128 * bj + 32 * wc + 8 * fq;
                    f32x4 b0, b1; unpack8(*(const u32x4*)(hb + off), b0, b1);
                    const f32x4 v0 = acc[ai][bj][m][0] + b0, v1 = acc[ai][bj][m][1] + b1;
                    if (valid) *(u32x4*)(hb + off) = pack8(v0, v1);
                    ss += dot4(v0) + dot4(v1);
                }
                ss += __shfl_xor(ss, 16); ss += __shfl_xor(ss, 32);
                if (fq == 0 && valid) hp[(size_t)tok * 16 + u.pn * 4 + wc] = ss;
                if (m & 1) asm volatile("" ::: "memory");
            }
    }
};
struct EpiStore {
    bf16_t* O; int ldc;
    __device__ __forceinline__ void operator()(const f32x4 (&acc)[2][2][4][2], const Unit& u, int wr, int wc, int fr, int fq) const {
#pragma unroll
        for (int ai = 0; ai < 2; ++ai)
#pragma unroll
            for (int m = 0; m < 4; ++m) { const int row = u.pm * 256 + 128 * ai + 64 * wr + 16 * m + fr;
#pragma unroll
                for (int bj = 0; bj < 2; ++bj) *(u32x4*)(O + (size_t)row * ldc + u.pn * 256 + 128 * bj + 32 * wc + 8 * fq) = pack8(acc[ai][bj][m][0], acc[ai][bj][m][1]); }
    }
};
struct EpiPle {
    const float* hpin; const bf16_t* pp; const bf16_t* hbi; bf16_t* hbo; float* hp;
    __device__ __forceinline__ void operator()(const f32x4 (&acc)[2][2][4][2], const Unit& u, int wr, int wc, int fr, int fq) const {
#pragma unroll
        for (int ai = 0; ai < 2; ++ai)
#pragma unroll
            for (int m = 0; m < 4; ++m) {
                const int row = u.pm * 256 + 128 * ai + 64 * wr + 16 * m + fr;
                const float rs = row_rs<16>(hpin + (size_t)row * 16, 1.0f / 1024.0f);
                float ss = 0.f;
#pragma unroll
                for (int bj = 0; bj < 2; ++bj) {
                    const size_t off = (size_t)row * 1024 + u.pn * 256 + 128 * bj + 32 * wc + 8 * fq;
                    f32x4 p0, p1, v0, v1; unpack8(*(const u32x4*)(pp + off), p0, p1); unpack8(*(const u32x4*)(hbi + off), v0, v1);
#pragma unroll
                    for (int e = 0; e < 4; ++e) { v0[e] += sigmoidf_fast(acc[ai][bj][m][0][e] * rs) * p0[e]; v1[e] += sigmoidf_fast(acc[ai][bj][m][1][e] * rs) * p1[e]; }
                    *(u32x4*)(hbo + off) = pack8(v0, v1);
                    ss += dot4(v0) + dot4(v1);
                }
                ss += __shfl_xor(ss, 16); ss += __shfl_xor(ss, 32);
                if (fq == 0) hp[(size_t)row * 16 + u.pn * 4 + wc] = ss;
                if (m & 1) asm volatile("" ::: "memory");
            }
    }
};
__device__ __forceinline__ u32x2 pack4(f32x4 a) { u32x2 w = {cvtpk(a[0], a[1]), cvtpk(a[2], a[3])}; return w; }
struct EpiDqkv {
    const float* hp; const float* cosB; const float* sinB; bf16_t* cq; bf16_t* ckv; bf16_t* krope; float* cqp; float* kvp;
    __device__ __forceinline__ void operator()(const f32x4 (&acc)[2][2][4][2], const Unit& u, int wr, int wc, int fr, int fq) const {
#pragma unroll
        for (int ai = 0; ai < 2; ++ai)
#pragma unroll
            for (int m = 0; m < 4; ++m) {
                const int row = u.pm * 256 + 128 * ai + 64 * wr + 16 * m + fr, s = row & (NS - 1);
                const float rs = row_rs<16>(hp + (size_t)row * 16, 1.0f / 1024.0f);
                if (u.pn < 2) {
                    float ss = 0.f;
#pragma unroll
                    for (int bj = 0; bj < 2; ++bj) { const f32x4 v0 = acc[ai][bj][m][0] * rs, v1 = acc[ai][bj][m][1] * rs; ss += dot4(v0) + dot4(v1);
                        const int c = 128 * bj + 32 * wc + 8 * fq;
                        if (u.pn == 0) *(u32x4*)(cq + (size_t)row * 384 + c) = pack8(v0, v1); else *(u32x4*)(ckv + (size_t)row * 256 + c) = pack8(v0, v1); }
                    ss += __shfl_xor(ss, 16); ss += __shfl_xor(ss, 32);
                    if (fq == 0) { if (u.pn == 0) cqp[(size_t)row * 8 + wc] = ss; else kvp[(size_t)row * 4 + wc] = ss; }
                } else {
                    const f32x4 v0 = acc[ai][0][m][0] * rs, v1 = acc[ai][0][m][1] * rs;
                    float ss = dot4(v0) + dot4(v1);
                    *(u32x4*)(cq + (size_t)row * 384 + 256 + 32 * wc + 8 * fq) = pack8(v0, v1);
                    ss += __shfl_xor(ss, 16); ss += __shfl_xor(ss, 32);
                    if (fq == 0) cqp[(size_t)row * 8 + 4 + wc] = ss;
                    if (wc < 2) {
                        const int j = 16 * wc + 4 * fq;
                        const f32x4 cs = *(const f32x4*)(cosB + (size_t)s * 32 + j), sn = *(const f32x4*)(sinB + (size_t)s * 32 + j);
                        const f32x4 x1 = acc[ai][1][m][0] * rs, x2 = acc[ai][1][m][1] * rs;
                        *(u32x2*)(krope + (size_t)row * 64 + j) = pack4(x1 * cs - x2 * sn);
                        *(u32x2*)(krope + (size_t)row * 64 + 32 + j) = pack4(x1 * sn + x2 * cs);
                    }
                }
            }
    }
};
struct EpiUq {
    const float* cqp; const float* cosB; const float* sinB; bf16_t* q;
    __device__ __forceinline__ void operator()(const f32x4 (&acc)[2][2][4][2], const Unit& u, int wr, int wc, int fr, int fq) const {
        const int bb = u.pm >> 5;
#pragma unroll
        for (int ai = 0; ai < 2; ++ai)
#pragma unroll
            for (int m = 0; m < 4; ++m) {
                const int row = u.pm * 256 + 128 * ai + 64 * wr + 16 * m + fr, s = row & (NS - 1);
                const float rs = row_rs<8>(cqp + (size_t)row * 8, 1.0f / 384.0f);
#pragma unroll
                for (int bj = 0; bj < 2; ++bj) {
                    if (u.pn < 4) {
                        const int hh = 2 * u.pn + bj;
                        *(u32x4*)(q + ((size_t)(bb * NH + hh) * NS + s) * 192 + 32 * wc + 8 * fq) = pack8(acc[ai][bj][m][0] * rs, acc[ai][bj][m][1] * rs);
                    } else {
                        const int gidx = bj * 4 + wc, hh = 4 * (u.pn - 4) + (gidx >> 1), j = 16 * (gidx & 1) + 4 * fq;
                        const f32x4 cs = *(const f32x4*)(cosB + (size_t)s * 32 + j), sn = *(const f32x4*)(sinB + (size_t)s * 32 + j);
                        const f32x4 x1 = acc[ai][bj][m][0] * rs, x2 = acc[ai][bj][m][1] * rs;
                        bf16_t* d = q + ((size_t)(bb * NH + hh) * NS + s) * 192 + 128 + j;
                        *(u32x2*)d = pack4(x1 * cs - x2 * sn); *(u32x2*)(d + 32) = pack4(x1 * sn + x2 * cs);
                    }
                }
            }
    }
};
struct EpiUkv {
    const float* kvp; bf16_t* kn; bf16_t* v;
    __device__ __forceinline__ void operator()(const f32x4 (&acc)[2][2][4][2], const Unit& u, int wr, int wc, int fr, int fq) const {
        const int bb = u.pm >> 5;
#pragma unroll
        for (int ai = 0; ai < 2; ++ai)
#pragma unroll
            for (int m = 0; m < 4; ++m) {
                const int row = u.pm * 256 + 128 * ai + 64 * wr + 16 * m + fr, s = row & (NS - 1);
                const float rs = row_rs<4>(kvp + (size_t)row * 4, 1.0f / 256.0f);
                const size_t o = ((size_t)(bb * NH + u.pn) * NS + s) * 128 + 32 * wc + 8 * fq;
                *(u32x4*)(kn + o) = pack8(acc[ai][0][m][0] * rs, acc[ai][0][m][1] * rs);
                *(u32x4*)(v + o) = pack8(acc[ai][1][m][0] * rs, acc[ai][1][m][1] * rs);
            }
    }
};

struct WConv { const float* src0; const float* src1; const float* gain; bf16_t* dst; int N0, N1, K, Nout, kind; };
__device__ __forceinline__ int colmap(int kind, int n) {
    switch (kind) {
    case 1: {
        const int pn = n >> 8; if (pn >= 8) return n;
        const int t = pn >> 2, bj = (n >> 7) & 1, r = n & 127, hh = 2 * (pn & 3) + (r >> 6), d = 64 * bj + (r & 63);
        return t * 1024 + hh * 128 + d; }
    case 2: {
        if (n < 256) return n;
        if (n < 512) return 384 + (n - 256);
        if (n < 640) return 256 + (n - 512);
        const int r = n - 640, wc = r >> 5, fq = (r >> 3) & 3, nn = (r >> 2) & 1, i = r & 3;
        if (wc >= 2) return -1;
        return 384 + 256 + 32 * nn + 16 * wc + 4 * fq + i; }
    case 3: {
        if (n < 1024) return (n >> 7) * 192 + (n & 127);
        const int m = n - 1024, pn4 = m >> 8, gidx = (m >> 5) & 7, fq = (m >> 3) & 3, nn = (m >> 2) & 1, i = m & 3;
        const int hh = 4 * pn4 + (gidx >> 1), j = 16 * (gidx & 1) + 4 * fq + i;
        return hh * 192 + 128 + 32 * nn + j; }
    case 4: {
        const int q = n >> 8, bj = (n >> 7) & 1, r = n & 127;
        return bj * 256 + 128 * q + r; }
    default: return n;
    }
}
__device__ __forceinline__ void conv_item(const WConv& w, LAS float* scr, int item, int lane) {
    const int nblk = w.Nout / 32, kb = item / nblk, nb = item % nblk, k0 = 64 * kb, n0 = 32 * nb;
    const int n4 = lane & 7, ks = lane >> 3;
    const int s = colmap(w.kind, n0 + 4 * n4);
    const bool z = s < 0, first = s < w.N0;
    const float* sp = first ? w.src0 + s : w.src1 + (s - w.N0);
    const int ld = first ? w.N0 : w.N1;
    f32x4 v[8];
#pragma unroll
    for (int it = 0; it < 8; ++it) { const int k = it * 8 + ks; v[it] = z ? (f32x4){0.f, 0.f, 0.f, 0.f} : *(const f32x4*)(sp + (size_t)(k0 + k) * ld); }
#pragma unroll
    for (int it = 0; it < 8; ++it) { const int k = it * 8 + ks; const float g = w.gain ? w.gain[k0 + k] : 1.0f;
#pragma unroll
        for (int e = 0; e < 4; ++e) scr[k * 33 + 4 * n4 + e] = v[it][e] * g; }
    asm volatile("s_waitcnt lgkmcnt(0)" ::: "memory");
    const int c = lane & 7;
#pragma unroll
    for (int j = 0; j < 4; ++j) { const int n = (lane >> 3) + 8 * j; const LAS float* sv = scr + (8 * c) * 33 + n;
        u32x4 o; o.x = cvtpk(sv[0 * 33], sv[1 * 33]); o.y = cvtpk(sv[2 * 33], sv[3 * 33]); o.z = cvtpk(sv[4 * 33], sv[5 * 33]); o.w = cvtpk(sv[6 * 33], sv[7 * 33]);
        *(u32x4*)(w.dst + (size_t)(n0 + n) * w.K + k0 + 8 * c) = o; }
    asm volatile("s_waitcnt lgkmcnt(0)" ::: "memory");
}
__device__ __forceinline__ bool get_conv(int mi, const Args& a, WConv& w) {
    unsigned char* ws = a.ws;
    w.src1 = nullptr; w.N1 = 0; w.gain = nullptr; w.kind = 0;
    if (mi == 0) { w.src0 = a.in[6]; w.N0 = 3072; w.K = 1024; w.Nout = 3072; w.kind = 1; w.gain = a.in[2]; w.dst = (bf16_t*)(ws + WS_WQKV0); return true; }
    if (mi == 1) { w.src0 = a.in[7]; w.N0 = 1024; w.K = 1024; w.Nout = 1024; w.dst = (bf16_t*)(ws + WS_WO0); return true; }
    if (mi == 2) { w.src0 = a.in[8]; w.N0 = 384; w.src1 = a.in[11]; w.N1 = 320; w.K = 1024; w.Nout = 768; w.kind = 2; w.gain = a.in[2] + 1024; w.dst = (bf16_t*)(ws + WS_WDQKV); return true; }
    if (mi == 3) { w.src0 = a.in[10]; w.N0 = 1536; w.K = 384; w.Nout = 1536; w.kind = 3; w.gain = a.in[9]; w.dst = (bf16_t*)(ws + WS_WUQ); return true; }
    if (mi == 4) { w.src0 = a.in[13]; w.N0 = 2048; w.K = 256; w.Nout = 2048; w.gain = a.in[12]; w.dst = (bf16_t*)(ws + WS_WUKV); return true; }
    if (mi == 5) { w.src0 = a.in[14]; w.N0 = 1024; w.K = 1024; w.Nout = 1024; w.dst = (bf16_t*)(ws + WS_WO1); return true; }
    if (mi < 38) { const int le = mi - 6, l = le >> 4;
        w.src0 = a.in[17] + (size_t)le * 1024 * 256; w.N0 = 256; w.src1 = a.in[18] + (size_t)le * 1024 * 256; w.N1 = 256; w.K = 1024; w.Nout = 512; w.kind = 4;
        w.gain = a.in[3] + l * 1024; w.dst = (bf16_t*)(ws + WS_WGU) + (size_t)le * 512 * 1024; return true; }
    if (mi < 70) { const int le = mi - 38;
        w.src0 = a.in[19] + (size_t)le * 256 * 1024; w.N0 = 1024; w.K = 256; w.Nout = 1024; w.dst = (bf16_t*)(ws + WS_WD) + (size_t)le * 1024 * 256; return true; }
    if (mi < 72) { const int l = mi - 70;
        w.src0 = a.in[20] + (size_t)l * 1024 * 1024; w.N0 = 1024; w.K = 1024; w.Nout = 1024; w.gain = a.in[4] + l * 1024; w.dst = (bf16_t*)(ws + WS_WPG) + (size_t)l * 1024 * 1024; return true; }
    if (mi < 74) { const int l = mi - 72;
        w.src0 = a.in[21] + (size_t)l * 256 * 1024; w.N0 = 1024; w.K = 256; w.Nout = 1024; w.dst = (bf16_t*)(ws + WS_WPP) + (size_t)l * 1024 * 256; return true; }
    return false;
}

__device__ __forceinline__ void p_prologue(const Args& a, LAS unsigned char* lds, int vcu, int G) {
    int tid = threadIdx.x; asm volatile("" : "+v"(tid));
    const int lane = tid & 63, wave = __builtin_amdgcn_readfirstlane(tid >> 6);
    const int gw = vcu * NWAVES + wave, NGW = G * NWAVES;
    unsigned char* ws = a.ws;
    LAS float* scr = (LAS float*)(lds + wave * 16384);
    int base = 0;
    for (int mi = 0; mi < 74; ++mi) {
        WConv w; get_conv(mi, a, w);
        const int n = (w.K / 64) * (w.Nout / 32);
        int it = (gw - (base % NGW) + NGW) % NGW;
        for (; it < n; it += NGW) conv_item(w, scr, it, lane);
        base += n;
    }
    {   const float* x = a.in[0]; bf16_t* hb = (bf16_t*)(ws + WS_HB); float* hpx = (float*)(ws + WS_HPX);
        for (int m = gw; m < NT; m += 2 * NGW) {
            const int m2 = (m + NGW < NT) ? m + NGW : m;
            const f32x4* xr = (const f32x4*)(x + (size_t)m * 1024) + lane; const f32x4* xr2 = (const f32x4*)(x + (size_t)m2 * 1024) + lane;
            f32x4 v[4], v2[4]; float s = 0.f, s2 = 0.f;
#pragma unroll
            for (int j = 0; j < 4; ++j) { v[j] = xr[64 * j]; v2[j] = xr2[64 * j]; }
#pragma unroll
            for (int j = 0; j < 4; ++j) { s += dot4(v[j]); s2 += dot4(v2[j]); }
            s = wave_sum(s); s2 = wave_sum(s2);
            u32x2* o8 = (u32x2*)(hb + (size_t)m * 1024) + lane; u32x2* o82 = (u32x2*)(hb + (size_t)m2 * 1024) + lane;
#pragma unroll
            for (int j = 0; j < 4; ++j) { u32x2 o; o.x = cvtpk(v[j][0], v[j][1]); o.y = cvtpk(v[j][2], v[j][3]); o8[64 * j] = o;
                                          u32x2 o2; o2.x = cvtpk(v2[j][0], v2[j][1]); o2.y = cvtpk(v2[j][2], v2[j][3]); o82[64 * j] = o2; }
            if (lane < 16) { hpx[(size_t)m * 16 + lane] = (lane == 0) ? s : 0.f; hpx[(size_t)m2 * 16 + lane] = (lane == 0) ? s2 : 0.f; }
        } }
    {   const int gt = (vcu * NTHR) + tid, NGT = G * NTHR;
        float* cosA = (float*)(ws + WS_COSA); float* sinA = (float*)(ws + WS_SINA); float* cosB = (float*)(ws + WS_COSB); float* sinB = (float*)(ws + WS_SINB);
        for (int i = gt; i < NS * 64; i += NGT) { const int s = i >> 6, j = i & 63; const float inv = powf(10000.0f, -(float)j / 64.0f); float sn, cs; sincosf((float)s * inv, &sn, &cs); cosA[i] = cs; sinA[i] = sn; }
        for (int i = gt; i < NS * 32; i += NGT) { const int s = i >> 5, j = i & 31; const float inv = powf(10000.0f, -(float)j / 32.0f); float sn, cs; sincosf((float)s * inv, &sn, &cs); cosB[i] = cs; sinB[i] = sn; }
        float* km = (float*)(ws + WS_KMEAN);
        for (int i = gt; i < NB * NH * 32 * 128; i += NGT) km[i] = 0.f;
        float* wrt = (float*)(ws + WS_WRT);
        for (int i = gt; i < 2 * 1024 * 20; i += NGT) { const int l = i / 20480, r = i % 20480, k = r / 20, c = r % 20;
            const float g = a.in[3][l * 1024 + k];
            wrt[i] = g * (c < 4 ? a.in[15][(size_t)(l * 1024 + k) * 4 + c] : a.in[16][(size_t)(l * 1024 + k) * 16 + (c - 4)]); }
    }
}

__device__ __forceinline__ at::SparseBufs sparse_bufs(const Args& a) {
    unsigned char* ws = a.ws;
    at::SparseBufs SB;
    SB.lists = (unsigned short*)(ws + WS_R + 200 * MiB); SB.lcnt = (unsigned*)(ws + WS_CTL) + CW_LCNT; SB.selinfo = (unsigned*)(ws + WS_R + 210 * MiB);
    SB.ml = (float*)(ws + WS_R + 192 * MiB); SB.part01 = (unsigned char*)a.out; SB.part2 = ws + WS_PART2;
    return SB;
}
__device__ __forceinline__ void p_attention_mla(const Args& a, unsigned char* ldsg) {
    unsigned char* ws = a.ws;
    const at::SparseBufs SB = sparse_bufs(a);
    for (int L = blockIdx.x; L < 512; L += gridDim.x) {
        const int xcd = L & 7, k = L >> 3, bh = xcd + 8 * (k >> 4), x = k & 15, b = bh >> 3, h = bh & 7;
        for (int pass = 0; pass < 2; ++pass) {
            const int qb = pass ? x : 31 - x, P0 = qb * 256;
            at::AttnP A;
            A.Qp = (const bf16_t*)(ws + WS_Q) + ((size_t)bh * NS + P0) * 192; A.Kn = (const bf16_t*)(ws + WS_KN1) + (size_t)bh * NS * 128;
            A.Kr = (const bf16_t*)(ws + WS_KROPE) + (size_t)b * NS * 64; A.Vp = (const bf16_t*)(ws + WS_V1) + (size_t)bh * NS * 128;
            A.Op = (bf16_t*)(ws + WS_O) + ((size_t)(b * NS + P0) * 1024 + h * 128); A.P0 = P0; A.t0 = 0; A.NT = (P0 + 256) / 64; A.bh = bh; A.nent = 0; A.ents = nullptr;
            at::attn_unit<192, 0>((char*)ldsg, A, SB);
        }
    }
}
__device__ __forceinline__ void p_moba_gate(const Args& a, unsigned char* ldsg) {
    unsigned char* ws = a.ws;
    const at::SparseBufs SB = sparse_bufs(a);
    for (int L = blockIdx.x; L < 1024; L += gridDim.x) {
        const int bh = L >> 5, qb = L & 31;
        at::gate_unit((char*)ldsg, (const bf16_t*)(ws + WS_Q) + ((size_t)bh * NS + qb * 256) * 128, (const float*)(ws + WS_KMEAN) + (size_t)bh * 32 * 128, bh, qb, SB);
    }
}
constexpr int MOBA_PART = 512;
__device__ __forceinline__ void p_moba_gather(const Args& a, unsigned char* ldsg) {
    unsigned char* ws = a.ws;
    const at::SparseBufs SB = sparse_bufs(a);
    int tid = threadIdx.x; asm volatile("" : "+v"(tid));
    int* pre = (int*)(ldsg + 139264); int* seg = pre + 1032;
    if (tid < 32) { int s = 0; for (int j = 0; j < 32; ++j) s += (int)((SB.lcnt[tid * 32 + j] + (MOBA_PART - 1)) / MOBA_PART); seg[tid] = s; }
    __syncthreads();
    if (tid < 32) { int s = 0; for (int j = 0; j < tid; ++j) s += seg[j];
        for (int j = 0; j < 32; ++j) { pre[tid * 32 + j] = s; s += (int)((SB.lcnt[tid * 32 + j] + (MOBA_PART - 1)) / MOBA_PART); }
        if (tid == 31) pre[1024] = s; }
    __syncthreads();
    const int NU = __builtin_amdgcn_readfirstlane(pre[1024]);
    for (int u = blockIdx.x; u < NU; u += gridDim.x) {
        int lo = 0, hi = 1024;
        while (hi - lo > 1) { const int mid = (lo + hi) >> 1; if (pre[mid] <= u) lo = mid; else hi = mid; }
        const int li = __builtin_amdgcn_readfirstlane(lo), c = u - __builtin_amdgcn_readfirstlane(pre[lo]), bh = li >> 5, n = li & 31;
        const int cnt = (int)SB.lcnt[li], nrows = (cnt - MOBA_PART * c) < MOBA_PART ? (cnt - MOBA_PART * c) : MOBA_PART;
        at::moba_gather_unit((char*)ldsg, (const bf16_t*)(ws + WS_Q) + (size_t)bh * NS * 128, (const bf16_t*)(ws + WS_K0) + (size_t)bh * NS * 128, (const bf16_t*)(ws + WS_V0) + (size_t)bh * NS * 128,
                             bh, n, SB.lists + (size_t)bh * at::LCAP + at::loff(n) + MOBA_PART * c, nrows, SB);
    }
}
__device__ __forceinline__ void p_moba_own(const Args& a, unsigned char* ldsg) {
    unsigned char* ws = a.ws;
    const at::SparseBufs SB = sparse_bufs(a);
    for (int L = blockIdx.x; L < 1024; L += gridDim.x) {
        const int bh = L >> 5, qb = L & 31;
        at::moba_own_unit((char*)ldsg, (const bf16_t*)(ws + WS_Q) + (size_t)bh * NS * 128, (const bf16_t*)(ws + WS_K0) + (size_t)bh * NS * 128, (const bf16_t*)(ws + WS_V0) + (size_t)bh * NS * 128,
                          (bf16_t*)(ws + WS_O), bh, qb, SB);
    }
}

__global__ void __launch_bounds__(NTHR, 2) mega(Args a) {
    extern __shared__ __attribute__((aligned(16))) unsigned char lds_g[];
    LAS unsigned char* lds = (LAS unsigned char*)lds_g;
    const int tid = threadIdx.x;
    const int G = gridDim.x, bx = blockIdx.x, vcu = (G % 8 == 0) ? (bx % 8) * (G / 8) + bx / 8 : bx;
    unsigned char* ws = a.ws;
    volatile LAS unsigned* MISC = (volatile LAS unsigned*)(lds + LDS_MISC);
    for (int u = tid; u < 256; u += NTHR) MISC[u] = 0u;
    __syncthreads();
    XcdBarrier bar = xcd_barrier_post((unsigned*)(ws + WS_CTL) + CW_BAR, MISC);
    const int lo = a.ph_lo, hi = a.ph_hi;
#ifndef DBG_ONLY
#define DBG_EN(k) true
#else
#define DBG_EN(k) ((k) == DBG_ONLY)
#endif
#define IN(k) (DBG_EN(k) && lo <= (k) && (k) < hi)
#define SEAM(k) do { if (IN(k) && IN((k) + 1)) xcd_barrier(bar); } while (0)
    if (IN(0)) { p_prologue(a, lds, vcu, G); }
    SEAM(0);
    if (IN(1)) {
        g8::DenseP P{(const char*)(ws + WS_HB), (const char*)(ws + WS_WQKV0), 1024, 1024, 1024, NT / 256, 3072 / 256, G, bx};
        EpiQKV E{(const float*)(ws + WS_HPX), (const float*)(ws + WS_COSA), (const float*)(ws + WS_SINA), (bf16_t*)(ws + WS_Q), (bf16_t*)(ws + WS_K0), (bf16_t*)(ws + WS_V0), (float*)(ws + WS_KMEAN)};
        g8::gemm_phase(lds, P, E);
    }
    SEAM(1);
    if (IN(2)) { p_moba_gate(a, lds_g); }
    SEAM(2);
    if (IN(3)) { p_moba_gather(a, lds_g); }
    SEAM(3);
    if (IN(4)) { p_moba_own(a, lds_g); }
    SEAM(4);
    if (IN(5)) {
        g8::DenseP P{(const char*)(ws + WS_O), (const char*)(ws + WS_WO0), 1024, 1024, 1024, NT / 256, 4, G, bx};
        EpiResid E{(const bf16_t*)(ws + WS_HB), (bf16_t*)(ws + WS_HB), (float*)(ws + WS_HP0)};
        g8::gemm_phase(lds, P, E);
    }
    SEAM(5);
#define MOE_PLE(PB, layer, HBC, HBN) \
    if (IN((PB) + 0)) { p_route(a, lds, (layer), (const bf16_t*)(HBC), vcu, G); } \
    SEAM((PB) + 0); \
    if (IN((PB) + 1)) { \
        const int NRT = moe_prefix(a, lds, (layer)); \
        const unsigned* cnt = (const unsigned*)(ws + WS_CTL) + CW_CNT + (layer) * 24 * 16; \
        MoeUnits U{(LAS const int*)(lds + LDS_TB), NRT, G, bx}; \
        MoeGuP P{(const char*)(HBC), (const char*)(ws + WS_WGU) + (size_t)(layer) * 16 * 512 * 1024 * 2, (const int*)(ws + WS_LIST), cnt, U, 1024, 1024}; \
        EpiGateUp E{(const float*)(ws + WS_HP0), (const float*)(ws + WS_TOKW), (const int*)(ws + WS_LIST), cnt, (LAS const int*)(lds + LDS_TB), (bf16_t*)(ws + WS_ACT)}; \
        g8::gemm_phase(lds, P, E); \
        g8::DenseP P2{(const char*)(ws + WS_PB), (const char*)(ws + WS_WPP) + (size_t)(layer) * 1024 * 256 * 2, 256, 256, 256, NT / 256, 4, G, bx}; \
        EpiStore E2{(bf16_t*)(ws + WS_PP), 1024}; \
        g8::gemm_phase(lds, P2, E2); \
    } \
    SEAM((PB) + 1); \
    if (IN((PB) + 2)) { \
        const int NRT = moe_prefix(a, lds, (layer)); \
        const unsigned* cnt = (const unsigned*)(ws + WS_CTL) + CW_CNT + (layer) * 24 * 16; \
        MoeUnits U{(LAS const int*)(lds + LDS_TB), NRT, G, bx}; \
        MoeDownP P{(const char*)(ws + WS_ACT), (const char*)(ws + WS_WD) + (size_t)(layer) * 16 * 1024 * 256 * 2, U, 256, 512}; \
        EpiDown E{(bf16_t*)(HBC), (float*)(ws + WS_HP1), (const int*)(ws + WS_LIST), cnt, (LAS const int*)(lds + LDS_TB)}; \
        g8::gemm_phase(lds, P, E); \
    } \
    SEAM((PB) + 2); \
    if (IN((PB) + 3)) { \
        g8::DenseP P{(const char*)(HBC), (const char*)(ws + WS_WPG) + (size_t)(layer) * 1024 * 1024 * 2, 1024, 1024, 1024, NT / 256, 4, G, bx}; \
        EpiPle E{(const float*)(ws + WS_HP1), (const bf16_t*)(ws + WS_PP), (const bf16_t*)(HBC), (bf16_t*)(HBN), (float*)(ws + WS_HP2)}; \
        g8::gemm_phase(lds, P, E); \
    } \
    SEAM((PB) + 3);
    MOE_PLE(6, 0, ws + WS_HB, a.out)
    if (IN(10)) {
        g8::DenseP P{(const char*)a.out, (const char*)(ws + WS_WDQKV), 1024, 1024, 1024, NT / 256, 3, G, bx};
        EpiDqkv E{(const float*)(ws + WS_HP2), (const float*)(ws + WS_COSB), (const float*)(ws + WS_SINB), (bf16_t*)(ws + WS_CQ), (bf16_t*)(ws + WS_CKV), (bf16_t*)(ws + WS_KROPE), (float*)(ws + WS_CQP), (float*)(ws + WS_KVP)};
        g8::gemm_phase(lds, P, E);
    }
    SEAM(10);
    if (IN(11)) {
        g8::DenseP P{(const char*)(ws + WS_CQ), (const char*)(ws + WS_WUQ), 384, 384, 384, NT / 256, 6, G, bx};
        EpiUq E{(const float*)(ws + WS_CQP), (const float*)(ws + WS_COSB), (const float*)(ws + WS_SINB), (bf16_t*)(ws + WS_Q)};
        g8::gemm_phase(lds, P, E);
        g8::DenseP P2{(const char*)(ws + WS_CKV), (const char*)(ws + WS_WUKV), 256, 256, 256, NT / 256, 8, G, bx};
        EpiUkv E2{(const float*)(ws + WS_KVP), (bf16_t*)(ws + WS_KN1), (bf16_t*)(ws + WS_V1)};
        g8::gemm_phase(lds, P2, E2);
    }
    SEAM(11);
    if (IN(12)) { p_attention_mla(a, lds_g); }
    SEAM(12);
    if (IN(13)) {
        g8::DenseP P{(const char*)(ws + WS_O), (const char*)(ws + WS_WO1), 1024, 1024, 1024, NT / 256, 4, G, bx};
        EpiResid E{(const bf16_t*)a.out, (bf16_t*)a.out, (float*)(ws + WS_HP0)};
        g8::gemm_phase(lds, P, E);
    }
    SEAM(13);
    MOE_PLE(14, 1, a.out, ws + WS_HB)
    if (IN(18)) {
        int t2 = threadIdx.x; asm volatile("" : "+v"(t2)); const int lane = t2 & 63, wave = t2 >> 6; const float* fg = a.in[5];
        const bf16_t* hfin = (const bf16_t*)(ws + WS_HB);
        for (int mrow = vcu * NWAVES + wave; mrow < NT; mrow += G * NWAVES) {
            f32x4 v[4]; float s = 0.f;
#pragma unroll
            for (int j = 0; j < 2; ++j) { unpack8(*((const u32x4*)(hfin + (size_t)mrow * 1024) + lane + 64 * j), v[2 * j], v[2 * j + 1]); s += dot4(v[2 * j]) + dot4(v[2 * j + 1]); }
            s = wave_sum(s);
            const float r = rsqrtf(s * (1.0f / 1024.0f) + EPS);
            f32x4* xr = (f32x4*)(a.out + (size_t)mrow * 1024);
#pragma unroll
            for (int j = 0; j < 2; ++j) { const int c4 = 2 * (lane + 64 * j);
                xr[c4] = v[2 * j] * r * *((const f32x4*)fg + c4); xr[c4 + 1] = v[2 * j + 1] * r * *((const f32x4*)fg + c4 + 1); }
        }
    }
#undef IN
#undef SEAM
}

constexpr int N_PHASES = 19;
static int g_grid = 0;
static bool setup() {
    if (g_grid) return g_grid > 0;
    int dev = 0, cus = 0;
    if (hipGetDevice(&dev) != hipSuccess || hipDeviceGetAttribute(&cus, hipDeviceAttributeMultiprocessorCount, dev) != hipSuccess) { g_grid = -1; return false; }
    if (hipFuncSetAttribute((const void*)mega, hipFuncAttributeMaxDynamicSharedMemorySize, LDS_BYTES) != hipSuccess) { fprintf(stderr, "hipFuncSetAttribute failed\n"); g_grid = -1; return false; }
    int per_cu = 0;
    if (hipOccupancyMaxActiveBlocksPerMultiprocessor(&per_cu, (const void*)mega, NTHR, LDS_BYTES) != hipSuccess || per_cu < 1) { fprintf(stderr, "occupancy query: %d\n", per_cu); }
    (void)hipGetLastError();
    g_grid = cus;
    return true;
}
static void run_phases(const Args& base, int lo, int hi, bool one_launch, hipStream_t st) {
    if (one_launch) { Args a = base; a.ph_lo = lo; a.ph_hi = hi; hipLaunchKernelGGL(mega, dim3(g_grid), dim3(NTHR), LDS_BYTES, st, a); }
    else for (int p = lo; p < hi; ++p) { Args a = base; a.ph_lo = p; a.ph_hi = p + 1;
#ifdef PROBE_ROUTE
        if (p == 6) { Args b = base; b.ph_lo = 14; b.ph_hi = 15; hipLaunchKernelGGL(mega, dim3(g_grid), dim3(NTHR), LDS_BYTES, st, b); }
        if (p == 14) (void)hipMemsetAsync(base.ws + WS_CTL + (CW_CNT + 24 * 16) * 4, 0, 24 * 16 * 4, st);
#endif
        hipLaunchKernelGGL(mega, dim3(g_grid), dim3(NTHR), LDS_BYTES, st, a);
#ifdef DOUBLE_PHASE
        if (p == DOUBLE_PHASE) hipLaunchKernelGGL(mega, dim3(g_grid), dim3(NTHR), LDS_BYTES, st, a);
#endif
    }
}
}
#ifndef ONE_LAUNCH
#define ONE_LAUNCH 1
#endif
extern "C" void kernel_launch(void* const* d_in, const int* in_sizes, int n_in, void* d_out, int out_size, void* d_ws, size_t ws_size, hipStream_t stream) {
    (void)in_sizes; (void)out_size;
    if (n_in != 22) { fprintf(stderr, "kernel_launch: expected 22 inputs, got %d\n", n_in); return; }
    if (ws_size < fk::WS_END) { fprintf(stderr, "kernel_launch: workspace too small (%zu)\n", ws_size); return; }
    if (!fk::setup()) return;
    (void)hipMemsetAsync((char*)d_ws + fk::WS_CTL, 0, fk::CTL_ZERO_BYTES, stream);
    fk::Args a{};
    for (int i = 0; i < 22; ++i) a.in[i] = (const float*)d_in[i];
    a.out = (float*)d_out; a.ws = (unsigned char*)d_ws;
    fk::run_phases(a, 0, fk::N_PHASES, ONE_LAUNCH != 0, stream);
}
```

```cpp
#include <hip/hip_runtime.h>
#include <cstdio>
#include <cstdint>
#include <cmath>
namespace fk {
#define LAS __attribute__((address_space(3)))
#define GAS __attribute__((address_space(1)))
typedef unsigned short bf16_t;
typedef short bf16x8 __attribute__((ext_vector_type(8)));
typedef short s16x4 __attribute__((ext_vector_type(4)));
typedef float f32x4 __attribute__((ext_vector_type(4)));
typedef float f32x16 __attribute__((ext_vector_type(16)));
typedef unsigned u32x4 __attribute__((ext_vector_type(4)));
typedef unsigned u32x2 __attribute__((ext_vector_type(2)));
typedef float f32x2_t __attribute__((ext_vector_type(2)));
typedef __bf16 bf16x2_t __attribute__((ext_vector_type(2)));

constexpr int NB = 4, NS = 8192, ND = 1024, NT = NB * NS, NH = 8;
constexpr float EPS = 1e-6f;
constexpr int NWAVES = 8, NTHR = 512;

constexpr size_t MiB = 1u << 20;
constexpr size_t WS_CTL = 0, CTL_ZERO_BYTES = 1 * MiB;
constexpr size_t WS_COSA = 1 * MiB, WS_SINA = 3 * MiB, WS_COSB = 5 * MiB, WS_SINB = 6 * MiB;
constexpr size_t WS_KMEAN = 7 * MiB;
constexpr size_t WS_WRT = 7 * MiB + 512 * 1024;
constexpr size_t WS_HPX = 8 * MiB, WS_HP0 = 10 * MiB, WS_HP1 = 12 * MiB, WS_HP2 = 14 * MiB;
constexpr size_t WS_CQP = 16 * MiB, WS_KVP = 17 * MiB;
constexpr size_t WS_TOKW = 18 * MiB;
constexpr size_t WS_LIST = 19 * MiB;
constexpr size_t WS_WQKV0 = 24 * MiB, WS_WO0 = 30 * MiB, WS_WDQKV = 32 * MiB, WS_WUQ = 34 * MiB, WS_WUKV = 36 * MiB, WS_WO1 = 37 * MiB;
constexpr size_t WS_WGU = 40 * MiB;
constexpr size_t WS_WD = 72 * MiB;
constexpr size_t WS_WPG = 88 * MiB;
constexpr size_t WS_WPP = 92 * MiB;
constexpr size_t WS_HB = 94 * MiB;
constexpr size_t WS_CQ = WS_HB, WS_CKV = WS_HB + 24 * MiB, WS_KROPE = WS_HB + 40 * MiB;
constexpr size_t WS_O = 158 * MiB;
constexpr size_t WS_R = 222 * MiB;
constexpr size_t WS_Q = WS_R, WS_K0 = WS_R + 64 * MiB, WS_V0 = WS_R + 128 * MiB;
constexpr size_t WS_KN1 = WS_R + 96 * MiB, WS_V1 = WS_R + 160 * MiB;
constexpr size_t WS_ACT = WS_R, WS_PB = WS_R + 40 * MiB, WS_PP = WS_R + 64 * MiB;
constexpr size_t WS_PART2 = WS_R + 224 * MiB;
constexpr size_t WS_END = WS_PART2 + 64 * MiB;
constexpr int CW_CNT = 1024;
constexpr int CW_BAR = 4096;
constexpr int CW_LCNT = 8192;

constexpr int RING_BYTES = 131072;
constexpr int LDS_MISC = RING_BYTES;
constexpr int LDS_BYTES = 147456;

struct Args { const float* in[22]; float* out; unsigned char* ws; int ph_lo, ph_hi; };

__device__ __forceinline__ unsigned cvtpk(float lo, float hi) { f32x2_t v = {lo, hi}; bf16x2_t b = __builtin_convertvector(v, bf16x2_t); return __builtin_bit_cast(unsigned, b); }
__device__ __forceinline__ float bf2f(unsigned short b) { return __builtin_bit_cast(float, (unsigned)b << 16); }
__device__ __forceinline__ u32x4 pack8(f32x4 a, f32x4 b) { u32x4 w = {cvtpk(a[0], a[1]), cvtpk(a[2], a[3]), cvtpk(b[0], b[1]), cvtpk(b[2], b[3])}; return w; }
__device__ __forceinline__ float wave_sum(float v) {
#pragma unroll
    for (int o = 1; o < 64; o <<= 1) v += __shfl_xor(v, o);
    return v;
}
__device__ __forceinline__ float dot4(f32x4 a) { return (a[0] * a[0] + a[1] * a[1]) + (a[2] * a[2] + a[3] * a[3]); }
template <int NP> __device__ __forceinline__ float row_rs(const float* hp, float invd) {
    float s = 0.f;
#pragma unroll
    for (int i = 0; i < NP / 4; ++i) { const f32x4 a = *(const f32x4*)(hp + 4 * i); s += (a[0] + a[1]) + (a[2] + a[3]); }
    return rsqrtf(s * invd + EPS);
}

#define XB_TMO      128
#define XB_XCNT(j)  (256  + 64 * (j))
#define XB_XSUB(j)  (1280 + 64 * (j))
#define XB_XGEN(j)  (2304 + 64 * (j))
#define XB_TOP      3328
#define XB_TOPGEN   3392
#define XCD_BAR_WORDS 3456
#define XB_SPIN_CAP (1u << 18)
__device__ __forceinline__ unsigned xb_ld(unsigned* p)              { return __hip_atomic_load(p, __ATOMIC_RELAXED, __HIP_MEMORY_SCOPE_AGENT); }
__device__ __forceinline__ unsigned xb_add(unsigned* p, unsigned v) { return __hip_atomic_fetch_add(p, v, __ATOMIC_RELAXED, __HIP_MEMORY_SCOPE_AGENT); }
__device__ __forceinline__ unsigned xb_xcc_id() { return (unsigned)__builtin_amdgcn_s_getreg((3 << 11) | 20) & 0xFu; }
#define XB_SPIN(cond, bar) do { unsigned _sp = 0; while (cond) { __builtin_amdgcn_s_sleep(1); \
    if ((++_sp & 255u) == 0u) { if (xb_ld(&(bar)[XB_TMO])) break; if (_sp > XB_SPIN_CAP) { atomicAdd(&(bar)[XB_TMO], 1u); break; } } } } while (0)
struct XcdBarrier { unsigned* bar; unsigned x; volatile LAS unsigned* st; };
__device__ __forceinline__ XcdBarrier xcd_barrier_post(unsigned* bar, volatile LAS unsigned* st) {
    XcdBarrier b; b.bar = bar; b.x = xb_xcc_id(); b.st = st;
    if (threadIdx.x == 0) (void)xb_add(&bar[XB_XCNT(b.x)], 1u);
    return b;
}
__device__ __forceinline__ void xcd_barrier_complete(unsigned* bar, unsigned x, unsigned& nloc, unsigned& nx) {
    const unsigned G = gridDim.x * gridDim.y * gridDim.z;
    unsigned sum, cnt, mine, sp = 0u;
    for (;;) {
        sum = 0u; cnt = 0u; mine = 0u;
#pragma unroll
        for (unsigned j = 0; j < 16; ++j) { const unsigned c = xb_ld(&bar[XB_XCNT(j)]); sum += c; cnt += (c > 0u) ? 1u : 0u; mine = (j == x) ? c : mine; }
        if (sum == G) break;
        __builtin_amdgcn_s_sleep(1);
        if ((++sp & 255u) == 0u) { if (xb_ld(&bar[XB_TMO])) break; if (sp > XB_SPIN_CAP) { atomicAdd(&bar[XB_TMO], 1u); break; } }
    }
    nloc = mine > 0u ? mine : 1u; nx = cnt > 0u ? cnt : 1u;
}
__device__ __forceinline__ void xcd_barrier(const XcdBarrier& b) {
    asm volatile("s_waitcnt vmcnt(0)" ::: "memory");
    __syncthreads();
    if (threadIdx.x == 0) {
        unsigned* bar = b.bar;
        __builtin_amdgcn_s_waitcnt(0);
        unsigned nloc = b.st[0], nx = b.st[1];
        if (nloc == 0u) { xcd_barrier_complete(bar, b.x, nloc, nx); b.st[0] = nloc; b.st[1] = nx; }
        const unsigned old = xb_add(&bar[XB_XSUB(b.x)], 1u);
        const unsigned gen = old / nloc;
        if (old + 1u == (gen + 1u) * nloc) {
            __builtin_amdgcn_fence(__ATOMIC_RELEASE, "agent");
            asm volatile("s_waitcnt vmcnt(0)" ::: "memory");
            const unsigned og = xb_add(&bar[XB_TOP], 1u);
            const unsigned tg = og / nx;
            if (og + 1u == (tg + 1u) * nx) xb_add(&bar[XB_TOPGEN], 1u);
            else XB_SPIN(xb_ld(&bar[XB_TOPGEN]) == tg, bar);
            __builtin_amdgcn_fence(__ATOMIC_ACQUIRE, "agent");
            xb_add(&bar[XB_XGEN(b.x)], 1u);
            asm volatile("s_waitcnt vmcnt(0)" ::: "memory");
        } else {
            XB_SPIN(xb_ld(&bar[XB_XGEN(b.x)]) == gen, bar);
            __builtin_amdgcn_fence(__ATOMIC_ACQUIRE, "agent");
            asm volatile("s_waitcnt vmcnt(0)" ::: "memory");
        }
    }
    __syncthreads();
}

namespace g8 {
constexpr int BM = 256, BK = 64, HALF = 128, HTB = HALF * BK * 2, STAGE_BYTES = 8 * HTB, NXCD = 8, WGM = 8;
__device__ __forceinline__ int lds_byte(int r, int c) { const int st = (r >> 4) * 2 + (c >> 5), rr = r & 15, cc = c & 31, ob = rr * 64 + cc * 2; return st * 1024 + (ob ^ (((ob >> 9) & 1) << 5)); }
__device__ __forceinline__ void stage_rc(int b, int& R, int& C) { const int st = b / 1024, sb = b % 1024, swz = sb ^ (((sb >> 9) & 1) << 5); R = (st >> 1) * 16 + swz / 64; C = (st & 1) * 32 + (swz % 64) / 2; }
__device__ __forceinline__ int perm32(int rho) { const int n = rho >> 4, i = rho & 15; return 8 * (i >> 2) + 4 * n + (i & 3); }
struct Unit { int pm, pn, aux; };
struct AOff { unsigned o[2][2]; };

__device__ __forceinline__ bool static_order(int i, int G, int c, int nM, int nN, int& pm, int& pn) {
    const int nwg = nM * nN; const long L = (long)i * G + c; if (L >= nwg) return false;
    int wgid = (int)L; { const int q = nwg / NXCD, r = nwg % NXCD, xcd = wgid % NXCD, off = wgid / NXCD; wgid = (xcd < r ? xcd * (q + 1) : r * (q + 1) + (xcd - r) * q) + off; }
    const int nig = WGM * nN, gid = wgid / nig, fm = gid * WGM, gsz = (nM - fm) < WGM ? (nM - fm) : WGM;
    pm = fm + ((wgid % nig) % gsz); pn = (wgid % nig) / gsz; return true;
}
struct DenseP {
    const char* A; const char* B; int lda, ldb, K, nM, nN, G, c;
    __device__ __forceinline__ bool next(int i, Unit& u) const { u.aux = 0; return static_order(i, G, c, nM, nN, u.pm, u.pn); }
    __device__ __forceinline__ void aoff(const Unit& u, const int (&R)[2], const int (&C)[2], AOff& o) const {
#pragma unroll
        for (int h = 0; h < 2; ++h)
#pragma unroll
            for (int i = 0; i < 2; ++i) o.o[h][i] = (unsigned)(((u.pm * BM + h * HALF + R[i]) * lda + C[i]) * 2);
    }
    __device__ __forceinline__ const char* bbase(const Unit& u, int kt) const { return B + ((size_t)u.pn * BM * ldb + (size_t)kt * BK) * 2; }
};

template <class Prov, class Epi>
__device__ __forceinline__ void gemm_phase(LAS unsigned char* lds, const Prov& P, const Epi& E) {
    int tid = threadIdx.x; asm volatile("" : "+v"(tid));
    const int wid = __builtin_amdgcn_readfirstlane(tid >> 6), lane = tid & 63, wr = wid >> 2, wc = wid & 3, fr = lane & 15, fq = lane >> 4;
    const int K = P.K, nt = K / BK;
    int R[2], C[2]; unsigned voffB[2];
#pragma unroll
    for (int i = 0; i < 2; ++i) { stage_rc(tid * 16 + i * 8192, R[i], C[i]); const int Rb = (R[i] & ~31) + perm32(R[i] & 31); voffB[i] = (unsigned)(Rb * P.ldb + C[i]) * 2u; }
    const size_t hstepB = (size_t)HALF * P.ldb * 2;
    const unsigned ldsw = (unsigned)wid * 1024u;
    const int aoff = lds_byte(wr * 64 + fr, fq * 8), boff = lds_byte(wc * 32 + fr, fq * 8);
#define G8_SA(b, h) (((b) * 2 + (h)) * HTB)
#define G8_SB(b, h) ((4 + (b) * 2 + (h)) * HTB)
#define G8_STAGE_A(bufoff, h, AO, kb) do { _Pragma("unroll") for (int _i = 0; _i < 2; ++_i) \
        __builtin_amdgcn_global_load_lds((const unsigned*)(P.A + (size_t)((AO).o[h][_i] + (kb))), (LAS unsigned*)(lds + (bufoff) + ldsw + _i * 8192), 16, 0, 0); } while (0)
#define G8_STAGE_B(bufoff, bp) do { _Pragma("unroll") for (int _i = 0; _i < 2; ++_i) \
        __builtin_amdgcn_global_load_lds((const unsigned*)((bp) + voffB[_i]), (LAS unsigned*)(lds + (bufoff) + ldsw + _i * 8192), 16, 0, 0); } while (0)
#define G8_LDA(dst, b, h) do { _Pragma("unroll") for (int m = 0; m < 4; ++m) _Pragma("unroll") for (int k = 0; k < 2; ++k) dst[m][k] = *(const LAS bf16x8*)(lds + G8_SA(b, h) + aoff + m * 2048 + k * 1024); } while (0)
#define G8_LDB(dst, b, h) do { _Pragma("unroll") for (int n = 0; n < 2; ++n) _Pragma("unroll") for (int k = 0; k < 2; ++k) dst[n][k] = *(const LAS bf16x8*)(lds + G8_SB(b, h) + boff + n * 2048 + k * 1024); } while (0)
#define G8_MMA(ai, bj, At, Bt) do { __builtin_amdgcn_s_setprio(1); _Pragma("unroll") for (int m = 0; m < 4; ++m) _Pragma("unroll") for (int n = 0; n < 2; ++n) _Pragma("unroll") for (int k = 0; k < 2; ++k) \
        acc[ai][bj][m][n] = __builtin_amdgcn_mfma_f32_16x16x32_bf16(Bt[n][k], At[m][k], acc[ai][bj][m][n], 0, 0, 0); __builtin_amdgcn_s_setprio(0); } while (0)
#define G8_WAIT_V(n) asm volatile("s_waitcnt vmcnt(" #n ")" ::: "memory")
#define G8_WAIT_L(n) asm volatile("s_waitcnt lgkmcnt(" #n ")" ::: "memory")
#define G8_BAR __builtin_amdgcn_s_barrier()
#define G8_SCHED __builtin_amdgcn_sched_barrier(0)
    Unit cur, nxt; int ui = 0;
    if (!P.next(0, cur)) return;
    f32x4 acc[2][2][4][2];
#pragma unroll
    for (int a = 0; a < 2; ++a)
#pragma unroll
        for (int b = 0; b < 2; ++b)
#pragma unroll
            for (int m = 0; m < 4; ++m)
#pragma unroll
                for (int n = 0; n < 2; ++n) acc[a][b][m][n] = (f32x4){0.f, 0.f, 0.f, 0.f};
    bf16x8 At[4][2], B0[2][2], B1[2][2];
    AOff cA, nA;
    P.aoff(cur, R, C, cA);
    {   const char* b0 = P.bbase(cur, 0); const char* b1 = P.bbase(cur, 1);
        G8_STAGE_B(G8_SB(0, 0), b0); G8_STAGE_B(G8_SB(0, 1), b0 + hstepB); G8_STAGE_A(G8_SA(0, 0), 0, cA, 0u); G8_STAGE_A(G8_SA(0, 1), 1, cA, 0u);
        if (wr == 1) G8_BAR;
        G8_WAIT_V(2); G8_BAR;
        G8_STAGE_B(G8_SB(1, 0), b1); G8_STAGE_A(G8_SA(1, 0), 0, cA, 128u); G8_STAGE_B(G8_SB(1, 1), b1 + hstepB);
        G8_WAIT_V(6); G8_BAR; }
    for (;;) {
        const bool has_next = P.next(ui + 1, nxt);
        if (has_next) P.aoff(nxt, R, C, nA); else { nA = cA; nxt = cur; }
        for (int t = 0; t < nt; t += 2) {
            const bool last = (t == nt - 2);
            const unsigned kb1 = (unsigned)(t + 1) * 128u;
            const unsigned kb2 = last ? 0u : (unsigned)(t + 2) * 128u, kb3 = kb2 + 128u;
            AOff s;
#pragma unroll
            for (int h = 0; h < 2; ++h)
#pragma unroll
                for (int i = 0; i < 2; ++i) s.o[h][i] = last ? nA.o[h][i] : cA.o[h][i];
            const char* b2 = last ? P.bbase(nxt, 0) : P.bbase(cur, t + 2);
            const char* b3 = last ? P.bbase(nxt, 1) : P.bbase(cur, t + 3);
            G8_LDB(B0, 0, 0); G8_LDB(B1, 0, 1); G8_SCHED; G8_LDA(At, 0, 0); G8_STAGE_A(G8_SA(1, 1), 1, cA, kb1);
            G8_WAIT_V(8); G8_WAIT_L(0); G8_BAR; G8_MMA(0, 0, At, B0); G8_MMA(0, 1, At, B1); G8_BAR; G8_SCHED;
            G8_LDA(At, 0, 1); G8_STAGE_B(G8_SB(0, 0), b2); G8_STAGE_B(G8_SB(0, 1), b2 + hstepB); G8_STAGE_A(G8_SA(0, 0), 0, s, kb2);
            G8_WAIT_V(8); G8_WAIT_L(0); G8_BAR; G8_MMA(1, 0, At, B0); G8_MMA(1, 1, At, B1); G8_BAR; G8_SCHED;
            G8_LDB(B0, 1, 0); G8_LDB(B1, 1, 1); G8_SCHED; G8_LDA(At, 1, 0); G8_STAGE_A(G8_SA(0, 1), 1, s, kb2);
            G8_WAIT_V(8); G8_WAIT_L(0); G8_BAR; G8_MMA(0, 0, At, B0); G8_MMA(0, 1, At, B1); G8_BAR; G8_SCHED;
            G8_LDA(At, 1, 1); G8_STAGE_B(G8_SB(1, 0), b3); G8_STAGE_B(G8_SB(1, 1), b3 + hstepB); G8_STAGE_A(G8_SA(1, 0), 0, s, kb3);
            G8_WAIT_V(8); G8_WAIT_L(0); G8_BAR; G8_MMA(1, 0, At, B0); G8_MMA(1, 1, At, B1); G8_BAR; G8_SCHED;
        }
        if (wr == 0) G8_BAR;
        E(acc, cur, wr, wc, fr, fq);
        if (!has_next) break;
#pragma unroll
        for (int a = 0; a < 2; ++a)
#pragma unroll
            for (int b = 0; b < 2; ++b)
#pragma unroll
                for (int m = 0; m < 4; ++m)
#pragma unroll
                    for (int n = 0; n < 2; ++n) acc[a][b][m][n] = (f32x4){0.f, 0.f, 0.f, 0.f};
        cur = nxt; cA = nA; ++ui;
        if (wr == 1) G8_BAR;
    }
    G8_WAIT_V(0);
    G8_BAR;
#undef G8_SA
#undef G8_SB
#undef G8_STAGE_A
#undef G8_STAGE_B
#undef G8_LDA
#undef G8_LDB
#undef G8_MMA
#undef G8_WAIT_V
#undef G8_WAIT_L
#undef G8_BAR
#undef G8_SCHED
}
}
using g8::Unit;


struct EpiQKV {
    const float* hpx; const float* cosA; const float* sinA; bf16_t* Q; bf16_t* Kk; bf16_t* V; float* kmean;
    __device__ __forceinline__ void operator()(const f32x4 (&acc)[2][2][4][2], const Unit& u, int wr, int wc, int fr, int fq) const {
        const int t = u.pn >> 2;
        const int bb = u.pm >> 5;
        if (t < 2) {
            const int hh = 2 * (u.pn & 3) + (wc >> 1), j0 = 32 * (wc & 1) + 8 * fq;
            bf16_t* dst0 = (t == 0 ? Q : Kk) + ((size_t)(bb * NH + hh) * NS) * 128;
            f32x4 ks[2][2] = {{{0.f, 0.f, 0.f, 0.f}, {0.f, 0.f, 0.f, 0.f}}, {{0.f, 0.f, 0.f, 0.f}, {0.f, 0.f, 0.f, 0.f}}};
#pragma unroll
            for (int ai = 0; ai < 2; ++ai)
#pragma unroll
                for (int m = 0; m < 4; ++m) {
                    const int row = u.pm * 256 + 128 * ai + 64 * wr + 16 * m + fr, s = row & (NS - 1);
                    const float rs = row_rs<16>(hpx + (size_t)row * 16, 1.0f / 1024.0f);
                    f32x4 o1[2], o2[2];
#pragma unroll
                    for (int n = 0; n < 2; ++n) {
                        const f32x4 cs = *(const f32x4*)(cosA + (size_t)s * 64 + j0 + 4 * n), sn = *(const f32x4*)(sinA + (size_t)s * 64 + j0 + 4 * n);
                        const f32x4 x1 = acc[ai][0][m][n] * rs, x2 = acc[ai][1][m][n] * rs;
                        o1[n] = x1 * cs - x2 * sn; o2[n] = x1 * sn + x2 * cs;
                        ks[0][n] += o1[n]; ks[1][n] += o2[n];
                    }
                    bf16_t* d = dst0 + (size_t)s * 128 + j0;
                    *(u32x4*)d = pack8(o1[0], o1[1]); *(u32x4*)(d + 64) = pack8(o2[0], o2[1]);
                }
            if (t == 1) {
#pragma unroll
                for (int q = 0; q < 2; ++q)
#pragma unroll
                    for (int n = 0; n < 2; ++n)
#pragma unroll
                        for (int e = 0; e < 4; ++e) { float v = ks[q][n][e]; v += __shfl_xor(v, 1); v += __shfl_xor(v, 2); v += __shfl_xor(v, 4); v += __shfl_xor(v, 8); ks[q][n][e] = v; }
                if (fr == 0) {
                    float* km = kmean + ((size_t)(bb * NH + hh) * 32 + (u.pm & 31)) * 128 + j0;
#pragma unroll
                    for (int q = 0; q < 2; ++q)
#pragma unroll
                        for (int n = 0; n < 2; ++n)
#pragma unroll
                            for (int e = 0; e < 4; ++e) atomicAdd(km + 64 * q + 4 * n + e, ks[q][n][e]);
                }
            }
        } else {
            const int d0 = 32 * wc + 8 * fq;
#pragma unroll
            for (int ai = 0; ai < 2; ++ai)
#pragma unroll
                for (int m = 0; m < 4; ++m) {
                    const int row = u.pm * 256 + 128 * ai + 64 * wr + 16 * m + fr, s = row & (NS - 1);
                    const float rs = row_rs<16>(hpx + (size_t)row * 16, 1.0f / 1024.0f);
#pragma unroll
                    for (int bj = 0; bj < 2; ++bj) {
                        const int hh = 2 * (u.pn - 8) + bj;
                        bf16_t* d = V + ((size_t)(bb * NH + hh) * NS + s) * 128 + d0;
                        *(u32x4*)d = pack8(acc[ai][bj][m][0] * rs, acc[ai][bj][m][1] * rs);
                    }
                }
        }
    }
};

__device__ __forceinline__ void unpack8(u32x4 w, f32x4& a, f32x4& b) {
#pragma unroll
    for (int e = 0; e < 2; ++e) { a[2 * e] = __builtin_bit_cast(float, w[e] << 16); a[2 * e + 1] = __builtin_bit_cast(float, w[e] & 0xffff0000u);
                                  b[2 * e] = __builtin_bit_cast(float, w[2 + e] << 16); b[2 * e + 1] = __builtin_bit_cast(float, w[2 + e] & 0xffff0000u); }
}
struct EpiResid {
    const bf16_t* base; bf16_t* hb; float* hp;
    __device__ __forceinline__ void operator()(const f32x4 (&acc)[2][2][4][2], const Unit& u, int wr, int wc, int fr, int fq) const {
#pragma unroll
        for (int ai = 0; ai < 2; ++ai)
#pragma unroll
            for (int m = 0; m < 4; ++m) {
                const int row = u.pm * 256 + 128 * ai + 64 * wr + 16 * m + fr;
                float ss = 0.f;
#pragma unroll
                for (int bj = 0; bj < 2; ++bj) {
                    const size_t off = (size_t)row * 1024 + u.pn * 256 + 128 * bj + 32 * wc + 8 * fq;
                    f32x4 b0, b1; unpack8(*(const u32x4*)(base + off), b0, b1);
                    const f32x4 v0 = acc[ai][bj][m][0] + b0, v1 = acc[ai][bj][m][1] + b1;
                    *(u32x4*)(hb + off) = pack8(v0, v1);
                    ss += dot4(v0) + dot4(v1);
                }
                ss += __shfl_xor(ss, 16); ss += __shfl_xor(ss, 32);
                if (fq == 0) hp[(size_t)row * 16 + u.pn * 4 + wc] = ss;
                if (m & 1) asm volatile("" ::: "memory");
            }
    }
};
namespace at {
constexpr int KVBLK = 64, SHM_V = KVBLK * 128 * 2;
constexpr float THR = 8.f;
#define AT_SBAR() __builtin_amdgcn_sched_barrier(0)
__device__ __forceinline__ int v_st(int k, int c) { const int kk = (k & ~0xC) | ((k & 4) << 1) | ((k & 8) >> 1); return ((kk >> 3) * 4 + (c >> 5)) * 512 + ((kk & 7) * 32 + (c & 31)) * 2; }
__device__ __forceinline__ int v_rd_base(int lane) { return ((lane & 3) << 3) | (((lane >> 2) & 3) << 6) | (((lane >> 4) & 1) << 5) | (((lane >> 5) & 1) << 8); }
constexpr int v_rd_off(int d0, int ks, int half) { return d0 * 512 + ks * 4096 + half * 2048; }
__device__ __forceinline__ int crow(int r, int hi) { return (r & 3) + 8 * (r >> 2) + 4 * hi; }

template <int DQK> constexpr int krow() { return DQK == 192 ? 400 : DQK * 2; }
template <int DQK> __device__ __forceinline__ int kswz(int row, int colB) { return DQK == 192 ? row * 400 + colB : row * (DQK * 2) + (colB ^ ((row & 7) << 4)); }

__device__ __forceinline__ void mask_causal(f32x16& p0, f32x16& p1, int dq) {
    const float NEG = -__builtin_inff();
#pragma unroll
    for (int r = 0; r < 16; ++r) {
        const int c = (r & 3) + 8 * (r >> 2);
        if (dq - c < 0) p0[r] = NEG;
        if (dq - c - 32 < 0) p1[r] = NEG;
    }
}
__device__ __forceinline__ void mask_all(f32x16& p0, f32x16& p1, bool keep) {
    const float NEG = -__builtin_inff();
#pragma unroll
    for (int r = 0; r < 16; ++r) { p0[r] = keep ? p0[r] : NEG; p1[r] = keep ? p1[r] : NEG; }
}
__device__ __forceinline__ void partialSM(f32x16& p0, f32x16& p1, float& m_reg, float& mn, float& alpha, const float SC, const float C2) {
    float pmax = p0[0];
#pragma unroll
    for (int r = 1; r < 16; ++r) pmax = fmaxf(pmax, p0[r]);
#pragma unroll
    for (int r = 0; r < 16; ++r) pmax = fmaxf(pmax, p1[r]);
    { auto rr = __builtin_amdgcn_permlane32_swap(__float_as_uint(pmax), __float_as_uint(pmax), false, false);
      pmax = fmaxf(__uint_as_float(rr[0]), __uint_as_float(rr[1])); }
    if (__builtin_expect(__all((pmax - m_reg) * SC <= THR), 1)) { mn = m_reg; alpha = 1.f; }
    else { mn = fmaxf(m_reg, pmax); alpha = __builtin_amdgcn_exp2f((m_reg - mn) * C2); m_reg = mn; }
    const float mnL = -mn * C2;
#pragma unroll
    for (int r = 0; r < 16; ++r) p0[r] = fmaf(p0[r], C2, mnL);
#pragma unroll
    for (int r = 0; r < 16; ++r) p1[r] = fmaf(p1[r], C2, mnL);
#pragma unroll
    for (int r = 0; r < 16; ++r) p0[r] = __builtin_amdgcn_exp2f(p0[r]);
}
__device__ __forceinline__ void finishSM(f32x16& p0, f32x16& p1, float alpha, float& l_reg, bf16x8& pa0, bf16x8& pa1, bf16x8& pa2, bf16x8& pa3) {
#pragma unroll
    for (int r = 0; r < 16; ++r) p1[r] = __builtin_amdgcn_exp2f(p1[r]);
    float ps = 0;
#pragma unroll
    for (int r = 0; r < 16; ++r) ps += p0[r];
#pragma unroll
    for (int r = 0; r < 16; ++r) ps += p1[r];
    { auto rr = __builtin_amdgcn_permlane32_swap(__float_as_uint(ps), __float_as_uint(ps), false, false);
      ps = __uint_as_float(rr[0]) + __uint_as_float(rr[1]); }
    l_reg = l_reg * alpha + ps;
#define AT_PK4(P, B_, OUT) do { unsigned a0 = cvtpk(P[B_+0], P[B_+1]), a1 = cvtpk(P[B_+2], P[B_+3]);                          \
        unsigned b0 = cvtpk(P[B_+4], P[B_+5]), b1 = cvtpk(P[B_+6], P[B_+7]);                                             \
        auto r0 = __builtin_amdgcn_permlane32_swap(a0, b0, false, false); auto r1 = __builtin_amdgcn_permlane32_swap(a1, b1, false, false); \
        u32x4 w = {r0[0], r1[0], r0[1], r1[1]}; OUT = __builtin_bit_cast(bf16x8, w); } while (0)
    AT_PK4(p0, 0, pa0); AT_PK4(p0, 8, pa1); AT_PK4(p1, 0, pa2); AT_PK4(p1, 8, pa3);
#undef AT_PK4
}
template <int DQK>
__device__ __forceinline__ void qkt(f32x16& p0, f32x16& p1, const char* Kt, int r32, int hi, const bf16x8* qr, bool act) {
    if (!act) { const float NEG = -__builtin_inff();
#pragma unroll
        for (int r = 0; r < 16; ++r) { p0[r] = NEG; p1[r] = NEG; } return; }
    p0 = f32x16{}; p1 = f32x16{};
    const char* kb[4];
#pragma unroll
    for (int dd = 0; dd < 4; ++dd) kb[dd] = Kt + kswz<DQK>(r32, (dd * 16 + hi * 8) * 2);
#pragma unroll
    for (int d0 = 0; d0 < DQK / 16; ++d0) { const char* a = kb[d0 & 3] + (d0 >> 2) * 128;
        bf16x8 b0 = *reinterpret_cast<const bf16x8*>(a);
        bf16x8 b1 = *reinterpret_cast<const bf16x8*>(a + 32 * krow<DQK>());
        p0 = __builtin_amdgcn_mfma_f32_32x32x16_bf16(b0, qr[d0], p0, 0, 0, 0);
        p1 = __builtin_amdgcn_mfma_f32_32x32x16_bf16(b1, qr[d0], p1, 0, 0, 0); }
}
template <int VB>
__device__ __forceinline__ void pv_tile(f32x16* o, int vb0, bf16x8 pa0, bf16x8 pa1, bf16x8 pa2, bf16x8 pa3, bool act) {
    if (!act) return;
#define AT_TRRD(dst, off) asm volatile("ds_read_b64_tr_b16 %0, %1 offset:%2" : "=&v"(dst) : "v"(vb0), "i"(off) : "memory")
#define AT_PV_D0(d0) do { s16x4 l0, l1, l2, l3, h0, h1, h2, h3; constexpr int b_ = VB * SHM_V + v_rd_off(d0, 0, 0); \
        AT_TRRD(l0, b_); AT_TRRD(h0, b_ + 2048); AT_TRRD(l1, b_ + 4096); AT_TRRD(h1, b_ + 6144); AT_TRRD(l2, b_ + 8192); AT_TRRD(h2, b_ + 10240); AT_TRRD(l3, b_ + 12288); AT_TRRD(h3, b_ + 14336); \
        asm volatile("s_waitcnt lgkmcnt(0)" ::: "memory"); AT_SBAR();   \
        o[d0] = __builtin_amdgcn_mfma_f32_32x32x16_bf16((bf16x8){l0[0], l0[1], l0[2], l0[3], h0[0], h0[1], h0[2], h0[3]}, pa0, o[d0], 0, 0, 0);   \
        o[d0] = __builtin_amdgcn_mfma_f32_32x32x16_bf16((bf16x8){l1[0], l1[1], l1[2], l1[3], h1[0], h1[1], h1[2], h1[3]}, pa1, o[d0], 0, 0, 0);   \
        o[d0] = __builtin_amdgcn_mfma_f32_32x32x16_bf16((bf16x8){l2[0], l2[1], l2[2], l2[3], h2[0], h2[1], h2[2], h2[3]}, pa2, o[d0], 0, 0, 0);   \
        o[d0] = __builtin_amdgcn_mfma_f32_32x32x16_bf16((bf16x8){l3[0], l3[1], l3[2], l3[3], h3[0], h3[1], h3[2], h3[3]}, pa3, o[d0], 0, 0, 0); } while (0)
    AT_PV_D0(0); AT_PV_D0(1); AT_PV_D0(2); AT_PV_D0(3);
#undef AT_PV_D0
#undef AT_TRRD
}

__device__ __forceinline__ void ochunk(const f32x16 (&o)[4], int d0, int j, f32x4& c0, f32x4& c1) {
#pragma unroll
    for (int e = 0; e < 4; ++e) { auto rr = __builtin_amdgcn_permlane32_swap(__float_as_uint(o[d0][8 * j + e]), __float_as_uint(o[d0][8 * j + 4 + e]), false, false);
        c0[e] = __uint_as_float(rr[0]); c1[e] = __uint_as_float(rr[1]); }
}
template <int DQK> struct Lds { static constexpr int SHM_K = KVBLK * DQK * 2, K_OFF = 2 * SHM_V, WS_OFF = K_OFF + 2 * SHM_K, BYTES = WS_OFF + NWAVES * 64 * 4, F_OFF = BYTES; };

constexpr int LCAP = 256 * 496;
__device__ __forceinline__ int loff(int n) { return 256 * (31 * n - (n * (n - 1)) / 2); }
struct SparseBufs { unsigned short* lists; unsigned* lcnt; unsigned* selinfo; float* ml; unsigned char* part01; unsigned char* part2; };

struct AttnP { const bf16_t* Qp; const bf16_t* Kn; const bf16_t* Kr; const bf16_t* Vp; bf16_t* Op; int P0, t0, NT, bh, nent; const unsigned short* ents; };

template <int DQK, int MODE>
__device__ __forceinline__ void attn_unit(char* lds, const AttnP& A, const SparseBufs& SB) {
    constexpr int SHM_K = KVBLK * krow<DQK>(), K_OFF = 3 * SHM_V;
    constexpr float SC = (DQK == 128) ? 0.08838834764831845f : 0.07216878364870323f;
    constexpr float C2 = 1.4426950408889634f * SC;
    constexpr int ND0 = DQK / 16;
    (void)SB;
    int tid = threadIdx.x; asm volatile("" : "+v"(tid));
    const int wid = __builtin_amdgcn_readfirstlane(tid >> 6), lane = tid & 63, r32 = lane & 31, hi = lane >> 5;
    const int NT = A.NT, P0 = A.P0;
    const int qlo = P0 + wid * 32, qm = qlo + r32 - 4 * hi;
    char* V_lds = lds; char* K_lds = lds + K_OFF;
    float m_reg = -1e30f, l_reg = 0; f32x16 o[4] = {};
    const int sr = tid >> 4, sc = (tid & 15) * 8, vst0 = v_st(sr, sc), vst1 = v_st(32 + sr, sc), kws = kswz<DQK>(sr, sc * 2);
    const int rr_ = tid >> 3, rc_ = (tid & 7) * 8, kws_r = kswz<DQK>(rr_, 256 + rc_ * 2);
    const int vb0 = (int)(uintptr_t)V_lds + v_rd_base(lane);
    bf16x8 qr[ND0];
    {   const unsigned qo = (unsigned)(((wid * 32 + r32) * DQK + hi * 8) * 2);
#pragma unroll
        for (int d0 = 0; d0 < ND0; ++d0) qr[d0] = *(const bf16x8*)((const char*)A.Qp + qo + d0 * 32); }
    bf16x8 st_v0, st_v1, st_k0, st_k1, st_k2;
    const unsigned lo_a = (unsigned)((sr * 128 + sc) * 2), lo_r = (unsigned)((rr_ * 64 + rc_) * 2);
#define AT_VMW() asm volatile("s_waitcnt vmcnt(0)" ::: "memory")
    const __amdgpu_buffer_rsrc_t rsV = __builtin_amdgcn_make_buffer_rsrc((void*)A.Vp, 0, NS * 256, 0x00020000), rsK = __builtin_amdgcn_make_buffer_rsrc((void*)A.Kn, 0, NS * 256, 0x00020000);
    const __amdgpu_buffer_rsrc_t rsR = __builtin_amdgcn_make_buffer_rsrc((void*)(DQK == 192 ? A.Kr : A.Kn), 0, NS * 128, 0x00020000);
#define AT_BL(rs, vo, so) __builtin_bit_cast(bf16x8, __builtin_amdgcn_raw_buffer_load_b128(rs, (int)(vo), (int)(so), 0))
#define AT_SLOAD(k0) do { const int so_ = (k0) * 256; \
                          st_v0 = AT_BL(rsV, lo_a, so_); st_v1 = AT_BL(rsV, lo_a, so_ + 8192); \
                          st_k0 = AT_BL(rsK, lo_a, so_); st_k1 = AT_BL(rsK, lo_a, so_ + 8192); \
                          if (DQK == 192) { st_k2 = AT_BL(rsR, lo_r, (k0) * 128); } } while (0)
#define AT_SWRITE(bf) do { char* vd_ = V_lds + (bf) * SHM_V; char* kd_ = K_lds + (bf) * SHM_K; \
                           *(bf16x8*)(vd_ + vst0) = st_v0; *(bf16x8*)(vd_ + vst1) = st_v1; \
                           *(bf16x8*)(kd_ + kws) = st_k0; *(bf16x8*)(kd_ + kws + 32 * krow<DQK>()) = st_k1; \
                           if (DQK == 192) *(bf16x8*)(kd_ + kws_r) = st_k2; } while (0)
#define AT_RESC(a) do { if (__any((a) < 1.f)) { _Pragma("unroll") for (int d_ = 0; d_ < 4; ++d_) o[d_] *= (a); } } while (0)
#define AT_KBASE(t) ((t) * KVBLK)
#define AT_MASKT(P0_, P1_, t) do { const int kb_ = AT_KBASE(t); if (kb_ + KVBLK - 1 > qlo) mask_causal(P0_, P1_, qm - kb_); } while (0)
    f32x16 pA0, pA1, pB0, pB1; float mnA, mnB, alA, alB; bf16x8 pa0, pa1, pa2, pa3;
    AT_SLOAD(AT_KBASE(0)); AT_VMW(); AT_SWRITE(0);
    AT_SLOAD(AT_KBASE(1)); AT_VMW(); AT_SWRITE(1);
    AT_SLOAD(AT_KBASE(2));
    __syncthreads();
    AT_SBAR(); qkt<DQK>(pA0, pA1, K_lds, r32, hi, qr, true);
    AT_MASKT(pA0, pA1, 0); partialSM(pA0, pA1, m_reg, mnA, alA, SC, C2);
#define AT_STEP(PX0, PX1, mnX, alX, PY0, PY1, alY, t, bc, bp, bn) do {                                                           \
        if ((t) + 1 < NT) { AT_VMW(); AT_SWRITE(bn); if ((t) + 2 < NT) AT_SLOAD(AT_KBASE((t) + 2)); }                            \
        AT_SBAR(); qkt<DQK>(PX0, PX1, K_lds + (bc) * SHM_K, r32, hi, qr, true);                                                  \
        finishSM(PY0, PY1, alY, l_reg, pa0, pa1, pa2, pa3); AT_SBAR();                                                           \
        pv_tile<0>(o, vb0 + (bp) * SHM_V, pa0, pa1, pa2, pa3, true); AT_MASKT(PX0, PX1, (t)); partialSM(PX0, PX1, m_reg, mnX, alX, SC, C2); \
        AT_RESC(alX); __syncthreads(); } while (0)
    int bc = 1, bp = 0, bn = 2;
    for (int t = 1; t + 1 < NT; t += 2) {
        AT_STEP(pB0, pB1, mnB, alB, pA0, pA1, alA, t, bc, bp, bn);
        { const int x = bp; bp = bc; bc = bn; bn = x; }
        AT_STEP(pA0, pA1, mnA, alA, pB0, pB1, alB, t + 1, bc, bp, bn);
        { const int x = bp; bp = bc; bc = bn; bn = x; }
    }
    AT_SBAR(); qkt<DQK>(pB0, pB1, K_lds + bc * SHM_K, r32, hi, qr, true); AT_SBAR();
    finishSM(pA0, pA1, alA, l_reg, pa0, pa1, pa2, pa3); AT_SBAR();
    pv_tile<0>(o, vb0 + bp * SHM_V, pa0, pa1, pa2, pa3, true);
    AT_MASKT(pB0, pB1, NT - 1); partialSM(pB0, pB1, m_reg, mnB, alB, SC, C2); AT_RESC(alB);
    finishSM(pB0, pB1, alB, l_reg, pa0, pa1, pa2, pa3); AT_SBAR(); pv_tile<0>(o, vb0 + bc * SHM_V, pa0, pa1, pa2, pa3, true);
    {
        const float il = __builtin_amdgcn_rcpf(l_reg);
        unsigned lofs = (unsigned)(((wid * 32 + r32) * 1024 + 8 * hi) * 2);
        asm volatile("" : "+v"(lofs));
#pragma unroll
        for (int d0 = 0; d0 < 4; ++d0)
#pragma unroll
            for (int j = 0; j < 2; ++j) { f32x4 c0, c1; ochunk(o, d0, j, c0, c1);
                *(u32x4*)((char*)A.Op + (size_t)((32 * d0 + 16 * j) * 2) + lofs) = pack8(c0 * il, c1 * il); }
    }
    __syncthreads();
#undef AT_VMW
#undef AT_SLOAD
#undef AT_BL
#undef AT_SWRITE
#undef AT_RESC
#undef AT_KBASE
#undef AT_MASKT
#undef AT_STEP
}

constexpr int RES_WS = 132096, RES_F = 134144;
__device__ __forceinline__ void moba_stage_kv(char* lds, const bf16_t* Kn, const bf16_t* Vp, int n) {
    int tid = threadIdx.x; asm volatile("" : "+v"(tid));
    const int sr = tid >> 4, sc = (tid & 15) * 8, vst0 = v_st(sr, sc), vst1 = v_st(32 + sr, sc), kws = kswz<128>(sr, sc * 2);
    const unsigned lo_a = (unsigned)((sr * 128 + sc) * 2);
    const __amdgpu_buffer_rsrc_t rsV = __builtin_amdgcn_make_buffer_rsrc((void*)Vp, 0, NS * 256, 0x00020000), rsK = __builtin_amdgcn_make_buffer_rsrc((void*)Kn, 0, NS * 256, 0x00020000);
    bf16x8 kv[4][4];
#pragma unroll
    for (int t = 0; t < 4; ++t) { const int so = (4 * n + t) * 64 * 256;
        kv[t][0] = __builtin_bit_cast(bf16x8, __builtin_amdgcn_raw_buffer_load_b128(rsV, (int)lo_a, so, 0)); kv[t][1] = __builtin_bit_cast(bf16x8, __builtin_amdgcn_raw_buffer_load_b128(rsV, (int)lo_a, so + 8192, 0));
        kv[t][2] = __builtin_bit_cast(bf16x8, __builtin_amdgcn_raw_buffer_load_b128(rsK, (int)lo_a, so, 0)); kv[t][3] = __builtin_bit_cast(bf16x8, __builtin_amdgcn_raw_buffer_load_b128(rsK, (int)lo_a, so + 8192, 0)); }
#pragma unroll
    for (int t = 0; t < 4; ++t) {
        *(bf16x8*)(lds + t * SHM_V + vst0) = kv[t][0]; *(bf16x8*)(lds + t * SHM_V + vst1) = kv[t][1];
        *(bf16x8*)(lds + 65536 + t * 16384 + kws) = kv[t][2]; *(bf16x8*)(lds + 65536 + t * 16384 + kws + 32 * 256) = kv[t][3]; }
    __syncthreads();
}
template <int MODE>
__device__ __forceinline__ void moba_rows(char* lds, const bf16_t* Qh  , bf16_t* Op  , int bh, const unsigned short* ents, int nvalid  , int qrow0  , int kb0, const SparseBufs& SB, int wid, int lane) {
    constexpr float SC = 0.08838834764831845f, C2 = 1.4426950408889634f * SC;
    const int r32 = lane & 31, hi = lane >> 5;
    char* V_lds = lds; char* K_lds = lds + 65536;
    float* ws = (float*)(lds + RES_WS) + wid * 64; float* li_l = ws, * al_l = ws + 32;
    const int vb0 = (int)(uintptr_t)V_lds + v_rd_base(lane);
    int ent = -1, srow;
    if (MODE == 2) { const bool valid = r32 < nvalid; const int e = (int)ents[valid ? r32 : 0]; ent = valid ? e : -1; srow = e & 8191; } else srow = qrow0 + r32;
    bf16x8 qr[8];
    {   const __amdgpu_buffer_rsrc_t rsQ = __builtin_amdgcn_make_buffer_rsrc((void*)Qh, 0, NS * 256, 0x00020000);
        const unsigned qo = (unsigned)(srow * 256 + hi * 16);
#pragma unroll
        for (int d0 = 0; d0 < 8; ++d0) qr[d0] = __builtin_bit_cast(bf16x8, __builtin_amdgcn_raw_buffer_load_b128(rsQ, (int)(qo + d0 * 32), 0, 0)); }
    float m_reg = -1e30f, l_reg = 0; f32x16 o[4] = {};
    const int qlo = qrow0, qm = qrow0 + r32 - 4 * hi;
#define MR_ACT(t) (MODE == 2 ? true : (kb0 + (t) * 64 <= qlo + 31))
#define MR_MASK(P0_, P1_, t) do { if (MODE == 3) { const int kb_ = kb0 + (t) * 64; if (kb_ + 63 > qlo && kb_ <= qlo + 31) mask_causal(P0_, P1_, qm - kb_); } } while (0)
#define MR_RESC(a) do { if (__any((a) < 1.f)) { _Pragma("unroll") for (int d_ = 0; d_ < 4; ++d_) o[d_] *= (a); } } while (0)
    f32x16 pA0, pA1, pB0, pB1; float mnA, mnB, alA, alB; bf16x8 pa0, pa1, pa2, pa3;
    qkt<128>(pA0, pA1, K_lds, r32, hi, qr, MR_ACT(0)); MR_MASK(pA0, pA1, 0); partialSM(pA0, pA1, m_reg, mnA, alA, SC, C2);
    AT_SBAR(); qkt<128>(pB0, pB1, K_lds + 16384, r32, hi, qr, MR_ACT(1)); finishSM(pA0, pA1, alA, l_reg, pa0, pa1, pa2, pa3); AT_SBAR();
    pv_tile<0>(o, vb0, pa0, pa1, pa2, pa3, MR_ACT(0)); MR_MASK(pB0, pB1, 1); partialSM(pB0, pB1, m_reg, mnB, alB, SC, C2); MR_RESC(alB);
    AT_SBAR(); qkt<128>(pA0, pA1, K_lds + 2 * 16384, r32, hi, qr, MR_ACT(2)); finishSM(pB0, pB1, alB, l_reg, pa0, pa1, pa2, pa3); AT_SBAR();
    pv_tile<1>(o, vb0, pa0, pa1, pa2, pa3, MR_ACT(1)); MR_MASK(pA0, pA1, 2); partialSM(pA0, pA1, m_reg, mnA, alA, SC, C2); MR_RESC(alA);
    AT_SBAR(); qkt<128>(pB0, pB1, K_lds + 3 * 16384, r32, hi, qr, MR_ACT(3)); finishSM(pA0, pA1, alA, l_reg, pa0, pa1, pa2, pa3); AT_SBAR();
    pv_tile<2>(o, vb0, pa0, pa1, pa2, pa3, MR_ACT(2)); MR_MASK(pB0, pB1, 3); partialSM(pB0, pB1, m_reg, mnB, alB, SC, C2); MR_RESC(alB);
    finishSM(pB0, pB1, alB, l_reg, pa0, pa1, pa2, pa3); AT_SBAR(); pv_tile<3>(o, vb0, pa0, pa1, pa2, pa3, MR_ACT(3));
#undef MR_ACT
#undef MR_MASK
#undef MR_RESC
    if (MODE == 2) {
        if (hi == 0 && ent >= 0) { f32x2_t mlv = {m_reg, l_reg}; *(f32x2_t*)(SB.ml + ((size_t)(ent >> 13) * (NB * NH * NS) + (size_t)bh * NS + srow) * 2) = mlv; }
        const float il = __builtin_amdgcn_rcpf(l_reg);
        const int slot = ent >> 13;
        unsigned char* pb = (slot == 2) ? SB.part2 : SB.part01 + (size_t)(slot & 1) * ((size_t)NB * NH * NS * 256);
        unsigned po = (unsigned)((bh * NS + srow) * 256 + 16 * hi); asm volatile("" : "+v"(po));
#pragma unroll
        for (int d0 = 0; d0 < 4; ++d0)
#pragma unroll
            for (int j = 0; j < 2; ++j) { f32x4 c0, c1; ochunk(o, d0, j, c0, c1);
                if (ent >= 0) *(u32x4*)(pb + po + (32 * d0 + 16 * j) * 2) = pack8(c0 * il, c1 * il); }
    } else {
        const int s = qrow0 + r32; const unsigned si = SB.selinfo[(size_t)bh * NS + s];
        float mk[3], lk[3]; float M = m_reg;
#pragma unroll
        for (int k = 0; k < 3; ++k) { const bool v = ((si >> (8 * k)) & 255u) < 32u; mk[k] = -1e30f; lk[k] = 0.f;
            if (v) { const f32x2_t t = *(const f32x2_t*)(SB.ml + ((size_t)k * (NB * NH * NS) + (size_t)bh * NS + s) * 2); mk[k] = t[0]; lk[k] = t[1]; }
            M = fmaxf(M, mk[k]); }
        const float w_own = __builtin_amdgcn_exp2f((m_reg - M) * C2);
        float den = w_own * l_reg, wk[3];
#pragma unroll
        for (int k = 0; k < 3; ++k) { wk[k] = lk[k] * __builtin_amdgcn_exp2f((mk[k] - M) * C2); den += wk[k]; }
        const float inv = __builtin_amdgcn_rcpf(den), f_own = w_own * inv;
#pragma unroll
        for (int k = 0; k < 3; ++k) wk[k] *= inv;
        unsigned po = (unsigned)((bh * NS + s) * 256 + 16 * hi); asm volatile("" : "+v"(po));
        const int b = bh >> 3, h = bh & 7;
        char* orow = (char*)Op + ((size_t)(b * NS + s) * 1024 + h * 128 + 8 * hi) * 2;
#pragma unroll
        for (int d0 = 0; d0 < 4; ++d0)
#pragma unroll
            for (int j = 0; j < 2; ++j) { f32x4 c0, c1; ochunk(o, d0, j, c0, c1); c0 *= f_own; c1 *= f_own;
                u32x4 pw[3];
#pragma unroll
                for (int k = 0; k < 3; ++k) { const unsigned char* pb = (k == 2) ? SB.part2 : SB.part01 + (size_t)k * ((size_t)NB * NH * NS * 256);
                    pw[k] = *(const u32x4*)(pb + po + (32 * d0 + 16 * j) * 2); }
#pragma unroll
                for (int k = 0; k < 3; ++k) { f32x4 b0, b1; const bool use = wk[k] != 0.f;
                    u32x4 w = pw[k]; w.x = use ? w.x : 0u; w.y = use ? w.y : 0u; w.z = use ? w.z : 0u; w.w = use ? w.w : 0u;
                    unpack8(w, b0, b1); c0 += b0 * wk[k]; c1 += b1 * wk[k]; }
                *(u32x4*)(orow + (32 * d0 + 16 * j) * 2) = pack8(c0, c1); }
    }
}
__device__ __forceinline__ void moba_own_unit(char* lds, const bf16_t* Qh, const bf16_t* Kn, const bf16_t* Vp, bf16_t* O, int bh, int qb, const SparseBufs& SB) {
    int tid = threadIdx.x; asm volatile("" : "+v"(tid));
    const int wid = __builtin_amdgcn_readfirstlane(tid >> 6), lane = tid & 63;
    moba_stage_kv(lds, Kn, Vp, qb);
    moba_rows<3>(lds, Qh, O, bh, nullptr, 0, qb * 256 + wid * 32, qb * 256, SB, wid, lane);
    __syncthreads();
}
__device__ __forceinline__ void moba_gather_unit(char* lds, const bf16_t* Qh, const bf16_t* Kn, const bf16_t* Vp, int bh, int n, const unsigned short* ents, int nrows, const SparseBufs& SB) {
    int tid = threadIdx.x; asm volatile("" : "+v"(tid));
    const int wid = __builtin_amdgcn_readfirstlane(tid >> 6), lane = tid & 63;
    moba_stage_kv(lds, Kn, Vp, n);
    const int ng = (nrows + 31) >> 5;
    for (int g = wid; g < ng; g += NWAVES) { const int nv = nrows - 32 * g; moba_rows<2>(lds, Qh, nullptr, bh, ents + 32 * g, nv < 32 ? nv : 32, 0, 0, SB, wid, lane); }
    __syncthreads();
}

__device__ __forceinline__ void gate_unit(char* lds, const bf16_t* Qp  , const float* kms, int bh, int qb, const SparseBufs& SB) {
    typedef Lds<128> L; constexpr int SHM_K = L::SHM_K;
    int tid = threadIdx.x; asm volatile("" : "+v"(tid));
    const int wid = __builtin_amdgcn_readfirstlane(tid >> 6), lane = tid & 63, r32 = lane & 31, hi = lane >> 5;
    char* K_lds = lds + L::K_OFF;
    int* hist = (int*)(lds + L::WS_OFF); int* base = hist + 32;
    const int sr = tid >> 4, sc = (tid & 15) * 8, kws = kswz<128>(sr, sc * 2);
    bf16x8 qr[8];
    {   const unsigned qo = (unsigned)(((wid * 32 + r32) * 128 + hi * 8) * 2);
#pragma unroll
        for (int d0 = 0; d0 < 8; ++d0) qr[d0] = *(const bf16x8*)((const char*)Qp + qo + d0 * 32); }
    {   unsigned ko = (unsigned)((sr * 128 + sc) * 4); asm volatile("" : "+v"(ko));
        const f32x4 a = *(const f32x4*)((const char*)kms + ko) * (1.0f / 256.0f), b = *(const f32x4*)((const char*)kms + ko + 16) * (1.0f / 256.0f);
        const u32x4 h8 = pack8(a, b);
        f32x4 ha, hb_; unpack8(h8, ha, hb_);
        const u32x4 l8 = pack8(a - ha, b - hb_);
        *(u32x4*)(K_lds + kws) = h8; *(u32x4*)(K_lds + SHM_K + kws) = l8; }
    if (tid < 64) hist[tid] = 0;
    __syncthreads();
    f32x16 g = f32x16{};
    {   const char* kb[4];
#pragma unroll
        for (int dd = 0; dd < 4; ++dd) kb[dd] = K_lds + kswz<128>(r32, (dd * 16 + hi * 8) * 2);
#pragma unroll
        for (int d0 = 0; d0 < 8; ++d0) { const char* a = kb[d0 & 3] + (d0 >> 2) * 128;
            g = __builtin_amdgcn_mfma_f32_32x32x16_bf16(*reinterpret_cast<const bf16x8*>(a), qr[d0], g, 0, 0, 0);
            g = __builtin_amdgcn_mfma_f32_32x32x16_bf16(*reinterpret_cast<const bf16x8*>(a + SHM_K), qr[d0], g, 0, 0, 0); } }
    const float NINF = -__builtin_inff();
    float v1 = NINF, v2 = NINF, v3 = NINF; int i1 = 64, i2 = 65, i3 = 66;
    const int ownl = qb - 4 * hi;
#pragma unroll
    for (int r = 0; r < 16; ++r) {
        const int idx = (r & 3) + 8 * (r >> 2); const float val = (idx < ownl) ? g[r] : NINF;
        const bool c1 = val > v1, c2 = val > v2, c3 = val > v3;
        v3 = c2 ? v2 : (c3 ? val : v3); i3 = c2 ? i2 : (c3 ? idx : i3);
        v2 = c1 ? v1 : (c2 ? val : v2); i2 = c1 ? i1 : (c2 ? idx : i2);
        v1 = c1 ? val : v1;             i1 = c1 ? idx : i1;
    }
    i1 += 4 * hi; i2 += 4 * hi; i3 += 4 * hi;
    float pv_[3]; int pi_[3];
    pv_[0] = __shfl_xor(v1, 32); pv_[1] = __shfl_xor(v2, 32); pv_[2] = __shfl_xor(v3, 32);
    pi_[0] = __shfl_xor(i1, 32); pi_[1] = __shfl_xor(i2, 32); pi_[2] = __shfl_xor(i3, 32);
#pragma unroll
    for (int c = 0; c < 3; ++c) {
        const float val = pv_[c]; const int idx = pi_[c];
        const bool c1 = (val > v1) || (val == v1 && idx < i1), c2 = (val > v2) || (val == v2 && idx < i2), c3 = (val > v3) || (val == v3 && idx < i3);
        v3 = c2 ? v2 : (c3 ? val : v3); i3 = c2 ? i2 : (c3 ? idx : i3);
        v2 = c1 ? v1 : (c2 ? val : v2); i2 = c1 ? i1 : (c2 ? idx : i2);
        v1 = c1 ? val : v1;             i1 = c1 ? idx : i1;
    }
    const int s = qb * 256 + wid * 32 + r32;
    int rk1 = 0, rk2 = 0, rk3 = 0;
    if (hi == 0) {
        SB.selinfo[(size_t)bh * NS + s] = (unsigned)(i1 < 32 ? i1 : 255) | ((unsigned)(i2 < 32 ? i2 : 255) << 8) | ((unsigned)(i3 < 32 ? i3 : 255) << 16);
        if (i1 < 32) rk1 = __hip_atomic_fetch_add(hist + i1, 1, __ATOMIC_RELAXED, __HIP_MEMORY_SCOPE_WORKGROUP);
        if (i2 < 32) rk2 = __hip_atomic_fetch_add(hist + i2, 1, __ATOMIC_RELAXED, __HIP_MEMORY_SCOPE_WORKGROUP);
        if (i3 < 32) rk3 = __hip_atomic_fetch_add(hist + i3, 1, __ATOMIC_RELAXED, __HIP_MEMORY_SCOPE_WORKGROUP);
    }
    __syncthreads();
    if (tid < 32) { const int c = hist[tid]; base[tid] = c > 0 ? (int)__hip_atomic_fetch_add(SB.lcnt + bh * 32 + tid, (unsigned)c, __ATOMIC_RELAXED, __HIP_MEMORY_SCOPE_AGENT) : 0; }
    __syncthreads();
    if (hi == 0) {
        unsigned short* lb = SB.lists + (size_t)bh * LCAP;
        if (i1 < 32) lb[loff(i1) + base[i1] + rk1] = (unsigned short)(s | (0 << 13));
        if (i2 < 32) lb[loff(i2) + base[i2] + rk2] = (unsigned short)(s | (1 << 13));
        if (i3 < 32) lb[loff(i3) + base[i3] + rk3] = (unsigned short)(s | (2 << 13));
    }
    __syncthreads();
}
}
__device__ __forceinline__ int pair_lo(int p) { return p < 3 ? 0 : (p < 5 ? 1 : 2); }
__device__ __forceinline__ int pair_hi(int p) { return p < 3 ? p + 1 : (p < 5 ? p - 1 : 3); }
constexpr int LDS_TB = LDS_MISC + 64;

__device__ __forceinline__ void p_route(const Args& a, LAS unsigned char* lds, int layer, const bf16_t* h, int vcu, int G) {
    int tid = threadIdx.x; asm volatile("" : "+v"(tid));
    const int lane = tid & 63, wave = __builtin_amdgcn_readfirstlane(tid >> 6), i32 = lane & 31, kk = lane >> 5;
    unsigned char* ws = a.ws;
    LAS float* wl = (LAS float*)lds;
    {   const float* wrt = (const float*)(ws + WS_WRT) + (size_t)layer * 20480;
        for (int i = tid; i < 20480; i += NTHR) { const int k = i / 20, c = i % 20; wl[c * 1024 + k] = wrt[i]; } }
    __syncthreads();
    float* tokw = (float*)(ws + WS_TOKW); int* list = (int*)(ws + WS_LIST);
    unsigned* cnt = (unsigned*)(ws + WS_CTL) + CW_CNT + layer * 24 * 16;
    const int gw = vcu * NWAVES + wave, NGW = G * NWAVES;
    const int lrow = i32 < 4 ? i32 : (i32 < 8 ? 12 + i32 : ((i32 & 4) ? -1 : ((i32 >> 3) == 1 ? i32 - 4 : ((i32 >> 3) == 2 ? i32 - 8 : i32 - 12))));
    const LAS float* wrow = wl + (lrow < 0 ? 0 : lrow) * 1024 + 8 * kk;
    const float wmask = lrow < 0 ? 0.f : 1.f;
    for (int task = gw; task < NT / 32; task += NGW) {
        const int t = task * 32 + i32;
        const bf16_t* hrow = h + (size_t)t * 1024 + 8 * kk;
        f32x16 c = f32x16{}; float ssp = 0.f;
#pragma unroll 4
        for (int it = 0; it < 64; ++it) {
            f32x4 h0, h1; unpack8(*(const u32x4*)(hrow + 16 * it), h0, h1);
            const f32x4 w0 = *(const LAS f32x4*)(wrow + 16 * it) * wmask, w1 = *(const LAS f32x4*)(wrow + 16 * it + 4) * wmask;
            ssp += dot4(h0) + dot4(h1);
#pragma unroll
            for (int e = 0; e < 4; ++e) c = __builtin_amdgcn_mfma_f32_32x32x2f32(w0[e], h0[e], c, 0, 0, 0);
#pragma unroll
            for (int e = 0; e < 4; ++e) c = __builtin_amdgcn_mfma_f32_32x32x2f32(w1[e], h1[e], c, 0, 0, 0);
        }
        const float ss = ssp + __shfl_xor(ssp, 32);
        float ex[4];
#pragma unroll
        for (int e = 0; e < 4; ++e) ex[e] = __shfl_xor(c[e], 32);
        const float rs = rsqrtf(ss * (1.0f / 1024.0f) + EPS);
        float lg[20];
#pragma unroll
        for (int e = 0; e < 16; ++e) lg[e] = c[e] * rs;
#pragma unroll
        for (int e = 0; e < 4; ++e) lg[16 + e] = ex[e] * rs;
        int gs = 0; float gm = lg[0];
#pragma unroll
        for (int i = 1; i < 4; ++i) if (lg[i] > gm) { gm = lg[i]; gs = i; }
        float den = 0.f;
#pragma unroll
        for (int i = 0; i < 4; ++i) den += __expf(lg[i] - gm);
        const float gwt = 1.0f / den;
        float ein[4];
#pragma unroll
        for (int i = 0; i < 4; ++i) ein[i] = gs == 0 ? lg[4 + i] : (gs == 1 ? lg[8 + i] : (gs == 2 ? lg[12 + i] : lg[16 + i]));
        int i1 = 0; float e1 = ein[0];
#pragma unroll
        for (int i = 1; i < 4; ++i) if (ein[i] > e1) { e1 = ein[i]; i1 = i; }
        int i2 = -1; float e2 = 0.f;
#pragma unroll
        for (int i = 0; i < 4; ++i) if (i != i1 && (i2 < 0 || ein[i] > e2)) { e2 = ein[i]; i2 = i; }
        const float x2 = __expf(e2 - e1), w1 = gwt / (1.0f + x2), w2 = gwt * x2 / (1.0f + x2);
        const int lo = i1 < i2 ? i1 : i2, hi = i1 < i2 ? i2 : i1;
        const int pidx = lo == 0 ? hi - 1 : (lo == 1 ? hi + 1 : 5);
        const int bucket = gs * 6 + pidx;
        if (kk == 0) {
            f32x2_t wv2 = {(i1 == lo) ? w1 : w2, (i1 == lo) ? w2 : w1};
            *(f32x2_t*)(tokw + (size_t)t * 2) = wv2;
            const unsigned pos = __hip_atomic_fetch_add(cnt + bucket * 16, 1u, __ATOMIC_RELAXED, __HIP_MEMORY_SCOPE_AGENT);
            list[(size_t)bucket * NT + pos] = t;
        }
    }
    {   const float* p = a.in[1] + (size_t)layer * NT * 256; bf16_t* pb = (bf16_t*)(ws + WS_PB);
        const int gt = vcu * NTHR + tid, NGT = G * NTHR;
        for (int i = gt; i < NT * 256 / 8; i += NGT) { const f32x4 x0 = *(const f32x4*)(p + (size_t)i * 8), x1 = *(const f32x4*)(p + (size_t)i * 8 + 4); *(u32x4*)(pb + (size_t)i * 8) = pack8(x0, x1); } }
    __syncthreads();
}

__device__ __forceinline__ int moe_prefix(const Args& a, LAS unsigned char* lds, int layer) {
    LAS int* tb = (LAS int*)(lds + LDS_TB);
    if (threadIdx.x == 0) { const unsigned* cnt = (const unsigned*)(a.ws + WS_CTL) + CW_CNT + layer * 24 * 16; int s = 0;
        for (int b = 0; b < 24; ++b) { tb[b] = s; s += (int)((__hip_atomic_load(cnt + b * 16, __ATOMIC_RELAXED, __HIP_MEMORY_SCOPE_AGENT) + 255u) >> 8); }
        tb[24] = s; }
    __syncthreads();
    return __builtin_amdgcn_readfirstlane(tb[24]);
}
struct MoeUnits {
    LAS const int* tb; int NRT, G, c;
    __device__ __forceinline__ bool next(int i, Unit& u) const {
        const int L = i * G + c, rt = L >> 2; if (rt >= NRT) return false;
        int b = 0;
        for (int q = 1; q < 24; ++q) b = (tb[q] <= rt) ? q : b;
        u.pm = rt; u.pn = L & 3; u.aux = __builtin_amdgcn_readfirstlane(b); return true;
    }
};
struct MoeGuP {
    const char* A; const char* W; const int* list; const unsigned* cnt; MoeUnits U; int ldb, K;
    __device__ __forceinline__ bool next(int i, Unit& u) const { return U.next(i, u); }
    __device__ __forceinline__ void aoff(const Unit& u, const int (&R)[2], const int (&C)[2], g8::AOff& o) const {
        const int n = (int)cnt[u.aux * 16], p0 = (u.pm - __builtin_amdgcn_readfirstlane(U.tb[u.aux])) * 256;
#pragma unroll
        for (int h = 0; h < 2; ++h)
#pragma unroll
            for (int i = 0; i < 2; ++i) { int pos = p0 + h * 128 + R[i]; pos = pos < n ? pos : n - 1; const int tok = list[(size_t)u.aux * NT + pos]; o.o[h][i] = (unsigned)((tok * 1024 + C[i]) * 2); }
    }
    __device__ __forceinline__ const char* bbase(const Unit& u, int kt) const {
        const int g = u.aux / 6, pi = u.aux % 6, e = g * 4 + ((u.pn < 2) ? pair_lo(pi) : pair_hi(pi));
        return W + ((size_t)(e * 512 + (u.pn & 1) * 256) * 1024 + (size_t)kt * 64) * 2;
    }
};
struct MoeDownP {
    const char* A; const char* W; MoeUnits U; int ldb, K;
    __device__ __forceinline__ bool next(int i, Unit& u) const { return U.next(i, u); }
    __device__ __forceinline__ void aoff(const Unit& u, const int (&R)[2], const int (&C)[2], g8::AOff& o) const {
#pragma unroll
        for (int h = 0; h < 2; ++h)
#pragma unroll
            for (int i = 0; i < 2; ++i) o.o[h][i] = (unsigned)(((u.pm * 256 + h * 128 + R[i]) * 512 + C[i]) * 2);
    }
    __device__ __forceinline__ const char* bbase(const Unit& u, int kt) const {
        const int g = u.aux / 6, pi = u.aux % 6, e = g * 4 + ((kt < 4) ? pair_lo(pi) : pair_hi(pi));
        return W + ((size_t)(e * 1024 + u.pn * 256) * 256 + (size_t)(kt & 3) * 64) * 2;
    }
};
__device__ __forceinline__ float sigmoidf_fast(float x) { return __builtin_amdgcn_rcpf(1.0f + __builtin_amdgcn_exp2f(-1.4426950408889634f * x)); }

struct EpiGateUp {
    const float* hp; const float* tokw; const int* list; const unsigned* cnt; LAS const int* tb; bf16_t* act;
    __device__ __forceinline__ void operator()(const f32x4 (&acc)[2][2][4][2], const Unit& u, int wr, int wc, int fr, int fq) const {
        const int n = (int)cnt[u.aux * 16], p0 = (u.pm - __builtin_amdgcn_readfirstlane(tb[u.aux])) * 256, half = u.pn >> 1;
#pragma unroll
        for (int ai = 0; ai < 2; ++ai)
#pragma unroll
            for (int m = 0; m < 4; ++m) {
                const int r = 128 * ai + 64 * wr + 16 * m + fr; int pos = p0 + r; pos = pos < n ? pos : n - 1;
                const int tok = list[(size_t)u.aux * NT + pos];
                const float rs = row_rs<16>(hp + (size_t)tok * 16, 1.0f / 1024.0f), w = tokw[(size_t)tok * 2 + half];
                f32x4 o[2];
#pragma unroll
                for (int nn = 0; nn < 2; ++nn)
#pragma unroll
                    for (int e = 0; e < 4; ++e) { const float g = acc[ai][0][m][nn][e] * rs, up = acc[ai][1][m][nn][e] * rs; o[nn][e] = g * sigmoidf_fast(g) * up * w; }
                *(u32x4*)(act + (size_t)(u.pm * 256 + r) * 512 + half * 256 + (u.pn & 1) * 128 + 32 * wc + 8 * fq) = pack8(o[0], o[1]);
            }
    }
};
struct EpiDown {
    bf16_t* hb; float* hp; const int* list; const unsigned* cnt; LAS const int* tb;
    __device__ __forceinline__ void operator()(const f32x4 (&acc)[2][2][4][2], const Unit& u, int wr, int wc, int fr, int fq) const {
        const int n = (int)cnt[u.aux * 16], p0 = (u.pm - __builtin_amdgcn_readfirstlane(tb[u.aux])) * 256;
#pragma unroll
        for (int ai = 0; ai < 2; ++ai)
#pragma unroll
            for (int m = 0; m < 4; ++m) {
                const int r = 128 * ai + 64 * wr + 16 * m + fr, pos = p0 + r; const bool valid = pos < n;
                const int tok = list[(size_t)u.aux * NT + (valid ? pos : n - 1)];
                float ss = 0.f;
#pragma unroll
                for (int bj = 0; bj < 2; ++bj) {
                    const size_t off = (size_t)tok * 1024 + u.pn * 256 + 128 * bj + 32 * wc + 8 * fq;
                    f32x4 b0, b1; unpack8(*(const u32x4*)(hb + off), b0, b1);
                    const f32x4 v0 = acc[ai][bj][m][0] + b0, v1 = acc[ai][bj][m][1] + b1;
                    if (valid) *(u32x4*)(hb + off) = pack8(v0, v1);
                    ss += dot4(v0) + dot4(v1);
                }
                ss += __shfl_xor(ss, 16); ss += __shfl_xor(ss, 32);
                if (fq == 0 && valid) hp[(size_t)tok * 16 + u.pn * 4 + wc] = ss;
                if (m & 1) asm volatile("" ::: "memory");
            }
    }
};
struct EpiStore {
    bf16_t* O; int ldc;
    __device__ __forceinline__ void operator()(const f32x4 (&acc)[2][2][4][2], const Unit& u, int wr, int wc, int fr, int fq) const {
#pragma unroll
        for (int ai = 0; ai < 2; ++ai)
#pragma unroll
            for (int m = 0; m < 4; ++m) { const int row = u.pm * 256 + 128 * ai + 64 * wr + 16 * m + fr;
#pragma unroll
                for (int bj = 0; bj < 2; ++bj) *(u32x4*)(O + (size_t)row * ldc + u.pn * 256 + 128 * bj + 32 * wc + 8 * fq) = pack8(acc[ai][bj][m][0], acc[ai][bj][m][1]); }
    }
};
struct EpiPle {
    const float* hpin; const bf16_t* pp; const bf16_t* hbi; bf16_t* hbo; float* hp;
    __device__ __forceinline__ void operator()(const f32x4 (&acc)[2][2][4][2], const Unit& u, int wr, int wc, int fr, int fq) const {
#pragma unroll
        for (int ai = 0; ai < 2; ++ai)
#pragma unroll
            for (int m = 0; m < 4; ++m) {
                const int row = u.pm * 256 + 128 * ai + 64 * wr + 16 * m + fr;
                const float rs = row_rs<16>(hpin + (size_t)row * 16, 1.0f / 1024.0f);
                float ss = 0.f;
#pragma unroll
                for (int bj = 0; bj < 2; ++bj) {
                    const size_t off = (size_t)row * 1024 + u.pn * 256 + 128 * bj + 32 * wc + 8 * fq;
                    f32x4 p0, p1, v0, v1; unpack8(*(const u32x4*)(pp + off), p0, p1); unpack8(*(const u32x4*)(hbi + off), v0, v1);
#pragma unroll
                    for (int e = 0; e < 4; ++e) { v0[e] += sigmoidf_fast(acc[ai][bj][m][0][e] * rs) * p0[e]; v1[e] += sigmoidf_fast(acc[ai][bj][m][1][e] * rs) * p1[e]; }
                    *(u32x4*)(hbo + off) = pack8(v0, v1);
                    ss += dot4(v0) + dot4(v1);
                }
                ss += __shfl_xor(ss, 16); ss += __shfl_xor(ss, 32);
                if (fq == 0) hp[(size_t)row * 16 + u.pn * 4 + wc] = ss;
                if (m & 1) asm volatile("" ::: "memory");
            }
    }
};
__device__ __forceinline__ u32x2 pack4(f32x4 a) { u32x2 w = {cvtpk(a[0], a[1]), cvtpk(a[2], a[3])}; return w; }
struct EpiDqkv {
    const float* hp; const float* cosB; const float* sinB; bf16_t* cq; bf16_t* ckv; bf16_t* krope; float* cqp; float* kvp;
    __device__ __forceinline__ void operator()(const f32x4 (&acc)[2][2][4][2], const Unit& u, int wr, int wc, int fr, int fq) const {
#pragma unroll
        for (int ai = 0; ai < 2; ++ai)
#pragma unroll
            for (int m = 0; m < 4; ++m) {
                const int row = u.pm * 256 + 128 * ai + 64 * wr + 16 * m + fr, s = row & (NS - 1);
                const float rs = row_rs<16>(hp + (size_t)row * 16, 1.0f / 1024.0f);
                if (u.pn < 2) {
                    float ss = 0.f;
#pragma unroll
                    for (int bj = 0; bj < 2; ++bj) { const f32x4 v0 = acc[ai][bj][m][0] * rs, v1 = acc[ai][bj][m][1] * rs; ss += dot4(v0) + dot4(v1);
                        const int c = 128 * bj + 32 * wc + 8 * fq;
                        if (u.pn == 0) *(u32x4*)(cq + (size_t)row * 384 + c) = pack8(v0, v1); else *(u32x4*)(ckv + (size_t)row * 256 + c) = pack8(v0, v1); }
                    ss += __shfl_xor(ss, 16); ss += __shfl_xor(ss, 32);
                    if (fq == 0) { if (u.pn == 0) cqp[(size_t)row * 8 + wc] = ss; else kvp[(size_t)row * 4 + wc] = ss; }
                } else {
                    const f32x4 v0 = acc[ai][0][m][0] * rs, v1 = acc[ai][0][m][1] * rs;
                    float ss = dot4(v0) + dot4(v1);
                    *(u32x4*)(cq + (size_t)row * 384 + 256 + 32 * wc + 8 * fq) = pack8(v0, v1);
                    ss += __shfl_xor(ss, 16); ss += __shfl_xor(ss, 32);
                    if (fq == 0) cqp[(size_t)row * 8 + 4 + wc] = ss;
                    if (wc < 2) {
                        const int j = 16 * wc + 4 * fq;
                        const f32x4 cs = *(const f32x4*)(cosB + (size_t)s * 32 + j), sn = *(const f32x4*)(sinB + (size_t)s * 32 + j);
                        const f32x4 x1 = acc[ai][1][m][0] * rs, x2 = acc[ai][1][m][1] * rs;
                        *(u32x2*)(krope + (size_t)row * 64 + j) = pack4(x1 * cs - x2 * sn);
                        *(u32x2*)(krope + (size_t)row * 64 + 32 + j) = pack4(x1 * sn + x2 * cs);
                    }
                }
            }
    }
};
struct EpiUq {
    const float* cqp; const float* cosB; const float* sinB; bf16_t* q;
    __device__ __forceinline__ void operator()(const f32x4 (&acc)[2][2][4][2], const Unit& u, int wr, int wc, int fr, int fq) const {
        const int bb = u.pm >> 5;
#pragma unroll
        for (int ai = 0; ai < 2; ++ai)
#pragma unroll
            for (int m = 0; m < 4; ++m) {
                const int row = u.pm * 256 + 128 * ai + 64 * wr + 16 * m + fr, s = row & (NS - 1);
                const float rs = row_rs<8>(cqp + (size_t)row * 8, 1.0f / 384.0f);
#pragma unroll
                for (int bj = 0; bj < 2; ++bj) {
                    if (u.pn < 4) {
                        const int hh = 2 * u.pn + bj;
                        *(u32x4*)(q + ((size_t)(bb * NH + hh) * NS + s) * 192 + 32 * wc + 8 * fq) = pack8(acc[ai][bj][m][0] * rs, acc[ai][bj][m][1] * rs);
                    } else {
                        const int gidx = bj * 4 + wc, hh = 4 * (u.pn - 4) + (gidx >> 1), j = 16 * (gidx & 1) + 4 * fq;
                        const f32x4 cs = *(const f32x4*)(cosB + (size_t)s * 32 + j), sn = *(const f32x4*)(sinB + (size_t)s * 32 + j);
                        const f32x4 x1 = acc[ai][bj][m][0] * rs, x2 = acc[ai][bj][m][1] * rs;
                        bf16_t* d = q + ((size_t)(bb * NH + hh) * NS + s) * 192 + 128 + j;
                        *(u32x2*)d = pack4(x1 * cs - x2 * sn); *(u32x2*)(d + 32) = pack4(x1 * sn + x2 * cs);
                    }
                }
            }
    }
};
struct EpiUkv {
    const float* kvp; bf16_t* kn; bf16_t* v;
    __device__ __forceinline__ void operator()(const f32x4 (&acc)[2][2][4][2], const Unit& u, int wr, int wc, int fr, int fq) const {
        const int bb = u.pm >> 5;
#pragma unroll
        for (int ai = 0; ai < 2; ++ai)
#pragma unroll
            for (int m = 0; m < 4; ++m) {
                const int row = u.pm * 256 + 128 * ai + 64 * wr + 16 * m + fr, s = row & (NS - 1);
                const float rs = row_rs<4>(kvp + (size_t)row * 4, 1.0f / 256.0f);
                const size_t o = ((size_t)(bb * NH + u.pn) * NS + s) * 128 + 32 * wc + 8 * fq;
                *(u32x4*)(kn + o) = pack8(acc[ai][0][m][0] * rs, acc[ai][0][m][1] * rs);
                *(u32x4*)(v + o) = pack8(acc[ai][1][m][0] * rs, acc[ai][1][m][1] * rs);
            }
    }
};

struct WConv { const float* src0; const float* src1; const float* gain; bf16_t* dst; int N0, N1, K, Nout, kind; };
__device__ __forceinline__ int colmap(int kind, int n) {
    switch (kind) {
    case 1: {
        const int pn = n >> 8; if (pn >= 8) return n;
        const int t = pn >> 2, bj = (n >> 7) & 1, r = n & 127, hh = 2 * (pn & 3) + (r >> 6), d = 64 * bj + (r & 63);
        return t * 1024 + hh * 128 + d; }
    case 2: {
        if (n < 256) return n;
        if (n < 512) return 384 + (n - 256);
        if (n < 640) return 256 + (n - 512);
        const int r = n - 640, wc = r >> 5, fq = (r >> 3) & 3, nn = (r >> 2) & 1, i = r & 3;
        if (wc >= 2) return -1;
        return 384 + 256 + 32 * nn + 16 * wc + 4 * fq + i; }
    case 3: {
        if (n < 1024) return (n >> 7) * 192 + (n & 127);
        const int m = n - 1024, pn4 = m >> 8, gidx = (m >> 5) & 7, fq = (m >> 3) & 3, nn = (m >> 2) & 1, i = m & 3;
        const int hh = 4 * pn4 + (gidx >> 1), j = 16 * (gidx & 1) + 4 * fq + i;
        return hh * 192 + 128 + 32 * nn + j; }
    case 4: {
        const int q = n >> 8, bj = (n >> 7) & 1, r = n & 127;
        return bj * 256 + 128 * q + r; }
    default: return n;
    }
}
__device__ __forceinline__ void conv_item(const WConv& w, LAS float* scr, int item, int lane) {
    const int nblk = w.Nout / 32, kb = item / nblk, nb = item % nblk, k0 = 64 * kb, n0 = 32 * nb;
    const int n4 = lane & 7, ks = lane >> 3;
    const int s = colmap(w.kind, n0 + 4 * n4);
    const bool z = s < 0, first = s < w.N0;
    const float* sp = first ? w.src0 + s : w.src1 + (s - w.N0);
    const int ld = first ? w.N0 : w.N1;
    f32x4 v[8];
#pragma unroll
    for (int it = 0; it < 8; ++it) { const int k = it * 8 + ks; v[it] = z ? (f32x4){0.f, 0.f, 0.f, 0.f} : *(const f32x4*)(sp + (size_t)(k0 + k) * ld); }
#pragma unroll
    for (int it = 0; it < 8; ++it) { const int k = it * 8 + ks; const float g = w.gain ? w.gain[k0 + k] : 1.0f;
#pragma unroll
        for (int e = 0; e < 4; ++e) scr[k * 33 + 4 * n4 + e] = v[it][e] * g; }
    asm volatile("s_waitcnt lgkmcnt(0)" ::: "memory");
    const int c = lane & 7;
#pragma unroll
    for (int j = 0; j < 4; ++j) { const int n = (lane >> 3) + 8 * j; const LAS float* sv = scr + (8 * c) * 33 + n;
        u32x4 o; o.x = cvtpk(sv[0 * 33], sv[1 * 33]); o.y = cvtpk(sv[2 * 33], sv[3 * 33]); o.z = cvtpk(sv[4 * 33], sv[5 * 33]); o.w = cvtpk(sv[6 * 33], sv[7 * 33]);
        *(u32x4*)(w.dst + (size_t)(n0 + n) * w.K + k0 + 8 * c) = o; }
    asm volatile("s_waitcnt lgkmcnt(0)" ::: "memory");
}
__device__ __forceinline__ bool get_conv(int mi, const Args& a, WConv& w) {
    unsigned char* ws = a.ws;
    w.src1 = nullptr; w.N1 = 0; w.gain = nullptr; w.kind = 0;
    if (mi == 0) { w.src0 = a.in[6]; w.N0 = 3072; w.K = 1024; w.Nout = 3072; w.kind = 1; w.gain = a.in[2]; w.dst = (bf16_t*)(ws + WS_WQKV0); return true; }
    if (mi == 1) { w.src0 = a.in[7]; w.N0 = 1024; w.K = 1024; w.Nout = 1024; w.dst = (bf16_t*)(ws + WS_WO0); return true; }
    if (mi == 2) { w.src0 = a.in[8]; w.N0 = 384; w.src1 = a.in[11]; w.N1 = 320; w.K = 1024; w.Nout = 768; w.kind = 2; w.gain = a.in[2] + 1024; w.dst = (bf16_t*)(ws + WS_WDQKV); return true; }
    if (mi == 3) { w.src0 = a.in[10]; w.N0 = 1536; w.K = 384; w.Nout = 1536; w.kind = 3; w.gain = a.in[9]; w.dst = (bf16_t*)(ws + WS_WUQ); return true; }
    if (mi == 4) { w.src0 = a.in[13]; w.N0 = 2048; w.K = 256; w.Nout = 2048; w.gain = a.in[12]; w.dst = (bf16_t*)(ws + WS_WUKV); return true; }
    if (mi == 5) { w.src0 = a.in[14]; w.N0 = 1024; w.K = 1024; w.Nout = 1024; w.dst = (bf16_t*)(ws + WS_WO1); return true; }
    if (mi < 38) { const int le = mi - 6, l = le >> 4;
        w.src0 = a.in[17] + (size_t)le * 1024 * 256; w.N0 = 256; w.src1 = a.in[18] + (size_t)le * 1024 * 256; w.N1 = 256; w.K = 1024; w.Nout = 512; w.kind = 4;
        w.gain = a.in[3] + l * 1024; w.dst = (bf16_t*)(ws + WS_WGU) + (size_t)le * 512 * 1024; return true; }
    if (mi < 70) { const int le = mi - 38;
        w.src0 = a.in[19] + (size_t)le * 256 * 1024; w.N0 = 1024; w.K = 256; w.Nout = 1024; w.dst = (bf16_t*)(ws + WS_WD) + (size_t)le * 1024 * 256; return true; }
    if (mi < 72) { const int l = mi - 70;
        w.src0 = a.in[20] + (size_t)l * 1024 * 1024; w.N0 = 1024; w.K = 1024; w.Nout = 1024; w.gain = a.in[4] + l * 1024; w.dst = (bf16_t*)(ws + WS_WPG) + (size_t)l * 1024 * 1024; return true; }
    if (mi < 74) { const int l = mi - 72;
        w.src0 = a.in[21] + (size_t)l * 256 * 1024; w.N0 = 1024; w.K = 256; w.Nout = 1024; w.dst = (bf16_t*)(ws + WS_WPP) + (size_t)l * 1024 * 256; return true; }
    return false;
}

__device__ __forceinline__ void p_prologue(const Args& a, LAS unsigned char* lds, int vcu, int G) {
    int tid = threadIdx.x; asm volatile("" : "+v"(tid));
    const int lane = tid & 63, wave = __builtin_amdgcn_readfirstlane(tid >> 6);
    const int gw = vcu * NWAVES + wave, NGW = G * NWAVES;
    unsigned char* ws = a.ws;
    LAS float* scr = (LAS float*)(lds + wave * 16384);
    int base = 0;
    for (int mi = 0; mi < 74; ++mi) {
        WConv w; get_conv(mi, a, w);
        const int n = (w.K / 64) * (w.Nout / 32);
        int it = (gw - (base % NGW) + NGW) % NGW;
        for (; it < n; it += NGW) conv_item(w, scr, it, lane);
        base += n;
    }
    {   const float* x = a.in[0]; bf16_t* hb = (bf16_t*)(ws + WS_HB); float* hpx = (float*)(ws + WS_HPX);
        for (int m = gw; m < NT; m += 2 * NGW) {
            const int m2 = (m + NGW < NT) ? m + NGW : m;
            const f32x4* xr = (const f32x4*)(x + (size_t)m * 1024) + lane; const f32x4* xr2 = (const f32x4*)(x + (size_t)m2 * 1024) + lane;
            f32x4 v[4], v2[4]; float s = 0.f, s2 = 0.f;
#pragma unroll
            for (int j = 0; j < 4; ++j) { v[j] = xr[64 * j]; v2[j] = xr2[64 * j]; }
#pragma unroll
            for (int j = 0; j < 4; ++j) { s += dot4(v[j]); s2 += dot4(v2[j]); }
            s = wave_sum(s); s2 = wave_sum(s2);
            u32x2* o8 = (u32x2*)(hb + (size_t)m * 1024) + lane; u32x2* o82 = (u32x2*)(hb + (size_t)m2 * 1024) + lane;
#pragma unroll
            for (int j = 0; j < 4; ++j) { u32x2 o; o.x = cvtpk(v[j][0], v[j][1]); o.y = cvtpk(v[j][2], v[j][3]); o8[64 * j] = o;
                                          u32x2 o2; o2.x = cvtpk(v2[j][0], v2[j][1]); o2.y = cvtpk(v2[j][2], v2[j][3]); o82[64 * j] = o2; }
            if (lane < 16) { hpx[(size_t)m * 16 + lane] = (lane == 0) ? s : 0.f; hpx[(size_t)m2 * 16 + lane] = (lane == 0) ? s2 : 0.f; }
        } }
    {   const int gt = (vcu * NTHR) + tid, NGT = G * NTHR;
        float* cosA = (float*)(ws + WS_COSA); float* sinA = (float*)(ws + WS_SINA); float* cosB = (float*)(ws + WS_COSB); float* sinB = (float*)(ws + WS_SINB);
        for (int i = gt; i < NS * 64; i += NGT) { const int s = i >> 6, j = i & 63; const float inv = powf(10000.0f, -(float)j / 64.0f); float sn, cs; sincosf((float)s * inv, &sn, &cs); cosA[i] = cs; sinA[i] = sn; }
        for (int i = gt; i < NS * 32; i += NGT) { const int s = i >> 5, j = i & 31; const float inv = powf(10000.0f, -(float)j / 32.0f); float sn, cs; sincosf((float)s * inv, &sn, &cs); cosB[i] = cs; sinB[i] = sn; }
        float* km = (float*)(ws + WS_KMEAN);
        for (int i = gt; i < NB * NH * 32 * 128; i += NGT) km[i] = 0.f;
        float* wrt = (float*)(ws + WS_WRT);
        for (int i = gt; i < 2 * 1024 * 20; i += NGT) { const int l = i / 20480, r = i % 20480, k = r / 20, c = r % 20;
            const float g = a.in[3][l * 1024 + k];
            wrt[i] = g * (c < 4 ? a.in[15][(size_t)(l * 1024 + k) * 4 + c] : a.in[16][(size_t)(l * 1024 + k) * 16 + (c - 4)]); }
    }
}

__device__ __forceinline__ at::SparseBufs sparse_bufs(const Args& a) {
    unsigned char* ws = a.ws;
    at::SparseBufs SB;
    SB.lists = (unsigned short*)(ws + WS_R + 200 * MiB); SB.lcnt = (unsigned*)(ws + WS_CTL) + CW_LCNT; SB.selinfo = (unsigned*)(ws + WS_R + 210 * MiB);
    SB.ml = (float*)(ws + WS_R + 192 * MiB); SB.part01 = (unsigned char*)a.out; SB.part2 = ws + WS_PART2;
    return SB;
}
__device__ __forceinline__ void p_attention_mla(const Args& a, unsigned char* ldsg) {
    unsigned char* ws = a.ws;
    const at::SparseBufs SB = sparse_bufs(a);
    for (int L = blockIdx.x; L < 512; L += gridDim.x) {
        const int xcd = L & 7, k = L >> 3, bh = xcd + 8 * (k >> 4), x = k & 15, b = bh >> 3, h = bh & 7;
        for (int pass = 0; pass < 2; ++pass) {
            const int qb = pass ? x : 31 - x, P0 = qb * 256;
            at::AttnP A;
            A.Qp = (const bf16_t*)(ws + WS_Q) + ((size_t)bh * NS + P0) * 192; A.Kn = (const bf16_t*)(ws + WS_KN1) + (size_t)bh * NS * 128;
            A.Kr = (const bf16_t*)(ws + WS_KROPE) + (size_t)b * NS * 64; A.Vp = (const bf16_t*)(ws + WS_V1) + (size_t)bh * NS * 128;
            A.Op = (bf16_t*)(ws + WS_O) + ((size_t)(b * NS + P0) * 1024 + h * 128); A.P0 = P0; A.t0 = 0; A.NT = (P0 + 256) / 64; A.bh = bh; A.nent = 0; A.ents = nullptr;
            at::attn_unit<192, 0>((char*)ldsg, A, SB);
        }
    }
}
__device__ __forceinline__ void p_moba_gate(const Args& a, unsigned char* ldsg) {
    unsigned char* ws = a.ws;
    const at::SparseBufs SB = sparse_bufs(a);
    for (int L = blockIdx.x; L < 1024; L += gridDim.x) {
        const int bh = L >> 5, qb = L & 31;
        at::gate_unit((char*)ldsg, (const bf16_t*)(ws + WS_Q) + ((size_t)bh * NS + qb * 256) * 128, (const float*)(ws + WS_KMEAN) + (size_t)bh * 32 * 128, bh, qb, SB);
    }
}
constexpr int MOBA_PART = 512;
__device__ __forceinline__ void p_moba_gather(const Args& a, unsigned char* ldsg) {
    unsigned char* ws = a.ws;
    const at::SparseBufs SB = sparse_bufs(a);
    int tid = threadIdx.x; asm volatile("" : "+v"(tid));
    int* pre = (int*)(ldsg + 139264); int* seg = pre + 1032;
    if (tid < 32) { int s = 0; for (int j = 0; j < 32; ++j) s += (int)((SB.lcnt[tid * 32 + j] + (MOBA_PART - 1)) / MOBA_PART); seg[tid] = s; }
    __syncthreads();
    if (tid < 32) { int s = 0; for (int j = 0; j < tid; ++j) s += seg[j];
        for (int j = 0; j < 32; ++j) { pre[tid * 32 + j] = s; s += (int)((SB.lcnt[tid * 32 + j] + (MOBA_PART - 1)) / MOBA_PART); }
        if (tid == 31) pre[1024] = s; }
    __syncthreads();
    const int NU = __builtin_amdgcn_readfirstlane(pre[1024]);
    for (int u = blockIdx.x; u < NU; u += gridDim.x) {
        int lo = 0, hi = 1024;
        while (hi - lo > 1) { const int mid = (lo + hi) >> 1; if (pre[mid] <= u) lo = mid; else hi = mid; }
        const int li = __builtin_amdgcn_readfirstlane(lo), c = u - __builtin_amdgcn_readfirstlane(pre[lo]), bh = li >> 5, n = li & 31;
        const int cnt = (int)SB.lcnt[li], nrows = (cnt - MOBA_PART * c) < MOBA_PART ? (cnt - MOBA_PART * c) : MOBA_PART;
        at::moba_gather_unit((char*)ldsg, (const bf16_t*)(ws + WS_Q) + (size_t)bh * NS * 128, (const bf16_t*)(ws + WS_K0) + (size_t)bh * NS * 128, (const bf16_t*)(ws + WS_V0) + (size_t)bh * NS * 128,
                             bh, n, SB.lists + (size_t)bh * at::LCAP + at::loff(n) + MOBA_PART * c, nrows, SB);
    }
}
__device__ __forceinline__ void p_moba_own(const Args& a, unsigned char* ldsg) {
    unsigned char* ws = a.ws;
    const at::SparseBufs SB = sparse_bufs(a);
    for (int L = blockIdx.x; L < 1024; L += gridDim.x) {
        const int bh = L >> 5, qb = L & 31;
        at::moba_own_unit((char*)ldsg, (const bf16_t*)(ws + WS_Q) + (size_t)bh * NS * 128, (const bf16_t*)(ws + WS_K0) + (size_t)bh * NS * 128, (const bf16_t*)(ws + WS_V0) + (size_t)bh * NS * 128,
                          (bf16_t*)(ws + WS_O), bh, qb, SB);
    }
}

__global__ void __launch_bounds__(NTHR, 2) mega(Args a) {
    extern __shared__ __attribute__((aligned(16))) unsigned char lds_g[];
    LAS unsigned char* lds = (LAS unsigned char*)lds_g;
    const int tid = threadIdx.x;
    const int G = gridDim.x, bx = blockIdx.x, vcu = (G % 8 == 0) ? (bx % 8) * (G / 8) + bx / 8 : bx;
    unsigned char* ws = a.ws;
    volatile LAS unsigned* MISC = (volatile LAS unsigned*)(lds + LDS_MISC);
    for (int u = tid; u < 256; u += NTHR) MISC[u] = 0u;
    __syncthreads();
    XcdBarrier bar = xcd_barrier_post((unsigned*)(ws + WS_CTL) + CW_BAR, MISC);
    const int lo = a.ph_lo, hi = a.ph_hi;
#ifndef DBG_ONLY
#define DBG_EN(k) true
#else
#define DBG_EN(k) ((k) == DBG_ONLY)
#endif
#define IN(k) (DBG_EN(k) && lo <= (k) && (k) < hi)
#define SEAM(k) do { if (IN(k) && IN((k) + 1)) xcd_barrier(bar); } while (0)
    if (IN(0)) { p_prologue(a, lds, vcu, G); }
    SEAM(0);
    if (IN(1)) {
        g8::DenseP P{(const char*)(ws + WS_HB), (const char*)(ws + WS_WQKV0), 1024, 1024, 1024, NT / 256, 3072 / 256, G, bx};
        EpiQKV E{(const float*)(ws + WS_HPX), (const float*)(ws + WS_COSA), (const float*)(ws + WS_SINA), (bf16_t*)(ws + WS_Q), (bf16_t*)(ws + WS_K0), (bf16_t*)(ws + WS_V0), (float*)(ws + WS_KMEAN)};
        g8::gemm_phase(lds, P, E);
    }
    SEAM(1);
    if (IN(2)) { p_moba_gate(a, lds_g); }
    SEAM(2);
    if (IN(3)) { p_moba_gather(a, lds_g); }
    SEAM(3);
    if (IN(4)) { p_moba_own(a, lds_g); }
    SEAM(4);
    if (IN(5)) {
        g8::DenseP P{(const char*)(ws + WS_O), (const char*)(ws + WS_WO0), 1024, 1024, 1024, NT / 256, 4, G, bx};
        EpiResid E{(const bf16_t*)(ws + WS_HB), (bf16_t*)(ws + WS_HB), (float*)(ws + WS_HP0)};
        g8::gemm_phase(lds, P, E);
    }
    SEAM(5);
#define MOE_PLE(PB, layer, HBC, HBN) \
    if (IN((PB) + 0)) { p_route(a, lds, (layer), (const bf16_t*)(HBC), vcu, G); } \
    SEAM((PB) + 0); \
    if (IN((PB) + 1)) { \
        const int NRT = moe_prefix(a, lds, (layer)); \
        const unsigned* cnt = (const unsigned*)(ws + WS_CTL) + CW_CNT + (layer) * 24 * 16; \
        MoeUnits U{(LAS const int*)(lds + LDS_TB), NRT, G, bx}; \
        MoeGuP P{(const char*)(HBC), (const char*)(ws + WS_WGU) + (size_t)(layer) * 16 * 512 * 1024 * 2, (const int*)(ws + WS_LIST), cnt, U, 1024, 1024}; \
        EpiGateUp E{(const float*)(ws + WS_HP0), (const float*)(ws + WS_TOKW), (const int*)(ws + WS_LIST), cnt, (LAS const int*)(lds + LDS_TB), (bf16_t*)(ws + WS_ACT)}; \
        g8::gemm_phase(lds, P, E); \
        g8::DenseP P2{(const char*)(ws + WS_PB), (const char*)(ws + WS_WPP) + (size_t)(layer) * 1024 * 256 * 2, 256, 256, 256, NT / 256, 4, G, bx}; \
        EpiStore E2{(bf16_t*)(ws + WS_PP), 1024}; \
        g8::gemm_phase(lds, P2, E2); \
    } \
    SEAM((PB) + 1); \
    if (IN((PB) + 2)) { \
        const int NRT = moe_prefix(a, lds, (layer)); \
        const unsigned* cnt = (const unsigned*)(ws + WS_CTL) + CW_CNT + (layer) * 24 * 16; \
        MoeUnits U{(LAS const int*)(lds + LDS_TB), NRT, G, bx}; \
        MoeDownP P{(const char*)(ws + WS_ACT), (const char*)(ws + WS_WD) + (size_t)(layer) * 16 * 1024 * 256 * 2, U, 256, 512}; \
        EpiDown E{(bf16_t*)(HBC), (float*)(ws + WS_HP1), (const int*)(ws + WS_LIST), cnt, (LAS const int*)(lds + LDS_TB)}; \
        g8::gemm_phase(lds, P, E); \
    } \
    SEAM((PB) + 2); \
    if (IN((PB) + 3)) { \
        g8::DenseP P{(const char*)(HBC), (const char*)(ws + WS_WPG) + (size_t)(layer) * 1024 * 1024 * 2, 1024, 1024, 1024, NT / 256, 4, G, bx}; \
        EpiPle E{(const float*)(ws + WS_HP1), (const bf16_t*)(ws + WS_PP), (const bf16_t*)(HBC), (bf16_t*)(HBN), (float*)(ws + WS_HP2)}; \
        g8::gemm_phase(lds, P, E); \
    } \
    SEAM((PB) + 3);
    MOE_PLE(6, 0, ws + WS_HB, a.out)
    if (IN(10)) {
        g8::DenseP P{(const char*)a.out, (const char*)(ws + WS_WDQKV), 1024, 1024, 1024, NT / 256, 3, G, bx};
        EpiDqkv E{(const float*)(ws + WS_HP2), (const float*)(ws + WS_COSB), (const float*)(ws + WS_SINB), (bf16_t*)(ws + WS_CQ), (bf16_t*)(ws + WS_CKV), (bf16_t*)(ws + WS_KROPE), (float*)(ws + WS_CQP), (float*)(ws + WS_KVP)};
        g8::gemm_phase(lds, P, E);
    }
    SEAM(10);
    if (IN(11)) {
        g8::DenseP P{(const char*)(ws + WS_CQ), (const char*)(ws + WS_WUQ), 384, 384, 384, NT / 256, 6, G, bx};
        EpiUq E{(const float*)(ws + WS_CQP), (const float*)(ws + WS_COSB), (const float*)(ws + WS_SINB), (bf16_t*)(ws + WS_Q)};
        g8::gemm_phase(lds, P, E);
        g8::DenseP P2{(const char*)(ws + WS_CKV), (const char*)(ws + WS_WUKV), 256, 256, 256, NT / 256, 8, G, bx};
        EpiUkv E2{(const float*)(ws + WS_KVP), (bf16_t*)(ws + WS_KN1), (bf16_t*)(ws + WS_V1)};
        g8::gemm_phase(lds, P2, E2);
    }
    SEAM(11);
    if (IN(12)) { p_attention_mla(a, lds_g); }
    SEAM(12);
    if (IN(13)) {
        g8::DenseP P{(const char*)(ws + WS_O), (const char*)(ws + WS_WO1), 1024, 1024, 1024, NT / 256, 4, G, bx};
        EpiResid E{(const bf16_t*)a.out, (bf16_t*)a.out, (float*)(ws + WS_HP0)};
        g8::gemm_phase(lds, P, E);
    }
    SEAM(13);
    MOE_PLE(14, 1, a.out, ws + WS_HB)
    if (IN(18)) {
        int t2 = threadIdx.x; asm volatile("" : "+v"(t2)); const int lane = t2 & 63, wave = t2 >> 6; const float* fg = a.in[5];
        const bf16_t* hfin = (const bf16_t*)(ws + WS_HB);
        for (int mrow = vcu * NWAVES + wave; mrow < NT; mrow += G * NWAVES) {
            f32x4 v[4]; float s = 0.f;
#pragma unroll
            for (int j = 0; j < 2; ++j) { unpack8(*((const u32x4*)(hfin + (size_t)mrow * 1024) + lane + 64 * j), v[2 * j], v[2 * j + 1]); s += dot4(v[2 * j]) + dot4(v[2 * j + 1]); }
            s = wave_sum(s);
            const float r = rsqrtf(s * (1.0f / 1024.0f) + EPS);
            f32x4* xr = (f32x4*)(a.out + (size_t)mrow * 1024);
#pragma unroll
            for (int j = 0; j < 2; ++j) { const int c4 = 2 * (lane + 64 * j);
                xr[c4] = v[2 * j] * r * *((const f32x4*)fg + c4); xr[c4 + 1] = v[2 * j + 1] * r * *((const f32x4*)fg + c4 + 1); }
        }
    }
#undef IN
#undef SEAM
}

constexpr int N_PHASES = 19;
static int g_grid = 0;
static bool setup() {
    if (g_grid) return g_grid > 0;
    int dev = 0, cus = 0;
    if (hipGetDevice(&dev) != hipSuccess || hipDeviceGetAttribute(&cus, hipDeviceAttributeMultiprocessorCount, dev) != hipSuccess) { g_grid = -1; return false; }
    if (hipFuncSetAttribute((const void*)mega, hipFuncAttributeMaxDynamicSharedMemorySize, LDS_BYTES) != hipSuccess) { fprintf(stderr, "hipFuncSetAttribute failed\n"); g_grid = -1; return false; }
    int per_cu = 0;
    if (hipOccupancyMaxActiveBlocksPerMultiprocessor(&per_cu, (const void*)mega, NTHR, LDS_BYTES) != hipSuccess || per_cu < 1) { fprintf(stderr, "occupancy query: %d\n", per_cu); }
    (void)hipGetLastError();
    g_grid = cus;
    return true;
}
static void run_phases(const Args& base, int lo, int hi, bool one_launch, hipStream_t st) {
    if (one_launch) { Args a = base; a.ph_lo = lo; a.ph_hi = hi; hipLaunchKernelGGL(mega, dim3(g_grid), dim3(NTHR), LDS_BYTES, st, a); }
    else for (int p = lo; p < hi; ++p) { Args a = base; a.ph_lo = p; a.ph_hi = p + 1;
#ifdef PROBE_ROUTE
        if (p == 6) { Args b = base; b.ph_lo = 14; b.ph_hi = 15; hipLaunchKernelGGL(mega, dim3(g_grid), dim3(NTHR), LDS_BYTES, st, b); }
        if (p == 14) (void)hipMemsetAsync(base.ws + WS_CTL + (CW_CNT + 24 * 16) * 4, 0, 24 * 16 * 4, st);
#endif
        hipLaunchKernelGGL(mega, dim3(g_grid), dim3(NTHR), LDS_BYTES, st, a);
#ifdef DOUBLE_PHASE
        if (p == DOUBLE_PHASE) hipLaunchKernelGGL(mega, dim3(g_grid), dim3(NTHR), LDS_BYTES, st, a);
#endif
    }
}
}
#ifndef ONE_LAUNCH
#define ONE_LAUNCH 1
#endif
extern "C" void kernel_launch(void* const* d_in, const int* in_sizes, int n_in, void* d_out, int out_size, void* d_ws, size_t ws_size, hipStream_t stream) {
    (void)in_sizes; (void)out_size;
    if (n_in != 22) { fprintf(stderr, "kernel_launch: expected 22 inputs, got %d\n", n_in); return; }
    if (ws_size < fk::WS_END) { fprintf(stderr, "kernel_launch: workspace too small (%zu)\n", ws_size); return; }
    if (!fk::setup()) return;
    (void)hipMemsetAsync((char*)d_ws + fk::WS_CTL, 0, fk::CTL_ZERO_BYTES, stream);
    fk::Args a{};
    for (int i = 0; i < 22; ++i) a.in[i] = (const float*)d_in[i];
    a.out = (float*)d_out; a.ws = (unsigned char*)d_ws;
    fk::run_phases(a, 0, fk::N_PHASES, ONE_LAUNCH != 0, stream);
}
```

```cpp
#include <hip/hip_runtime.h>
#include <cstdio>
#include <cstdint>
#include <cmath>
namespace fk {
#define LAS __attribute__((address_space(3)))
#define GAS __attribute__((address_space(1)))
typedef unsigned short bf16_t;
typedef short bf16x8 __attribute__((ext_vector_type(8)));
typedef short s16x4 __attribute__((ext_vector_type(4)));
typedef float f32x4 __attribute__((ext_vector_type(4)));
typedef float f32x16 __attribute__((ext_vector_type(16)));
typedef unsigned u32x4 __attribute__((ext_vector_type(4)));
typedef unsigned u32x2 __attribute__((ext_vector_type(2)));
typedef float f32x2_t __attribute__((ext_vector_type(2)));
typedef __bf16 bf16x2_t __attribute__((ext_vector_type(2)));

constexpr int NB = 4, NS = 8192, ND = 1024, NT = NB * NS, NH = 8;
constexpr float EPS = 1e-6f;
constexpr int NWAVES = 8, NTHR = 512;

constexpr size_t MiB = 1u << 20;
constexpr size_t WS_CTL = 0, CTL_ZERO_BYTES = 1 * MiB;
constexpr size_t WS_COSA = 1 * MiB, WS_SINA = 3 * MiB, WS_COSB = 5 * MiB, WS_SINB = 6 * MiB;
constexpr size_t WS_KMEAN = 7 * MiB;
constexpr size_t WS_WRT = 7 * MiB + 512 * 1024;
constexpr size_t WS_HPX = 8 * MiB, WS_HP0 = 10 * MiB, WS_HP1 = 12 * MiB, WS_HP2 = 14 * MiB;
constexpr size_t WS_CQP = 16 * MiB, WS_KVP = 17 * MiB;
constexpr size_t WS_TOKW = 18 * MiB;
constexpr size_t WS_LIST = 19 * MiB;
constexpr size_t WS_WQKV0 = 24 * MiB, WS_WO0 = 30 * MiB, WS_WDQKV = 32 * MiB, WS_WUQ = 34 * MiB, WS_WUKV = 36 * MiB, WS_WO1 = 37 * MiB;
constexpr size_t WS_WGU = 40 * MiB;
constexpr size_t WS_WD = 72 * MiB;
constexpr size_t WS_WPG = 88 * MiB;
constexpr size_t WS_WPP = 92 * MiB;
constexpr size_t WS_HB = 94 * MiB;
constexpr size_t WS_CQ = WS_HB, WS_CKV = WS_HB + 24 * MiB, WS_KROPE = WS_HB + 40 * MiB;
constexpr size_t WS_O = 158 * MiB;
constexpr size_t WS_R = 222 * MiB;
constexpr size_t WS_Q = WS_R, WS_K0 = WS_R + 64 * MiB, WS_V0 = WS_R + 128 * MiB;
constexpr size_t WS_KN1 = WS_R + 96 * MiB, WS_V1 = WS_R + 160 * MiB;
constexpr size_t WS_ACT = WS_R, WS_PB = WS_R + 40 * MiB, WS_PP = WS_R + 64 * MiB;
constexpr size_t WS_PART2 = WS_R + 224 * MiB;
constexpr size_t WS_END = WS_PART2 + 64 * MiB;
constexpr int CW_CNT = 1024;
constexpr int CW_BAR = 4096;
constexpr int CW_LCNT = 8192;

constexpr int RING_BYTES = 131072;
constexpr int LDS_MISC = RING_BYTES;
constexpr int LDS_BYTES = 147456;

struct Args { const float* in[22]; float* out; unsigned char* ws; int ph_lo, ph_hi; };

__device__ __forceinline__ unsigned cvtpk(float lo, float hi) { f32x2_t v = {lo, hi}; bf16x2_t b = __builtin_convertvector(v, bf16x2_t); return __builtin_bit_cast(unsigned, b); }
__device__ __forceinline__ float bf2f(unsigned short b) { return __builtin_bit_cast(float, (unsigned)b << 16); }
__device__ __forceinline__ u32x4 pack8(f32x4 a, f32x4 b) { u32x4 w = {cvtpk(a[0], a[1]), cvtpk(a[2], a[3]), cvtpk(b[0], b[1]), cvtpk(b[2], b[3])}; return w; }
__device__ __forceinline__ float wave_sum(float v) {
#pragma unroll
    for (int o = 1; o < 64; o <<= 1) v += __shfl_xor(v, o);
    return v;
}
__device__ __forceinline__ float dot4(f32x4 a) { return (a[0] * a[0] + a[1] * a[1]) + (a[2] * a[2] + a[3] * a[3]); }
template <int NP> __device__ __forceinline__ float row_rs(const float* hp, float invd) {
    float s = 0.f;
#pragma unroll
    for (int i = 0; i < NP / 4; ++i) { const f32x4 a = *(const f32x4*)(hp + 4 * i); s += (a[0] + a[1]) + (a[2] + a[3]); }
    return rsqrtf(s * invd + EPS);
}

#define XB_TMO      128
#define XB_XCNT(j)  (256  + 64 * (j))
#define XB_XSUB(j)  (1280 + 64 * (j))
#define XB_XGEN(j)  (2304 + 64 * (j))
#define XB_TOP      3328
#define XB_TOPGEN   3392
#define XCD_BAR_WORDS 3456
#define XB_SPIN_CAP (1u << 18)
__device__ __forceinline__ unsigned xb_ld(unsigned* p)              { return __hip_atomic_load(p, __ATOMIC_RELAXED, __HIP_MEMORY_SCOPE_AGENT); }
__device__ __forceinline__ unsigned xb_add(unsigned* p, unsigned v) { return __hip_atomic_fetch_add(p, v, __ATOMIC_RELAXED, __HIP_MEMORY_SCOPE_AGENT); }
__device__ __forceinline__ unsigned xb_xcc_id() { return (unsigned)__builtin_amdgcn_s_getreg((3 << 11) | 20) & 0xFu; }
#define XB_SPIN(cond, bar) do { unsigned _sp = 0; while (cond) { __builtin_amdgcn_s_sleep(1); \
    if ((++_sp & 255u) == 0u) { if (xb_ld(&(bar)[XB_TMO])) break; if (_sp > XB_SPIN_CAP) { atomicAdd(&(bar)[XB_TMO], 1u); break; } } } } while (0)
struct XcdBarrier { unsigned* bar; unsigned x; volatile LAS unsigned* st; };
__device__ __forceinline__ XcdBarrier xcd_barrier_post(unsigned* bar, volatile LAS unsigned* st) {
    XcdBarrier b; b.bar = bar; b.x = xb_xcc_id(); b.st = st;
    if (threadIdx.x == 0) (void)xb_add(&bar[XB_XCNT(b.x)], 1u);
    return b;
}
__device__ __forceinline__ void xcd_barrier_complete(unsigned* bar, unsigned x, unsigned& nloc, unsigned& nx) {
    const unsigned G = gridDim.x * gridDim.y * gridDim.z;
    unsigned sum, cnt, mine, sp = 0u;
    for (;;) {
        sum = 0u; cnt = 0u; mine = 0u;
#pragma unroll
        for (unsigned j = 0; j < 16; ++j) { const unsigned c = xb_ld(&bar[XB_XCNT(j)]); sum += c; cnt += (c > 0u) ? 1u : 0u; mine = (j == x) ? c : mine; }
        if (sum == G) break;
        __builtin_amdgcn_s_sleep(1);
        if ((++sp & 255u) == 0u) { if (xb_ld(&bar[XB_TMO])) break; if (sp > XB_SPIN_CAP) { atomicAdd(&bar[XB_TMO], 1u); break; } }
    }
    nloc = mine > 0u ? mine : 1u; nx = cnt > 0u ? cnt : 1u;
}
__device__ __forceinline__ void xcd_barrier(const XcdBarrier& b) {
    asm volatile("s_waitcnt vmcnt(0)" ::: "memory");
    __syncthreads();
    if (threadIdx.x == 0) {
        unsigned* bar = b.bar;
        __builtin_amdgcn_s_waitcnt(0);
        unsigned nloc = b.st[0], nx = b.st[1];
        if (nloc == 0u) { xcd_barrier_complete(bar, b.x, nloc, nx); b.st[0] = nloc; b.st[1] = nx; }
        const unsigned old = xb_add(&bar[XB_XSUB(b.x)], 1u);
        const unsigned gen = old / nloc;
        if (old + 1u == (gen + 1u) * nloc) {
            __builtin_amdgcn_fence(__ATOMIC_RELEASE, "agent");
            asm volatile("s_waitcnt vmcnt(0)" ::: "memory");
            const unsigned og = xb_add(&bar[XB_TOP], 1u);
            const unsigned tg = og / nx;
            if (og + 1u == (tg + 1u) * nx) xb_add(&bar[XB_TOPGEN], 1u);
            else XB_SPIN(xb_ld(&bar[XB_TOPGEN]) == tg, bar);
            __builtin_amdgcn_fence(__ATOMIC_ACQUIRE, "agent");
            xb_add(&bar[XB_XGEN(b.x)], 1u);
            asm volatile("s_waitcnt vmcnt(0)" ::: "memory");
        } else {
            XB_SPIN(xb_ld(&bar[XB_XGEN(b.x)]) == gen, bar);
            __builtin_amdgcn_fence(__ATOMIC_ACQUIRE, "agent");
            asm volatile("s_waitcnt vmcnt(0)" ::: "memory");
        }
    }
    __syncthreads();
}

namespace g8 {
constexpr int BM = 256, BK = 64, HALF = 128, HTB = HALF * BK * 2, STAGE_BYTES = 8 * HTB, NXCD = 8, WGM = 8;
__device__ __forceinline__ int lds_byte(int r, int c) { const int st = (r >> 4) * 2 + (c >> 5), rr = r & 15, cc = c & 31, ob = rr * 64 + cc * 2; return st * 1024 + (ob ^ (((ob >> 9) & 1) << 5)); }
__device__ __forceinline__ void stage_rc(int b, int& R, int& C) { const int st = b / 1024, sb = b % 1024, swz = sb ^ (((sb >> 9) & 1) << 5); R = (st >> 1) * 16 + swz / 64; C = (st & 1) * 32 + (swz % 64) / 2; }
__device__ __forceinline__ int perm32(int rho) { const int n = rho >> 4, i = rho & 15; return 8 * (i >> 2) + 4 * n + (i & 3); }
struct Unit { int pm, pn, aux; };
struct AOff { unsigned o[2][2]; };

__device__ __forceinline__ bool static_order(int i, int G, int c, int nM, int nN, int& pm, int& pn) {
    const int nwg = nM * nN; const long L = (long)i * G + c; if (L >= nwg) return false;
    int wgid = (int)L; { const int q = nwg / NXCD, r = nwg % NXCD, xcd = wgid % NXCD, off = wgid / NXCD; wgid = (xcd < r ? xcd * (q + 1) : r * (q + 1) + (xcd - r) * q) + off; }
    const int nig = WGM * nN, gid = wgid / nig, fm = gid * WGM, gsz = (nM - fm) < WGM ? (nM - fm) : WGM;
    pm = fm + ((wgid % nig) % gsz); pn = (wgid % nig) / gsz; return true;
}
struct DenseP {
    const char* A; const char* B; int lda, ldb, K, nM, nN, G, c;
    __device__ __forceinline__ bool next(int i, Unit& u) const { u.aux = 0; return static_order(i, G, c, nM, nN, u.pm, u.pn); }
    __device__ __forceinline__ void aoff(const Unit& u, const int (&R)[2], const int (&C)[2], AOff& o) const {
#pragma unroll
        for (int h = 0; h < 2; ++h)
#pragma unroll
            for (int i = 0; i < 2; ++i) o.o[h][i] = (unsigned)(((u.pm * BM + h * HALF + R[i]) * lda + C[i]) * 2);
    }
    __device__ __forceinline__ const char* bbase(const Unit& u, int kt) const { return B + ((size_t)u.pn * BM * ldb + (size_t)kt * BK) * 2; }
};

template <class Prov, class Epi>
__device__ __forceinline__ void gemm_phase(LAS unsigned char* lds, const Prov& P, const Epi& E) {
    int tid = threadIdx.x; asm volatile("" : "+v"(tid));
    const int wid = __builtin_amdgcn_readfirstlane(tid >> 6), lane = tid & 63, wr = wid >> 2, wc = wid & 3, fr = lane & 15, fq = lane >> 4;
    const int K = P.K, nt = K / BK;
    int R[2], C[2]; unsigned voffB[2];
#pragma unroll
    for (int i = 0; i < 2; ++i) { stage_rc(tid * 16 + i * 8192, R[i], C[i]); const int Rb = (R[i] & ~31) + perm32(R[i] & 31); voffB[i] = (unsigned)(Rb * P.ldb + C[i]) * 2u; }
    const size_t hstepB = (size_t)HALF * P.ldb * 2;
    const unsigned ldsw = (unsigned)wid * 1024u;
    const int aoff = lds_byte(wr * 64 + fr, fq * 8), boff = lds_byte(wc * 32 + fr, fq * 8);
#define G8_SA(b, h) (((b) * 2 + (h)) * HTB)
#define G8_SB(b, h) ((4 + (b) * 2 + (h)) * HTB)
#define G8_STAGE_A(bufoff, h, AO, kb) do { _Pragma("unroll") for (int _i = 0; _i < 2; ++_i) \
        __builtin_amdgcn_global_load_lds((const unsigned*)(P.A + (size_t)((AO).o[h][_i] + (kb))), (LAS unsigned*)(lds + (bufoff) + ldsw + _i * 8192), 16, 0, 0); } while (0)
#define G8_STAGE_B(bufoff, bp) do { _Pragma("unroll") for (int _i = 0; _i < 2; ++_i) \
        __builtin_amdgcn_global_load_lds((const unsigned*)((bp) + voffB[_i]), (LAS unsigned*)(lds + (bufoff) + ldsw + _i * 8192), 16, 0, 0); } while (0)
#define G8_LDA(dst, b, h) do { _Pragma("unroll") for (int m = 0; m < 4; ++m) _Pragma("unroll") for (int k = 0; k < 2; ++k) dst[m][k] = *(const LAS bf16x8*)(lds + G8_SA(b, h) + aoff + m * 2048 + k * 1024); } while (0)
#define G8_LDB(dst, b, h) do { _Pragma("unroll") for (int n = 0; n < 2; ++n) _Pragma("unroll") for (int k = 0; k < 2; ++k) dst[n][k] = *(const LAS bf16x8*)(lds + G8_SB(b, h) + boff + n * 2048 + k * 1024); } while (0)
#define G8_MMA(ai, bj, At, Bt) do { __builtin_amdgcn_s_setprio(1); _Pragma("unroll") for (int m = 0; m < 4; ++m) _Pragma("unroll") for (int n = 0; n < 2; ++n) _Pragma("unroll") for (int k = 0; k < 2; ++k) \
        acc[ai][bj][m][n] = __builtin_amdgcn_mfma_f32_16x16x32_bf16(Bt[n][k], At[m][k], acc[ai][bj][m][n], 0, 0, 0); __builtin_amdgcn_s_setprio(0); } while (0)
#define G8_WAIT_V(n) asm volatile("s_waitcnt vmcnt(" #n ")" ::: "memory")
#define G8_WAIT_L(n) asm volatile("s_waitcnt lgkmcnt(" #n ")" ::: "memory")
#define G8_BAR __builtin_amdgcn_s_barrier()
#define G8_SCHED __builtin_amdgcn_sched_barrier(0)
    Unit cur, nxt; int ui = 0;
    if (!P.next(0, cur)) return;
    f32x4 acc[2][2][4][2];
#pragma unroll
    for (int a = 0; a < 2; ++a)
#pragma unroll
        for (int b = 0; b < 2; ++b)
#pragma unroll
            for (int m = 0; m < 4; ++m)
#pragma unroll
                for (int n = 0; n < 2; ++n) acc[a][b][m][n] = (f32x4){0.f, 0.f, 0.f, 0.f};
    bf16x8 At[4][2], B0[2][2], B1[2][2];
    AOff cA, nA;
    P.aoff(cur, R, C, cA);
    {   const char* b0 = P.bbase(cur, 0); const char* b1 = P.bbase(cur, 1);
        G8_STAGE_B(G8_SB(0, 0), b0); G8_STAGE_B(G8_SB(0, 1), b0 + hstepB); G8_STAGE_A(G8_SA(0, 0), 0, cA, 0u); G8_STAGE_A(G8_SA(0, 1), 1, cA, 0u);
        if (wr == 1) G8_BAR;
        G8_WAIT_V(2); G8_BAR;
        G8_STAGE_B(G8_SB(1, 0), b1); G8_STAGE_A(G8_SA(1, 0), 0, cA, 128u); G8_STAGE_B(G8_SB(1, 1), b1 + hstepB);
        G8_WAIT_V(6); G8_BAR; }
    for (;;) {
        const bool has_next = P.next(ui + 1, nxt);
        if (has_next) P.aoff(nxt, R, C, nA); else { nA = cA; nxt = cur; }
        for (int t = 0; t < nt; t += 2) {
            const bool last = (t == nt - 2);
            const unsigned kb1 = (unsigned)(t + 1) * 128u;
            const unsigned kb2 = last ? 0u : (unsigned)(t + 2) * 128u, kb3 = kb2 + 128u;
            AOff s;
#pragma unroll
            for (int h = 0; h < 2; ++h)
#pragma unroll
                for (int i = 0; i < 2; ++i) s.o[h][i] = last ? nA.o[h][i] : cA.o[h][i];
            const char* b2 = last ? P.bbase(nxt, 0) : P.bbase(cur, t + 2);
            const char* b3 = last ? P.bbase(nxt, 1) : P.bbase(cur, t + 3);
            G8_LDB(B0, 0, 0); G8_LDB(B1, 0, 1); G8_SCHED; G8_LDA(At, 0, 0); G8_STAGE_A(G8_SA(1, 1), 1, cA, kb1);
            G8_WAIT_V(8); G8_WAIT_L(0); G8_BAR; G8_MMA(0, 0, At, B0); G8_MMA(0, 1, At, B1); G8_BAR; G8_SCHED;
            G8_LDA(At, 0, 1); G8_STAGE_B(G8_SB(0, 0), b2); G8_STAGE_B(G8_SB(0, 1), b2 + hstepB); G8_STAGE_A(G8_SA(0, 0), 0, s, kb2);
            G8_WAIT_V(8); G8_WAIT_L(0); G8_BAR; G8_MMA(1, 0, At, B0); G8_MMA(1, 1, At, B1); G8_BAR; G8_SCHED;
            G8_LDB(B0, 1, 0); G8_LDB(B1, 1, 1); G8_SCHED; G8_LDA(At, 1, 0); G8_STAGE_A(G8_SA(0, 1), 1, s, kb2);
            G8_WAIT_V(8); G8_WAIT_L(0); G8_BAR; G8_MMA(0, 0, At, B0); G8_MMA(0, 1, At, B1); G8_BAR; G8_SCHED;
            G8_LDA(At, 1, 1); G8_STAGE_B(G8_SB(1, 0), b3); G8_STAGE_B(G8_SB(1, 1), b3 + hstepB); G8_STAGE_A(G8_SA(1, 0), 0, s, kb3);
            G8_WAIT_V(8); G8_WAIT_L(0); G8_BAR; G8_MMA(1, 0, At, B0); G8_MMA(1, 1, At, B1); G8_BAR; G8_SCHED;
        }
        if (wr == 0) G8_BAR;
        E(acc, cur, wr, wc, fr, fq);
        if (!has_next) break;
#pragma unroll
        for (int a = 0; a < 2; ++a)
#pragma unroll
            for (int b = 0; b < 2; ++b)
#pragma unroll
                for (int m = 0; m < 4; ++m)
#pragma unroll
                    for (int n = 0; n < 2; ++n) acc[a][b][m][n] = (f32x4){0.f, 0.f, 0.f, 0.f};
        cur = nxt; cA = nA; ++ui;
        if (wr == 1) G8_BAR;
    }
    G8_WAIT_V(0);
    G8_BAR;
#undef G8_SA
#undef G8_SB
#undef G8_STAGE_A
#undef G8_STAGE_B
#undef G8_LDA
#undef G8_LDB
#undef G8_MMA
#undef G8_WAIT_V
#undef G8_WAIT_L
#undef G8_BAR
#undef G8_SCHED
}
}
using g8::Unit;


struct EpiQKV {
    const float* hpx; const float* cosA; const float* sinA; bf16_t* Q; bf16_t* Kk; bf16_t* V; float* kmean;
    __device__ __forceinline__ void operator()(const f32x4 (&acc)[2][2][4][2], const Unit& u, int wr, int wc, int fr, int fq) const {
        const int t = u.pn >> 2;
        const int bb = u.pm >> 5;
        if (t < 2) {
            const int hh = 2 * (u.pn & 3) + (wc >> 1), j0 = 32 * (wc & 1) + 8 * fq;
            bf16_t* dst0 = (t == 0 ? Q : Kk) + ((size_t)(bb * NH + hh) * NS) * 128;
            f32x4 ks[2][2] = {{{0.f, 0.f, 0.f, 0.f}, {0.f, 0.f, 0.f, 0.f}}, {{0.f, 0.f, 0.f, 0.f}, {0.f, 0.f, 0.f, 0.f}}};
#pragma unroll
            for (int ai = 0; ai < 2; ++ai)
#pragma unroll
                for (int m = 0; m < 4; ++m) {
                    const int row = u.pm * 256 + 128 * ai + 64 * wr + 16 * m + fr, s = row & (NS - 1);
                    const float rs = row_rs<16>(hpx + (size_t)row * 16, 1.0f / 1024.0f);
                    f32x4 o1[2], o2[2];
#pragma unroll
                    for (int n = 0; n < 2; ++n) {
                        const f32x4 cs = *(const f32x4*)(cosA + (size_t)s * 64 + j0 + 4 * n), sn = *(const f32x4*)(sinA + (size_t)s * 64 + j0 + 4 * n);
                        const f32x4 x1 = acc[ai][0][m][n] * rs, x2 = acc[ai][1][m][n] * rs;
                        o1[n] = x1 * cs - x2 * sn; o2[n] = x1 * sn + x2 * cs;
                        ks[0][n] += o1[n]; ks[1][n] += o2[n];
                    }
                    bf16_t* d = dst0 + (size_t)s * 128 + j0;
                    *(u32x4*)d = pack8(o1[0], o1[1]); *(u32x4*)(d + 64) = pack8(o2[0], o2[1]);
                }
            if (t == 1) {
#pragma unroll
                for (int q = 0; q < 2; ++q)
#pragma unroll
                    for (int n = 0; n < 2; ++n)
#pragma unroll
                        for (int e = 0; e < 4; ++e) { float v = ks[q][n][e]; v += __shfl_xor(v, 1); v += __shfl_xor(v, 2); v += __shfl_xor(v, 4); v += __shfl_xor(v, 8); ks[q][n][e] = v; }
                if (fr == 0) {
                    float* km = kmean + ((size_t)(bb * NH + hh) * 32 + (u.pm & 31)) * 128 + j0;
#pragma unroll
                    for (int q = 0; q < 2; ++q)
#pragma unroll
                        for (int n = 0; n < 2; ++n)
#pragma unroll
                            for (int e = 0; e < 4; ++e) atomicAdd(km + 64 * q + 4 * n + e, ks[q][n][e]);
                }
            }
        } else {
            const int d0 = 32 * wc + 8 * fq;
#pragma unroll
            for (int ai = 0; ai < 2; ++ai)
#pragma unroll
                for (int m = 0; m < 4; ++m) {
                    const int row = u.pm * 256 + 128 * ai + 64 * wr + 16 * m + fr, s = row & (NS - 1);
                    const float rs = row_rs<16>(hpx + (size_t)row * 16, 1.0f / 1024.0f);
#pragma unroll
                    for (int bj = 0; bj < 2; ++bj) {
                        const int hh = 2 * (u.pn - 8) + bj;
                        bf16_t* d = V + ((size_t)(bb * NH + hh) * NS + s) * 128 + d0;
                        *(u32x4*)d = pack8(acc[ai][bj][m][0] * rs, acc[ai][bj][m][1] * rs);
                    }
                }
        }
    }
};

__device__ __forceinline__ void unpack8(u32x4 w, f32x4& a, f32x4& b) {
#pragma unroll
    for (int e = 0; e < 2; ++e) { a[2 * e] = __builtin_bit_cast(float, w[e] << 16); a[2 * e + 1] = __builtin_bit_cast(float, w[e] & 0xffff0000u);
                                  b[2 * e] = __builtin_bit_cast(float, w[2 + e] << 16); b[2 * e + 1] = __builtin_bit_cast(float, w[2 + e] & 0xffff0000u); }
}
struct EpiResid {
    const bf16_t* base; bf16_t* hb; float* hp;
    __device__ __forceinline__ void operator()(const f32x4 (&acc)[2][2][4][2], const Unit& u, int wr, int wc, int fr, int fq) const {
#pragma unroll
        for (int ai = 0; ai < 2; ++ai)
#pragma unroll
            for (int m = 0; m < 4; ++m) {
                const int row = u.pm * 256 + 128 * ai + 64 * wr + 16 * m + fr;
                float ss = 0.f;
#pragma unroll
                for (int bj = 0; bj < 2; ++bj) {
                    const size_t off = (size_t)row * 1024 + u.pn * 256 + 128 * bj + 32 * wc + 8 * fq;
                    f32x4 b0, b1; unpack8(*(const u32x4*)(base + off), b0, b1);
                    const f32x4 v0 = acc[ai][bj][m][0] + b0, v1 = acc[ai][bj][m][1] + b1;
                    *(u32x4*)(hb + off) = pack8(v0, v1);
                    ss += dot4(v0) + dot4(v1);
                }
                ss += __shfl_xor(ss, 16); ss += __shfl_xor(ss, 32);
                if (fq == 0) hp[(size_t)row * 16 + u.pn * 4 + wc] = ss;
                if (m & 1) asm volatile("" ::: "memory");
            }
    }
};
namespace at {
constexpr int KVBLK = 64, SHM_V = KVBLK * 128 * 2;
constexpr float THR = 8.f;
#define AT_SBAR() __builtin_amdgcn_sched_barrier(0)
__device__ __forceinline__ int v_st(int k, int c) { const int kk = (k & ~0xC) | ((k & 4) << 1) | ((k & 8) >> 1); return ((kk >> 3) * 4 + (c >> 5)) * 512 + ((kk & 7) * 32 + (c & 31)) * 2; }
__device__ __forceinline__ int v_rd_base(int lane) { return ((lane & 3) << 3) | (((lane >> 2) & 3) << 6) | (((lane >> 4) & 1) << 5) | (((lane >> 5) & 1) << 8); }
constexpr int v_rd_off(int d0, int ks, int half) { return d0 * 512 + ks * 4096 + half * 2048; }
__device__ __forceinline__ int crow(int r, int hi) { return (r & 3) + 8 * (r >> 2) + 4 * hi; }

template <int DQK> constexpr int krow() { return DQK == 192 ? 400 : DQK * 2; }
template <int DQK> __device__ __forceinline__ int kswz(int row, int colB) { return DQK == 192 ? row * 400 + colB : row * (DQK * 2) + (colB ^ ((row & 7) << 4)); }

__device__ __forceinline__ void mask_causal(f32x16& p0, f32x16& p1, int dq) {
    const float NEG = -__builtin_inff();
#pragma unroll
    for (int r = 0; r < 16; ++r) {
        const int c = (r & 3) + 8 * (r >> 2);
        if (dq - c < 0) p0[r] = NEG;
        if (dq - c - 32 < 0) p1[r] = NEG;
    }
}
__device__ __forceinline__ void mask_all(f32x16& p0, f32x16& p1, bool keep) {
    const float NEG = -__builtin_inff();
#pragma unroll
    for (int r = 0; r < 16; ++r) { p0[r] = keep ? p0[r] : NEG; p1[r] = keep ? p1[r] : NEG; }
}
__device__ __forceinline__ void partialSM(f32x16& p0, f32x16& p1, float& m_reg, float& mn, float& alpha, const float SC, const float C2) {
    float pmax = p0[0];
#pragma unroll
    for (int r = 1; r < 16; ++r) pmax = fmaxf(pmax, p0[r]);
#pragma unroll
    for (int r = 0; r < 16; ++r) pmax = fmaxf(pmax, p1[r]);
    { auto rr = __builtin_amdgcn_permlane32_swap(__float_as_uint(pmax), __float_as_uint(pmax), false, false);
      pmax = fmaxf(__uint_as_float(rr[0]), __uint_as_float(rr[1])); }
    if (__builtin_expect(__all((pmax - m_reg) * SC <= THR), 1)) { mn = m_reg; alpha = 1.f; }
    else { mn = fmaxf(m_reg, pmax); alpha = __builtin_amdgcn_exp2f((m_reg - mn) * C2); m_reg = mn; }
    const float mnL = -mn * C2;
#pragma unroll
    for (int r = 0; r < 16; ++r) p0[r] = fmaf(p0[r], C2, mnL);
#pragma unroll
    for (int r = 0; r < 16; ++r) p1[r] = fmaf(p1[r], C2, mnL);
#pragma unroll
    for (int r = 0; r < 16; ++r) p0[r] = __builtin_amdgcn_exp2f(p0[r]);
}
__device__ __forceinline__ void finishSM(f32x16& p0, f32x16& p1, float alpha, float& l_reg, bf16x8& pa0, bf16x8& pa1, bf16x8& pa2, bf16x8& pa3) {
#pragma unroll
    for (int r = 0; r < 16; ++r) p1[r] = __builtin_amdgcn_exp2f(p1[r]);
    float ps = 0;
#pragma unroll
    for (int r = 0; r < 16; ++r) ps += p0[r];
#pragma unroll
    for (int r = 0; r < 16; ++r) ps += p1[r];
    { auto rr = __builtin_amdgcn_permlane32_swap(__float_as_uint(ps), __float_as_uint(ps), false, false);
      ps = __uint_as_float(rr[0]) + __uint_as_float(rr[1]); }
    l_reg = l_reg * alpha + ps;
#define AT_PK4(P, B_, OUT) do { unsigned a0 = cvtpk(P[B_+0], P[B_+1]), a1 = cvtpk(P[B_+2], P[B_+3]);                          \
        unsigned b0 = cvtpk(P[B_+4], P[B_+5]), b1 = cvtpk(P[B_+6], P[B_+7]);                                             \
        auto r0 = __builtin_amdgcn_permlane32_swap(a0, b0, false, false); auto r1 = __builtin_amdgcn_permlane32_swap(a1, b1, false, false); \
        u32x4 w = {r0[0], r1[0], r0[1], r1[1]}; OUT = __builtin_bit_cast(bf16x8, w); } while (0)
    AT_PK4(p0, 0, pa0); AT_PK4(p0, 8, pa1); AT_PK4(p1, 0, pa2); AT_PK4(p1, 8, pa3);
#undef AT_PK4
}
template <int DQK>
__device__ __forceinline__ void qkt(f32x16& p0, f32x16& p1, const char* Kt, int r32, int hi, const bf16x8* qr, bool act) {
    if (!act) { const float NEG = -__builtin_inff();
#pragma unroll
        for (int r = 0; r < 16; ++r) { p0[r] = NEG; p1[r] = NEG; } return; }
    p0 = f32x16{}; p1 = f32x16{};
    const char* kb[4];
#pragma unroll
    for (int dd = 0; dd < 4; ++dd) kb[dd] = Kt + kswz<DQK>(r32, (dd * 16 + hi * 8) * 2);
#pragma unroll
    for (int d0 = 0; d0 < DQK / 16; ++d0) { const char* a = kb[d0 & 3] + (d0 >> 2) * 128;
        bf16x8 b0 = *reinterpret_cast<const bf16x8*>(a);
        bf16x8 b1 = *reinterpret_cast<const bf16x8*>(a + 32 * krow<DQK>());
        p0 = __builtin_amdgcn_mfma_f32_32x32x16_bf16(b0, qr[d0], p0, 0, 0, 0);
        p1 = __builtin_amdgcn_mfma_f32_32x32x16_bf16(b1, qr[d0], p1, 0, 0, 0); }
}
template <int VB>
__device__ __forceinline__ void pv_tile(f32x16* o, int vb0, bf16x8 pa0, bf16x8 pa1, bf16x8 pa2, bf16x8 pa3, bool act) {
    if (!act) return;
#define AT_TRRD(dst, off) asm volatile("ds_read_b64_tr_b16 %0, %1 offset:%2" : "=&v"(dst) : "v"(vb0), "i"(off) : "memory")
#define AT_PV_D0(d0) do { s16x4 l0, l1, l2, l3, h0, h1, h2, h3; constexpr int b_ = VB * SHM_V + v_rd_off(d0, 0, 0); \
        AT_TRRD(l0, b_); AT_TRRD(h0, b_ + 2048); AT_TRRD(l1, b_ + 4096); AT_TRRD(h1, b_ + 6144); AT_TRRD(l2, b_ + 8192); AT_TRRD(h2, b_ + 10240); AT_TRRD(l3, b_ + 12288); AT_TRRD(h3, b_ + 14336); \
        asm volatile("s_waitcnt lgkmcnt(0)" ::: "memory"); AT_SBAR();   \
        o[d0] = __builtin_amdgcn_mfma_f32_32x32x16_bf16((bf16x8){l0[0], l0[1], l0[2], l0[3], h0[0], h0[1], h0[2], h0[3]}, pa0, o[d0], 0, 0, 0);   \
        o[d0] = __builtin_amdgcn_mfma_f32_32x32x16_bf16((bf16x8){l1[0], l1[1], l1[2], l1[3], h1[0], h1[1], h1[2], h1[3]}, pa1, o[d0], 0, 0, 0);   \
        o[d0] = __builtin_amdgcn_mfma_f32_32x32x16_bf16((bf16x8){l2[0], l2[1], l2[2], l2[3], h2[0], h2[1], h2[2], h2[3]}, pa2, o[d0], 0, 0, 0);   \
        o[d0] = __builtin_amdgcn_mfma_f32_32x32x16_bf16((bf16x8){l3[0], l3[1], l3[2], l3[3], h3[0], h3[1], h3[2], h3[3]}, pa3, o[d0], 0, 0, 0); } while (0)
    AT_PV_D0(0); AT_PV_D0(1); AT_PV_D0(2); AT_PV_D0(3);
#undef AT_PV_D0
#undef AT_TRRD
}

__device__ __forceinline__ void ochunk(const f32x16 (&o)[4], int d0, int j, f32x4& c0, f32x4& c1) {
#pragma unroll
    for (int e = 0; e < 4; ++e) { auto rr = __builtin_amdgcn_permlane32_swap(__float_as_uint(o[d0][8 * j + e]), __float_as_uint(o[d0][8 * j + 4 + e]), false, false);
        c0[e] = __uint_as_float(rr[0]); c1[e] = __uint_as_float(rr[1]); }
}
template <int DQK> struct Lds { static constexpr int SHM_K = KVBLK * DQK * 2, K_OFF = 2 * SHM_V, WS_OFF = K_OFF + 2 * SHM_K, BYTES = WS_OFF + NWAVES * 64 * 4, F_OFF = BYTES; };

constexpr int LCAP = 256 * 496;
__device__ __forceinline__ int loff(int n) { return 256 * (31 * n - (n * (n - 1)) / 2); }
struct SparseBufs { unsigned short* lists; unsigned* lcnt; unsigned* selinfo; float* ml; unsigned char* part01; unsigned char* part2; };

struct AttnP { const bf16_t* Qp; const bf16_t* Kn; const bf16_t* Kr; const bf16_t* Vp; bf16_t* Op; int P0, t0, NT, bh, nent; const unsigned short* ents; };

template <int DQK, int MODE>
__device__ __forceinline__ void attn_unit(char* lds, const AttnP& A, const SparseBufs& SB) {
    constexpr int SHM_K = KVBLK * krow<DQK>(), K_OFF = 3 * SHM_V;
    constexpr float SC = (DQK == 128) ? 0.08838834764831845f : 0.07216878364870323f;
    constexpr float C2 = 1.4426950408889634f * SC;
    constexpr int ND0 = DQK / 16;
    (void)SB;
    int tid = threadIdx.x; asm volatile("" : "+v"(tid));
    const int wid = __builtin_amdgcn_readfirstlane(tid >> 6), lane = tid & 63, r32 = lane & 31, hi = lane >> 5;
    const int NT = A.NT, P0 = A.P0;
    const int qlo = P0 + wid * 32, qm = qlo + r32 - 4 * hi;
    char* V_lds = lds; char* K_lds = lds + K_OFF;
    float m_reg = -1e30f, l_reg = 0; f32x16 o[4] = {};
    const int sr = tid >> 4, sc = (tid & 15) * 8, vst0 = v_st(sr, sc), vst1 = v_st(32 + sr, sc), kws = kswz<DQK>(sr, sc * 2);
    const int rr_ = tid >> 3, rc_ = (tid & 7) * 8, kws_r = kswz<DQK>(rr_, 256 + rc_ * 2);
    const int vb0 = (int)(uintptr_t)V_lds + v_rd_base(lane);
    bf16x8 qr[ND0];
    {   const unsigned qo = (unsigned)(((wid * 32 + r32) * DQK + hi * 8) * 2);
#pragma unroll
        for (int d0 = 0; d0 < ND0; ++d0) qr[d0] = *(const bf16x8*)((const char*)A.Qp + qo + d0 * 32); }
    bf16x8 st_v0, st_v1, st_k0, st_k1, st_k2;
    const unsigned lo_a = (unsigned)((sr * 128 + sc) * 2), lo_r = (unsigned)((rr_ * 64 + rc_) * 2);
#define AT_VMW() asm volatile("s_waitcnt vmcnt(0)" ::: "memory")
    const __amdgpu_buffer_rsrc_t rsV = __builtin_amdgcn_make_buffer_rsrc((void*)A.Vp, 0, NS * 256, 0x00020000), rsK = __builtin_amdgcn_make_buffer_rsrc((void*)A.Kn, 0, NS * 256, 0x00020000);
    const __amdgpu_buffer_rsrc_t rsR = __builtin_amdgcn_make_buffer_rsrc((void*)(DQK == 192 ? A.Kr : A.Kn), 0, NS * 128, 0x00020000);
#define AT_BL(rs, vo, so) __builtin_bit_cast(bf16x8, __builtin_amdgcn_raw_buffer_load_b128(rs, (int)(vo), (int)(so), 0))
#define AT_SLOAD(k0) do { const int so_ = (k0) * 256; \
                          st_v0 = AT_BL(rsV, lo_a, so_); st_v1 = AT_BL(rsV, lo_a, so_ + 8192); \
                          st_k0 = AT_BL(rsK, lo_a, so_); st_k1 = AT_BL(rsK, lo_a, so_ + 8192); \
                          if (DQK == 192) { st_k2 = AT_BL(rsR, lo_r, (k0) * 128); } } while (0)
#define AT_SWRITE(bf) do { char* vd_ = V_lds + (bf) * SHM_V; char* kd_ = K_lds + (bf) * SHM_K; \
                           *(bf16x8*)(vd_ + vst0) = st_v0; *(bf16x8*)(vd_ + vst1) = st_v1; \
                           *(bf16x8*)(kd_ + kws) = st_k0; *(bf16x8*)(kd_ + kws + 32 * krow<DQK>()) = st_k1; \
                           if (DQK == 192) *(bf16x8*)(kd_ + kws_r) = st_k2; } while (0)
#define AT_RESC(a) do { if (__any((a) < 1.f)) { _Pragma("unroll") for (int d_ = 0; d_ < 4; ++d_) o[d_] *= (a); } } while (0)
#define AT_KBASE(t) ((t) * KVBLK)
#define AT_MASKT(P0_, P1_, t) do { const int kb_ = AT_KBASE(t); if (kb_ + KVBLK - 1 > qlo) mask_causal(P0_, P1_, qm - kb_); } while (0)
    f32x16 pA0, pA1, pB0, pB1; float mnA, mnB, alA, alB; bf16x8 pa0, pa1, pa2, pa3;
    AT_SLOAD(AT_KBASE(0)); AT_VMW(); AT_SWRITE(0);
    AT_SLOAD(AT_KBASE(1)); AT_VMW(); AT_SWRITE(1);
    AT_SLOAD(AT_KBASE(2));
    __syncthreads();
    AT_SBAR(); qkt<DQK>(pA0, pA1, K_lds, r32, hi, qr, true);
    AT_MASKT(pA0, pA1, 0); partialSM(pA0, pA1, m_reg, mnA, alA, SC, C2);
#define AT_STEP(PX0, PX1, mnX, alX, PY0, PY1, alY, t, bc, bp, bn) do {                                                           \
        if ((t) + 1 < NT) { AT_VMW(); AT_SWRITE(bn); if ((t) + 2 < NT) AT_SLOAD(AT_KBASE((t) + 2)); }                            \
        finishSM(PY0, PY1, alY, l_reg, pa0, pa1, pa2, pa3); AT_SBAR();                                                           \
        qkt<DQK>(PX0, PX1, K_lds + (bc) * SHM_K, r32, hi, qr, true); AT_SBAR();                                                  \
        pv_tile<0>(o, vb0 + (bp) * SHM_V, pa0, pa1, pa2, pa3, true); AT_MASKT(PX0, PX1, (t)); partialSM(PX0, PX1, m_reg, mnX, alX, SC, C2); \
        AT_RESC(alX); __syncthreads(); } while (0)
    int bc = 1, bp = 0, bn = 2;
    for (int t = 1; t + 1 < NT; t += 2) {
        AT_STEP(pB0, pB1, mnB, alB, pA0, pA1, alA, t, bc, bp, bn);
        { const int x = bp; bp = bc; bc = bn; bn = x; }
        AT_STEP(pA0, pA1, mnA, alA, pB0, pB1, alB, t + 1, bc, bp, bn);
        { const int x = bp; bp = bc; bc = bn; bn = x; }
    }
    AT_SBAR(); qkt<DQK>(pB0, pB1, K_lds + bc * SHM_K, r32, hi, qr, true); AT_SBAR();
    finishSM(pA0, pA1, alA, l_reg, pa0, pa1, pa2, pa3); AT_SBAR();
    pv_tile<0>(o, vb0 + bp * SHM_V, pa0, pa1, pa2, pa3, true);
    AT_MASKT(pB0, pB1, NT - 1); partialSM(pB0, pB1, m_reg, mnB, alB, SC, C2); AT_RESC(alB);
    finishSM(pB0, pB1, alB, l_reg, pa0, pa1, pa2, pa3); AT_SBAR(); pv_tile<0>(o, vb0 + bc * SHM_V, pa0, pa1, pa2, pa3, true);
    {
        const float il = __builtin_amdgcn_rcpf(l_reg);
        unsigned lofs = (unsigned)(((wid * 32 + r32) * 1024 + 8 * hi) * 2);
        asm volatile("" : "+v"(lofs));
#pragma unroll
        for (int d0 = 0; d0 < 4; ++d0)
#pragma unroll
            for (int j = 0; j < 2; ++j) { f32x4 c0, c1; ochunk(o, d0, j, c0, c1);
                *(u32x4*)((char*)A.Op + (size_t)((32 * d0 + 16 * j) * 2) + lofs) = pack8(c0 * il, c1 * il); }
    }
    __syncthreads();
#undef AT_VMW
#undef AT_SLOAD
#undef AT_BL
#undef AT_SWRITE
#undef AT_RESC
#undef AT_KBASE
#undef AT_MASKT
#undef AT_STEP
}

constexpr int RES_WS = 132096, RES_F = 134144;
__device__ __forceinline__ void moba_stage_kv(char* lds, const bf16_t* Kn, const bf16_t* Vp, int n) {
    int tid = threadIdx.x; asm volatile("" : "+v"(tid));
    const int sr = tid >> 4, sc = (tid & 15) * 8, vst0 = v_st(sr, sc), vst1 = v_st(32 + sr, sc), kws = kswz<128>(sr, sc * 2);
    const unsigned lo_a = (unsigned)((sr * 128 + sc) * 2);
    const __amdgpu_buffer_rsrc_t rsV = __builtin_amdgcn_make_buffer_rsrc((void*)Vp, 0, NS * 256, 0x00020000), rsK = __builtin_amdgcn_make_buffer_rsrc((void*)Kn, 0, NS * 256, 0x00020000);
    bf16x8 kv[4][4];
#pragma unroll
    for (int t = 0; t < 4; ++t) { const int so = (4 * n + t) * 64 * 256;
        kv[t][0] = __builtin_bit_cast(bf16x8, __builtin_amdgcn_raw_buffer_load_b128(rsV, (int)lo_a, so, 0)); kv[t][1] = __builtin_bit_cast(bf16x8, __builtin_amdgcn_raw_buffer_load_b128(rsV, (int)lo_a, so + 8192, 0));
        kv[t][2] = __builtin_bit_cast(bf16x8, __builtin_amdgcn_raw_buffer_load_b128(rsK, (int)lo_a, so, 0)); kv[t][3] = __builtin_bit_cast(bf16x8, __builtin_amdgcn_raw_buffer_load_b128(rsK, (int)lo_a, so + 8192, 0)); }
#pragma unroll
    for (int t = 0; t < 4; ++t) {
        *(bf16x8*)(lds + t * SHM_V + vst0) = kv[t][0]; *(bf16x8*)(lds + t * SHM_V + vst1) = kv[t][1];
        *(bf16x8*)(lds + 65536 + t * 16384 + kws) = kv[t][2]; *(bf16x8*)(lds + 65536 + t * 16384 + kws + 32 * 256) = kv[t][3]; }
    __syncthreads();
}
template <int MODE>
__device__ __forceinline__ void moba_rows(char* lds, const bf16_t* Qh  , bf16_t* Op  , int bh, const unsigned short* ents, int nvalid  , int qrow0  , int kb0, const SparseBufs& SB, int wid, int lane) {
    constexpr float SC = 0.08838834764831845f, C2 = 1.4426950408889634f * SC;
    const int r32 = lane & 31, hi = lane >> 5;
    char* V_lds = lds; char* K_lds = lds + 65536;
    float* ws = (float*)(lds + RES_WS) + wid * 64; float* li_l = ws, * al_l = ws + 32;
    const int vb0 = (int)(uintptr_t)V_lds + v_rd_base(lane);
    int ent = -1, srow;
    if (MODE == 2) { const bool valid = r32 < nvalid; const int e = (int)ents[valid ? r32 : 0]; ent = valid ? e : -1; srow = e & 8191; } else srow = qrow0 + r32;
    bf16x8 qr[8];
    {   const __amdgpu_buffer_rsrc_t rsQ = __builtin_amdgcn_make_buffer_rsrc((void*)Qh, 0, NS * 256, 0x00020000);
        const unsigned qo = (unsigned)(srow * 256 + hi * 16);
#pragma unroll
        for (int d0 = 0; d0 < 8; ++d0) qr[d0] = __builtin_bit_cast(bf16x8, __builtin_amdgcn_raw_buffer_load_b128(rsQ, (int)(qo + d0 * 32), 0, 0)); }
    float m_reg = -1e30f, l_reg = 0; f32x16 o[4] = {};
    const int qlo = qrow0, qm = qrow0 + r32 - 4 * hi;
#define MR_ACT(t) (MODE == 2 ? true : (kb0 + (t) * 64 <= qlo + 31))
#define MR_MASK(P0_, P1_, t) do { if (MODE == 3) { const int kb_ = kb0 + (t) * 64; if (kb_ + 63 > qlo && kb_ <= qlo + 31) mask_causal(P0_, P1_, qm - kb_); } } while (0)
#define MR_RESC(a) do { if (__any((a) < 1.f)) { _Pragma("unroll") for (int d_ = 0; d_ < 4; ++d_) o[d_] *= (a); } } while (0)
    f32x16 pA0, pA1, pB0, pB1; float mnA, mnB, alA, alB; bf16x8 pa0, pa1, pa2, pa3;
    qkt<128>(pA0, pA1, K_lds, r32, hi, qr, MR_ACT(0)); MR_MASK(pA0, pA1, 0); partialSM(pA0, pA1, m_reg, mnA, alA, SC, C2);
    AT_SBAR(); qkt<128>(pB0, pB1, K_lds + 16384, r32, hi, qr, MR_ACT(1)); finishSM(pA0, pA1, alA, l_reg, pa0, pa1, pa2, pa3); AT_SBAR();
    pv_tile<0>(o, vb0, pa0, pa1, pa2, pa3, MR_ACT(0)); MR_MASK(pB0, pB1, 1); partialSM(pB0, pB1, m_reg, mnB, alB, SC, C2); MR_RESC(alB);
    AT_SBAR(); qkt<128>(pA0, pA1, K_lds + 2 * 16384, r32, hi, qr, MR_ACT(2)); finishSM(pB0, pB1, alB, l_reg, pa0, pa1, pa2, pa3); AT_SBAR();
    pv_tile<1>(o, vb0, pa0, pa1, pa2, pa3, MR_ACT(1)); MR_MASK(pA0, pA1, 2); partialSM(pA0, pA1, m_reg, mnA, alA, SC, C2); MR_RESC(alA);
    AT_SBAR(); qkt<128>(pB0, pB1, K_lds + 3 * 16384, r32, hi, qr, MR_ACT(3)); finishSM(pA0, pA1, alA, l_reg, pa0, pa1, pa2, pa3); AT_SBAR();
    pv_tile<2>(o, vb0, pa0, pa1, pa2, pa3, MR_ACT(2)); MR_MASK(pB0, pB1, 3); partialSM(pB0, pB1, m_reg, mnB, alB, SC, C2); MR_RESC(alB);
    finishSM(pB0, pB1, alB, l_reg, pa0, pa1, pa2, pa3); AT_SBAR(); pv_tile<3>(o, vb0, pa0, pa1, pa2, pa3, MR_ACT(3));
#undef MR_ACT
#undef MR_MASK
#undef MR_RESC
    if (MODE == 2) {
        if (hi == 0 && ent >= 0) { f32x2_t mlv = {m_reg, l_reg}; *(f32x2_t*)(SB.ml + ((size_t)(ent >> 13) * (NB * NH * NS) + (size_t)bh * NS + srow) * 2) = mlv; }
        const float il = __builtin_amdgcn_rcpf(l_reg);
        const int slot = ent >> 13;
        unsigned char* pb = (slot == 2) ? SB.part2 : SB.part01 + (size_t)(slot & 1) * ((size_t)NB * NH * NS * 256);
        unsigned po = (unsigned)((bh * NS + srow) * 256 + 16 * hi); asm volatile("" : "+v"(po));
#pragma unroll
        for (int d0 = 0; d0 < 4; ++d0)
#pragma unroll
            for (int j = 0; j < 2; ++j) { f32x4 c0, c1; ochunk(o, d0, j, c0, c1);
                if (ent >= 0) *(u32x4*)(pb + po + (32 * d0 + 16 * j) * 2) = pack8(c0 * il, c1 * il); }
    } else {
        const int s = qrow0 + r32; const unsigned si = SB.selinfo[(size_t)bh * NS + s];
        float mk[3], lk[3]; float M = m_reg;
#pragma unroll
        for (int k = 0; k < 3; ++k) { const bool v = ((si >> (8 * k)) & 255u) < 32u; mk[k] = -1e30f; lk[k] = 0.f;
            if (v) { const f32x2_t t = *(const f32x2_t*)(SB.ml + ((size_t)k * (NB * NH * NS) + (size_t)bh * NS + s) * 2); mk[k] = t[0]; lk[k] = t[1]; }
            M = fmaxf(M, mk[k]); }
        const float w_own = __builtin_amdgcn_exp2f((m_reg - M) * C2);
        float den = w_own * l_reg, wk[3];
#pragma unroll
        for (int k = 0; k < 3; ++k) { wk[k] = lk[k] * __builtin_amdgcn_exp2f((mk[k] - M) * C2); den += wk[k]; }
        const float inv = __builtin_amdgcn_rcpf(den), f_own = w_own * inv;
#pragma unroll
        for (int k = 0; k < 3; ++k) wk[k] *= inv;
        unsigned po = (unsigned)((bh * NS + s) * 256 + 16 * hi); asm volatile("" : "+v"(po));
        const int b = bh >> 3, h = bh & 7;
        char* orow = (char*)Op + ((size_t)(b * NS + s) * 1024 + h * 128 + 8 * hi) * 2;
        u32x4 pw[3][8];
#pragma unroll
        for (int k = 0; k < 3; ++k) { const unsigned char* pb = (k == 2) ? SB.part2 : SB.part01 + (size_t)k * ((size_t)NB * NH * NS * 256);
#pragma unroll
            for (int c = 0; c < 8; ++c) pw[k][c] = *(const u32x4*)(pb + po + c * 32); }
#pragma unroll
        for (int d0 = 0; d0 < 4; ++d0)
#pragma unroll
            for (int j = 0; j < 2; ++j) { f32x4 c0, c1; ochunk(o, d0, j, c0, c1); c0 *= f_own; c1 *= f_own;
#pragma unroll
                for (int k = 0; k < 3; ++k) { f32x4 b0, b1; const bool use = wk[k] != 0.f;
                    u32x4 w = pw[k][2 * d0 + j]; w.x = use ? w.x : 0u; w.y = use ? w.y : 0u; w.z = use ? w.z : 0u; w.w = use ? w.w : 0u;
                    unpack8(w, b0, b1); c0 += b0 * wk[k]; c1 += b1 * wk[k]; }
                *(u32x4*)(orow + (32 * d0 + 16 * j) * 2) = pack8(c0, c1); }
    }
}
__device__ __forceinline__ void moba_own_unit(char* lds, const bf16_t* Qh, const bf16_t* Kn, const bf16_t* Vp, bf16_t* O, int bh, int qb, const SparseBufs& SB) {
    int tid = threadIdx.x; asm volatile("" : "+v"(tid));
    const int wid = __builtin_amdgcn_readfirstlane(tid >> 6), lane = tid & 63;
    moba_stage_kv(lds, Kn, Vp, qb);
    moba_rows<3>(lds, Qh, O, bh, nullptr, 0, qb * 256 + wid * 32, qb * 256, SB, wid, lane);
    __syncthreads();
}
__device__ __forceinline__ void moba_gather_unit(char* lds, const bf16_t* Qh, const bf16_t* Kn, const bf16_t* Vp, int bh, int n, const unsigned short* ents, int nrows, const SparseBufs& SB) {
    int tid = threadIdx.x; asm volatile("" : "+v"(tid));
    const int wid = __builtin_amdgcn_readfirstlane(tid >> 6), lane = tid & 63;
    moba_stage_kv(lds, Kn, Vp, n);
    const int ng = (nrows + 31) >> 5;
    for (int g = wid; g < ng; g += NWAVES) { const int nv = nrows - 32 * g; moba_rows<2>(lds, Qh, nullptr, bh, ents + 32 * g, nv < 32 ? nv : 32, 0, 0, SB, wid, lane); }
    __syncthreads();
}

__device__ __forceinline__ void gate_unit(char* lds, const bf16_t* Qp  , const float* kms, int bh, int qb, const SparseBufs& SB) {
    typedef Lds<128> L; constexpr int SHM_K = L::SHM_K;
    int tid = threadIdx.x; asm volatile("" : "+v"(tid));
    const int wid = __builtin_amdgcn_readfirstlane(tid >> 6), lane = tid & 63, r32 = lane & 31, hi = lane >> 5;
    char* K_lds = lds + L::K_OFF;
    int* hist = (int*)(lds + L::WS_OFF); int* base = hist + 32;
    const int sr = tid >> 4, sc = (tid & 15) * 8, kws = kswz<128>(sr, sc * 2);
    bf16x8 qr[8];
    {   const unsigned qo = (unsigned)(((wid * 32 + r32) * 128 + hi * 8) * 2);
#pragma unroll
        for (int d0 = 0; d0 < 8; ++d0) qr[d0] = *(const bf16x8*)((const char*)Qp + qo + d0 * 32); }
    {   unsigned ko = (unsigned)((sr * 128 + sc) * 4); asm volatile("" : "+v"(ko));
        const f32x4 a = *(const f32x4*)((const char*)kms + ko) * (1.0f / 256.0f), b = *(const f32x4*)((const char*)kms + ko + 16) * (1.0f / 256.0f);
        const u32x4 h8 = pack8(a, b);
        f32x4 ha, hb_; unpack8(h8, ha, hb_);
        const u32x4 l8 = pack8(a - ha, b - hb_);
        *(u32x4*)(K_lds + kws) = h8; *(u32x4*)(K_lds + SHM_K + kws) = l8; }
    if (tid < 64) hist[tid] = 0;
    __syncthreads();
    f32x16 g = f32x16{};
    {   const char* kb[4];
#pragma unroll
        for (int dd = 0; dd < 4; ++dd) kb[dd] = K_lds + kswz<128>(r32, (dd * 16 + hi * 8) * 2);
#pragma unroll
        for (int d0 = 0; d0 < 8; ++d0) { const char* a = kb[d0 & 3] + (d0 >> 2) * 128;
            g = __builtin_amdgcn_mfma_f32_32x32x16_bf16(*reinterpret_cast<const bf16x8*>(a), qr[d0], g, 0, 0, 0);
            g = __builtin_amdgcn_mfma_f32_32x32x16_bf16(*reinterpret_cast<const bf16x8*>(a + SHM_K), qr[d0], g, 0, 0, 0); } }
    const float NINF = -__builtin_inff();
    float v1 = NINF, v2 = NINF, v3 = NINF; int i1 = 64, i2 = 65, i3 = 66;
    const int ownl = qb - 4 * hi;
#pragma unroll
    for (int r = 0; r < 16; ++r) {
        const int idx = (r & 3) + 8 * (r >> 2); const float val = (idx < ownl) ? g[r] : NINF;
        const bool c1 = val > v1, c2 = val > v2, c3 = val > v3;
        v3 = c2 ? v2 : (c3 ? val : v3); i3 = c2 ? i2 : (c3 ? idx : i3);
        v2 = c1 ? v1 : (c2 ? val : v2); i2 = c1 ? i1 : (c2 ? idx : i2);
        v1 = c1 ? val : v1;             i1 = c1 ? idx : i1;
    }
    i1 += 4 * hi; i2 += 4 * hi; i3 += 4 * hi;
    float pv_[3]; int pi_[3];
    pv_[0] = __shfl_xor(v1, 32); pv_[1] = __shfl_xor(v2, 32); pv_[2] = __shfl_xor(v3, 32);
    pi_[0] = __shfl_xor(i1, 32); pi_[1] = __shfl_xor(i2, 32); pi_[2] = __shfl_xor(i3, 32);
#pragma unroll
    for (int c = 0; c < 3; ++c) {
        const float val = pv_[c]; const int idx = pi_[c];
        const bool c1 = (val > v1) || (val == v1 && idx < i1), c2 = (val > v2) || (val == v2 && idx < i2), c3 = (val > v3) || (val == v3 && idx < i3);
        v3 = c2 ? v2 : (c3 ? val : v3); i3 = c2 ? i2 : (c3 ? idx : i3);
        v2 = c1 ? v1 : (c2 ? val : v2); i2 = c1 ? i1 : (c2 ? idx : i2);
        v1 = c1 ? val : v1;             i1 = c1 ? idx : i1;
    }
    const int s = qb * 256 + wid * 32 + r32;
    int rk1 = 0, rk2 = 0, rk3 = 0;
    if (hi == 0) {
        SB.selinfo[(size_t)bh * NS + s] = (unsigned)(i1 < 32 ? i1 : 255) | ((unsigned)(i2 < 32 ? i2 : 255) << 8) | ((unsigned)(i3 < 32 ? i3 : 255) << 16);
        if (i1 < 32) rk1 = __hip_atomic_fetch_add(hist + i1, 1, __ATOMIC_RELAXED, __HIP_MEMORY_SCOPE_WORKGROUP);
        if (i2 < 32) rk2 = __hip_atomic_fetch_add(hist + i2, 1, __ATOMIC_RELAXED, __HIP_MEMORY_SCOPE_WORKGROUP);
        if (i3 < 32) rk3 = __hip_atomic_fetch_add(hist + i3, 1, __ATOMIC_RELAXED, __HIP_MEMORY_SCOPE_WORKGROUP);
    }
    __syncthreads();
    if (tid < 32) { const int c = hist[tid]; base[tid] = c > 0 ? (int)__hip_atomic_fetch_add(SB.lcnt + bh * 32 + tid, (unsigned)c, __ATOMIC_RELAXED, __HIP_MEMORY_SCOPE_AGENT) : 0; }
    __syncthreads();
    if (hi == 0) {
        unsigned short* lb = SB.lists + (size_t)bh * LCAP;
        if (i1 < 32) lb[loff(i1) + base[i1] + rk1] = (unsigned short)(s | (0 << 13));
        if (i2 < 32) lb[loff(i2) + base[i2] + rk2] = (unsigned short)(s | (1 << 13));
        if (i3 < 32) lb[loff(i3) + base[i3] + rk3] = (unsigned short)(s | (2 << 13));
    }
    __syncthreads();
}
}
__device__ __forceinline__ int pair_lo(int p) { return p < 3 ? 0 : (p < 5 ? 1 : 2); }
__device__ __forceinline__ int pair_hi(int p) { return p < 3 ? p + 1 : (p < 5 ? p - 1 : 3); }
constexpr int LDS_TB = LDS_MISC + 64;

__device__ __forceinline__ void p_route(const Args& a, LAS unsigned char* lds, int layer, const bf16_t* h, int vcu, int G) {
    int tid = threadIdx.x; asm volatile("" : "+v"(tid));
    const int lane = tid & 63, wave = __builtin_amdgcn_readfirstlane(tid >> 6), i32 = lane & 31, kk = lane >> 5;
    unsigned char* ws = a.ws;
    LAS float* wl = (LAS float*)lds;
    {   const float* wrt = (const float*)(ws + WS_WRT) + (size_t)layer * 20480;
        for (int i = tid; i < 20480; i += NTHR) { const int k = i / 20, c = i % 20; wl[c * 1024 + k] = wrt[i]; } }
    __syncthreads();
    float* tokw = (float*)(ws + WS_TOKW); int* list = (int*)(ws + WS_LIST);
    unsigned* cnt = (unsigned*)(ws + WS_CTL) + CW_CNT + layer * 24 * 16;
    const int gw = vcu * NWAVES + wave, NGW = G * NWAVES;
    const int lrow = i32 < 4 ? i32 : (i32 < 8 ? 12 + i32 : ((i32 & 4) ? -1 : ((i32 >> 3) == 1 ? i32 - 4 : ((i32 >> 3) == 2 ? i32 - 8 : i32 - 12))));
    const LAS float* wrow = wl + (lrow < 0 ? 0 : lrow) * 1024 + 8 * kk;
    const float wmask = lrow < 0 ? 0.f : 1.f;
    for (int task = gw; task < NT / 32; task += NGW) {
        const int t = task * 32 + i32;
        const bf16_t* hrow = h + (size_t)t * 1024 + 8 * kk;
        f32x16 c = f32x16{}; float ssp = 0.f;
#pragma unroll 4
        for (int it = 0; it < 64; ++it) {
            f32x4 h0, h1; unpack8(*(const u32x4*)(hrow + 16 * it), h0, h1);
            const f32x4 w0 = *(const LAS f32x4*)(wrow + 16 * it) * wmask, w1 = *(const LAS f32x4*)(wrow + 16 * it + 4) * wmask;
            ssp += dot4(h0) + dot4(h1);
#pragma unroll
            for (int e = 0; e < 4; ++e) c = __builtin_amdgcn_mfma_f32_32x32x2f32(w0[e], h0[e], c, 0, 0, 0);
#pragma unroll
            for (int e = 0; e < 4; ++e) c = __builtin_amdgcn_mfma_f32_32x32x2f32(w1[e], h1[e], c, 0, 0, 0);
        }
        const float ss = ssp + __shfl_xor(ssp, 32);
        float ex[4];
#pragma unroll
        for (int e = 0; e < 4; ++e) ex[e] = __shfl_xor(c[e], 32);
        const float rs = rsqrtf(ss * (1.0f / 1024.0f) + EPS);
        float lg[20];
#pragma unroll
        for (int e = 0; e < 16; ++e) lg[e] = c[e] * rs;
#pragma unroll
        for (int e = 0; e < 4; ++e) lg[16 + e] = ex[e] * rs;
        int gs = 0; float gm = lg[0];
#pragma unroll
        for (int i = 1; i < 4; ++i) if (lg[i] > gm) { gm = lg[i]; gs = i; }
        float den = 0.f;
#pragma unroll
        for (int i = 0; i < 4; ++i) den += __expf(lg[i] - gm);
        const float gwt = 1.0f / den;
        float ein[4];
#pragma unroll
        for (int i = 0; i < 4; ++i) ein[i] = gs == 0 ? lg[4 + i] : (gs == 1 ? lg[8 + i] : (gs == 2 ? lg[12 + i] : lg[16 + i]));
        int i1 = 0; float e1 = ein[0];
#pragma unroll
        for (int i = 1; i < 4; ++i) if (ein[i] > e1) { e1 = ein[i]; i1 = i; }
        int i2 = -1; float e2 = 0.f;
#pragma unroll
        for (int i = 0; i < 4; ++i) if (i != i1 && (i2 < 0 || ein[i] > e2)) { e2 = ein[i]; i2 = i; }
        const float x2 = __expf(e2 - e1), w1 = gwt / (1.0f + x2), w2 = gwt * x2 / (1.0f + x2);
        const int lo = i1 < i2 ? i1 : i2, hi = i1 < i2 ? i2 : i1;
        const int pidx = lo == 0 ? hi - 1 : (lo == 1 ? hi + 1 : 5);
        const int bucket = gs * 6 + pidx;
        if (kk == 0) {
            f32x2_t wv2 = {(i1 == lo) ? w1 : w2, (i1 == lo) ? w2 : w1};
            *(f32x2_t*)(tokw + (size_t)t * 2) = wv2;
            const unsigned pos = __hip_atomic_fetch_add(cnt + bucket * 16, 1u, __ATOMIC_RELAXED, __HIP_MEMORY_SCOPE_AGENT);
            list[(size_t)bucket * NT + pos] = t;
        }
    }
    {   const float* p = a.in[1] + (size_t)layer * NT * 256; bf16_t* pb = (bf16_t*)(ws + WS_PB);
        const int gt = vcu * NTHR + tid, NGT = G * NTHR;
        for (int i = gt; i < NT * 256 / 8; i += NGT) { const f32x4 x0 = *(const f32x4*)(p + (size_t)i * 8), x1 = *(const f32x4*)(p + (size_t)i * 8 + 4); *(u32x4*)(pb + (size_t)i * 8) = pack8(x0, x1); } }
    __syncthreads();
}

__device__ __forceinline__ int moe_prefix(const Args& a, LAS unsigned char* lds, int layer) {
    LAS int* tb = (LAS int*)(lds + LDS_TB);
    if (threadIdx.x == 0) { const unsigned* cnt = (const unsigned*)(a.ws + WS_CTL) + CW_CNT + layer * 24 * 16; int s = 0;
        for (int b = 0; b < 24; ++b) { tb[b] = s; s += (int)((__hip_atomic_load(cnt + b * 16, __ATOMIC_RELAXED, __HIP_MEMORY_SCOPE_AGENT) + 255u) >> 8); }
        tb[24] = s; }
    __syncthreads();
    return __builtin_amdgcn_readfirstlane(tb[24]);
}
struct MoeUnits {
    LAS const int* tb; int NRT, G, c;
    __device__ __forceinline__ bool next(int i, Unit& u) const {
        const int L = i * G + c, rt = L >> 2; if (rt >= NRT) return false;
        int b = 0;
        for (int q = 1; q < 24; ++q) b = (tb[q] <= rt) ? q : b;
        u.pm = rt; u.pn = L & 3; u.aux = __builtin_amdgcn_readfirstlane(b); return true;
    }
};
struct MoeGuP {
    const char* A; const char* W; const int* list; const unsigned* cnt; MoeUnits U; int ldb, K;
    __device__ __forceinline__ bool next(int i, Unit& u) const { return U.next(i, u); }
    __device__ __forceinline__ void aoff(const Unit& u, const int (&R)[2], const int (&C)[2], g8::AOff& o) const {
        const int n = (int)cnt[u.aux * 16], p0 = (u.pm - __builtin_amdgcn_readfirstlane(U.tb[u.aux])) * 256;
#pragma unroll
        for (int h = 0; h < 2; ++h)
#pragma unroll
            for (int i = 0; i < 2; ++i) { int pos = p0 + h * 128 + R[i]; pos = pos < n ? pos : n - 1; const int tok = list[(size_t)u.aux * NT + pos]; o.o[h][i] = (unsigned)((tok * 1024 + C[i]) * 2); }
    }
    __device__ __forceinline__ const char* bbase(const Unit& u, int kt) const {
        const int g = u.aux / 6, pi = u.aux % 6, e = g * 4 + ((u.pn < 2) ? pair_lo(pi) : pair_hi(pi));
        return W + ((size_t)(e * 512 + (u.pn & 1) * 256) * 1024 + (size_t)kt * 64) * 2;
    }
};
struct MoeDownP {
    const char* A; const char* W; MoeUnits U; int ldb, K;
    __device__ __forceinline__ bool next(int i, Unit& u) const { return U.next(i, u); }
    __device__ __forceinline__ void aoff(const Unit& u, const int (&R)[2], const int (&C)[2], g8::AOff& o) const {
#pragma unroll
        for (int h = 0; h < 2; ++h)
#pragma unroll
            for (int i = 0; i < 2; ++i) o.o[h][i] = (unsigned)(((u.pm * 256 + h * 128 + R[i]) * 512 + C[i]) * 2);
    }
    __device__ __forceinline__ const char* bbase(const Unit& u, int kt) const {
        const int g = u.aux / 6, pi = u.aux % 6, e = g * 4 + ((kt < 4) ? pair_lo(pi) : pair_hi(pi));
        return W + ((size_t)(e * 1024 + u.pn * 256) * 256 + (size_t)(kt & 3) * 64) * 2;
    }
};
__device__ __forceinline__ float sigmoidf_fast(float x) { return __builtin_amdgcn_rcpf(1.0f + __builtin_amdgcn_exp2f(-1.4426950408889634f * x)); }

struct EpiGateUp {
    const float* hp; const float* tokw; const int* list; const unsigned* cnt; LAS const int* tb; bf16_t* act;
    __device__ __forceinline__ void operator()(const f32x4 (&acc)[2][2][4][2], const Unit& u, int wr, int wc, int fr, int fq) const {
        const int n = (int)cnt[u.aux * 16], p0 = (u.pm - __builtin_amdgcn_readfirstlane(tb[u.aux])) * 256, half = u.pn >> 1;
#pragma unroll
        for (int ai = 0; ai < 2; ++ai)
#pragma unroll
            for (int m = 0; m < 4; ++m) {
                const int r = 128 * ai + 64 * wr + 16 * m + fr; int pos = p0 + r; pos = pos < n ? pos : n - 1;
                const int tok = list[(size_t)u.aux * NT + pos];
                const float rs = row_rs<16>(hp + (size_t)tok * 16, 1.0f / 1024.0f), w = tokw[(size_t)tok * 2 + half];
                f32x4 o[2];
#pragma unroll
                for (int nn = 0; nn < 2; ++nn)
#pragma unroll
                    for (int e = 0; e < 4; ++e) { const float g = acc[ai][0][m][nn][e] * rs, up = acc[ai][1][m][nn][e] * rs; o[nn][e] = g * sigmoidf_fast(g) * up * w; }
                *(u32x4*)(act + (size_t)(u.pm * 256 + r) * 512 + half * 256 + (u.pn & 1) * 128 + 32 * wc + 8 * fq) = pack8(o[0], o[1]);
            }
    }
};
struct EpiDown {
    bf16_t* hb; float* hp; const int* list; const unsigned* cnt; LAS const int* tb;
    __device__ __forceinline__ void operator()(const f32x4 (&acc)[2][2][4][2], const Unit& u, int wr, int wc, int fr, int fq) const {
        const int n = (int)cnt[u.aux * 16], p0 = (u.pm - __builtin_amdgcn_readfirstlane(tb[u.aux])) * 256;
#pragma unroll
        for (int ai = 0; ai < 2; ++ai)
#pragma unroll
            for (int m = 0; m < 4; ++m) {
                const int r = 128 * ai + 64 * wr + 16 * m + fr, pos = p0 + r; const bool valid = pos < n;
                const int tok = list[(size_t)u.aux * NT + (valid ? pos : n - 1)];
                float ss = 0.f;
#pragma unroll
                for (int bj = 0; bj < 2; ++bj) {
                    const size_t off = (size_t)tok * 1024 + u.pn * 256 + 128 * bj + 32 * wc + 8 * fq;
                    f32x4 b0, b1; unpack8(*(const u32x4*)(hb + off), b0, b1);
                    const f32x4 v0 = acc[ai][bj][m][0] + b0, v1 = acc[ai][bj][m][1] + b1;
                    if (valid) *(u32x4*)(hb + off) = pack8(v0, v1);
                    ss += dot4(v0) + dot4(v1);
                }
                ss += __shfl_xor(ss, 16); ss += __shfl_xor(ss, 32);
                if (fq == 0 && valid) hp[(size_t)tok * 16 + u.pn * 4 + wc] = ss;
                if (m & 1) asm volatile("" ::: "memory");
            }
    }
};
struct EpiStore {
    bf16_t* O; int ldc;
    __device__ __forceinline__ void operator()(const f32x4 (&acc)[2][2][4][2], const Unit& u, int wr, int wc, int fr, int fq) const {
#pragma unroll
        for (int ai = 0; ai < 2; ++ai)
#pragma unroll
            for (int m = 0; m < 4; ++m) { const int row = u.pm * 256 + 128 * ai + 64 * wr + 16 * m + fr;
#pragma unroll
                for (int bj = 0; bj < 2; ++bj) *(u32x4*)(O + (size_t)row * ldc + u.pn * 256 + 128 * bj + 32 * wc + 8 * fq) = pack8(acc[ai][bj][m][0], acc[ai][bj][m][1]); }
    }
};
struct EpiPle {
    const float* hpin; const bf16_t* pp; const bf16_t* hbi; bf16_t* hbo; float* hp;
    __device__ __forceinline__ void operator()(const f32x4 (&acc)[2][2][4][2], const Unit& u, int wr, int wc, int fr, int fq) const {
#pragma unroll
        for (int ai = 0; ai < 2; ++ai)
#pragma unroll
            for (int m = 0; m < 4; ++m) {
                const int row = u.pm * 256 + 128 * ai + 64 * wr + 16 * m + fr;
                const float rs = row_rs<16>(hpin + (size_t)row * 16, 1.0f / 1024.0f);
                float ss = 0.f;
#pragma unroll
                for (int bj = 0; bj < 2; ++bj) {
                    const size_t off = (size_t)row * 1024 + u.pn * 256 + 128 * bj + 32 * wc + 8 * fq;
                    f32x4 p0, p1, v0, v1; unpack8(*(const u32x4*)(pp + off), p0, p1); unpack8(*(const u32x4*)(hbi + off), v0, v1);
#pragma unroll
                    for (int e = 0; e < 4; ++e) { v0[e] += sigmoidf_fast(acc[ai][bj][m][0][e] * rs) * p0[e]; v1[e] += sigmoidf_fast(acc[ai][bj][m][1][e] * rs) * p1[e]; }
                    *(u32x4*)(hbo + off) = pack8(v0, v1);
                    ss += dot4(v0) + dot4(v1);
                }
                ss += __shfl_xor(ss, 16); ss += __shfl_xor(ss, 32);
                if (fq == 0) hp[(size_t)row * 16 + u.pn * 4 + wc] = ss;
                if (m & 1) asm volatile("" ::: "memory");
            }
    }
};
__device__ __forceinline__ u32x2 pack4(f32x4 a) { u32x2 w = {cvtpk(a[0], a[1]), cvtpk(a[2], a[3])}; return w; }
struct EpiDqkv {
    const float* hp; const float* cosB; const float* sinB; bf16_t* cq; bf16_t* ckv; bf16_t* krope; float* cqp; float* kvp;
    __device__ __forceinline__ void operator()(const f32x4 (&acc)[2][2][4][2], const Unit& u, int wr, int wc, int fr, int fq) const {
#pragma unroll
        for (int ai = 0; ai < 2; ++ai)
#pragma unroll
            for (int m = 0; m < 4; ++m) {
                const int row = u.pm * 256 + 128 * ai + 64 * wr + 16 * m + fr, s = row & (NS - 1);
                const float rs = row_rs<16>(hp + (size_t)row * 16, 1.0f / 1024.0f);
                if (u.pn < 2) {
                    float ss = 0.f;
#pragma unroll
                    for (int bj = 0; bj < 2; ++bj) { const f32x4 v0 = acc[ai][bj][m][0] * rs, v1 = acc[ai][bj][m][1] * rs; ss += dot4(v0) + dot4(v1);
                        const int c = 128 * bj + 32 * wc + 8 * fq;
                        if (u.pn == 0) *(u32x4*)(cq + (size_t)row * 384 + c) = pack8(v0, v1); else *(u32x4*)(ckv + (size_t)row * 256 + c) = pack8(v0, v1); }
                    ss += __shfl_xor(ss, 16); ss += __shfl_xor(ss, 32);
                    if (fq == 0) { if (u.pn == 0) cqp[(size_t)row * 8 + wc] = ss; else kvp[(size_t)row * 4 + wc] = ss; }
                } else {
                    const f32x4 v0 = acc[ai][0][m][0] * rs, v1 = acc[ai][0][m][1] * rs;
                    float ss = dot4(v0) + dot4(v1);
                    *(u32x4*)(cq + (size_t)row * 384 + 256 + 32 * wc + 8 * fq) = pack8(v0, v1);
                    ss += __shfl_xor(ss, 16); ss += __shfl_xor(ss, 32);
                    if (fq == 0) cqp[(size_t)row * 8 + 4 + wc] = ss;
                    if (wc < 2) {
                        const int j = 16 * wc + 4 * fq;
                        const f32x4 cs = *(const f32x4*)(cosB + (size_t)s * 32 + j), sn = *(const f32x4*)(sinB + (size_t)s * 32 + j);
                        const f32x4 x1 = acc[ai][1][m][0] * rs, x2 = acc[ai][1][m][1] * rs;
                        *(u32x2*)(krope + (size_t)row * 64 + j) = pack4(x1 * cs - x2 * sn);
                        *(u32x2*)(krope + (size_t)row * 64 + 32 + j) = pack4(x1 * sn + x2 * cs);
                    }
                }
            }
    }
};
struct EpiUq {
    const float* cqp; const float* cosB; const float* sinB; bf16_t* q;
    __device__ __forceinline__ void operator()(const f32x4 (&acc)[2][2][4][2], const Unit& u, int wr, int wc, int fr, int fq) const {
        const int bb = u.pm >> 5;
#pragma unroll
        for (int ai = 0; ai < 2; ++ai)
#pragma unroll
            for (int m = 0; m < 4; ++m) {
                const int row = u.pm * 256 + 128 * ai + 64 * wr + 16 * m + fr, s = row & (NS - 1);
                const float rs = row_rs<8>(cqp + (size_t)row * 8, 1.0f / 384.0f);
#pragma unroll
                for (int bj = 0; bj < 2; ++bj) {
                    if (u.pn < 4) {
                        const int hh = 2 * u.pn + bj;
                        *(u32x4*)(q + ((size_t)(bb * NH + hh) * NS + s) * 192 + 32 * wc + 8 * fq) = pack8(acc[ai][bj][m][0] * rs, acc[ai][bj][m][1] * rs);
                    } else {
                        const int gidx = bj * 4 + wc, hh = 4 * (u.pn - 4) + (gidx >> 1), j = 16 * (gidx & 1) + 4 * fq;
                        const f32x4 cs = *(const f32x4*)(cosB + (size_t)s * 32 + j), sn = *(const f32x4*)(sinB + (size_t)s * 32 + j);
                        const f32x4 x1 = acc[ai][bj][m][0] * rs, x2 = acc[ai][bj][m][1] * rs;
                        bf16_t* d = q + ((size_t)(bb * NH + hh) * NS + s) * 192 + 128 + j;
                        *(u32x2*)d = pack4(x1 * cs - x2 * sn); *(u32x2*)(d + 32) = pack4(x1 * sn + x2 * cs);
                    }
                }
            }
    }
};
struct EpiUkv {
    const float* kvp; bf16_t* kn; bf16_t* v;
    __device__ __forceinline__ void operator()(const f32x4 (&acc)[2][2][4][2], const Unit& u, int wr, int wc, int fr, int fq) const {
        const int bb = u.pm >> 5;
#pragma unroll
        for (int ai = 0; ai < 2; ++ai)
#pragma unroll
            for (int m = 0; m < 4; ++m) {
                const int row = u.pm * 256 + 128 * ai + 64 * wr + 16 * m + fr, s = row & (NS - 1);
                const float rs = row_rs<4>(kvp + (size_t)row * 4, 1.0f / 256.0f);
                const size_t o = ((size_t)(bb * NH + u.pn) * NS + s) * 128 + 32 * wc + 8 * fq;
                *(u32x4*)(kn + o) = pack8(acc[ai][0][m][0] * rs, acc[ai][0][m][1] * rs);
                *(u32x4*)(v + o) = pack8(acc[ai][1][m][0] * rs, acc[ai][1][m][1] * rs);
            }
    }
};

struct WConv { const float* src0; const float* src1; const float* gain; bf16_t* dst; int N0, N1, K, Nout, kind; };
__device__ __forceinline__ int colmap(int kind, int n) {
    switch (kind) {
    case 1: {
        const int pn = n >> 8; if (pn >= 8) return n;
        const int t = pn >> 2, bj = (n >> 7) & 1, r = n & 127, hh = 2 * (pn & 3) + (r >> 6), d = 64 * bj + (r & 63);
        return t * 1024 + hh * 128 + d; }
    case 2: {
        if (n < 256) return n;
        if (n < 512) return 384 + (n - 256);
        if (n < 640) return 256 + (n - 512);
        const int r = n - 640, wc = r >> 5, fq = (r >> 3) & 3, nn = (r >> 2) & 1, i = r & 3;
        if (wc >= 2) return -1;
        return 384 + 256 + 32 * nn + 16 * wc + 4 * fq + i; }
    case 3: {
        if (n < 1024) return (n >> 7) * 192 + (n & 127);
        const int m = n - 1024, pn4 = m >> 8, gidx = (m >> 5) & 7, fq = (m >> 3) & 3, nn = (m >> 2) & 1, i = m & 3;
        const int hh = 4 * pn4 + (gidx >> 1), j = 16 * (gidx & 1) + 4 * fq + i;
        return hh * 192 + 128 + 32 * nn + j; }
    case 4: {
        const int q = n >> 8, bj = (n >> 7) & 1, r = n & 127;
        return bj * 256 + 128 * q + r; }
    default: return n;
    }
}
__device__ __forceinline__ void conv_item(const WConv& w, LAS float* scr, int item, int lane) {
    const int nblk = w.Nout / 32, kb = item / nblk, nb = item % nblk, k0 = 64 * kb, n0 = 32 * nb;
    const int n4 = lane & 7, ks = lane >> 3;
    const int s = colmap(w.kind, n0 + 4 * n4);
    const bool z = s < 0, first = s < w.N0;
    const float* sp = first ? w.src0 + s : w.src1 + (s - w.N0);
    const int ld = first ? w.N0 : w.N1;
    f32x4 v[8];
#pragma unroll
    for (int it = 0; it < 8; ++it) { const int k = it * 8 + ks; v[it] = z ? (f32x4){0.f, 0.f, 0.f, 0.f} : *(const f32x4*)(sp + (size_t)(k0 + k) * ld); }
#pragma unroll
    for (int it = 0; it < 8; ++it) { const int k = it * 8 + ks; const float g = w.gain ? w.gain[k0 + k] : 1.0f;
#pragma unroll
        for (int e = 0; e < 4; ++e) scr[k * 33 + 4 * n4 + e] = v[it][e] * g; }
    asm volatile("s_waitcnt lgkmcnt(0)" ::: "memory");
    const int c = lane & 7;
#pragma unroll
    for (int j = 0; j < 4; ++j) { const int n = (lane >> 3) + 8 * j; const LAS float* sv = scr + (8 * c) * 33 + n;
        u32x4 o; o.x = cvtpk(sv[0 * 33], sv[1 * 33]); o.y = cvtpk(sv[2 * 33], sv[3 * 33]); o.z = cvtpk(sv[4 * 33], sv[5 * 33]); o.w = cvtpk(sv[6 * 33], sv[7 * 33]);
        *(u32x4*)(w.dst + (size_t)(n0 + n) * w.K + k0 + 8 * c) = o; }
    asm volatile("s_waitcnt lgkmcnt(0)" ::: "memory");
}
__device__ __forceinline__ bool get_conv(int mi, const Args& a, WConv& w) {
    unsigned char* ws = a.ws;
    w.src1 = nullptr; w.N1 = 0; w.gain = nullptr; w.kind = 0;
    if (mi == 0) { w.src0 = a.in[6]; w.N0 = 3072; w.K = 1024; w.Nout = 3072; w.kind = 1; w.gain = a.in[2]; w.dst = (bf16_t*)(ws + WS_WQKV0); return true; }
    if (mi == 1) { w.src0 = a.in[7]; w.N0 = 1024; w.K = 1024; w.Nout = 1024; w.dst = (bf16_t*)(ws + WS_WO0); return true; }
    if (mi == 2) { w.src0 = a.in[8]; w.N0 = 384; w.src1 = a.in[11]; w.N1 = 320; w.K = 1024; w.Nout = 768; w.kind = 2; w.gain = a.in[2] + 1024; w.dst = (bf16_t*)(ws + WS_WDQKV); return true; }
    if (mi == 3) { w.src0 = a.in[10]; w.N0 = 1536; w.K = 384; w.Nout = 1536; w.kind = 3; w.gain = a.in[9]; w.dst = (bf16_t*)(ws + WS_WUQ); return true; }
    if (mi == 4) { w.src0 = a.in[13]; w.N0 = 2048; w.K = 256; w.Nout = 2048; w.gain = a.in[12]; w.dst = (bf16_t*)(ws + WS_WUKV); return true; }
    if (mi == 5) { w.src0 = a.in[14]; w.N0 = 1024; w.K = 1024; w.Nout = 1024; w.dst = (bf16_t*)(ws + WS_WO1); return true; }
    if (mi < 38) { const int le = mi - 6, l = le >> 4;
        w.src0 = a.in[17] + (size_t)le * 1024 * 256; w.N0 = 256; w.src1 = a.in[18] + (size_t)le * 1024 * 256; w.N1 = 256; w.K = 1024; w.Nout = 512; w.kind = 4;
        w.gain = a.in[3] + l * 1024; w.dst = (bf16_t*)(ws + WS_WGU) + (size_t)le * 512 * 1024; return true; }
    if (mi < 70) { const int le = mi - 38;
        w.src0 = a.in[19] + (size_t)le * 256 * 1024; w.N0 = 1024; w.K = 256; w.Nout = 1024; w.dst = (bf16_t*)(ws + WS_WD) + (size_t)le * 1024 * 256; return true; }
    if (mi < 72) { const int l = mi - 70;
        w.src0 = a.in[20] + (size_t)l * 1024 * 1024; w.N0 = 1024; w.K = 1024; w.Nout = 1024; w.gain = a.in[4] + l * 1024; w.dst = (bf16_t*)(ws + WS_WPG) + (size_t)l * 1024 * 1024; return true; }
    if (mi < 74) { const int l = mi - 72;
        w.src0 = a.in[21] + (size_t)l * 256 * 1024; w.N0 = 1024; w.K = 256; w.Nout = 1024; w.dst = (bf16_t*)(ws + WS_WPP) + (size_t)l * 1024 * 256; return true; }
    return false;
}

__device__ __forceinline__ void p_prologue(const Args& a, LAS unsigned char* lds, int vcu, int G) {
    int tid = threadIdx.x; asm volatile("" : "+v"(tid));
    const int lane = tid & 63, wave = __builtin_amdgcn_readfirstlane(tid >> 6);
    const int gw = vcu * NWAVES + wave, NGW = G * NWAVES;
    unsigned char* ws = a.ws;
    LAS float* scr = (LAS float*)(lds + wave * 16384);
    int base = 0;
    for (int mi = 0; mi < 74; ++mi) {
        WConv w; get_conv(mi, a, w);
        const int n = (w.K / 64) * (w.Nout / 32);
        int it = (gw - (base % NGW) + NGW) % NGW;
        for (; it < n; it += NGW) conv_item(w, scr, it, lane);
        base += n;
    }
    {   const float* x = a.in[0]; bf16_t* hb = (bf16_t*)(ws + WS_HB); float* hpx = (float*)(ws + WS_HPX);
        for (int m = gw; m < NT; m += 2 * NGW) {
            const int m2 = (m + NGW < NT) ? m + NGW : m;
            const f32x4* xr = (const f32x4*)(x + (size_t)m * 1024) + lane; const f32x4* xr2 = (const f32x4*)(x + (size_t)m2 * 1024) + lane;
            f32x4 v[4], v2[4]; float s = 0.f, s2 = 0.f;
#pragma unroll
            for (int j = 0; j < 4; ++j) { v[j] = xr[64 * j]; v2[j] = xr2[64 * j]; }
#pragma unroll
            for (int j = 0; j < 4; ++j) { s += dot4(v[j]); s2 += dot4(v2[j]); }
            s = wave_sum(s); s2 = wave_sum(s2);
            u32x2* o8 = (u32x2*)(hb + (size_t)m * 1024) + lane; u32x2* o82 = (u32x2*)(hb + (size_t)m2 * 1024) + lane;
#pragma unroll
            for (int j = 0; j < 4; ++j) { u32x2 o; o.x = cvtpk(v[j][0], v[j][1]); o.y = cvtpk(v[j][2], v[j][3]); o8[64 * j] = o;
                                          u32x2 o2; o2.x = cvtpk(v2[j][0], v2[j][1]); o2.y = cvtpk(v2[j][2], v2[j][3]); o82[64 * j] = o2; }
            if (lane < 16) { hpx[(size_t)m * 16 + lane] = (lane == 0) ? s : 0.f; hpx[(size_t)m2 * 16 + lane] = (lane == 0) ? s2 : 0.f; }
        } }
    {   const int gt = (vcu * NTHR) + tid, NGT = G * NTHR;
        float* cosA = (float*)(ws + WS_COSA); float* sinA = (float*)(ws + WS_SINA); float* cosB = (float*)(ws + WS_COSB); float* sinB = (float*)(ws + WS_SINB);
        for (int i = gt; i < NS * 64; i += NGT) { const int s = i >> 6, j = i & 63; const float inv = powf(10000.0f, -(float)j / 64.0f); float sn, cs; sincosf((float)s * inv, &sn, &cs); cosA[i] = cs; sinA[i] = sn; }
        for (int i = gt; i < NS * 32; i += NGT) { const int s = i >> 5, j = i & 31; const float inv = powf(10000.0f, -(float)j / 32.0f); float sn, cs; sincosf((float)s * inv, &sn, &cs); cosB[i] = cs; sinB[i] = sn; }
        float* km = (float*)(ws + WS_KMEAN);
        for (int i = gt; i < NB * NH * 32 * 128; i += NGT) km[i] = 0.f;
        float* wrt = (float*)(ws + WS_WRT);
        for (int i = gt; i < 2 * 1024 * 20; i += NGT) { const int l = i / 20480, r = i % 20480, k = r / 20, c = r % 20;
            const float g = a.in[3][l * 1024 + k];
            wrt[i] = g * (c < 4 ? a.in[15][(size_t)(l * 1024 + k) * 4 + c] : a.in[16][(size_t)(l * 1024 + k) * 16 + (c - 4)]); }
    }
}

__device__ __forceinline__ at::SparseBufs sparse_bufs(const Args& a) {
    unsigned char* ws = a.ws;
    at::SparseBufs SB;
    SB.lists = (unsigned short*)(ws + WS_R + 200 * MiB); SB.lcnt = (unsigned*)(ws + WS_CTL) + CW_LCNT; SB.selinfo = (unsigned*)(ws + WS_R + 210 * MiB);
    SB.ml = (float*)(ws + WS_R + 192 * MiB); SB.part01 = (unsigned char*)a.out; SB.part2 = ws + WS_PART2;
    return SB;
}
__device__ __forceinline__ void p_attention_mla(const Args& a, unsigned char* ldsg) {
    unsigned char* ws = a.ws;
    const at::SparseBufs SB = sparse_bufs(a);
    for (int L = blockIdx.x; L < 512; L += gridDim.x) {
        const int xcd = L & 7, k = L >> 3, bh = xcd + 8 * (k >> 4), x = k & 15, b = bh >> 3, h = bh & 7;
        for (int pass = 0; pass < 2; ++pass) {
            const int qb = pass ? x : 31 - x, P0 = qb * 256;
            at::AttnP A;
            A.Qp = (const bf16_t*)(ws + WS_Q) + ((size_t)bh * NS + P0) * 192; A.Kn = (const bf16_t*)(ws + WS_KN1) + (size_t)bh * NS * 128;
            A.Kr = (const bf16_t*)(ws + WS_KROPE) + (size_t)b * NS * 64; A.Vp = (const bf16_t*)(ws + WS_V1) + (size_t)bh * NS * 128;
            A.Op = (bf16_t*)(ws + WS_O) + ((size_t)(b * NS + P0) * 1024 + h * 128); A.P0 = P0; A.t0 = 0; A.NT = (P0 + 256) / 64; A.bh = bh; A.nent = 0; A.ents = nullptr;
            at::attn_unit<192, 0>((char*)ldsg, A, SB);
        }
    }
}
__device__ __forceinline__ void p_moba_gate(const Args& a, unsigned char* ldsg) {
    unsigned char* ws = a.ws;
    const at::SparseBufs SB = sparse_bufs(a);
    for (int L = blockIdx.x; L < 1024; L += gridDim.x) {
        const int bh = L >> 5, qb = L & 31;
        at::gate_unit((char*)ldsg, (const bf16_t*)(ws + WS_Q) + ((size_t)bh * NS + qb * 256) * 128, (const float*)(ws + WS_KMEAN) + (size_t)bh * 32 * 128, bh, qb, SB);
    }
}
constexpr int MOBA_PART = 512;
__device__ __forceinline__ void p_moba_gather(const Args& a, unsigned char* ldsg) {
    unsigned char* ws = a.ws;
    const at::SparseBufs SB = sparse_bufs(a);
    int tid = threadIdx.x; asm volatile("" : "+v"(tid));
    int* pre = (int*)(ldsg + 139264); int* seg = pre + 1032;
    if (tid < 32) { int s = 0; for (int j = 0; j < 32; ++j) s += (int)((SB.lcnt[tid * 32 + j] + (MOBA_PART - 1)) / MOBA_PART); seg[tid] = s; }
    __syncthreads();
    if (tid < 32) { int s = 0; for (int j = 0; j < tid; ++j) s += seg[j];
        for (int j = 0; j < 32; ++j) { pre[tid * 32 + j] = s; s += (int)((SB.lcnt[tid * 32 + j] + (MOBA_PART - 1)) / MOBA_PART); }
        if (tid == 31) pre[1024] = s; }
    __syncthreads();
    const int NU = __builtin_amdgcn_readfirstlane(pre[1024]);
    for (int u = blockIdx.x; u < NU; u += gridDim.x) {
        int lo = 0, hi = 1024;
        while (hi - lo > 1) { const int mid = (lo + hi) >> 1; if (pre[mid] <= u) lo = mid; else hi = mid; }
        const int li = __builtin_amdgcn_readfirstlane(lo), c = u - __builtin_amdgcn_readfirstlane(pre[lo]), bh = li >> 5, n = li & 31;
        const int cnt = (int)SB.lcnt[li], nrows = (cnt - MOBA_PART * c) < MOBA_PART ? (cnt - MOBA_PART * c) : MOBA_PART;
        at::moba_gather_unit((char*)ldsg, (const bf16_t*)(ws + WS_Q) + (size_t)bh * NS * 128, (const bf16_t*)(ws + WS_K0) + (size_t)bh * NS * 128, (const bf16_t*)(ws + WS_V0) + (size_t)bh * NS * 128,
                             bh, n, SB.lists + (size_t)bh * at::LCAP + at::loff(n) + MOBA_PART * c, nrows, SB);
    }
}
__device__ __forceinline__ void p_moba_own(const Args& a, unsigned char* ldsg) {
    unsigned char* ws = a.ws;
    const at::SparseBufs SB = sparse_bufs(a);
    for (int L = blockIdx.x; L < 1024; L += gridDim.x) {
        const int bh = L >> 5, qb = L & 31;
        at::moba_own_unit((char*)ldsg, (const bf16_t*)(ws + WS_Q) + (size_t)bh * NS * 128, (const bf16_t*)(ws + WS_K0) + (size_t)bh * NS * 128, (const bf16_t*)(ws + WS_V0) + (size_t)bh * NS * 128,
                          (bf16_t*)(ws + WS_O), bh, qb, SB);
    }
}

__global__ void __launch_bounds__(NTHR, 2) mega(Args a) {
    extern __shared__ __attribute__((aligned(16))) unsigned char lds_g[];
    LAS unsigned char* lds = (LAS unsigned char*)lds_g;
    const int tid = threadIdx.x;
    const int G = gridDim.x, bx = blockIdx.x, vcu = (G % 8 == 0) ? (bx % 8) * (G / 8) + bx / 8 : bx;
    unsigned char* ws = a.ws;
    volatile LAS unsigned* MISC = (volatile LAS unsigned*)(lds + LDS_MISC);
    for (int u = tid; u < 256; u += NTHR) MISC[u] = 0u;
    __syncthreads();
    XcdBarrier bar = xcd_barrier_post((unsigned*)(ws + WS_CTL) + CW_BAR, MISC);
    const int lo = a.ph_lo, hi = a.ph_hi;
#ifndef DBG_ONLY
#define DBG_EN(k) true
#else
#define DBG_EN(k) ((k) == DBG_ONLY)
#endif
#define IN(k) (DBG_EN(k) && lo <= (k) && (k) < hi)
#define SEAM(k) do { if (IN(k) && IN((k) + 1)) xcd_barrier(bar); } while (0)
    if (IN(0)) { p_prologue(a, lds, vcu, G); }
    SEAM(0);
    if (IN(1)) {
        g8::DenseP P{(const char*)(ws + WS_HB), (const char*)(ws + WS_WQKV0), 1024, 1024, 1024, NT / 256, 3072 / 256, G, bx};
        EpiQKV E{(const float*)(ws + WS_HPX), (const float*)(ws + WS_COSA), (const float*)(ws + WS_SINA), (bf16_t*)(ws + WS_Q), (bf16_t*)(ws + WS_K0), (bf16_t*)(ws + WS_V0), (float*)(ws + WS_KMEAN)};
        g8::gemm_phase(lds, P, E);
    }
    SEAM(1);
    if (IN(2)) { p_moba_gate(a, lds_g); }
    SEAM(2);
    if (IN(3)) { p_moba_gather(a, lds_g); }
    SEAM(3);
    if (IN(4)) { p_moba_own(a, lds_g); }
    SEAM(4);
    if (IN(5)) {
        g8::DenseP P{(const char*)(ws + WS_O), (const char*)(ws + WS_WO0), 1024, 1024, 1024, NT / 256, 4, G, bx};
        EpiResid E{(const bf16_t*)(ws + WS_HB), (bf16_t*)(ws + WS_HB), (float*)(ws + WS_HP0)};
        g8::gemm_phase(lds, P, E);
    }
    SEAM(5);
#define MOE_PLE(PB, layer, HBC, HBN) \
    if (IN((PB) + 0)) { p_route(a, lds, (layer), (const bf16_t*)(HBC), vcu, G); } \
    SEAM((PB) + 0); \
    if (IN((PB) + 1)) { \
        const int NRT = moe_prefix(a, lds, (layer)); \
        const unsigned* cnt = (const unsigned*)(ws + WS_CTL) + CW_CNT + (layer) * 24 * 16; \
        MoeUnits U{(LAS const int*)(lds + LDS_TB), NRT, G, bx}; \
        MoeGuP P{(const char*)(HBC), (const char*)(ws + WS_WGU) + (size_t)(layer) * 16 * 512 * 1024 * 2, (const int*)(ws + WS_LIST), cnt, U, 1024, 1024}; \
        EpiGateUp E{(const float*)(ws + WS_HP0), (const float*)(ws + WS_TOKW), (const int*)(ws + WS_LIST), cnt, (LAS const int*)(lds + LDS_TB), (bf16_t*)(ws + WS_ACT)}; \
        g8::gemm_phase(lds, P, E); \
          \
        const int extra_ = (NRT * 4) % G, gpp_ = (extra_ > 0 && (G - extra_) * 10 >= 1536) ? G - extra_ : G, cpp_ = gpp_ == G ? bx : bx - extra_; \
        g8::DenseP P2{(const char*)(ws + WS_PB), (const char*)(ws + WS_WPP) + (size_t)(layer) * 1024 * 256 * 2, 256, 256, 256, NT / 256, 4, gpp_, cpp_ < 0 ? (1 << 28) : cpp_}; \
        EpiStore E2{(bf16_t*)(ws + WS_PP), 1024}; \
        g8::gemm_phase(lds, P2, E2); \
    } \
    SEAM((PB) + 1); \
    if (IN((PB) + 2)) { \
        const int NRT = moe_prefix(a, lds, (layer)); \
        const unsigned* cnt = (const unsigned*)(ws + WS_CTL) + CW_CNT + (layer) * 24 * 16; \
        MoeUnits U{(LAS const int*)(lds + LDS_TB), NRT, G, bx}; \
        MoeDownP P{(const char*)(ws + WS_ACT), (const char*)(ws + WS_WD) + (size_t)(layer) * 16 * 1024 * 256 * 2, U, 256, 512}; \
        EpiDown E{(bf16_t*)(HBC), (float*)(ws + WS_HP1), (const int*)(ws + WS_LIST), cnt, (LAS const int*)(lds + LDS_TB)}; \
        g8::gemm_phase(lds, P, E); \
    } \
    SEAM((PB) + 2); \
    if (IN((PB) + 3)) { \
        g8::DenseP P{(const char*)(HBC), (const char*)(ws + WS_WPG) + (size_t)(layer) * 1024 * 1024 * 2, 1024, 1024, 1024, NT / 256, 4, G, bx}; \
        EpiPle E{(const float*)(ws + WS_HP1), (const bf16_t*)(ws + WS_PP), (const bf16_t*)(HBC), (bf16_t*)(HBN), (float*)(ws + WS_HP2)}; \
        g8::gemm_phase(lds, P, E); \
    } \
    SEAM((PB) + 3);
    MOE_PLE(6, 0, ws + WS_HB, a.out)
    if (IN(10)) {
        g8::DenseP P{(const char*)a.out, (const char*)(ws + WS_WDQKV), 1024, 1024, 1024, NT / 256, 3, G, bx};
        EpiDqkv E{(const float*)(ws + WS_HP2), (const float*)(ws + WS_COSB), (const float*)(ws + WS_SINB), (bf16_t*)(ws + WS_CQ), (bf16_t*)(ws + WS_CKV), (bf16_t*)(ws + WS_KROPE), (float*)(ws + WS_CQP), (float*)(ws + WS_KVP)};
        g8::gemm_phase(lds, P, E);
    }
    SEAM(10);
    if (IN(11)) {
        g8::DenseP P{(const char*)(ws + WS_CQ), (const char*)(ws + WS_WUQ), 384, 384, 384, NT / 256, 6, G, bx};
        EpiUq E{(const float*)(ws + WS_CQP), (const float*)(ws + WS_COSB), (const float*)(ws + WS_SINB), (bf16_t*)(ws + WS_Q)};
        g8::gemm_phase(lds, P, E);
        g8::DenseP P2{(const char*)(ws + WS_CKV), (const char*)(ws + WS_WUKV), 256, 256, 256, NT / 256, 8, G, bx};
        EpiUkv E2{(const float*)(ws + WS_KVP), (bf16_t*)(ws + WS_KN1), (bf16_t*)(ws + WS_V1)};
        g8::gemm_phase(lds, P2, E2);
    }
    SEAM(11);
    if (IN(12)) { p_attention_mla(a, lds_g); }
    SEAM(12);
    if (IN(13)) {
        g8::DenseP P{(const char*)(ws + WS_O), (const char*)(ws + WS_WO1), 1024, 1024, 1024, NT / 256, 4, G, bx};
        EpiResid E{(const bf16_t*)a.out, (bf16_t*)a.out, (float*)(ws + WS_HP0)};
        g8::gemm_phase(lds, P, E);
    }
    SEAM(13);
    MOE_PLE(14, 1, a.out, ws + WS_HB)
    if (IN(18)) {
        int t2 = threadIdx.x; asm volatile("" : "+v"(t2)); const int lane = t2 & 63, wave = t2 >> 6; const float* fg = a.in[5];
        const bf16_t* hfin = (const bf16_t*)(ws + WS_HB);
        for (int mrow = vcu * NWAVES + wave; mrow < NT; mrow += G * NWAVES) {
            f32x4 v[4]; float s = 0.f;
#pragma unroll
            for (int j = 0; j < 2; ++j) { unpack8(*((const u32x4*)(hfin + (size_t)mrow * 1024) + lane + 64 * j), v[2 * j], v[2 * j + 1]); s += dot4(v[2 * j]) + dot4(v[2 * j + 1]); }
            s = wave_sum(s);
            const float r = rsqrtf(s * (1.0f / 1024.0f) + EPS);
            f32x4* xr = (f32x4*)(a.out + (size_t)mrow * 1024);
#pragma unroll
            for (int j = 0; j < 2; ++j) { const int c4 = 2 * (lane + 64 * j);
                xr[c4] = v[2 * j] * r * *((const f32x4*)fg + c4); xr[c4 + 1] = v[2 * j + 1] * r * *((const f32x4*)fg + c4 + 1); }
        }
    }
#undef IN
#undef SEAM
}

constexpr int N_PHASES = 19;
static int g_grid = 0;
static bool setup() {
    if (g_grid) return g_grid > 0;
    int dev = 0, cus = 0;
    if (hipGetDevice(&dev) != hipSuccess || hipDeviceGetAttribute(&cus, hipDeviceAttributeMultiprocessorCount, dev) != hipSuccess) { g_grid = -1; return false; }
    if (hipFuncSetAttribute((const void*)mega, hipFuncAttributeMaxDynamicSharedMemorySize, LDS_BYTES) != hipSuccess) { fprintf(stderr, "hipFuncSetAttribute failed\n"); g_grid = -1; return false; }
    int per_cu = 0;
    if (hipOccupancyMaxActiveBlocksPerMultiprocessor(&per_cu, (const void*)mega, NTHR, LDS_BYTES) != hipSuccess || per_cu < 1) { fprintf(stderr, "occupancy query: %d\n", per_cu); }
    (void)hipGetLastError();
    g_grid = cus;
    return true;
}
static void run_phases(const Args& base, int lo, int hi, bool one_launch, hipStream_t st) {
    if (one_launch) { Args a = base; a.ph_lo = lo; a.ph_hi = hi; hipLaunchKernelGGL(mega, dim3(g_grid), dim3(NTHR), LDS_BYTES, st, a); }
    else for (int p = lo; p < hi; ++p) { Args a = base; a.ph_lo = p; a.ph_hi = p + 1;
#ifdef PROBE_ROUTE
        if (p == 6) { Args b = base; b.ph_lo = 14; b.ph_hi = 15; hipLaunchKernelGGL(mega, dim3(g_grid), dim3(NTHR), LDS_BYTES, st, b); }
        if (p == 14) (void)hipMemsetAsync(base.ws + WS_CTL + (CW_CNT + 24 * 16) * 4, 0, 24 * 16 * 4, st);
#endif
        hipLaunchKernelGGL(mega, dim3(g_grid), dim3(NTHR), LDS_BYTES, st, a);
#ifdef DOUBLE_PHASE
        if (p == DOUBLE_PHASE) hipLaunchKernelGGL(mega, dim3(g_grid), dim3(NTHR), LDS_BYTES, st, a);
#endif
    }
}
}
#ifndef ONE_LAUNCH
#define ONE_LAUNCH 1
#endif
extern "C" void kernel_launch(void* const* d_in, const int* in_sizes, int n_in, void* d_out, int out_size, void* d_ws, size_t ws_size, hipStream_t stream) {
    (void)in_sizes; (void)out_size;
    if (n_in != 22) { fprintf(stderr, "kernel_launch: expected 22 inputs, got %d\n", n_in); return; }
    if (ws_size < fk::WS_END) { fprintf(stderr, "kernel_launch: workspace too small (%zu)\n", ws_size); return; }
    if (!fk::setup()) return;
    (void)hipMemsetAsync((char*)d_ws + fk::WS_CTL, 0, fk::CTL_ZERO_BYTES, stream);
    fk::Args a{};
    for (int i = 0; i < 22; ++i) a.in[i] = (const float*)d_in[i];
    a.out = (float*)d_out; a.ws = (unsigned char*)d_ws;
    fk::run_phases(a, 0, fk::N_PHASES, ONE_LAUNCH != 0, stream);
}
```

```cpp
#include <hip/hip_runtime.h>
#include <cstdio>
#include <cstdint>
#include <cmath>
namespace fk {
#define LAS __attribute__((address_space(3)))
#define GAS __attribute__((address_space(1)))
typedef unsigned short bf16_t;
typedef short bf16x8 __attribute__((ext_vector_type(8)));
typedef short s16x4 __attribute__((ext_vector_type(4)));
typedef float f32x4 __attribute__((ext_vector_type(4)));
typedef float f32x16 __attribute__((ext_vector_type(16)));
typedef unsigned u32x4 __attribute__((ext_vector_type(4)));
typedef unsigned u32x2 __attribute__((ext_vector_type(2)));
typedef float f32x2_t __attribute__((ext_vector_type(2)));
typedef __bf16 bf16x2_t __attribute__((ext_vector_type(2)));

constexpr int NB = 4, NS = 8192, ND = 1024, NT = NB * NS, NH = 8;
constexpr float EPS = 1e-6f;
constexpr int NWAVES = 8, NTHR = 512;

constexpr size_t MiB = 1u << 20;
constexpr size_t WS_CTL = 0, CTL_ZERO_BYTES = 1 * MiB;
constexpr size_t WS_COSA = 1 * MiB, WS_SINA = 3 * MiB, WS_COSB = 5 * MiB, WS_SINB = 6 * MiB;
constexpr size_t WS_KMEAN = 7 * MiB;
constexpr size_t WS_WRT = 7 * MiB + 512 * 1024;
constexpr size_t WS_HPX = 8 * MiB, WS_HP0 = 10 * MiB, WS_HP1 = 12 * MiB, WS_HP2 = 14 * MiB;
constexpr size_t WS_CQP = 16 * MiB, WS_KVP = 17 * MiB;
constexpr size_t WS_TOKW = 18 * MiB;
constexpr size_t WS_LIST = 19 * MiB;
constexpr size_t WS_WQKV0 = 24 * MiB, WS_WO0 = 30 * MiB, WS_WDQKV = 32 * MiB, WS_WUQ = 34 * MiB, WS_WUKV = 36 * MiB, WS_WO1 = 37 * MiB;
constexpr size_t WS_WGU = 40 * MiB;
constexpr size_t WS_WD = 72 * MiB;
constexpr size_t WS_WPG = 88 * MiB;
constexpr size_t WS_WPP = 92 * MiB;
constexpr size_t WS_HB = 94 * MiB;
constexpr size_t WS_CQ = WS_HB, WS_CKV = WS_HB + 24 * MiB, WS_KROPE = WS_HB + 40 * MiB;
constexpr size_t WS_O = 158 * MiB;
constexpr size_t WS_R = 222 * MiB;
constexpr size_t WS_Q = WS_R, WS_K0 = WS_R + 64 * MiB, WS_V0 = WS_R + 128 * MiB;
constexpr size_t WS_K8 = WS_K0, WS_Q8 = WS_K0 + 32 * MiB;
constexpr size_t WS_X8 = WS_R + 192 * MiB;
constexpr size_t WS_KN1 = WS_R + 96 * MiB, WS_V1 = WS_R + 160 * MiB;
constexpr size_t WS_ACT = WS_R, WS_PB = WS_R + 40 * MiB, WS_PP = WS_R + 64 * MiB;
constexpr size_t WS_PART2 = WS_R + 224 * MiB;
constexpr size_t WS_END = WS_PART2 + 64 * MiB;
constexpr int CW_CNT = 1024;
constexpr int CW_BAR = 4096;
constexpr int CW_LCNT = 8192;

constexpr int RING_BYTES = 131072;
constexpr int LDS_MISC = RING_BYTES;
constexpr int LDS_BYTES = 147456;

struct Args { const float* in[22]; float* out; unsigned char* ws; int ph_lo, ph_hi; };

__device__ __forceinline__ unsigned cvtpk(float lo, float hi) { f32x2_t v = {lo, hi}; bf16x2_t b = __builtin_convertvector(v, bf16x2_t); return __builtin_bit_cast(unsigned, b); }
__device__ __forceinline__ float bf2f(unsigned short b) { return __builtin_bit_cast(float, (unsigned)b << 16); }
__device__ __forceinline__ u32x4 pack8(f32x4 a, f32x4 b) { u32x4 w = {cvtpk(a[0], a[1]), cvtpk(a[2], a[3]), cvtpk(b[0], b[1]), cvtpk(b[2], b[3])}; return w; }
__device__ __forceinline__ unsigned pack4_fp8(f32x4 a) { int t = __builtin_amdgcn_cvt_pk_fp8_f32(a[0], a[1], 0, false); t = __builtin_amdgcn_cvt_pk_fp8_f32(a[2], a[3], t, true); return (unsigned)t; }
__device__ __forceinline__ float wave_sum(float v) {
#pragma unroll
    for (int o = 1; o < 64; o <<= 1) v += __shfl_xor(v, o);
    return v;
}
__device__ __forceinline__ float dot4(f32x4 a) { return (a[0] * a[0] + a[1] * a[1]) + (a[2] * a[2] + a[3] * a[3]); }
template <int NP> __device__ __forceinline__ float row_rs(const float* hp, float invd) {
    float s = 0.f;
#pragma unroll
    for (int i = 0; i < NP / 4; ++i) { const f32x4 a = *(const f32x4*)(hp + 4 * i); s += (a[0] + a[1]) + (a[2] + a[3]); }
    return rsqrtf(s * invd + EPS);
}

#define XB_TMO      128
#define XB_XCNT(j)  (256  + 64 * (j))
#define XB_XSUB(j)  (1280 + 64 * (j))
#define XB_XGEN(j)  (2304 + 64 * (j))
#define XB_TOP      3328
#define XB_TOPGEN   3392
#define XCD_BAR_WORDS 3456
#define XB_SPIN_CAP (1u << 18)
__device__ __forceinline__ unsigned xb_ld(unsigned* p)              { return __hip_atomic_load(p, __ATOMIC_RELAXED, __HIP_MEMORY_SCOPE_AGENT); }
__device__ __forceinline__ unsigned xb_add(unsigned* p, unsigned v) { return __hip_atomic_fetch_add(p, v, __ATOMIC_RELAXED, __HIP_MEMORY_SCOPE_AGENT); }
__device__ __forceinline__ unsigned xb_xcc_id() { return (unsigned)__builtin_amdgcn_s_getreg((3 << 11) | 20) & 0xFu; }
#define XB_SPIN(cond, bar) do { unsigned _sp = 0; while (cond) { __builtin_amdgcn_s_sleep(1); \
    if ((++_sp & 255u) == 0u) { if (xb_ld(&(bar)[XB_TMO])) break; if (_sp > XB_SPIN_CAP) { atomicAdd(&(bar)[XB_TMO], 1u); break; } } } } while (0)
struct XcdBarrier { unsigned* bar; unsigned x; volatile LAS unsigned* st; };
__device__ __forceinline__ XcdBarrier xcd_barrier_post(unsigned* bar, volatile LAS unsigned* st) {
    XcdBarrier b; b.bar = bar; b.x = xb_xcc_id(); b.st = st;
    if (threadIdx.x == 0) (void)xb_add(&bar[XB_XCNT(b.x)], 1u);
    return b;
}
__device__ __forceinline__ void xcd_barrier_complete(unsigned* bar, unsigned x, unsigned& nloc, unsigned& nx) {
    const unsigned G = gridDim.x * gridDim.y * gridDim.z;
    unsigned sum, cnt, mine, sp = 0u;
    for (;;) {
        sum = 0u; cnt = 0u; mine = 0u;
#pragma unroll
        for (unsigned j = 0; j < 16; ++j) { const unsigned c = xb_ld(&bar[XB_XCNT(j)]); sum += c; cnt += (c > 0u) ? 1u : 0u; mine = (j == x) ? c : mine; }
        if (sum == G) break;
        __builtin_amdgcn_s_sleep(1);
        if ((++sp & 255u) == 0u) { if (xb_ld(&bar[XB_TMO])) break; if (sp > XB_SPIN_CAP) { atomicAdd(&bar[XB_TMO], 1u); break; } }
    }
    nloc = mine > 0u ? mine : 1u; nx = cnt > 0u ? cnt : 1u;
}
__device__ __forceinline__ void xcd_barrier(const XcdBarrier& b) {
    asm volatile("s_waitcnt vmcnt(0)" ::: "memory");
    __syncthreads();
    if (threadIdx.x == 0) {
        unsigned* bar = b.bar;
        __builtin_amdgcn_s_waitcnt(0);
        unsigned nloc = b.st[0], nx = b.st[1];
        if (nloc == 0u) { xcd_barrier_complete(bar, b.x, nloc, nx); b.st[0] = nloc; b.st[1] = nx; }
        const unsigned old = xb_add(&bar[XB_XSUB(b.x)], 1u);
        const unsigned gen = old / nloc;
        if (old + 1u == (gen + 1u) * nloc) {
            __builtin_amdgcn_fence(__ATOMIC_RELEASE, "agent");
            asm volatile("s_waitcnt vmcnt(0)" ::: "memory");
            const unsigned og = xb_add(&bar[XB_TOP], 1u);
            const unsigned tg = og / nx;
            if (og + 1u == (tg + 1u) * nx) xb_add(&bar[XB_TOPGEN], 1u);
            else XB_SPIN(xb_ld(&bar[XB_TOPGEN]) == tg, bar);
            __builtin_amdgcn_fence(__ATOMIC_ACQUIRE, "agent");
            xb_add(&bar[XB_XGEN(b.x)], 1u);
            asm volatile("s_waitcnt vmcnt(0)" ::: "memory");
        } else {
            XB_SPIN(xb_ld(&bar[XB_XGEN(b.x)]) == gen, bar);
            __builtin_amdgcn_fence(__ATOMIC_ACQUIRE, "agent");
            asm volatile("s_waitcnt vmcnt(0)" ::: "memory");
        }
    }
    __syncthreads();
}

namespace g8 {
constexpr int BM = 256, BK = 64, HALF = 128, HTB = HALF * BK * 2, STAGE_BYTES = 8 * HTB, NXCD = 8, WGM = 8;
__device__ __forceinline__ int lds_byte(int r, int c) { const int st = (r >> 4) * 2 + (c >> 5), rr = r & 15, cc = c & 31, ob = rr * 64 + cc * 2; return st * 1024 + (ob ^ (((ob >> 9) & 1) << 5)); }
__device__ __forceinline__ void stage_rc(int b, int& R, int& C) { const int st = b / 1024, sb = b % 1024, swz = sb ^ (((sb >> 9) & 1) << 5); R = (st >> 1) * 16 + swz / 64; C = (st & 1) * 32 + (swz % 64) / 2; }
__device__ __forceinline__ int perm32(int rho) { const int n = rho >> 4, i = rho & 15; return 8 * (i >> 2) + 4 * n + (i & 3); }
struct Unit { int pm, pn, aux; };
struct AOff { unsigned o[2][2]; };

__device__ __forceinline__ bool static_order(int i, int G, int c, int nM, int nN, int& pm, int& pn) {
    const int nwg = nM * nN; const long L = (long)i * G + c; if (L >= nwg) return false;
    int wgid = (int)L; { const int q = nwg / NXCD, r = nwg % NXCD, xcd = wgid % NXCD, off = wgid / NXCD; wgid = (xcd < r ? xcd * (q + 1) : r * (q + 1) + (xcd - r) * q) + off; }
    const int nig = WGM * nN, gid = wgid / nig, fm = gid * WGM, gsz = (nM - fm) < WGM ? (nM - fm) : WGM;
    pm = fm + ((wgid % nig) % gsz); pn = (wgid % nig) / gsz; return true;
}
struct DenseP {
    const char* A; const char* B; int lda, ldb, K, nM, nN, G, c;
    __device__ __forceinline__ bool next(int i, Unit& u) const { u.aux = 0; return static_order(i, G, c, nM, nN, u.pm, u.pn); }
    __device__ __forceinline__ void aoff(const Unit& u, const int (&R)[2], const int (&C)[2], AOff& o) const {
#pragma unroll
        for (int h = 0; h < 2; ++h)
#pragma unroll
            for (int i = 0; i < 2; ++i) o.o[h][i] = (unsigned)(((u.pm * BM + h * HALF + R[i]) * lda + C[i]) * 2);
    }
    __device__ __forceinline__ const char* bbase(const Unit& u, int kt) const { return B + ((size_t)u.pn * BM * ldb + (size_t)kt * BK) * 2; }
};

template <class Prov, class Epi, bool F8 = false>
__device__ __forceinline__ void gemm_phase(LAS unsigned char* lds, const Prov& P, const Epi& E) {
    int tid = threadIdx.x; asm volatile("" : "+v"(tid));
    const int wid = __builtin_amdgcn_readfirstlane(tid >> 6), lane = tid & 63, wr = wid >> 2, wc = wid & 3, fr = lane & 15, fq = lane >> 4;
    const int K = P.K, nt = K / BK;
    unsigned voffB[2];
#pragma unroll
    for (int i = 0; i < 2; ++i) { int R_, C_; stage_rc(tid * 16 + i * 8192, R_, C_); const int Rb = (R_ & ~31) + perm32(R_ & 31); voffB[i] = (unsigned)(Rb * P.ldb + C_) * 2u; }
#define G8_AOFF(u, dst) do { int t_ = tid; asm volatile("" : "+v"(t_)); int R[2], C[2]; _Pragma("unroll") for (int i_ = 0; i_ < 2; ++i_) stage_rc(t_ * 16 + i_ * 8192, R[i_], C[i_]); P.aoff(u, R, C, dst); } while (0)
    const size_t hstepB = (size_t)HALF * P.ldb * 2;
    const unsigned ldsw = (unsigned)wid * 1024u;
    const int aoff = lds_byte(wr * 64 + fr, fq * 8), boff = lds_byte(wc * 32 + fr, fq * 8);
#define G8_SA(b, h) (((b) * 2 + (h)) * HTB)
#define G8_SB(b, h) ((4 + (b) * 2 + (h)) * HTB)
#define G8_STAGE_A(bufoff, h, AO, kb) do { _Pragma("unroll") for (int _i = 0; _i < 2; ++_i) \
        __builtin_amdgcn_global_load_lds((const unsigned*)(P.A + (size_t)((AO).o[h][_i] + (kb))), (LAS unsigned*)(lds + (bufoff) + ldsw + _i * 8192), 16, 0, 0); } while (0)
#define G8_STAGE_A2(bufoff, h, kb) do { _Pragma("unroll") for (int _i = 0; _i < 2; ++_i) \
        __builtin_amdgcn_global_load_lds((const unsigned*)(P.A + (size_t)((last ? nA.o[h][_i] : cA.o[h][_i]) + (kb))), (LAS unsigned*)(lds + (bufoff) + ldsw + _i * 8192), 16, 0, 0); } while (0)
#define G8_STAGE_B(bufoff, bp) do { _Pragma("unroll") for (int _i = 0; _i < 2; ++_i) \
        __builtin_amdgcn_global_load_lds((const unsigned*)((bp) + voffB[_i]), (LAS unsigned*)(lds + (bufoff) + ldsw + _i * 8192), 16, 0, 0); } while (0)
    typedef int v8i_ __attribute__((ext_vector_type(8))); typedef int v4i_ __attribute__((ext_vector_type(4)));
#define G8_LDA(dst, b, h) do { _Pragma("unroll") for (int m = 0; m < 4; ++m) { if constexpr (F8) { const v4i_ x0_ = *(const LAS v4i_*)(lds + G8_SA(b, h) + aoff + m * 2048), x1_ = *(const LAS v4i_*)(lds + G8_SA(b, h) + aoff + m * 2048 + 1024); \
            dst##8[m] = (v8i_){x0_[0], x0_[1], x0_[2], x0_[3], x1_[0], x1_[1], x1_[2], x1_[3]}; } \
        else { _Pragma("unroll") for (int k = 0; k < 2; ++k) dst[m][k] = *(const LAS bf16x8*)(lds + G8_SA(b, h) + aoff + m * 2048 + k * 1024); } } } while (0)
#define G8_LDB(dst, b, h) do { _Pragma("unroll") for (int n = 0; n < 2; ++n) { if constexpr (F8) { const v4i_ x0_ = *(const LAS v4i_*)(lds + G8_SB(b, h) + boff + n * 2048), x1_ = *(const LAS v4i_*)(lds + G8_SB(b, h) + boff + n * 2048 + 1024); \
            dst##8[n] = (v8i_){x0_[0], x0_[1], x0_[2], x0_[3], x1_[0], x1_[1], x1_[2], x1_[3]}; } \
        else { _Pragma("unroll") for (int k = 0; k < 2; ++k) dst[n][k] = *(const LAS bf16x8*)(lds + G8_SB(b, h) + boff + n * 2048 + k * 1024); } } } while (0)
#define G8_MMA(ai, bj, At, Bt) do { __builtin_amdgcn_s_setprio(1); _Pragma("unroll") for (int m = 0; m < 4; ++m) _Pragma("unroll") for (int n = 0; n < 2; ++n) { \
        if constexpr (F8) asm volatile("v_mfma_scale_f32_16x16x128_f8f6f4 %0, %1, %2, %0, %3, %3 op_sel_hi:[0,0,0]" : "+v"(acc[ai][bj][m][n]) : "v"(Bt##8[n]), "v"(At##8[m]), "v"(sc8));   \
        else { _Pragma("unroll") for (int k = 0; k < 2; ++k) acc[ai][bj][m][n] = __builtin_amdgcn_mfma_f32_16x16x32_bf16(Bt[n][k], At[m][k], acc[ai][bj][m][n], 0, 0, 0); } } \
        __builtin_amdgcn_s_setprio(0); } while (0)
#define G8_WAIT_V(n) asm volatile("s_waitcnt vmcnt(" #n ")" ::: "memory")
#define G8_WAIT_L(n) asm volatile("s_waitcnt lgkmcnt(" #n ")" ::: "memory")
#define G8_BAR __builtin_amdgcn_s_barrier()
#define G8_SCHED __builtin_amdgcn_sched_barrier(0)
    Unit cur, nxt; int ui = 0;
    if (!P.next(0, cur)) return;
    f32x4 acc[2][2][4][2];
#pragma unroll
    for (int a = 0; a < 2; ++a)
#pragma unroll
        for (int b = 0; b < 2; ++b)
#pragma unroll
            for (int m = 0; m < 4; ++m)
#pragma unroll
                for (int n = 0; n < 2; ++n) acc[a][b][m][n] = (f32x4){0.f, 0.f, 0.f, 0.f};
    int sc8 = 0x7f7f7f7f; asm volatile("" : "+v"(sc8));
    bf16x8 At[4][2], B0[2][2], B1[2][2]; v8i_ At8[4], B08[2], B18[2];
    AOff cA, nA;
    G8_AOFF(cur, cA);
    {   const char* b0 = P.bbase(cur, 0); const char* b1 = P.bbase(cur, 1);
        G8_STAGE_B(G8_SB(0, 0), b0); G8_STAGE_B(G8_SB(0, 1), b0 + hstepB); G8_STAGE_A(G8_SA(0, 0), 0, cA, 0u); G8_STAGE_A(G8_SA(0, 1), 1, cA, 0u);
        if (wr == 1) G8_BAR;
        G8_WAIT_V(2); G8_BAR;
        G8_STAGE_B(G8_SB(1, 0), b1); G8_STAGE_A(G8_SA(1, 0), 0, cA, 128u); G8_STAGE_B(G8_SB(1, 1), b1 + hstepB);
        G8_WAIT_V(6); G8_BAR; }
    for (;;) {
        const bool has_next = P.next(ui + 1, nxt);
        if (has_next) G8_AOFF(nxt, nA); else { nA = cA; nxt = cur; }
        for (int t = 0; t < nt; t += 2) {
            const bool last = (t == nt - 2);
            const unsigned kb1 = (unsigned)(t + 1) * 128u;
            const unsigned kb2 = last ? 0u : (unsigned)(t + 2) * 128u, kb3 = kb2 + 128u;
            const char* b2 = last ? P.bbase(nxt, 0) : P.bbase(cur, t + 2);
            const char* b3 = last ? P.bbase(nxt, 1) : P.bbase(cur, t + 3);
            G8_LDB(B0, 0, 0); G8_LDB(B1, 0, 1); G8_SCHED; G8_LDA(At, 0, 0); G8_STAGE_A(G8_SA(1, 1), 1, cA, kb1);
            G8_WAIT_V(8); G8_WAIT_L(0); G8_BAR; G8_MMA(0, 0, At, B0); G8_MMA(0, 1, At, B1); G8_BAR; G8_SCHED;
            G8_LDA(At, 0, 1); G8_STAGE_B(G8_SB(0, 0), b2); G8_STAGE_B(G8_SB(0, 1), b2 + hstepB); G8_STAGE_A2(G8_SA(0, 0), 0, kb2);
            G8_WAIT_V(8); G8_WAIT_L(0); G8_BAR; G8_MMA(1, 0, At, B0); G8_MMA(1, 1, At, B1); G8_BAR; G8_SCHED;
            G8_LDB(B0, 1, 0); G8_LDB(B1, 1, 1); G8_SCHED; G8_LDA(At, 1, 0); G8_STAGE_A2(G8_SA(0, 1), 1, kb2);
            G8_WAIT_V(8); G8_WAIT_L(0); G8_BAR; G8_MMA(0, 0, At, B0); G8_MMA(0, 1, At, B1); G8_BAR; G8_SCHED;
            G8_LDA(At, 1, 1); G8_STAGE_B(G8_SB(1, 0), b3); G8_STAGE_B(G8_SB(1, 1), b3 + hstepB); G8_STAGE_A2(G8_SA(1, 0), 0, kb3);
            G8_WAIT_V(8); G8_WAIT_L(0); G8_BAR; G8_MMA(1, 0, At, B0); G8_MMA(1, 1, At, B1); G8_BAR; G8_SCHED;
        }
        if (wr == 0) G8_BAR;
        if constexpr (F8) asm volatile("s_nop 15\n\ts_nop 15" ::: "memory");
        E(acc, cur, wr, wc, fr, fq);
        if (!has_next) break;
#pragma unroll
        for (int a = 0; a < 2; ++a)
#pragma unroll
            for (int b = 0; b < 2; ++b)
#pragma unroll
                for (int m = 0; m < 4; ++m)
#pragma unroll
                    for (int n = 0; n < 2; ++n) acc[a][b][m][n] = (f32x4){0.f, 0.f, 0.f, 0.f};
        cur = nxt; cA = nA; ++ui;
        if (wr == 1) G8_BAR;
    }
    G8_WAIT_V(0);
    G8_BAR;
#undef G8_SA
#undef G8_SB
#undef G8_STAGE_A
#undef G8_STAGE_A2
#undef G8_AOFF
#undef G8_STAGE_B
#undef G8_LDA
#undef G8_LDB
#undef G8_MMA
#undef G8_WAIT_V
#undef G8_WAIT_L
#undef G8_BAR
#undef G8_SCHED
}
}
using g8::Unit;


struct EpiQKV {
    const float* hpx; const float* cosA; const float* sinA; bf16_t* Q; bf16_t* Kk; bf16_t* V; float* kmean; unsigned char* Q8; unsigned char* K8; int pn0; float ascale;
    __device__ __forceinline__ void operator()(const f32x4 (&acc)[2][2][4][2], const Unit& u0, int wr, int wc, int fr, int fq) const {
        Unit u = u0; u.pn += pn0;
        const int t = u.pn >> 2;
        const int bb = u.pm >> 5;
        if (t < 2) {
            const int hh = 2 * (u.pn & 3) + (wc >> 1), j0 = 32 * (wc & 1) + 8 * fq;
            bf16_t* dst0 = (t == 0 ? Q : Kk) + ((size_t)(bb * NH + hh) * NS) * 128;
            f32x4 ks[2][2] = {{{0.f, 0.f, 0.f, 0.f}, {0.f, 0.f, 0.f, 0.f}}, {{0.f, 0.f, 0.f, 0.f}, {0.f, 0.f, 0.f, 0.f}}};
#pragma unroll
            for (int ai = 0; ai < 2; ++ai)
#pragma unroll
                for (int m = 0; m < 4; ++m) {
                    const int row = u.pm * 256 + 128 * ai + 64 * wr + 16 * m + fr, s = row & (NS - 1);
                    const float rs = row_rs<16>(hpx + (size_t)row * 16, 1.0f / 1024.0f) * ascale;
                    f32x4 o1[2], o2[2];
#pragma unroll
                    for (int n = 0; n < 2; ++n) {
                        const f32x4 cs = *(const f32x4*)(cosA + (size_t)s * 64 + j0 + 4 * n), sn = *(const f32x4*)(sinA + (size_t)s * 64 + j0 + 4 * n);
                        const f32x4 x1 = acc[ai][0][m][n] * rs, x2 = acc[ai][1][m][n] * rs;
                        o1[n] = x1 * cs - x2 * sn; o2[n] = x1 * sn + x2 * cs;
                        ks[0][n] += o1[n]; ks[1][n] += o2[n];
                    }
                    if (t == 0) { bf16_t* d = dst0 + (size_t)s * 128 + j0; *(u32x4*)d = pack8(o1[0], o1[1]); *(u32x4*)(d + 64) = pack8(o2[0], o2[1]); }
                    {   unsigned char* d8 = (t == 0 ? Q8 : K8) + ((size_t)(bb * NH + hh) * NS + s) * 128 + j0;
                        u32x2 w1, w2; w1.x = pack4_fp8(o1[0]); w1.y = pack4_fp8(o1[1]); w2.x = pack4_fp8(o2[0]); w2.y = pack4_fp8(o2[1]);
                        *(u32x2*)d8 = w1; *(u32x2*)(d8 + 64) = w2; }
                }
            if (t == 1) {
#pragma unroll
                for (int q = 0; q < 2; ++q)
#pragma unroll
                    for (int n = 0; n < 2; ++n)
#pragma unroll
                        for (int e = 0; e < 4; ++e) { float v = ks[q][n][e]; v += __shfl_xor(v, 1); v += __shfl_xor(v, 2); v += __shfl_xor(v, 4); v += __shfl_xor(v, 8); ks[q][n][e] = v; }
                if (fr == 0) {
                    float* km = kmean + ((size_t)(bb * NH + hh) * 32 + (u.pm & 31)) * 128 + j0;
#pragma unroll
                    for (int q = 0; q < 2; ++q)
#pragma unroll
                        for (int n = 0; n < 2; ++n)
#pragma unroll
                            for (int e = 0; e < 4; ++e) atomicAdd(km + 64 * q + 4 * n + e, ks[q][n][e]);
                }
            }
        } else {
            const int d0 = 32 * wc + 8 * fq;
#pragma unroll
            for (int ai = 0; ai < 2; ++ai)
#pragma unroll
                for (int m = 0; m < 4; ++m) {
                    const int row = u.pm * 256 + 128 * ai + 64 * wr + 16 * m + fr, s = row & (NS - 1);
                    const float rs = row_rs<16>(hpx + (size_t)row * 16, 1.0f / 1024.0f) * ascale;
#pragma unroll
                    for (int bj = 0; bj < 2; ++bj) {
                        const int hh = 2 * (u.pn - 8) + bj;
                        bf16_t* d = V + ((size_t)(bb * NH + hh) * NS + s) * 128 + d0;
                        *(u32x4*)d = pack8(acc[ai][bj][m][0] * rs, acc[ai][bj][m][1] * rs);
                    }
                }
        }
    }
};

__device__ __forceinline__ void unpack8(u32x4 w, f32x4& a, f32x4& b) {
#pragma unroll
    for (int e = 0; e < 2; ++e) { a[2 * e] = __builtin_bit_cast(float, w[e] << 16); a[2 * e + 1] = __builtin_bit_cast(float, w[e] & 0xffff0000u);
                                  b[2 * e] = __builtin_bit_cast(float, w[2 + e] << 16); b[2 * e + 1] = __builtin_bit_cast(float, w[2 + e] & 0xffff0000u); }
}
struct EpiResid {
    const bf16_t* base; bf16_t* hb; float* hp; float ascale;
    __device__ __forceinline__ void operator()(const f32x4 (&acc)[2][2][4][2], const Unit& u, int wr, int wc, int fr, int fq) const {
#pragma unroll
        for (int ai = 0; ai < 2; ++ai)
#pragma unroll
            for (int m = 0; m < 4; ++m) {
                const int row = u.pm * 256 + 128 * ai + 64 * wr + 16 * m + fr;
                float ss = 0.f;
#pragma unroll
                for (int bj = 0; bj < 2; ++bj) {
                    const size_t off = (size_t)row * 1024 + u.pn * 256 + 128 * bj + 32 * wc + 8 * fq;
                    f32x4 b0, b1; unpack8(*(const u32x4*)(base + off), b0, b1);
                    const f32x4 v0 = acc[ai][bj][m][0] * ascale + b0, v1 = acc[ai][bj][m][1] * ascale + b1;
                    *(u32x4*)(hb + off) = pack8(v0, v1);
                    ss += dot4(v0) + dot4(v1);
                }
                ss += __shfl_xor(ss, 16); ss += __shfl_xor(ss, 32);
                if (fq == 0) hp[(size_t)row * 16 + u.pn * 4 + wc] = ss;
                if (m & 1) asm volatile("" ::: "memory");
            }
    }
};
namespace at {
constexpr int KVBLK = 64, SHM_V = KVBLK * 128 * 2;
constexpr float THR = 8.f;
#define AT_SBAR() __builtin_amdgcn_sched_barrier(0)
__device__ __forceinline__ int v_st(int k, int c) { const int kk = (k & ~0xC) | ((k & 4) << 1) | ((k & 8) >> 1); return ((kk >> 3) * 4 + (c >> 5)) * 512 + ((kk & 7) * 32 + (c & 31)) * 2; }
__device__ __forceinline__ int v_rd_base(int lane) { return ((lane & 3) << 3) | (((lane >> 2) & 3) << 6) | (((lane >> 4) & 1) << 5) | (((lane >> 5) & 1) << 8); }
constexpr int v_rd_off(int d0, int ks, int half) { return d0 * 512 + ks * 4096 + half * 2048; }
__device__ __forceinline__ int crow(int r, int hi) { return (r & 3) + 8 * (r >> 2) + 4 * hi; }

template <int DQK> constexpr int krow() { return DQK == 192 ? 400 : DQK * 2; }
template <int DQK> __device__ __forceinline__ int kswz(int row, int colB) { return DQK == 192 ? row * 400 + colB : row * (DQK * 2) + (colB ^ ((row & 7) << 4)); }

__device__ __forceinline__ void mask_causal(f32x16& p0, f32x16& p1, int dq) {
    const float NEG = -__builtin_inff();
#pragma unroll
    for (int r = 0; r < 16; ++r) {
        const int c = (r & 3) + 8 * (r >> 2);
        if (dq - c < 0) p0[r] = NEG;
        if (dq - c - 32 < 0) p1[r] = NEG;
    }
}
__device__ __forceinline__ void mask_all(f32x16& p0, f32x16& p1, bool keep) {
    const float NEG = -__builtin_inff();
#pragma unroll
    for (int r = 0; r < 16; ++r) { p0[r] = keep ? p0[r] : NEG; p1[r] = keep ? p1[r] : NEG; }
}
__device__ __forceinline__ void partialSM(f32x16& p0, f32x16& p1, float& m_reg, float& mn, float& alpha, const float SC, const float C2) {
    float pmax = p0[0];
#pragma unroll
    for (int r = 1; r < 16; ++r) pmax = fmaxf(pmax, p0[r]);
#pragma unroll
    for (int r = 0; r < 16; ++r) pmax = fmaxf(pmax, p1[r]);
    { auto rr = __builtin_amdgcn_permlane32_swap(__float_as_uint(pmax), __float_as_uint(pmax), false, false);
      pmax = fmaxf(__uint_as_float(rr[0]), __uint_as_float(rr[1])); }
    if (__builtin_expect(__all((pmax - m_reg) * SC <= THR), 1)) { mn = m_reg; alpha = 1.f; }
    else { mn = fmaxf(m_reg, pmax); alpha = __builtin_amdgcn_exp2f((m_reg - mn) * C2); m_reg = mn; }
    const float mnL = -mn * C2;
#pragma unroll
    for (int r = 0; r < 16; ++r) p0[r] = fmaf(p0[r], C2, mnL);
#pragma unroll
    for (int r = 0; r < 16; ++r) p1[r] = fmaf(p1[r], C2, mnL);
#pragma unroll
    for (int r = 0; r < 16; ++r) p0[r] = __builtin_amdgcn_exp2f(p0[r]);
}
__device__ __forceinline__ void partialSM8(f32x16& p0, f32x16& p1, float& m_reg, float& mn, float& alpha, const float SC, const float C2) {
    float pmax = p0[0];
#pragma unroll
    for (int r = 1; r < 16; ++r) pmax = fmaxf(pmax, p0[r]);
#pragma unroll
    for (int r = 0; r < 16; ++r) pmax = fmaxf(pmax, p1[r]);
    { auto rr = __builtin_amdgcn_permlane32_swap(__float_as_uint(pmax), __float_as_uint(pmax), false, false);
      pmax = fmaxf(__uint_as_float(rr[0]), __uint_as_float(rr[1])); }
    if (__builtin_expect(__all((pmax - m_reg) * SC <= 4.0f), 1)) { mn = m_reg; alpha = 1.f; }
    else { mn = fmaxf(m_reg, pmax); alpha = __builtin_amdgcn_exp2f((m_reg - mn) * C2); m_reg = mn; }
    const float mnL = -mn * C2;
#pragma unroll
    for (int r = 0; r < 16; ++r) p0[r] = fmaf(p0[r], C2, mnL);
#pragma unroll
    for (int r = 0; r < 16; ++r) p1[r] = fmaf(p1[r], C2, mnL);
#pragma unroll
    for (int r = 0; r < 16; ++r) p0[r] = __builtin_amdgcn_exp2f(p0[r]);
}
__device__ __forceinline__ void finishSM(f32x16& p0, f32x16& p1, float alpha, float& l_reg, bf16x8& pa0, bf16x8& pa1, bf16x8& pa2, bf16x8& pa3) {
#pragma unroll
    for (int r = 0; r < 16; ++r) p1[r] = __builtin_amdgcn_exp2f(p1[r]);
    float ps = 0;
#pragma unroll
    for (int r = 0; r < 16; ++r) ps += p0[r];
#pragma unroll
    for (int r = 0; r < 16; ++r) ps += p1[r];
    { auto rr = __builtin_amdgcn_permlane32_swap(__float_as_uint(ps), __float_as_uint(ps), false, false);
      ps = __uint_as_float(rr[0]) + __uint_as_float(rr[1]); }
    l_reg = l_reg * alpha + ps;
#define AT_PK4(P, B_, OUT) do { unsigned a0 = cvtpk(P[B_+0], P[B_+1]), a1 = cvtpk(P[B_+2], P[B_+3]);                          \
        unsigned b0 = cvtpk(P[B_+4], P[B_+5]), b1 = cvtpk(P[B_+6], P[B_+7]);                                             \
        auto r0 = __builtin_amdgcn_permlane32_swap(a0, b0, false, false); auto r1 = __builtin_amdgcn_permlane32_swap(a1, b1, false, false); \
        u32x4 w = {r0[0], r1[0], r0[1], r1[1]}; OUT = __builtin_bit_cast(bf16x8, w); } while (0)
    AT_PK4(p0, 0, pa0); AT_PK4(p0, 8, pa1); AT_PK4(p1, 0, pa2); AT_PK4(p1, 8, pa3);
#undef AT_PK4
}
template <int DQK>
__device__ __forceinline__ void qkt(f32x16& p0, f32x16& p1, const char* Kt, int r32, int hi, const bf16x8* qr, bool act) {
    if (!act) { const float NEG = -__builtin_inff();
#pragma unroll
        for (int r = 0; r < 16; ++r) { p0[r] = NEG; p1[r] = NEG; } return; }
    p0 = f32x16{}; p1 = f32x16{};
    const char* kb[4];
#pragma unroll
    for (int dd = 0; dd < 4; ++dd) kb[dd] = Kt + kswz<DQK>(r32, (dd * 16 + hi * 8) * 2);
#pragma unroll
    for (int d0 = 0; d0 < DQK / 16; ++d0) { const char* a = kb[d0 & 3] + (d0 >> 2) * 128;
        bf16x8 b0 = *reinterpret_cast<const bf16x8*>(a);
        bf16x8 b1 = *reinterpret_cast<const bf16x8*>(a + 32 * krow<DQK>());
        p0 = __builtin_amdgcn_mfma_f32_32x32x16_bf16(b0, qr[d0], p0, 0, 0, 0);
        p1 = __builtin_amdgcn_mfma_f32_32x32x16_bf16(b1, qr[d0], p1, 0, 0, 0); }
}
template <int VB>
__device__ __forceinline__ void pv_tile(f32x16* o, int vb0, bf16x8 pa0, bf16x8 pa1, bf16x8 pa2, bf16x8 pa3, bool act) {
    if (!act) return;
#define AT_TRRD(dst, off) asm volatile("ds_read_b64_tr_b16 %0, %1 offset:%2" : "=&v"(dst) : "v"(vb0), "i"(off) : "memory")
#define AT_PV_RD(S, d0) do { constexpr int b_ = VB * SHM_V + v_rd_off(d0, 0, 0); \
        AT_TRRD(S[0], b_); AT_TRRD(S[1], b_ + 2048); AT_TRRD(S[2], b_ + 4096); AT_TRRD(S[3], b_ + 6144); AT_TRRD(S[4], b_ + 8192); AT_TRRD(S[5], b_ + 10240); AT_TRRD(S[6], b_ + 12288); AT_TRRD(S[7], b_ + 14336); } while (0)
#define AT_PV_MM(S, d0) do { \
        o[d0] = __builtin_amdgcn_mfma_f32_32x32x16_bf16((bf16x8){S[0][0], S[0][1], S[0][2], S[0][3], S[1][0], S[1][1], S[1][2], S[1][3]}, pa0, o[d0], 0, 0, 0);   \
        o[d0] = __builtin_amdgcn_mfma_f32_32x32x16_bf16((bf16x8){S[2][0], S[2][1], S[2][2], S[2][3], S[3][0], S[3][1], S[3][2], S[3][3]}, pa1, o[d0], 0, 0, 0);   \
        o[d0] = __builtin_amdgcn_mfma_f32_32x32x16_bf16((bf16x8){S[4][0], S[4][1], S[4][2], S[4][3], S[5][0], S[5][1], S[5][2], S[5][3]}, pa2, o[d0], 0, 0, 0);   \
        o[d0] = __builtin_amdgcn_mfma_f32_32x32x16_bf16((bf16x8){S[6][0], S[6][1], S[6][2], S[6][3], S[7][0], S[7][1], S[7][2], S[7][3]}, pa3, o[d0], 0, 0, 0); } while (0)
    s16x4 sa[8], sb[8];
    AT_PV_RD(sa, 0); AT_PV_RD(sb, 1);
    asm volatile("s_waitcnt lgkmcnt(8)" ::: "memory"); AT_SBAR(); AT_PV_MM(sa, 0); AT_SBAR();
    AT_PV_RD(sa, 2);
    asm volatile("s_waitcnt lgkmcnt(8)" ::: "memory"); AT_SBAR(); AT_PV_MM(sb, 1); AT_SBAR();
    AT_PV_RD(sb, 3);
    asm volatile("s_waitcnt lgkmcnt(8)" ::: "memory"); AT_SBAR(); AT_PV_MM(sa, 2); AT_SBAR();
    asm volatile("s_waitcnt lgkmcnt(0)" ::: "memory"); AT_SBAR(); AT_PV_MM(sb, 3);
#undef AT_PV_RD
#undef AT_PV_MM
#undef AT_TRRD
}

__device__ __forceinline__ void ochunk(const f32x16 (&o)[4], int d0, int j, f32x4& c0, f32x4& c1) {
#pragma unroll
    for (int e = 0; e < 4; ++e) { auto rr = __builtin_amdgcn_permlane32_swap(__float_as_uint(o[d0][8 * j + e]), __float_as_uint(o[d0][8 * j + 4 + e]), false, false);
        c0[e] = __uint_as_float(rr[0]); c1[e] = __uint_as_float(rr[1]); }
}
template <int DQK> struct Lds { static constexpr int SHM_K = KVBLK * DQK * 2, K_OFF = 2 * SHM_V, WS_OFF = K_OFF + 2 * SHM_K, BYTES = WS_OFF + NWAVES * 64 * 4, F_OFF = BYTES; };

constexpr int LCAP = 256 * 496;
__device__ __forceinline__ int loff(int n) { return 256 * (31 * n - (n * (n - 1)) / 2); }
struct SparseBufs { unsigned short* lists; unsigned* lcnt; unsigned* selinfo; float* ml; unsigned char* part01; unsigned char* part2; };

struct AttnP { const bf16_t* Qp; const bf16_t* Kn; const bf16_t* Kr; const bf16_t* Vp; bf16_t* Op; int P0, t0, NT, bh, nent; const unsigned short* ents; };

typedef int v8i_t __attribute__((ext_vector_type(8)));
typedef int v4i_t __attribute__((ext_vector_type(4)));
constexpr int K8ROW = 208, SHM_K8 = KVBLK * K8ROW;
constexpr int M8ROW = 144, SHM_M8 = KVBLK * M8ROW;
template <int NSTEP, int ROWB>
__device__ __forceinline__ void qkt8(f32x16& p0, f32x16& p1, const char* Kt, int r32, int hi, const v8i_t* qf) {
    p0 = f32x16{}; p1 = f32x16{};
    const char* kb = Kt + r32 * ROWB + 32 * hi;
#pragma unroll
    for (int s = 0; s < NSTEP; ++s) {
        const v4i_t a0 = *reinterpret_cast<const v4i_t*>(kb + 64 * s), a1 = *reinterpret_cast<const v4i_t*>(kb + 64 * s + 16);
        const v4i_t b0 = *reinterpret_cast<const v4i_t*>(kb + 32 * ROWB + 64 * s), b1 = *reinterpret_cast<const v4i_t*>(kb + 32 * ROWB + 64 * s + 16);
        const v8i_t k0 = {a0[0], a0[1], a0[2], a0[3], a1[0], a1[1], a1[2], a1[3]}, k1 = {b0[0], b0[1], b0[2], b0[3], b1[0], b1[1], b1[2], b1[3]};
        p0 = __builtin_amdgcn_mfma_scale_f32_32x32x64_f8f6f4(k0, qf[s], p0, 0, 0, 0, 0x7f7f7f7f, 0, 0x7f7f7f7f);
        p1 = __builtin_amdgcn_mfma_scale_f32_32x32x64_f8f6f4(k1, qf[s], p1, 0, 0, 0, 0x7f7f7f7f, 0, 0x7f7f7f7f);
    }
}
__device__ __forceinline__ void finishSM8(f32x16& p0, f32x16& p1, float alpha, float& l_reg, v8i_t& pf) {
#pragma unroll
    for (int r = 0; r < 16; ++r) p1[r] = __builtin_amdgcn_exp2f(p1[r]);
    float ps = 0;
#pragma unroll
    for (int r = 0; r < 16; ++r) ps += p0[r];
#pragma unroll
    for (int r = 0; r < 16; ++r) ps += p1[r];
    { auto rr = __builtin_amdgcn_permlane32_swap(__float_as_uint(ps), __float_as_uint(ps), false, false);
      ps = __uint_as_float(rr[0]) + __uint_as_float(rr[1]); }
    l_reg = l_reg * alpha + ps;
#pragma unroll
    for (int g = 0; g < 4; ++g) {
        const unsigned a = pack4_fp8((f32x4){p0[4 * g], p0[4 * g + 1], p0[4 * g + 2], p0[4 * g + 3]}), b = pack4_fp8((f32x4){p1[4 * g], p1[4 * g + 1], p1[4 * g + 2], p1[4 * g + 3]});
        auto rr = __builtin_amdgcn_permlane32_swap(a, b, false, false);
        pf[2 * g] = (int)rr[0]; pf[2 * g + 1] = (int)rr[1]; }
}
constexpr int V8ROW = 80, SHM_V8 = 128 * V8ROW;
__device__ __forceinline__ void pv8(f32x16* o, const char* Vt, int r32, int hi, const v8i_t& pf) {
    const char* vb = Vt + r32 * V8ROW + 32 * hi;
#pragma unroll
    for (int d0 = 0; d0 < 4; ++d0) {
        const v4i_t a0 = *reinterpret_cast<const v4i_t*>(vb + d0 * 32 * V8ROW), a1 = *reinterpret_cast<const v4i_t*>(vb + d0 * 32 * V8ROW + 16);
        const v8i_t vf = {a0[0], a0[1], a0[2], a0[3], a1[0], a1[1], a1[2], a1[3]};
        o[d0] = __builtin_amdgcn_mfma_scale_f32_32x32x64_f8f6f4(vf, pf, o[d0], 0, 0, 0, 0x7f7f7f7f, 0, 0x7f7f7f7f);
    }
}
template <int DQK, int MODE>
__device__ __forceinline__ void attn_unit(char* lds, const AttnP& A, const SparseBufs& SB) {
    constexpr int K_OFF = 3 * SHM_V8;
    constexpr float SC = 0.07216878364870323f;
    constexpr float C2 = 1.4426950408889634f * SC;
    (void)SB;
    int tid = threadIdx.x; asm volatile("" : "+v"(tid));
    const int wid = __builtin_amdgcn_readfirstlane(tid >> 6), lane = tid & 63, r32 = lane & 31, hi = lane >> 5;
    const int NT = A.NT, P0 = A.P0;
    const int qlo = P0 + wid * 32, qm = qlo + r32 - 4 * hi;
    char* V_lds = lds; char* K_lds = lds + K_OFF;
    float m_reg = -1e30f, l_reg = 0; f32x16 o[4] = {};
    const int vr_ = tid >> 2, vc_ = (tid & 3) * 16, vws = vr_ * V8ROW + vc_;
    const int kr_ = tid >> 3, kc_ = (tid & 7) * 16, kws = kr_ * K8ROW + kc_;
    const int rr_ = (tid & 255) >> 2, rc_ = (tid & 3) * 16, kws_r = rr_ * K8ROW + 128 + rc_;
    const bool do_r = tid < 256;
    v8i_t qf[3];
    {   const unsigned qo = (unsigned)((wid * 32 + r32) * 192 + 32 * hi);
#pragma unroll
        for (int s = 0; s < 3; ++s) { const v4i_t x0 = *(const v4i_t*)((const char*)A.Qp + qo + 64 * s), x1 = *(const v4i_t*)((const char*)A.Qp + qo + 64 * s + 16);
            qf[s] = (v8i_t){x0[0], x0[1], x0[2], x0[3], x1[0], x1[1], x1[2], x1[3]}; } }
    v4i_t st_v0, st_k0, st_k2;
    const unsigned lo_v = (unsigned)(vr_ * NS + vc_), lo_k = (unsigned)(kr_ * 128 + kc_), lo_r = (unsigned)(rr_ * 64 + rc_);
#define AT_VMW() asm volatile("s_waitcnt vmcnt(0)" ::: "memory")
    const __amdgpu_buffer_rsrc_t rsV = __builtin_amdgcn_make_buffer_rsrc((void*)A.Vp, 0, NS * 128, 0x00020000), rsK = __builtin_amdgcn_make_buffer_rsrc((void*)A.Kn, 0, NS * 128, 0x00020000);
    const __amdgpu_buffer_rsrc_t rsR = __builtin_amdgcn_make_buffer_rsrc((void*)A.Kr, 0, NS * 64, 0x00020000);
#define AT_BL(rs, vo, so) __builtin_bit_cast(bf16x8, __builtin_amdgcn_raw_buffer_load_b128(rs, (int)(vo), (int)(so), 0))
#define AT_BLI(rs, vo, so) __builtin_bit_cast(v4i_t, __builtin_amdgcn_raw_buffer_load_b128(rs, (int)(vo), (int)(so), 0))
#define AT_SLOAD(k0) do { st_v0 = AT_BLI(rsV, lo_v, (k0)); \
                          st_k0 = AT_BLI(rsK, lo_k, (k0) * 128); if (do_r) st_k2 = AT_BLI(rsR, lo_r, (k0) * 64); } while (0)
#define AT_SWRITE(bf) do { char* vd_ = V_lds + (bf) * SHM_V8; char* kd_ = K_lds + (bf) * SHM_K8; \
                           *(v4i_t*)(vd_ + vws) = st_v0; \
                           *(v4i_t*)(kd_ + kws) = st_k0; if (do_r) *(v4i_t*)(kd_ + kws_r) = st_k2; } while (0)
#define AT_RESC(a) do { if (__any((a) < 1.f)) { _Pragma("unroll") for (int d_ = 0; d_ < 4; ++d_) o[d_] *= (a); } } while (0)
#define AT_KBASE(t) ((t) * KVBLK)
#define AT_MASKT(P0_, P1_, t) do { const int kb_ = AT_KBASE(t); if (kb_ + KVBLK - 1 > qlo) mask_causal(P0_, P1_, qm - kb_); } while (0)
    f32x16 pA0, pA1, pB0, pB1; float mnA, mnB, alA, alB; v8i_t pf;
    AT_SLOAD(AT_KBASE(0)); AT_VMW(); AT_SWRITE(0);
    AT_SLOAD(AT_KBASE(1)); AT_VMW(); AT_SWRITE(1);
    AT_SLOAD(AT_KBASE(2));
    __syncthreads();
    AT_SBAR(); qkt8<3, K8ROW>(pA0, pA1, K_lds, r32, hi, qf);
    AT_MASKT(pA0, pA1, 0); partialSM8(pA0, pA1, m_reg, mnA, alA, SC, C2);
#define AT_STEP(PX0, PX1, mnX, alX, PY0, PY1, alY, t, bc, bp, bn) do {                                                           \
        if ((t) + 1 < NT) { AT_VMW(); AT_SWRITE(bn); if ((t) + 2 < NT) AT_SLOAD(AT_KBASE((t) + 2)); }                            \
        finishSM8(PY0, PY1, alY, l_reg, pf); AT_SBAR();                                                           \
        qkt8<3, K8ROW>(PX0, PX1, K_lds + (bc) * SHM_K8, r32, hi, qf); AT_SBAR();                                                           \
        pv8(o, V_lds + (bp) * SHM_V8, r32, hi, pf); AT_MASKT(PX0, PX1, (t)); partialSM8(PX0, PX1, m_reg, mnX, alX, SC, C2); \
        AT_RESC(alX); __syncthreads(); } while (0)
    int bc = 1, bp = 0, bn = 2;
    for (int t = 1; t + 1 < NT; t += 2) {
        AT_STEP(pB0, pB1, mnB, alB, pA0, pA1, alA, t, bc, bp, bn);
        { const int x = bp; bp = bc; bc = bn; bn = x; }
        AT_STEP(pA0, pA1, mnA, alA, pB0, pB1, alB, t + 1, bc, bp, bn);
        { const int x = bp; bp = bc; bc = bn; bn = x; }
    }
    AT_SBAR(); qkt8<3, K8ROW>(pB0, pB1, K_lds + bc * SHM_K8, r32, hi, qf); AT_SBAR();
    finishSM8(pA0, pA1, alA, l_reg, pf); AT_SBAR();
    pv8(o, V_lds + bp * SHM_V8, r32, hi, pf);
    AT_MASKT(pB0, pB1, NT - 1); partialSM8(pB0, pB1, m_reg, mnB, alB, SC, C2); AT_RESC(alB);
    finishSM8(pB0, pB1, alB, l_reg, pf); AT_SBAR(); pv8(o, V_lds + bc * SHM_V8, r32, hi, pf);
    {
        const float il = __builtin_amdgcn_rcpf(l_reg) * 16.0f;
        unsigned lofs = (unsigned)((wid * 32 + r32) * 1024 + 8 * hi);
        asm volatile("" : "+v"(lofs));
#pragma unroll
        for (int d0 = 0; d0 < 4; ++d0)
#pragma unroll
            for (int j = 0; j < 2; ++j) { f32x4 c0, c1; ochunk(o, d0, j, c0, c1); u32x2 w8; w8.x = pack4_fp8(c0 * il); w8.y = pack4_fp8(c1 * il);
                *(u32x2*)((char*)A.Op + (size_t)(32 * d0 + 16 * j) + lofs) = w8; }
    }
    __syncthreads();
#undef AT_VMW
#undef AT_SLOAD
#undef AT_BL
#undef AT_BLI
#undef AT_SWRITE
#undef AT_RESC
#undef AT_KBASE
#undef AT_MASKT
#undef AT_STEP
}

constexpr int RES_WS = 132096, RES_F = 134144;
__device__ __forceinline__ void moba_stage_kv(char* lds, const bf16_t* K8h  , const bf16_t* Vp, int n) {
    int tid = threadIdx.x; asm volatile("" : "+v"(tid));
    const int sr = tid >> 4, sc = (tid & 15) * 8, vst0 = v_st(sr, sc), vst1 = v_st(32 + sr, sc);
    const int kr_ = tid >> 3, kc_ = (tid & 7) * 16, kws = kr_ * M8ROW + kc_;
    const unsigned lo_a = (unsigned)((sr * 128 + sc) * 2), lo_k = (unsigned)(kr_ * 128 + kc_);
    const __amdgpu_buffer_rsrc_t rsV = __builtin_amdgcn_make_buffer_rsrc((void*)Vp, 0, NS * 256, 0x00020000), rsK = __builtin_amdgcn_make_buffer_rsrc((void*)K8h, 0, NS * 128, 0x00020000);
    bf16x8 kv[4][3];
#pragma unroll
    for (int t = 0; t < 4; ++t) { const int so = (4 * n + t) * 64 * 256;
        kv[t][0] = __builtin_bit_cast(bf16x8, __builtin_amdgcn_raw_buffer_load_b128(rsV, (int)lo_a, so, 0)); kv[t][1] = __builtin_bit_cast(bf16x8, __builtin_amdgcn_raw_buffer_load_b128(rsV, (int)lo_a, so + 8192, 0));
        kv[t][2] = __builtin_bit_cast(bf16x8, __builtin_amdgcn_raw_buffer_load_b128(rsK, (int)lo_k, (4 * n + t) * 64 * 128, 0)); }
#pragma unroll
    for (int t = 0; t < 4; ++t) {
        *(bf16x8*)(lds + t * SHM_V + vst0) = kv[t][0]; *(bf16x8*)(lds + t * SHM_V + vst1) = kv[t][1];
        *(bf16x8*)(lds + 65536 + t * SHM_M8 + kws) = kv[t][2]; }
    __syncthreads();
}
template <int MODE>
__device__ __forceinline__ void moba_rows(char* lds, const bf16_t* Qh  , bf16_t* Op  , int bh, const unsigned short* ents, int nvalid  , int qrow0  , int kb0, const SparseBufs& SB, int wid, int lane) {
    constexpr float SC = 0.08838834764831845f, C2 = 1.4426950408889634f * SC;
    const int r32 = lane & 31, hi = lane >> 5;
    char* V_lds = lds; char* K_lds = lds + 65536;
    float* ws = (float*)(lds + RES_WS) + wid * 64; float* li_l = ws, * al_l = ws + 32;
    const int vb0 = (int)(uintptr_t)V_lds + v_rd_base(lane);
    int ent = -1, srow;
    if (MODE == 2) { const bool valid = r32 < nvalid; const int e = (int)ents[valid ? r32 : 0]; ent = valid ? e : -1; srow = e & 8191; } else srow = qrow0 + r32;
    v8i_t qf[2];
    {   const __amdgpu_buffer_rsrc_t rsQ = __builtin_amdgcn_make_buffer_rsrc((void*)Qh, 0, NS * 128, 0x00020000);
        const unsigned qo = (unsigned)(srow * 128 + hi * 32);
#pragma unroll
        for (int s = 0; s < 2; ++s) { const v4i_t x0 = __builtin_bit_cast(v4i_t, __builtin_amdgcn_raw_buffer_load_b128(rsQ, (int)(qo + 64 * s), 0, 0)), x1 = __builtin_bit_cast(v4i_t, __builtin_amdgcn_raw_buffer_load_b128(rsQ, (int)(qo + 64 * s + 16), 0, 0));
            qf[s] = (v8i_t){x0[0], x0[1], x0[2], x0[3], x1[0], x1[1], x1[2], x1[3]}; } }
    float m_reg = -1e30f, l_reg = 0; f32x16 o[4] = {};
    const int qlo = qrow0, qm = qrow0 + r32 - 4 * hi;
#define MR_ACT(t) (MODE == 2 ? true : (kb0 + (t) * 64 <= qlo + 31))
#define MR_QKT(P0_, P1_, t) do { if (MR_ACT(t)) qkt8<2, M8ROW>(P0_, P1_, K_lds + (t) * SHM_M8, r32, hi, qf); else { const float NEG_ = -__builtin_inff(); _Pragma("unroll") for (int r_ = 0; r_ < 16; ++r_) { P0_[r_] = NEG_; P1_[r_] = NEG_; } } } while (0)
#define MR_MASK(P0_, P1_, t) do { if (MODE == 3) { const int kb_ = kb0 + (t) * 64; if (kb_ + 63 > qlo && kb_ <= qlo + 31) mask_causal(P0_, P1_, qm - kb_); } } while (0)
#define MR_RESC(a) do { if (__any((a) < 1.f)) { _Pragma("unroll") for (int d_ = 0; d_ < 4; ++d_) o[d_] *= (a); } } while (0)
    f32x16 pA0, pA1, pB0, pB1; float mnA, mnB, alA, alB; bf16x8 pa0, pa1, pa2, pa3;
    MR_QKT(pA0, pA1, 0); MR_MASK(pA0, pA1, 0); partialSM(pA0, pA1, m_reg, mnA, alA, SC, C2);
    AT_SBAR(); MR_QKT(pB0, pB1, 1); finishSM(pA0, pA1, alA, l_reg, pa0, pa1, pa2, pa3); AT_SBAR();
    pv_tile<0>(o, vb0, pa0, pa1, pa2, pa3, MR_ACT(0)); MR_MASK(pB0, pB1, 1); partialSM(pB0, pB1, m_reg, mnB, alB, SC, C2); MR_RESC(alB);
    AT_SBAR(); MR_QKT(pA0, pA1, 2); finishSM(pB0, pB1, alB, l_reg, pa0, pa1, pa2, pa3); AT_SBAR();
    pv_tile<1>(o, vb0, pa0, pa1, pa2, pa3, MR_ACT(1)); MR_MASK(pA0, pA1, 2); partialSM(pA0, pA1, m_reg, mnA, alA, SC, C2); MR_RESC(alA);
    AT_SBAR(); MR_QKT(pB0, pB1, 3); finishSM(pA0, pA1, alA, l_reg, pa0, pa1, pa2, pa3); AT_SBAR();
    pv_tile<2>(o, vb0, pa0, pa1, pa2, pa3, MR_ACT(2)); MR_MASK(pB0, pB1, 3); partialSM(pB0, pB1, m_reg, mnB, alB, SC, C2); MR_RESC(alB);
    finishSM(pB0, pB1, alB, l_reg, pa0, pa1, pa2, pa3); AT_SBAR(); pv_tile<3>(o, vb0, pa0, pa1, pa2, pa3, MR_ACT(3));
#undef MR_ACT
#undef MR_QKT
#undef MR_MASK
#undef MR_RESC
    if (MODE == 2) {
        if (hi == 0 && ent >= 0) { f32x2_t mlv = {m_reg, l_reg}; *(f32x2_t*)(SB.ml + ((size_t)(ent >> 13) * (NB * NH * NS) + (size_t)bh * NS + srow) * 2) = mlv; }
        const float il = __builtin_amdgcn_rcpf(l_reg) * 16.0f;
        const int slot = ent >> 13;
        unsigned char* pb = SB.part01 + (size_t)slot * ((size_t)NB * NH * NS * 128);
        unsigned po = (unsigned)((bh * NS + srow) * 128 + 8 * hi); asm volatile("" : "+v"(po));
#pragma unroll
        for (int d0 = 0; d0 < 4; ++d0)
#pragma unroll
            for (int j = 0; j < 2; ++j) { f32x4 c0, c1; ochunk(o, d0, j, c0, c1); c0 *= il; c1 *= il;
                u32x2 w; int t0 = __builtin_amdgcn_cvt_pk_fp8_f32(c0[0], c0[1], 0, false); t0 = __builtin_amdgcn_cvt_pk_fp8_f32(c0[2], c0[3], t0, true);
                int t1 = __builtin_amdgcn_cvt_pk_fp8_f32(c1[0], c1[1], 0, false); t1 = __builtin_amdgcn_cvt_pk_fp8_f32(c1[2], c1[3], t1, true);
                w.x = (unsigned)t0; w.y = (unsigned)t1;
                if (ent >= 0) *(u32x2*)(pb + po + 32 * d0 + 16 * j) = w; }
    } else {
        const int s = qrow0 + r32; const unsigned si = SB.selinfo[(size_t)bh * NS + s];
        float mk[3], lk[3]; float M = m_reg;
#pragma unroll
        for (int k = 0; k < 3; ++k) { const bool v = ((si >> (8 * k)) & 255u) < 32u; mk[k] = -1e30f; lk[k] = 0.f;
            if (v) { const f32x2_t t = *(const f32x2_t*)(SB.ml + ((size_t)k * (NB * NH * NS) + (size_t)bh * NS + s) * 2); mk[k] = t[0]; lk[k] = t[1]; }
            M = fmaxf(M, mk[k]); }
        const float w_own = __builtin_amdgcn_exp2f((m_reg - M) * C2);
        float den = w_own * l_reg, wk[3];
#pragma unroll
        for (int k = 0; k < 3; ++k) { wk[k] = lk[k] * __builtin_amdgcn_exp2f((mk[k] - M) * C2); den += wk[k]; }
        const float inv = __builtin_amdgcn_rcpf(den), f_own = w_own * inv;
#pragma unroll
        for (int k = 0; k < 3; ++k) wk[k] *= inv;
        unsigned po = (unsigned)((bh * NS + s) * 128 + 8 * hi); asm volatile("" : "+v"(po));
        const int b = bh >> 3, h = bh & 7;
        char* orow = (char*)Op + ((size_t)(b * NS + s) * 1024 + h * 128 + 8 * hi);
        u32x2 pw[3][8];
#pragma unroll
        for (int k = 0; k < 3; ++k) { const unsigned char* pb = SB.part01 + (size_t)k * ((size_t)NB * NH * NS * 128);
#pragma unroll
            for (int c = 0; c < 8; ++c) pw[k][c] = *(const u32x2*)(pb + po + c * 16); }
#pragma unroll
        for (int k = 0; k < 3; ++k) wk[k] *= (1.0f / 16.0f);
#pragma unroll
        for (int d0 = 0; d0 < 4; ++d0)
#pragma unroll
            for (int j = 0; j < 2; ++j) { f32x4 c0, c1; ochunk(o, d0, j, c0, c1); c0 *= f_own; c1 *= f_own;
#pragma unroll
                for (int k = 0; k < 3; ++k) { const bool use = wk[k] != 0.f;
                    const int w0 = use ? (int)pw[k][2 * d0 + j].x : 0, w1 = use ? (int)pw[k][2 * d0 + j].y : 0;
                    const f32x2_t a0 = __builtin_amdgcn_cvt_pk_f32_fp8(w0, false), a1 = __builtin_amdgcn_cvt_pk_f32_fp8(w0, true), a2 = __builtin_amdgcn_cvt_pk_f32_fp8(w1, false), a3 = __builtin_amdgcn_cvt_pk_f32_fp8(w1, true);
                    c0[0] += a0[0] * wk[k]; c0[1] += a0[1] * wk[k]; c0[2] += a1[0] * wk[k]; c0[3] += a1[1] * wk[k];
                    c1[0] += a2[0] * wk[k]; c1[1] += a2[1] * wk[k]; c1[2] += a3[0] * wk[k]; c1[3] += a3[1] * wk[k]; }
                u32x2 w8; w8.x = pack4_fp8(c0 * 16.0f); w8.y = pack4_fp8(c1 * 16.0f); *(u32x2*)(orow + (32 * d0 + 16 * j)) = w8; }
    }
}
__device__ __forceinline__ void moba_own_unit(char* lds, const bf16_t* Qh, const bf16_t* Kn, const bf16_t* Vp, bf16_t* O, int bh, int qb, const SparseBufs& SB) {
    int tid = threadIdx.x; asm volatile("" : "+v"(tid));
    const int wid = __builtin_amdgcn_readfirstlane(tid >> 6), lane = tid & 63;
    moba_stage_kv(lds, Kn, Vp, qb);
    moba_rows<3>(lds, Qh, O, bh, nullptr, 0, qb * 256 + wid * 32, qb * 256, SB, wid, lane);
    __syncthreads();
}
__device__ __forceinline__ void moba_gather_unit(char* lds, const bf16_t* Qh, const bf16_t* Kn, const bf16_t* Vp, int bh, int n, const unsigned short* ents, int nrows, const SparseBufs& SB) {
    int tid = threadIdx.x; asm volatile("" : "+v"(tid));
    const int wid = __builtin_amdgcn_readfirstlane(tid >> 6), lane = tid & 63;
    moba_stage_kv(lds, Kn, Vp, n);
    const int ng = (nrows + 31) >> 5;
    for (int g = wid; g < ng; g += NWAVES) { const int nv = nrows - 32 * g; moba_rows<2>(lds, Qh, nullptr, bh, ents + 32 * g, nv < 32 ? nv : 32, 0, 0, SB, wid, lane); }
    __syncthreads();
}

__device__ __forceinline__ void gate_unit(char* lds, const bf16_t* Qp  , const float* kms, int bh, int qb, const SparseBufs& SB) {
    typedef Lds<128> L; constexpr int SHM_K = L::SHM_K;
    int tid = threadIdx.x; asm volatile("" : "+v"(tid));
    const int wid = __builtin_amdgcn_readfirstlane(tid >> 6), lane = tid & 63, r32 = lane & 31, hi = lane >> 5;
    char* K_lds = lds + L::K_OFF;
    int* hist = (int*)(lds + L::WS_OFF); int* base = hist + 32;
    const int sr = tid >> 4, sc = (tid & 15) * 8, kws = kswz<128>(sr, sc * 2);
    bf16x8 qr[8];
    {   const unsigned qo = (unsigned)(((wid * 32 + r32) * 128 + hi * 8) * 2);
#pragma unroll
        for (int d0 = 0; d0 < 8; ++d0) qr[d0] = *(const bf16x8*)((const char*)Qp + qo + d0 * 32); }
    {   unsigned ko = (unsigned)((sr * 128 + sc) * 4); asm volatile("" : "+v"(ko));
        const f32x4 a = *(const f32x4*)((const char*)kms + ko) * (1.0f / 256.0f), b = *(const f32x4*)((const char*)kms + ko + 16) * (1.0f / 256.0f);
        const u32x4 h8 = pack8(a, b);
        f32x4 ha, hb_; unpack8(h8, ha, hb_);
        const u32x4 l8 = pack8(a - ha, b - hb_);
        *(u32x4*)(K_lds + kws) = h8; *(u32x4*)(K_lds + SHM_K + kws) = l8; }
    if (tid < 64) hist[tid] = 0;
    __syncthreads();
    f32x16 g = f32x16{};
    {   const char* kb[4];
#pragma unroll
        for (int dd = 0; dd < 4; ++dd) kb[dd] = K_lds + kswz<128>(r32, (dd * 16 + hi * 8) * 2);
#pragma unroll
        for (int d0 = 0; d0 < 8; ++d0) { const char* a = kb[d0 & 3] + (d0 >> 2) * 128;
            g = __builtin_amdgcn_mfma_f32_32x32x16_bf16(*reinterpret_cast<const bf16x8*>(a), qr[d0], g, 0, 0, 0);
            g = __builtin_amdgcn_mfma_f32_32x32x16_bf16(*reinterpret_cast<const bf16x8*>(a + SHM_K), qr[d0], g, 0, 0, 0); } }
    const float NINF = -__builtin_inff();
    float v1 = NINF, v2 = NINF, v3 = NINF; int i1 = 64, i2 = 65, i3 = 66;
    const int ownl = qb - 4 * hi;
#pragma unroll
    for (int r = 0; r < 16; ++r) {
        const int idx = (r & 3) + 8 * (r >> 2); const float val = (idx < ownl) ? g[r] : NINF;
        const bool c1 = val > v1, c2 = val > v2, c3 = val > v3;
        v3 = c2 ? v2 : (c3 ? val : v3); i3 = c2 ? i2 : (c3 ? idx : i3);
        v2 = c1 ? v1 : (c2 ? val : v2); i2 = c1 ? i1 : (c2 ? idx : i2);
        v1 = c1 ? val : v1;             i1 = c1 ? idx : i1;
    }
    i1 += 4 * hi; i2 += 4 * hi; i3 += 4 * hi;
    float pv_[3]; int pi_[3];
    pv_[0] = __shfl_xor(v1, 32); pv_[1] = __shfl_xor(v2, 32); pv_[2] = __shfl_xor(v3, 32);
    pi_[0] = __shfl_xor(i1, 32); pi_[1] = __shfl_xor(i2, 32); pi_[2] = __shfl_xor(i3, 32);
#pragma unroll
    for (int c = 0; c < 3; ++c) {
        const float val = pv_[c]; const int idx = pi_[c];
        const bool c1 = (val > v1) || (val == v1 && idx < i1), c2 = (val > v2) || (val == v2 && idx < i2), c3 = (val > v3) || (val == v3 && idx < i3);
        v3 = c2 ? v2 : (c3 ? val : v3); i3 = c2 ? i2 : (c3 ? idx : i3);
        v2 = c1 ? v1 : (c2 ? val : v2); i2 = c1 ? i1 : (c2 ? idx : i2);
        v1 = c1 ? val : v1;             i1 = c1 ? idx : i1;
    }
    const int s = qb * 256 + wid * 32 + r32;
    int rk1 = 0, rk2 = 0, rk3 = 0;
    if (hi == 0) {
        SB.selinfo[(size_t)bh * NS + s] = (unsigned)(i1 < 32 ? i1 : 255) | ((unsigned)(i2 < 32 ? i2 : 255) << 8) | ((unsigned)(i3 < 32 ? i3 : 255) << 16);
        if (i1 < 32) rk1 = __hip_atomic_fetch_add(hist + i1, 1, __ATOMIC_RELAXED, __HIP_MEMORY_SCOPE_WORKGROUP);
        if (i2 < 32) rk2 = __hip_atomic_fetch_add(hist + i2, 1, __ATOMIC_RELAXED, __HIP_MEMORY_SCOPE_WORKGROUP);
        if (i3 < 32) rk3 = __hip_atomic_fetch_add(hist + i3, 1, __ATOMIC_RELAXED, __HIP_MEMORY_SCOPE_WORKGROUP);
    }
    __syncthreads();
    if (tid < 32) { const int c = hist[tid]; base[tid] = c > 0 ? (int)__hip_atomic_fetch_add(SB.lcnt + bh * 32 + tid, (unsigned)c, __ATOMIC_RELAXED, __HIP_MEMORY_SCOPE_AGENT) : 0; }
    __syncthreads();
    if (hi == 0) {
        unsigned short* lb = SB.lists + (size_t)bh * LCAP;
        if (i1 < 32) lb[loff(i1) + base[i1] + rk1] = (unsigned short)(s | (0 << 13));
        if (i2 < 32) lb[loff(i2) + base[i2] + rk2] = (unsigned short)(s | (1 << 13));
        if (i3 < 32) lb[loff(i3) + base[i3] + rk3] = (unsigned short)(s | (2 << 13));
    }
    __syncthreads();
}
}
__device__ __forceinline__ int pair_lo(int p) { return p < 3 ? 0 : (p < 5 ? 1 : 2); }
__device__ __forceinline__ int pair_hi(int p) { return p < 3 ? p + 1 : (p < 5 ? p - 1 : 3); }
constexpr int LDS_TB = LDS_MISC + 64;

__device__ __forceinline__ void p_route(const Args& a, LAS unsigned char* lds, int layer, const bf16_t* h, int vcu, int G) {
    int tid = threadIdx.x; asm volatile("" : "+v"(tid));
    const int lane = tid & 63, wave = __builtin_amdgcn_readfirstlane(tid >> 6), i32 = lane & 31, kk = lane >> 5;
    unsigned char* ws = a.ws;
    LAS float* wl = (LAS float*)lds;
    {   const float* wrt = (const float*)(ws + WS_WRT) + (size_t)layer * 20480;
        for (int i = tid; i < 20480; i += NTHR) { const int k = i / 20, c = i % 20; wl[c * 1024 + k] = wrt[i]; } }
    __syncthreads();
    float* tokw = (float*)(ws + WS_TOKW); int* list = (int*)(ws + WS_LIST);
    unsigned* cnt = (unsigned*)(ws + WS_CTL) + CW_CNT + layer * 24 * 16;
    const int gw = vcu * NWAVES + wave, NGW = G * NWAVES;
    const int lrow = i32 < 4 ? i32 : (i32 < 8 ? 12 + i32 : ((i32 & 4) ? -1 : ((i32 >> 3) == 1 ? i32 - 4 : ((i32 >> 3) == 2 ? i32 - 8 : i32 - 12))));
    const LAS float* wrow = wl + (lrow < 0 ? 0 : lrow) * 1024 + 8 * kk;
    const float wmask = lrow < 0 ? 0.f : 1.f;
    const int half = wave & 1, pr = wave >> 1;
    LAS float* xch = (LAS float*)(lds + 81920) + (pr * 64 + lane) * 17;
    (void)gw; (void)NGW;
    for (int tb = vcu * 4; tb < NT / 32; tb += G * 4) {
        const int task = tb + pr; const bool live = task < NT / 32;
        const int t = (live ? task : 0) * 32 + i32;
        const bf16_t* hrow = h + (size_t)t * 1024 + 512 * half + 8 * kk;
        const LAS float* wr2 = wrow + 512 * half;
        f32x16 c = f32x16{}; float ssp = 0.f;
#pragma unroll 8
        for (int it = 0; it < 32; ++it) {
            f32x4 h0, h1; unpack8(*(const u32x4*)(hrow + 16 * it), h0, h1);
            const f32x4 w0 = *(const LAS f32x4*)(wr2 + 16 * it) * wmask, w1 = *(const LAS f32x4*)(wr2 + 16 * it + 4) * wmask;
            ssp += dot4(h0) + dot4(h1);
#pragma unroll
            for (int e = 0; e < 4; ++e) c = __builtin_amdgcn_mfma_f32_32x32x2f32(w0[e], h0[e], c, 0, 0, 0);
#pragma unroll
            for (int e = 0; e < 4; ++e) c = __builtin_amdgcn_mfma_f32_32x32x2f32(w1[e], h1[e], c, 0, 0, 0);
        }
        LAS int* hist = (LAS int*)(lds + 81920 + 4 * 64 * 17 * 4); LAS int* basel = hist + 32;
        if (tid < 32) hist[tid] = 0;
        if (half == 1) {
#pragma unroll
            for (int e = 0; e < 16; ++e) xch[e] = c[e];
            xch[16] = ssp; }
        __syncthreads();
        if (half == 0) {
#pragma unroll
            for (int e = 0; e < 16; ++e) c[e] += xch[e];
            ssp += xch[16]; }
        const bool sel = half == 0 && live && kk == 0;
        const float ss = ssp + __shfl_xor(ssp, 32);
        float ex[4];
#pragma unroll
        for (int e = 0; e < 4; ++e) ex[e] = __shfl_xor(c[e], 32);
        const float rs = rsqrtf(ss * (1.0f / 1024.0f) + EPS);
        float lg[20];
#pragma unroll
        for (int e = 0; e < 16; ++e) lg[e] = c[e] * rs;
#pragma unroll
        for (int e = 0; e < 4; ++e) lg[16 + e] = ex[e] * rs;
        int gs = 0; float gm = lg[0];
#pragma unroll
        for (int i = 1; i < 4; ++i) if (lg[i] > gm) { gm = lg[i]; gs = i; }
        float den = 0.f;
#pragma unroll
        for (int i = 0; i < 4; ++i) den += __expf(lg[i] - gm);
        const float gwt = 1.0f / den;
        float ein[4];
#pragma unroll
        for (int i = 0; i < 4; ++i) ein[i] = gs == 0 ? lg[4 + i] : (gs == 1 ? lg[8 + i] : (gs == 2 ? lg[12 + i] : lg[16 + i]));
        int i1 = 0; float e1 = ein[0];
#pragma unroll
        for (int i = 1; i < 4; ++i) if (ein[i] > e1) { e1 = ein[i]; i1 = i; }
        int i2 = -1; float e2 = 0.f;
#pragma unroll
        for (int i = 0; i < 4; ++i) if (i != i1 && (i2 < 0 || ein[i] > e2)) { e2 = ein[i]; i2 = i; }
        const float x2 = __expf(e2 - e1), w1 = gwt / (1.0f + x2), w2 = gwt * x2 / (1.0f + x2);
        const int lo = i1 < i2 ? i1 : i2, hi = i1 < i2 ? i2 : i1;
        const int pidx = lo == 0 ? hi - 1 : (lo == 1 ? hi + 1 : 5);
        const int bucket = gs * 6 + pidx;
        int rank = 0;
        if (sel) {
            f32x2_t wv2 = {(i1 == lo) ? w1 : w2, (i1 == lo) ? w2 : w1};
            *(f32x2_t*)(tokw + (size_t)t * 2) = wv2;
            rank = __hip_atomic_fetch_add((int*)(hist + bucket), 1, __ATOMIC_RELAXED, __HIP_MEMORY_SCOPE_WORKGROUP);
        }
        __syncthreads();
        if (tid < 24) { const int cb = hist[tid]; basel[tid] = cb > 0 ? (int)__hip_atomic_fetch_add(cnt + tid * 16, (unsigned)cb, __ATOMIC_RELAXED, __HIP_MEMORY_SCOPE_AGENT) : 0; }
        __syncthreads();
        if (sel) list[(size_t)bucket * NT + basel[bucket] + rank] = t;
        __syncthreads();
    }
    {   const float* p = a.in[1] + (size_t)layer * NT * 256; bf16_t* pb = (bf16_t*)(ws + WS_PB);
        const int gt = vcu * NTHR + tid, NGT = G * NTHR;
        for (int i = gt; i < NT * 256 / 8; i += NGT) { const f32x4 x0 = *(const f32x4*)(p + (size_t)i * 8), x1 = *(const f32x4*)(p + (size_t)i * 8 + 4); *(u32x4*)(pb + (size_t)i * 8) = pack8(x0, x1); } }
    __syncthreads();
}

__device__ __forceinline__ int moe_prefix(const Args& a, LAS unsigned char* lds, int layer) {
    LAS int* tb = (LAS int*)(lds + LDS_TB);
    if (threadIdx.x == 0) { const unsigned* cnt = (const unsigned*)(a.ws + WS_CTL) + CW_CNT + layer * 24 * 16; int s = 0;
        for (int b = 0; b < 24; ++b) { tb[b] = s; s += (int)((__hip_atomic_load(cnt + b * 16, __ATOMIC_RELAXED, __HIP_MEMORY_SCOPE_AGENT) + 255u) >> 8); }
        tb[24] = s; }
    __syncthreads();
    return __builtin_amdgcn_readfirstlane(tb[24]);
}
struct MoeUnits {
    LAS const int* tb; int NRT, G, c;
    __device__ __forceinline__ bool next(int i, Unit& u) const {
        const int L = i * G + c, rt = L >> 2; if (rt >= NRT) return false;
        int b = 0;
        for (int q = 1; q < 24; ++q) b = (tb[q] <= rt) ? q : b;
        u.pm = rt; u.pn = L & 3; u.aux = __builtin_amdgcn_readfirstlane(b); return true;
    }
};
struct MoeGuP {
    const char* A; const char* W; const int* list; const unsigned* cnt; MoeUnits U; int ldb, K;
    __device__ __forceinline__ bool next(int i, Unit& u) const { return U.next(i, u); }
    __device__ __forceinline__ void aoff(const Unit& u, const int (&R)[2], const int (&C)[2], g8::AOff& o) const {
        const int n = (int)cnt[u.aux * 16], p0 = (u.pm - __builtin_amdgcn_readfirstlane(U.tb[u.aux])) * 256;
#pragma unroll
        for (int h = 0; h < 2; ++h)
#pragma unroll
            for (int i = 0; i < 2; ++i) { int pos = p0 + h * 128 + R[i]; pos = pos < n ? pos : n - 1; const int tok = list[(size_t)u.aux * NT + pos]; o.o[h][i] = (unsigned)((tok * 1024 + C[i]) * 2); }
    }
    __device__ __forceinline__ const char* bbase(const Unit& u, int kt) const {
        const int g = u.aux / 6, pi = u.aux % 6, e = g * 4 + ((u.pn < 2) ? pair_lo(pi) : pair_hi(pi));
        return W + ((size_t)(e * 512 + (u.pn & 1) * 256) * 1024 + (size_t)kt * 64) * 2;
    }
};
struct MoeDownP {
    const char* A; const char* W; MoeUnits U; int ldb, K;
    __device__ __forceinline__ bool next(int i, Unit& u) const { return U.next(i, u); }
    __device__ __forceinline__ void aoff(const Unit& u, const int (&R)[2], const int (&C)[2], g8::AOff& o) const {
#pragma unroll
        for (int h = 0; h < 2; ++h)
#pragma unroll
            for (int i = 0; i < 2; ++i) o.o[h][i] = (unsigned)(((u.pm * 256 + h * 128 + R[i]) * 512 + C[i]) * 2);
    }
    __device__ __forceinline__ const char* bbase(const Unit& u, int kt) const {
        const int g = u.aux / 6, pi = u.aux % 6, e = g * 4 + ((kt < 4) ? pair_lo(pi) : pair_hi(pi));
        return W + ((size_t)(e * 1024 + u.pn * 256) * 256 + (size_t)(kt & 3) * 64) * 2;
    }
};
__device__ __forceinline__ float sigmoidf_fast(float x) { return __builtin_amdgcn_rcpf(1.0f + __builtin_amdgcn_exp2f(-1.4426950408889634f * x)); }

struct EpiGateUp {
    const float* hp; const float* tokw; const int* list; const unsigned* cnt; LAS const int* tb; bf16_t* act;
    __device__ __forceinline__ void operator()(const f32x4 (&acc)[2][2][4][2], const Unit& u, int wr, int wc, int fr, int fq) const {
        const int n = (int)cnt[u.aux * 16], p0 = (u.pm - __builtin_amdgcn_readfirstlane(tb[u.aux])) * 256, half = u.pn >> 1;
        int toks[2][4];
#pragma unroll
        for (int ai = 0; ai < 2; ++ai)
#pragma unroll
            for (int m = 0; m < 4; ++m) { int pos = p0 + 128 * ai + 64 * wr + 16 * m + fr; pos = pos < n ? pos : n - 1; toks[ai][m] = list[(size_t)u.aux * NT + pos]; }
#pragma unroll
        for (int ai = 0; ai < 2; ++ai)
#pragma unroll
            for (int m = 0; m < 4; ++m) {
                const int r = 128 * ai + 64 * wr + 16 * m + fr;
                const int tok = toks[ai][m];
                const float rs = row_rs<16>(hp + (size_t)tok * 16, 1.0f / 1024.0f), w = tokw[(size_t)tok * 2 + half];
                f32x4 o[2];
#pragma unroll
                for (int nn = 0; nn < 2; ++nn)
#pragma unroll
                    for (int e = 0; e < 4; ++e) { const float g = acc[ai][0][m][nn][e] * rs, up = acc[ai][1][m][nn][e] * rs; o[nn][e] = g * sigmoidf_fast(g) * up * w; }
                *(u32x4*)(act + (size_t)(u.pm * 256 + r) * 512 + half * 256 + (u.pn & 1) * 128 + 32 * wc + 8 * fq) = pack8(o[0], o[1]);
            }
    }
};
struct EpiDown {
    bf16_t* hb; float* hp; const int* list; const unsigned* cnt; LAS const int* tb;
    __device__ __forceinline__ void operator()(const f32x4 (&acc)[2][2][4][2], const Unit& u, int wr, int wc, int fr, int fq) const {
        const int n = (int)cnt[u.aux * 16], p0 = (u.pm - __builtin_amdgcn_readfirstlane(tb[u.aux])) * 256;
        int toks[2][4];
#pragma unroll
        for (int ai = 0; ai < 2; ++ai)
#pragma unroll
            for (int m = 0; m < 4; ++m) { const int pos = p0 + 128 * ai + 64 * wr + 16 * m + fr; toks[ai][m] = list[(size_t)u.aux * NT + (pos < n ? pos : n - 1)]; }
        asm volatile("" ::: "memory");
#pragma unroll
        for (int ai = 0; ai < 2; ++ai)
#pragma unroll
            for (int m = 0; m < 4; ++m) {
                const int r = 128 * ai + 64 * wr + 16 * m + fr, pos = p0 + r; const bool valid = pos < n;
                const int tok = toks[ai][m];
                float ss = 0.f;
#pragma unroll
                for (int bj = 0; bj < 2; ++bj) {
                    const size_t off = (size_t)tok * 1024 + u.pn * 256 + 128 * bj + 32 * wc + 8 * fq;
                    f32x4 b0, b1; unpack8(*(const u32x4*)(hb + off), b0, b1);
                    const f32x4 v0 = acc[ai][bj][m][0] + b0, v1 = acc[ai][bj][m][1] + b1;
                    if (valid) *(u32x4*)(hb + off) = pack8(v0, v1);
                    ss += dot4(v0) + dot4(v1);
                }
                ss += __shfl_xor(ss, 16); ss += __shfl_xor(ss, 32);
                if (fq == 0 && valid) hp[(size_t)tok * 16 + u.pn * 4 + wc] = ss;
                if (m & 1) asm volatile("" ::: "memory");
            }
    }
};
struct EpiStore {
    bf16_t* O; int ldc;
    __device__ __forceinline__ void operator()(const f32x4 (&acc)[2][2][4][2], const Unit& u, int wr, int wc, int fr, int fq) const {
#pragma unroll
        for (int ai = 0; ai < 2; ++ai)
#pragma unroll
            for (int m = 0; m < 4; ++m) { const int row = u.pm * 256 + 128 * ai + 64 * wr + 16 * m + fr;
#pragma unroll
                for (int bj = 0; bj < 2; ++bj) *(u32x4*)(O + (size_t)row * ldc + u.pn * 256 + 128 * bj + 32 * wc + 8 * fq) = pack8(acc[ai][bj][m][0], acc[ai][bj][m][1]); }
    }
};
struct EpiPle {
    const float* hpin; const bf16_t* pp; const bf16_t* hbi; bf16_t* hbo; float* hp;
    __device__ __forceinline__ void operator()(const f32x4 (&acc)[2][2][4][2], const Unit& u, int wr, int wc, int fr, int fq) const {
#pragma unroll
        for (int ai = 0; ai < 2; ++ai)
#pragma unroll
            for (int m = 0; m < 4; ++m) {
                const int row = u.pm * 256 + 128 * ai + 64 * wr + 16 * m + fr;
                const float rs = row_rs<16>(hpin + (size_t)row * 16, 1.0f / 1024.0f);
                float ss = 0.f;
#pragma unroll
                for (int bj = 0; bj < 2; ++bj) {
                    const size_t off = (size_t)row * 1024 + u.pn * 256 + 128 * bj + 32 * wc + 8 * fq;
                    f32x4 p0, p1, v0, v1; unpack8(*(const u32x4*)(pp + off), p0, p1); unpack8(*(const u32x4*)(hbi + off), v0, v1);
#pragma unroll
                    for (int e = 0; e < 4; ++e) { v0[e] += sigmoidf_fast(acc[ai][bj][m][0][e] * rs) * p0[e]; v1[e] += sigmoidf_fast(acc[ai][bj][m][1][e] * rs) * p1[e]; }
                    *(u32x4*)(hbo + off) = pack8(v0, v1);
                    ss += dot4(v0) + dot4(v1);
                }
                ss += __shfl_xor(ss, 16); ss += __shfl_xor(ss, 32);
                if (fq == 0) hp[(size_t)row * 16 + u.pn * 4 + wc] = ss;
                if (m & 1) asm volatile("" ::: "memory");
            }
    }
};
__device__ __forceinline__ u32x2 pack4(f32x4 a) { u32x2 w = {cvtpk(a[0], a[1]), cvtpk(a[2], a[3])}; return w; }
struct EpiDqkv {
    const float* hp; const float* cosB; const float* sinB; bf16_t* cq; bf16_t* ckv; bf16_t* krope; float* cqp; float* kvp;
    __device__ __forceinline__ void operator()(const f32x4 (&acc)[2][2][4][2], const Unit& u, int wr, int wc, int fr, int fq) const {
#pragma unroll
        for (int ai = 0; ai < 2; ++ai)
#pragma unroll
            for (int m = 0; m < 4; ++m) {
                const int row = u.pm * 256 + 128 * ai + 64 * wr + 16 * m + fr, s = row & (NS - 1);
                const float rs = row_rs<16>(hp + (size_t)row * 16, 1.0f / 1024.0f);
                if (u.pn < 2) {
                    float ss = 0.f;
#pragma unroll
                    for (int bj = 0; bj < 2; ++bj) { const f32x4 v0 = acc[ai][bj][m][0] * rs, v1 = acc[ai][bj][m][1] * rs; ss += dot4(v0) + dot4(v1);
                        const int c = 128 * bj + 32 * wc + 8 * fq;
                        if (u.pn == 0) *(u32x4*)(cq + (size_t)row * 384 + c) = pack8(v0, v1); else *(u32x4*)(ckv + (size_t)row * 256 + c) = pack8(v0, v1); }
                    ss += __shfl_xor(ss, 16); ss += __shfl_xor(ss, 32);
                    if (fq == 0) { if (u.pn == 0) cqp[(size_t)row * 8 + wc] = ss; else kvp[(size_t)row * 4 + wc] = ss; }
                } else {
                    const f32x4 v0 = acc[ai][0][m][0] * rs, v1 = acc[ai][0][m][1] * rs;
                    float ss = dot4(v0) + dot4(v1);
                    *(u32x4*)(cq + (size_t)row * 384 + 256 + 32 * wc + 8 * fq) = pack8(v0, v1);
                    ss += __shfl_xor(ss, 16); ss += __shfl_xor(ss, 32);
                    if (fq == 0) cqp[(size_t)row * 8 + 4 + wc] = ss;
                    if (wc < 2) {
                        const int j = 16 * wc + 4 * fq;
                        const f32x4 cs = *(const f32x4*)(cosB + (size_t)s * 32 + j), sn = *(const f32x4*)(sinB + (size_t)s * 32 + j);
                        const f32x4 x1 = acc[ai][1][m][0] * rs, x2 = acc[ai][1][m][1] * rs;
                        *(unsigned*)((unsigned char*)krope + (size_t)row * 64 + j) = pack4_fp8(x1 * cs - x2 * sn);
                        *(unsigned*)((unsigned char*)krope + (size_t)row * 64 + 32 + j) = pack4_fp8(x1 * sn + x2 * cs);
                    }
                }
            }
    }
};
struct EpiUq {
    const float* cqp; const float* cosB; const float* sinB; bf16_t* q;
    __device__ __forceinline__ void operator()(const f32x4 (&acc)[2][2][4][2], const Unit& u, int wr, int wc, int fr, int fq) const {
        const int bb = u.pm >> 5;
#pragma unroll
        for (int ai = 0; ai < 2; ++ai)
#pragma unroll
            for (int m = 0; m < 4; ++m) {
                const int row = u.pm * 256 + 128 * ai + 64 * wr + 16 * m + fr, s = row & (NS - 1);
                const float rs = row_rs<8>(cqp + (size_t)row * 8, 1.0f / 384.0f);
#pragma unroll
                for (int bj = 0; bj < 2; ++bj) {
                    if (u.pn < 4) {
                        const int hh = 2 * u.pn + bj;
                        u32x2 w8; w8.x = pack4_fp8(acc[ai][bj][m][0] * rs); w8.y = pack4_fp8(acc[ai][bj][m][1] * rs);
                        *(u32x2*)((unsigned char*)q + ((size_t)(bb * NH + hh) * NS + s) * 192 + 32 * wc + 8 * fq) = w8;
                    } else {
                        const int gidx = bj * 4 + wc, hh = 4 * (u.pn - 4) + (gidx >> 1), j = 16 * (gidx & 1) + 4 * fq;
                        const f32x4 cs = *(const f32x4*)(cosB + (size_t)s * 32 + j), sn = *(const f32x4*)(sinB + (size_t)s * 32 + j);
                        const f32x4 x1 = acc[ai][bj][m][0] * rs, x2 = acc[ai][bj][m][1] * rs;
                        unsigned char* d = (unsigned char*)q + ((size_t)(bb * NH + hh) * NS + s) * 192 + 128 + j;
                        *(unsigned*)d = pack4_fp8(x1 * cs - x2 * sn); *(unsigned*)(d + 32) = pack4_fp8(x1 * sn + x2 * cs);
                    }
                }
            }
    }
};
struct EpiKn {
    const float* kvp; unsigned char* kn;
    __device__ __forceinline__ void operator()(const f32x4 (&acc)[2][2][4][2], const Unit& u, int wr, int wc, int fr, int fq) const {
        const int bb = u.pm >> 5;
#pragma unroll
        for (int ai = 0; ai < 2; ++ai)
#pragma unroll
            for (int m = 0; m < 4; ++m) {
                const int row = u.pm * 256 + 128 * ai + 64 * wr + 16 * m + fr, s = row & (NS - 1);
                const float rs = row_rs<4>(kvp + (size_t)row * 4, 1.0f / 256.0f);
#pragma unroll
                for (int bj = 0; bj < 2; ++bj) {
                    u32x2 w8; w8.x = pack4_fp8(acc[ai][bj][m][0] * rs); w8.y = pack4_fp8(acc[ai][bj][m][1] * rs);
                    *(u32x2*)(kn + ((size_t)(bb * NH + 2 * u.pn + bj) * NS + s) * 128 + 32 * wc + 8 * fq) = w8; }
            }
    }
};
struct EpiVT {
    const float* kvp; unsigned char* vt;
    __device__ __forceinline__ void operator()(const f32x4 (&acc)[2][2][4][2], const Unit& u, int wr, int wc, int fr, int fq) const {
        f32x4 rsv[2][2];
#pragma unroll
        for (int bj = 0; bj < 2; ++bj)
#pragma unroll
            for (int n = 0; n < 2; ++n)
#pragma unroll
                for (int e = 0; e < 4; ++e) { const int tok = u.pn * 256 + 128 * bj + 32 * wc + 8 * fq + 4 * n + e; rsv[bj][n][e] = row_rs<4>(kvp + (size_t)tok * 4, 1.0f / 256.0f); }
#pragma unroll
        for (int ai = 0; ai < 2; ++ai)
#pragma unroll
            for (int m = 0; m < 4; ++m) {
                const int hd = u.pm * 256 + 128 * ai + 64 * wr + 16 * m + fr, h = hd >> 7, d = hd & 127;
#pragma unroll
                for (int bj = 0; bj < 2; ++bj) {
                    const int tok = u.pn * 256 + 128 * bj + 32 * wc + 8 * fq, b = tok >> 13, s = tok & (NS - 1);
                    u32x2 w8; w8.x = pack4_fp8(acc[ai][bj][m][0] * rsv[bj][0]); w8.y = pack4_fp8(acc[ai][bj][m][1] * rsv[bj][1]);
                    *(u32x2*)(vt + ((size_t)((b * NH + h) * 128 + d)) * NS + s) = w8; }
            }
    }
};
constexpr float W8SCALE = 32.0f, O8SCALE = 16.0f;
struct WConv { const float* src0; const float* src1; const float* gain; bf16_t* dst; int N0, N1, K, Nout, kind; float f8scale; };
__device__ __forceinline__ int colmap(int kind, int n) {
    if (kind == 6) { kind = 1; n += 1024; }
    switch (kind) {
    case 1: {
        const int pn = n >> 8; if (pn >= 8) return n;
        const int t = pn >> 2, bj = (n >> 7) & 1, r = n & 127, hh = 2 * (pn & 3) + (r >> 6), d = 64 * bj + (r & 63);
        return t * 1024 + hh * 128 + d; }
    case 2: {
        if (n < 256) return n;
        if (n < 512) return 384 + (n - 256);
        if (n < 640) return 256 + (n - 512);
        const int r = n - 640, wc = r >> 5, fq = (r >> 3) & 3, nn = (r >> 2) & 1, i = r & 3;
        if (wc >= 2) return -1;
        return 384 + 256 + 32 * nn + 16 * wc + 4 * fq + i; }
    case 3: {
        if (n < 1024) return (n >> 7) * 192 + (n & 127);
        const int m = n - 1024, pn4 = m >> 8, gidx = (m >> 5) & 7, fq = (m >> 3) & 3, nn = (m >> 2) & 1, i = m & 3;
        const int hh = 4 * pn4 + (gidx >> 1), j = 16 * (gidx & 1) + 4 * fq + i;
        return hh * 192 + 128 + 32 * nn + j; }
    case 4: {
        const int q = n >> 8, bj = (n >> 7) & 1, r = n & 127;
        return bj * 256 + 128 * q + r; }
    case 5: {
        const int half = n >> 10, hd = n & 1023; return (hd >> 7) * 256 + half * 128 + (hd & 127); }
    default: return n;
    }
}
__device__ __forceinline__ void conv_item(const WConv& w, LAS float* scr, int item, int lane) {
    const int nblk = w.Nout / 32, kb = item / nblk, nb = item % nblk, k0 = 64 * kb, n0 = 32 * nb;
    const int n4 = lane & 7, ks = lane >> 3;
    const int s = colmap(w.kind, n0 + 4 * n4);
    const bool z = s < 0, first = s < w.N0;
    const float* sp = first ? w.src0 + s : w.src1 + (s - w.N0);
    const int ld = first ? w.N0 : w.N1;
    f32x4 v[8];
#pragma unroll
    for (int it = 0; it < 8; ++it) { const int k = it * 8 + ks; v[it] = z ? (f32x4){0.f, 0.f, 0.f, 0.f} : *(const f32x4*)(sp + (size_t)(k0 + k) * ld); }
#pragma unroll
    for (int it = 0; it < 8; ++it) { const int k = it * 8 + ks; const float g = w.gain ? w.gain[k0 + k] : 1.0f;
#pragma unroll
        for (int e = 0; e < 4; ++e) scr[k * 33 + 4 * n4 + e] = v[it][e] * g; }
    asm volatile("s_waitcnt lgkmcnt(0)" ::: "memory");
    const int c = lane & 7;
#pragma unroll
    for (int j = 0; j < 4; ++j) { const int n = (lane >> 3) + 8 * j; const LAS float* sv = scr + (8 * c) * 33 + n;
        if (w.f8scale != 0.f) { const float q = w.f8scale; u32x2 o8;
            o8.x = pack4_fp8((f32x4){sv[0 * 33] * q, sv[1 * 33] * q, sv[2 * 33] * q, sv[3 * 33] * q}); o8.y = pack4_fp8((f32x4){sv[4 * 33] * q, sv[5 * 33] * q, sv[6 * 33] * q, sv[7 * 33] * q});
            *(u32x2*)((unsigned char*)w.dst + (size_t)(n0 + n) * w.K + k0 + 8 * c) = o8; }
        else {
        u32x4 o; o.x = cvtpk(sv[0 * 33], sv[1 * 33]); o.y = cvtpk(sv[2 * 33], sv[3 * 33]); o.z = cvtpk(sv[4 * 33], sv[5 * 33]); o.w = cvtpk(sv[6 * 33], sv[7 * 33]);
        *(u32x4*)(w.dst + (size_t)(n0 + n) * w.K + k0 + 8 * c) = o; } }
    asm volatile("s_waitcnt lgkmcnt(0)" ::: "memory");
}
__device__ __forceinline__ bool get_conv(int mi, const Args& a, WConv& w) {
    unsigned char* ws = a.ws;
    w.src1 = nullptr; w.N1 = 0; w.gain = nullptr; w.kind = 0; w.f8scale = 0.f;
    if (mi == 0) { w.src0 = a.in[6]; w.N0 = 3072; w.K = 1024; w.Nout = 1024; w.kind = 1; w.gain = a.in[2]; w.dst = (bf16_t*)(ws + WS_WQKV0); return true; }
    if (mi == 74) { w.src0 = a.in[6]; w.N0 = 3072; w.K = 1024; w.Nout = 2048; w.kind = 6; w.gain = a.in[2]; w.f8scale = W8SCALE; w.dst = (bf16_t*)(ws + WS_WQKV0 + 2 * MiB); return true; }
    if (mi == 1) { w.src0 = a.in[7]; w.N0 = 1024; w.K = 1024; w.Nout = 1024; w.f8scale = W8SCALE; w.dst = (bf16_t*)(ws + WS_WO0); return true; }
    if (mi == 2) { w.src0 = a.in[8]; w.N0 = 384; w.src1 = a.in[11]; w.N1 = 320; w.K = 1024; w.Nout = 768; w.kind = 2; w.gain = a.in[2] + 1024; w.dst = (bf16_t*)(ws + WS_WDQKV); return true; }
    if (mi == 3) { w.src0 = a.in[10]; w.N0 = 1536; w.K = 384; w.Nout = 1536; w.kind = 3; w.gain = a.in[9]; w.dst = (bf16_t*)(ws + WS_WUQ); return true; }
    if (mi == 4) { w.src0 = a.in[13]; w.N0 = 2048; w.K = 256; w.Nout = 2048; w.kind = 5; w.gain = a.in[12]; w.dst = (bf16_t*)(ws + WS_WUKV); return true; }
    if (mi == 5) { w.src0 = a.in[14]; w.N0 = 1024; w.K = 1024; w.Nout = 1024; w.f8scale = W8SCALE; w.dst = (bf16_t*)(ws + WS_WO1); return true; }
    if (mi < 38) { const int le = mi - 6, l = le >> 4;
        w.src0 = a.in[17] + (size_t)le * 1024 * 256; w.N0 = 256; w.src1 = a.in[18] + (size_t)le * 1024 * 256; w.N1 = 256; w.K = 1024; w.Nout = 512; w.kind = 4;
        w.gain = a.in[3] + l * 1024; w.dst = (bf16_t*)(ws + WS_WGU) + (size_t)le * 512 * 1024; return true; }
    if (mi < 70) { const int le = mi - 38;
        w.src0 = a.in[19] + (size_t)le * 256 * 1024; w.N0 = 1024; w.K = 256; w.Nout = 1024; w.dst = (bf16_t*)(ws + WS_WD) + (size_t)le * 1024 * 256; return true; }
    if (mi < 72) { const int l = mi - 70;
        w.src0 = a.in[20] + (size_t)l * 1024 * 1024; w.N0 = 1024; w.K = 1024; w.Nout = 1024; w.gain = a.in[4] + l * 1024; w.dst = (bf16_t*)(ws + WS_WPG) + (size_t)l * 1024 * 1024; return true; }
    if (mi < 74 && mi >= 72) { const int l = mi - 72;
        w.src0 = a.in[21] + (size_t)l * 256 * 1024; w.N0 = 1024; w.K = 256; w.Nout = 1024; w.dst = (bf16_t*)(ws + WS_WPP) + (size_t)l * 1024 * 256; return true; }
    return false;
}

__device__ __forceinline__ void p_prologue(const Args& a, LAS unsigned char* lds, int vcu, int G) {
    int tid = threadIdx.x; asm volatile("" : "+v"(tid));
    const int lane = tid & 63, wave = __builtin_amdgcn_readfirstlane(tid >> 6);
    const int gw = vcu * NWAVES + wave, NGW = G * NWAVES;
    unsigned char* ws = a.ws;
    LAS float* scr = (LAS float*)(lds + wave * 16384);
    int base = 0;
    for (int mi = 0; mi < 75; ++mi) {
        WConv w; get_conv(mi, a, w);
        const int n = (w.K / 64) * (w.Nout / 32);
        int it = (gw - (base % NGW) + NGW) % NGW;
        for (; it < n; it += NGW) conv_item(w, scr, it, lane);
        base += n;
    }
    {   const float* x = a.in[0]; bf16_t* hb = (bf16_t*)(ws + WS_HB); float* hpx = (float*)(ws + WS_HPX);
        for (int m = gw; m < NT; m += 2 * NGW) {
            const int m2 = (m + NGW < NT) ? m + NGW : m;
            const f32x4* xr = (const f32x4*)(x + (size_t)m * 1024) + lane; const f32x4* xr2 = (const f32x4*)(x + (size_t)m2 * 1024) + lane;
            f32x4 v[4], v2[4]; float s = 0.f, s2 = 0.f;
#pragma unroll
            for (int j = 0; j < 4; ++j) { v[j] = xr[64 * j]; v2[j] = xr2[64 * j]; }
#pragma unroll
            for (int j = 0; j < 4; ++j) { s += dot4(v[j]); s2 += dot4(v2[j]); }
            s = wave_sum(s); s2 = wave_sum(s2);
            u32x2* o8 = (u32x2*)(hb + (size_t)m * 1024) + lane; u32x2* o82 = (u32x2*)(hb + (size_t)m2 * 1024) + lane;
            unsigned* x8a = (unsigned*)(ws + WS_X8 + (size_t)m * 1024) + lane; unsigned* x8b = (unsigned*)(ws + WS_X8 + (size_t)m2 * 1024) + lane;
#pragma unroll
            for (int j = 0; j < 4; ++j) { x8a[64 * j] = pack4_fp8(v[j]); x8b[64 * j] = pack4_fp8(v2[j]);
                                          u32x2 o; o.x = cvtpk(v[j][0], v[j][1]); o.y = cvtpk(v[j][2], v[j][3]); o8[64 * j] = o;
                                          u32x2 o2; o2.x = cvtpk(v2[j][0], v2[j][1]); o2.y = cvtpk(v2[j][2], v2[j][3]); o82[64 * j] = o2; }
            if (lane < 16) { hpx[(size_t)m * 16 + lane] = (lane == 0) ? s : 0.f; hpx[(size_t)m2 * 16 + lane] = (lane == 0) ? s2 : 0.f; }
        } }
    {   const int gt = (vcu * NTHR) + tid, NGT = G * NTHR;
        float* cosA = (float*)(ws + WS_COSA); float* sinA = (float*)(ws + WS_SINA); float* cosB = (float*)(ws + WS_COSB); float* sinB = (float*)(ws + WS_SINB);
        for (int i = gt; i < NS * 64; i += NGT) { const int s = i >> 6, j = i & 63; const float inv = powf(10000.0f, -(float)j / 64.0f); float sn, cs; sincosf((float)s * inv, &sn, &cs); cosA[i] = cs; sinA[i] = sn; }
        for (int i = gt; i < NS * 32; i += NGT) { const int s = i >> 5, j = i & 31; const float inv = powf(10000.0f, -(float)j / 32.0f); float sn, cs; sincosf((float)s * inv, &sn, &cs); cosB[i] = cs; sinB[i] = sn; }
        float* km = (float*)(ws + WS_KMEAN);
        for (int i = gt; i < NB * NH * 32 * 128; i += NGT) km[i] = 0.f;
        float* wrt = (float*)(ws + WS_WRT);
        for (int i = gt; i < 2 * 1024 * 20; i += NGT) { const int l = i / 20480, r = i % 20480, k = r / 20, c = r % 20;
            const float g = a.in[3][l * 1024 + k];
            wrt[i] = g * (c < 4 ? a.in[15][(size_t)(l * 1024 + k) * 4 + c] : a.in[16][(size_t)(l * 1024 + k) * 16 + (c - 4)]); }
    }
}

__device__ __forceinline__ at::SparseBufs sparse_bufs(const Args& a) {
    unsigned char* ws = a.ws;
    at::SparseBufs SB;
    SB.lists = (unsigned short*)(ws + WS_R + 200 * MiB); SB.lcnt = (unsigned*)(ws + WS_CTL) + CW_LCNT; SB.selinfo = (unsigned*)(ws + WS_R + 210 * MiB);
    SB.ml = (float*)(ws + WS_R + 192 * MiB); SB.part01 = (unsigned char*)a.out; SB.part2 = ws + WS_PART2;
    return SB;
}
__device__ __forceinline__ void p_attention_mla(const Args& a, unsigned char* ldsg) {
    unsigned char* ws = a.ws;
    const at::SparseBufs SB = sparse_bufs(a);
    for (int L = blockIdx.x; L < 512; L += gridDim.x) {
        const int xcd = L & 7, k = L >> 3, bh = xcd + 8 * (k >> 4), x = k & 15, b = bh >> 3, h = bh & 7;
        for (int pass = 0; pass < 2; ++pass) {
            const int qb = pass ? x : 31 - x, P0 = qb * 256;
            at::AttnP A;
            A.Qp = (const bf16_t*)(ws + WS_Q + ((size_t)bh * NS + P0) * 192); A.Kn = (const bf16_t*)(ws + WS_KN1 + (size_t)bh * NS * 128);
            A.Kr = (const bf16_t*)(ws + WS_KROPE + (size_t)b * NS * 64); A.Vp = (const bf16_t*)(ws + WS_V1 + (size_t)bh * NS * 128);
            A.Op = (bf16_t*)(ws + WS_O + ((size_t)(b * NS + P0) * 1024 + h * 128)); A.P0 = P0; A.t0 = 0; A.NT = (P0 + 256) / 64;
            at::attn_unit<192, 0>((char*)ldsg, A, SB);
        }
    }
}
__device__ __forceinline__ void p_moba_gate(const Args& a, unsigned char* ldsg) {
    unsigned char* ws = a.ws;
    const at::SparseBufs SB = sparse_bufs(a);
    for (int L = blockIdx.x; L < 1024; L += gridDim.x) {
        const int bh = L >> 5, qb = L & 31;
        at::gate_unit((char*)ldsg, (const bf16_t*)(ws + WS_Q) + ((size_t)bh * NS + qb * 256) * 128, (const float*)(ws + WS_KMEAN) + (size_t)bh * 32 * 128, bh, qb, SB);
    }
}
constexpr int MOBA_PART = 512;
__device__ __forceinline__ void p_moba_gather(const Args& a, unsigned char* ldsg) {
    unsigned char* ws = a.ws;
    const at::SparseBufs SB = sparse_bufs(a);
    int tid = threadIdx.x; asm volatile("" : "+v"(tid));
    int* pre = (int*)(ldsg + 139264); int* seg = pre + 1032;
    if (tid < 32) { int s = 0; for (int j = 0; j < 32; ++j) s += (int)((SB.lcnt[tid * 32 + j] + (MOBA_PART - 1)) / MOBA_PART); seg[tid] = s; }
    __syncthreads();
    if (tid < 32) { int s = 0; for (int j = 0; j < tid; ++j) s += seg[j];
        for (int j = 0; j < 32; ++j) { pre[tid * 32 + j] = s; s += (int)((SB.lcnt[tid * 32 + j] + (MOBA_PART - 1)) / MOBA_PART); }
        if (tid == 31) pre[1024] = s; }
    __syncthreads();
    const int NU = __builtin_amdgcn_readfirstlane(pre[1024]);
    for (int u = blockIdx.x; u < NU; u += gridDim.x) {
        int lo = 0, hi = 1024;
        while (hi - lo > 1) { const int mid = (lo + hi) >> 1; if (pre[mid] <= u) lo = mid; else hi = mid; }
        const int li = __builtin_amdgcn_readfirstlane(lo), c = u - __builtin_amdgcn_readfirstlane(pre[lo]), bh = li >> 5, n = li & 31;
        const int cnt = (int)SB.lcnt[li], nrows = (cnt - MOBA_PART * c) < MOBA_PART ? (cnt - MOBA_PART * c) : MOBA_PART;
        at::moba_gather_unit((char*)ldsg, (const bf16_t*)(ws + WS_Q8 + (size_t)bh * NS * 128), (const bf16_t*)(ws + WS_K8 + (size_t)bh * NS * 128), (const bf16_t*)(ws + WS_V0) + (size_t)bh * NS * 128,
                             bh, n, SB.lists + (size_t)bh * at::LCAP + at::loff(n) + MOBA_PART * c, nrows, SB);
    }
}
__device__ __forceinline__ void p_moba_own(const Args& a, unsigned char* ldsg) {
    unsigned char* ws = a.ws;
    const at::SparseBufs SB = sparse_bufs(a);
    for (int L = blockIdx.x; L < 1024; L += gridDim.x) {
        const int bh = L >> 5, qb = L & 31;
        at::moba_own_unit((char*)ldsg, (const bf16_t*)(ws + WS_Q8 + (size_t)bh * NS * 128), (const bf16_t*)(ws + WS_K8 + (size_t)bh * NS * 128), (const bf16_t*)(ws + WS_V0) + (size_t)bh * NS * 128,
                          (bf16_t*)(ws + WS_O), bh, qb, SB);
    }
}

__global__ void __launch_bounds__(NTHR, 2) mega(Args a) {
    extern __shared__ __attribute__((aligned(16))) unsigned char lds_g[];
    LAS unsigned char* lds = (LAS unsigned char*)lds_g;
    const int tid = threadIdx.x;
    const int G = gridDim.x, bx = blockIdx.x, vcu = (G % 8 == 0) ? (bx % 8) * (G / 8) + bx / 8 : bx;
    unsigned char* ws = a.ws;
    volatile LAS unsigned* MISC = (volatile LAS unsigned*)(lds + LDS_MISC);
    for (int u = tid; u < 256; u += NTHR) MISC[u] = 0u;
    __syncthreads();
    XcdBarrier bar = xcd_barrier_post((unsigned*)(ws + WS_CTL) + CW_BAR, MISC);
    const int lo = a.ph_lo, hi = a.ph_hi;
#ifndef DBG_ONLY
#define DBG_EN(k) true
#else
#define DBG_EN(k) ((k) == DBG_ONLY)
#endif
#define IN(k) (DBG_EN(k) && lo <= (k) && (k) < hi)
#ifdef TSTAMP_PHASE
#define TSTAMP(i) do { if (bx == 0 && tid == 0) ((unsigned long long*)(ws + WS_CTL + 65536))[i] = __builtin_amdgcn_s_memrealtime(); } while (0)
#else
#define TSTAMP(i) do { } while (0)
#endif
#define SEAM(k) do { if (IN(k) && IN((k) + 1)) xcd_barrier(bar); TSTAMP((k) + 1); } while (0)
    TSTAMP(0);
    if (IN(0)) { p_prologue(a, lds, vcu, G); }
    SEAM(0);
    if (IN(1)) {
        g8::DenseP P{(const char*)(ws + WS_HB), (const char*)(ws + WS_WQKV0), 1024, 1024, 1024, NT / 256, 4, G, bx};
        EpiQKV E{(const float*)(ws + WS_HPX), (const float*)(ws + WS_COSA), (const float*)(ws + WS_SINA), (bf16_t*)(ws + WS_Q), (bf16_t*)(ws + WS_K0), (bf16_t*)(ws + WS_V0), (float*)(ws + WS_KMEAN), ws + WS_Q8, ws + WS_K8, 0, 1.0f};
        g8::gemm_phase(lds, P, E);
        g8::DenseP P2{(const char*)(ws + WS_X8), (const char*)(ws + WS_WQKV0 + 2 * MiB), 512, 512, 512, NT / 256, 8, G, bx};
        EpiQKV E2{(const float*)(ws + WS_HPX), (const float*)(ws + WS_COSA), (const float*)(ws + WS_SINA), (bf16_t*)(ws + WS_Q), (bf16_t*)(ws + WS_K0), (bf16_t*)(ws + WS_V0), (float*)(ws + WS_KMEAN), ws + WS_Q8, ws + WS_K8, 4, 1.0f / W8SCALE};
        g8::gemm_phase<g8::DenseP, EpiQKV, true>(lds, P2, E2);
    }
    SEAM(1);
    if (IN(2)) { p_moba_gate(a, lds_g); }
    SEAM(2);
    if (IN(3)) { p_moba_gather(a, lds_g); }
    SEAM(3);
    if (IN(4)) { p_moba_own(a, lds_g); }
    SEAM(4);
    if (IN(5)) {
        g8::DenseP P{(const char*)(ws + WS_O), (const char*)(ws + WS_WO0), 512, 512, 512, NT / 256, 4, G, bx};
        EpiResid E{(const bf16_t*)(ws + WS_HB), (bf16_t*)(ws + WS_HB), (float*)(ws + WS_HP0), 1.0f / (W8SCALE * O8SCALE)};
        g8::gemm_phase<g8::DenseP, EpiResid, true>(lds, P, E);
    }
    SEAM(5);
#define MOE_PLE(PB, layer, HBC, HBN) \
    if (IN((PB) + 0)) { p_route(a, lds, (layer), (const bf16_t*)(HBC), vcu, G); } \
    SEAM((PB) + 0); \
    if (IN((PB) + 1)) { \
        const int NRT = moe_prefix(a, lds, (layer)); \
        const unsigned* cnt = (const unsigned*)(ws + WS_CTL) + CW_CNT + (layer) * 24 * 16; \
        MoeUnits U{(LAS const int*)(lds + LDS_TB), NRT, G, bx}; \
        MoeGuP P{(const char*)(HBC), (const char*)(ws + WS_WGU) + (size_t)(layer) * 16 * 512 * 1024 * 2, (const int*)(ws + WS_LIST), cnt, U, 1024, 1024}; \
        EpiGateUp E{(const float*)(ws + WS_HP0), (const float*)(ws + WS_TOKW), (const int*)(ws + WS_LIST), cnt, (LAS const int*)(lds + LDS_TB), (bf16_t*)(ws + WS_ACT)}; \
        g8::gemm_phase(lds, P, E); \
          \
        const int extra_ = (NRT * 4) % G, gpp_ = (extra_ > 0 && (G - extra_) * 10 >= 1536) ? G - extra_ : G, cpp_ = gpp_ == G ? bx : bx - extra_; \
        g8::DenseP P2{(const char*)(ws + WS_PB), (const char*)(ws + WS_WPP) + (size_t)(layer) * 1024 * 256 * 2, 256, 256, 256, NT / 256, 4, gpp_, cpp_ < 0 ? (1 << 28) : cpp_}; \
        EpiStore E2{(bf16_t*)(ws + WS_PP), 1024}; \
        g8::gemm_phase(lds, P2, E2); \
    } \
    SEAM((PB) + 1); \
    if (IN((PB) + 2)) { \
        const int NRT = moe_prefix(a, lds, (layer)); \
        const unsigned* cnt = (const unsigned*)(ws + WS_CTL) + CW_CNT + (layer) * 24 * 16; \
        MoeUnits U{(LAS const int*)(lds + LDS_TB), NRT, G, bx}; \
        MoeDownP P{(const char*)(ws + WS_ACT), (const char*)(ws + WS_WD) + (size_t)(layer) * 16 * 1024 * 256 * 2, U, 256, 512}; \
        EpiDown E{(bf16_t*)(HBC), (float*)(ws + WS_HP1), (const int*)(ws + WS_LIST), cnt, (LAS const int*)(lds + LDS_TB)}; \
        g8::gemm_phase(lds, P, E); \
    } \
    SEAM((PB) + 2); \
    if (IN((PB) + 3)) { \
        g8::DenseP P{(const char*)(HBC), (const char*)(ws + WS_WPG) + (size_t)(layer) * 1024 * 1024 * 2, 1024, 1024, 1024, NT / 256, 4, G, bx}; \
        EpiPle E{(const float*)(ws + WS_HP1), (const bf16_t*)(ws + WS_PP), (const bf16_t*)(HBC), (bf16_t*)(HBN), (float*)(ws + WS_HP2)}; \
        g8::gemm_phase(lds, P, E); \
    } \
    SEAM((PB) + 3);
    MOE_PLE(6, 0, ws + WS_HB, a.out)
    if (IN(10)) {
        g8::DenseP P{(const char*)a.out, (const char*)(ws + WS_WDQKV), 1024, 1024, 1024, NT / 256, 3, G, bx};
        EpiDqkv E{(const float*)(ws + WS_HP2), (const float*)(ws + WS_COSB), (const float*)(ws + WS_SINB), (bf16_t*)(ws + WS_CQ), (bf16_t*)(ws + WS_CKV), (bf16_t*)(ws + WS_KROPE), (float*)(ws + WS_CQP), (float*)(ws + WS_KVP)};
        g8::gemm_phase(lds, P, E);
    }
    SEAM(10);
    if (IN(11)) {
        g8::DenseP P{(const char*)(ws + WS_CQ), (const char*)(ws + WS_WUQ), 384, 384, 384, NT / 256, 6, G, bx};
        EpiUq E{(const float*)(ws + WS_CQP), (const float*)(ws + WS_COSB), (const float*)(ws + WS_SINB), (bf16_t*)(ws + WS_Q)};
        g8::gemm_phase(lds, P, E);
        g8::DenseP P2{(const char*)(ws + WS_CKV), (const char*)(ws + WS_WUKV), 256, 256, 256, NT / 256, 4, G, bx};
        EpiKn E2{(const float*)(ws + WS_KVP), ws + WS_KN1};
        g8::gemm_phase(lds, P2, E2);
        g8::DenseP P3{(const char*)(ws + WS_WUKV) + (size_t)1024 * 256 * 2, (const char*)(ws + WS_CKV), 256, 256, 256, 4, NT / 256, G, bx};
        EpiVT E3{(const float*)(ws + WS_KVP), ws + WS_V1};
        g8::gemm_phase(lds, P3, E3);
    }
    SEAM(11);
    if (IN(12)) { p_attention_mla(a, lds_g); }
    SEAM(12);
    if (IN(13)) {
        g8::DenseP P{(const char*)(ws + WS_O), (const char*)(ws + WS_WO1), 512, 512, 512, NT / 256, 4, G, bx};
        EpiResid E{(const bf16_t*)a.out, (bf16_t*)a.out, (float*)(ws + WS_HP0), 1.0f / (W8SCALE * O8SCALE)};
        g8::gemm_phase<g8::DenseP, EpiResid, true>(lds, P, E);
    }
    SEAM(13);
    MOE_PLE(14, 1, a.out, ws + WS_HB)
    if (IN(18)) {
        int t2 = threadIdx.x; asm volatile("" : "+v"(t2)); const int lane = t2 & 63, wave = t2 >> 6; const float* fg = a.in[5];
        const bf16_t* hfin = (const bf16_t*)(ws + WS_HB);
        for (int mrow = vcu * NWAVES + wave; mrow < NT; mrow += G * NWAVES) {
            f32x4 v[4]; float s = 0.f;
#pragma unroll
            for (int j = 0; j < 2; ++j) { unpack8(*((const u32x4*)(hfin + (size_t)mrow * 1024) + lane + 64 * j), v[2 * j], v[2 * j + 1]); s += dot4(v[2 * j]) + dot4(v[2 * j + 1]); }
            s = wave_sum(s);
            const float r = rsqrtf(s * (1.0f / 1024.0f) + EPS);
            f32x4* xr = (f32x4*)(a.out + (size_t)mrow * 1024);
#pragma unroll
            for (int j = 0; j < 2; ++j) { const int c4 = 2 * (lane + 64 * j);
                xr[c4] = v[2 * j] * r * *((const f32x4*)fg + c4); xr[c4 + 1] = v[2 * j + 1] * r * *((const f32x4*)fg + c4 + 1); }
        }
    }
#ifdef TSTAMP_PHASE
    xcd_barrier(bar);
    if (bx == 0 && tid == 0) { const unsigned long long* ts = (const unsigned long long*)(ws + WS_CTL + 65536);
        const unsigned long long t1 = (TSTAMP_PHASE == 18) ? __builtin_amdgcn_s_memrealtime() : ts[TSTAMP_PHASE + 1];
        a.out[0] += (float)(t1 - ts[TSTAMP_PHASE]) * TSTAMP_SCALE; }
#endif
#undef IN
#undef SEAM
}

constexpr int N_PHASES = 19;
static int g_grid = 0;
static bool setup() {
    if (g_grid) return g_grid > 0;
    int dev = 0, cus = 0;
    if (hipGetDevice(&dev) != hipSuccess || hipDeviceGetAttribute(&cus, hipDeviceAttributeMultiprocessorCount, dev) != hipSuccess) { g_grid = -1; return false; }
    if (hipFuncSetAttribute((const void*)mega, hipFuncAttributeMaxDynamicSharedMemorySize, LDS_BYTES) != hipSuccess) { fprintf(stderr, "hipFuncSetAttribute failed\n"); g_grid = -1; return false; }
    int per_cu = 0;
    if (hipOccupancyMaxActiveBlocksPerMultiprocessor(&per_cu, (const void*)mega, NTHR, LDS_BYTES) != hipSuccess || per_cu < 1) { fprintf(stderr, "occupancy query: %d\n", per_cu); }
    (void)hipGetLastError();
    g_grid = cus;
    return true;
}
static void run_phases(const Args& base, int lo, int hi, bool one_launch, hipStream_t st) {
    if (one_launch) { Args a = base; a.ph_lo = lo; a.ph_hi = hi; hipLaunchKernelGGL(mega, dim3(g_grid), dim3(NTHR), LDS_BYTES, st, a); }
    else for (int p = lo; p < hi; ++p) { Args a = base; a.ph_lo = p; a.ph_hi = p + 1;
#ifdef PROBE_ROUTE
        if (p == 6) { Args b = base; b.ph_lo = 14; b.ph_hi = 15; hipLaunchKernelGGL(mega, dim3(g_grid), dim3(NTHR), LDS_BYTES, st, b); }
        if (p == 14) (void)hipMemsetAsync(base.ws + WS_CTL + (CW_CNT + 24 * 16) * 4, 0, 24 * 16 * 4, st);
#endif
        hipLaunchKernelGGL(mega, dim3(g_grid), dim3(NTHR), LDS_BYTES, st, a);
#ifdef DOUBLE_PHASE
        if (p == DOUBLE_PHASE) hipLaunchKernelGGL(mega, dim3(g_grid), dim3(NTHR), LDS_BYTES, st, a);
#endif
    }
}
}
#ifndef ONE_LAUNCH
#define ONE_LAUNCH 1
#endif
extern "C" void kernel_launch(void* const* d_in, const int* in_sizes, int n_in, void* d_out, int out_size, void* d_ws, size_t ws_size, hipStream_t stream) {
    (void)in_sizes; (void)out_size;
    if (n_in != 22) { fprintf(stderr, "kernel_launch: expected 22 inputs, got %d\n", n_in); return; }
    if (ws_size < fk::WS_END) { fprintf(stderr, "kernel_launch: workspace too small (%zu)\n", ws_size); return; }
    if (!fk::setup()) return;
    (void)hipMemsetAsync((char*)d_ws + fk::WS_CTL, 0, fk::CTL_ZERO_BYTES, stream);
    fk::Args a{};
    for (int i = 0; i < 22; ++i) a.in[i] = (const float*)d_in[i];
    a.out = (float*)d_out; a.ws = (unsigned char*)d_ws;
    fk::run_phases(a, 0, fk::N_PHASES, ONE_LAUNCH != 0, stream);
}
```

```cpp
#include <hip/hip_runtime.h>
#include <cstdio>
#include <cstdint>
#include <cmath>
namespace fk {
#define LAS __attribute__((address_space(3)))
#define GAS __attribute__((address_space(1)))
typedef unsigned short bf16_t;
typedef short bf16x8 __attribute__((ext_vector_type(8)));
typedef short s16x4 __attribute__((ext_vector_type(4)));
typedef float f32x4 __attribute__((ext_vector_type(4)));
typedef float f32x16 __attribute__((ext_vector_type(16)));
typedef unsigned u32x4 __attribute__((ext_vector_type(4)));
typedef unsigned u32x2 __attribute__((ext_vector_type(2)));
typedef float f32x2_t __attribute__((ext_vector_type(2)));
typedef __bf16 bf16x2_t __attribute__((ext_vector_type(2)));

constexpr int NB = 4, NS = 8192, ND = 1024, NT = NB * NS, NH = 8;
constexpr float EPS = 1e-6f;
constexpr int NWAVES = 8, NTHR = 512;

constexpr size_t MiB = 1u << 20;
constexpr size_t WS_CTL = 0, CTL_ZERO_BYTES = 1 * MiB;
constexpr size_t WS_COSA = 1 * MiB, WS_SINA = 3 * MiB, WS_COSB = 5 * MiB, WS_SINB = 6 * MiB;
constexpr size_t WS_KMEAN = 7 * MiB;
constexpr size_t WS_WRT = 7 * MiB + 512 * 1024;
constexpr size_t WS_HPX = 8 * MiB, WS_HP0 = 10 * MiB, WS_HP1 = 12 * MiB, WS_HP2 = 14 * MiB;
constexpr size_t WS_CQP = 16 * MiB, WS_KVP = 17 * MiB;
constexpr size_t WS_TOKW = 18 * MiB;
constexpr size_t WS_LIST = 19 * MiB;
constexpr size_t WS_WQKV0 = 24 * MiB, WS_WO0 = 30 * MiB, WS_WDQKV = 32 * MiB, WS_WUQ = 34 * MiB, WS_WUKV = 36 * MiB, WS_WO1 = 37 * MiB;
constexpr size_t WS_WGU = 40 * MiB;
constexpr size_t WS_WD = 72 * MiB;
constexpr size_t WS_WPG = 88 * MiB;
constexpr size_t WS_WPP = 92 * MiB;
constexpr size_t WS_HB = 94 * MiB;
constexpr size_t WS_CQ = WS_HB, WS_CKV = WS_HB + 24 * MiB, WS_KROPE = WS_HB + 40 * MiB;
constexpr size_t WS_O = 158 * MiB;
constexpr size_t WS_R = 222 * MiB;
constexpr size_t WS_Q = WS_R, WS_K0 = WS_R + 64 * MiB, WS_V0 = WS_R + 128 * MiB;
constexpr size_t WS_K8 = WS_K0, WS_Q8 = WS_K0 + 32 * MiB;
constexpr size_t WS_X8 = WS_R + 192 * MiB;
constexpr size_t WS_KN1 = WS_R + 96 * MiB, WS_V1 = WS_R + 160 * MiB;
constexpr size_t WS_ACT = WS_R, WS_PB = WS_R + 40 * MiB, WS_PP = WS_R + 64 * MiB;
constexpr size_t WS_PART2 = WS_R + 224 * MiB;
constexpr size_t WS_END = WS_PART2 + 64 * MiB;
constexpr int CW_CNT = 1024;
constexpr int CW_BAR = 4096;
constexpr int CW_LCNT = 8192;

constexpr int RING_BYTES = 131072;
constexpr int LDS_BYTES = 147456;
constexpr int LDS_MISC = LDS_BYTES - 1024;

struct Args { const float* in[22]; float* out; unsigned char* ws; int ph_lo, ph_hi; };

__device__ __forceinline__ unsigned cvtpk(float lo, float hi) { f32x2_t v = {lo, hi}; bf16x2_t b = __builtin_convertvector(v, bf16x2_t); return __builtin_bit_cast(unsigned, b); }
__device__ __forceinline__ float bf2f(unsigned short b) { return __builtin_bit_cast(float, (unsigned)b << 16); }
__device__ __forceinline__ u32x4 pack8(f32x4 a, f32x4 b) { u32x4 w = {cvtpk(a[0], a[1]), cvtpk(a[2], a[3]), cvtpk(b[0], b[1]), cvtpk(b[2], b[3])}; return w; }
__device__ __forceinline__ unsigned pack4_fp8(f32x4 a) { int t = __builtin_amdgcn_cvt_pk_fp8_f32(a[0], a[1], 0, false); t = __builtin_amdgcn_cvt_pk_fp8_f32(a[2], a[3], t, true); return (unsigned)t; }
__device__ __forceinline__ float wave_sum(float v) {
#pragma unroll
    for (int o = 1; o < 64; o <<= 1) v += __shfl_xor(v, o);
    return v;
}
__device__ __forceinline__ float dot4(f32x4 a) { return (a[0] * a[0] + a[1] * a[1]) + (a[2] * a[2] + a[3] * a[3]); }
template <int NP> __device__ __forceinline__ float row_rs(const float* hp, float invd) {
    float s = 0.f;
#pragma unroll
    for (int i = 0; i < NP / 4; ++i) { const f32x4 a = *(const f32x4*)(hp + 4 * i); s += (a[0] + a[1]) + (a[2] + a[3]); }
    return rsqrtf(s * invd + EPS);
}

#define XB_TMO      128
#define XB_XCNT(j)  (256  + 64 * (j))
#define XB_XSUB(j)  (1280 + 64 * (j))
#define XB_XGEN(j)  (2304 + 64 * (j))
#define XB_TOP      3328
#define XB_TOPGEN   3392
#define XCD_BAR_WORDS 3456
#define XB_SPIN_CAP (1u << 18)
__device__ __forceinline__ unsigned xb_ld(unsigned* p)              { return __hip_atomic_load(p, __ATOMIC_RELAXED, __HIP_MEMORY_SCOPE_AGENT); }
__device__ __forceinline__ unsigned xb_add(unsigned* p, unsigned v) { return __hip_atomic_fetch_add(p, v, __ATOMIC_RELAXED, __HIP_MEMORY_SCOPE_AGENT); }
__device__ __forceinline__ unsigned xb_xcc_id() { return (unsigned)__builtin_amdgcn_s_getreg((3 << 11) | 20) & 0xFu; }
#define XB_SPIN(cond, bar) do { unsigned _sp = 0; while (cond) { __builtin_amdgcn_s_sleep(1); \
    if ((++_sp & 255u) == 0u) { if (xb_ld(&(bar)[XB_TMO])) break; if (_sp > XB_SPIN_CAP) { atomicAdd(&(bar)[XB_TMO], 1u); break; } } } } while (0)
struct XcdBarrier { unsigned* bar; unsigned x; volatile LAS unsigned* st; };
__device__ __forceinline__ XcdBarrier xcd_barrier_post(unsigned* bar, volatile LAS unsigned* st) {
    XcdBarrier b; b.bar = bar; b.x = xb_xcc_id(); b.st = st;
    if (threadIdx.x == 0) (void)xb_add(&bar[XB_XCNT(b.x)], 1u);
    return b;
}
__device__ __forceinline__ void xcd_barrier_complete(unsigned* bar, unsigned x, unsigned& nloc, unsigned& nx) {
    const unsigned G = gridDim.x * gridDim.y * gridDim.z;
    unsigned sum, cnt, mine, sp = 0u;
    for (;;) {
        sum = 0u; cnt = 0u; mine = 0u;
#pragma unroll
        for (unsigned j = 0; j < 16; ++j) { const unsigned c = xb_ld(&bar[XB_XCNT(j)]); sum += c; cnt += (c > 0u) ? 1u : 0u; mine = (j == x) ? c : mine; }
        if (sum == G) break;
        __builtin_amdgcn_s_sleep(1);
        if ((++sp & 255u) == 0u) { if (xb_ld(&bar[XB_TMO])) break; if (sp > XB_SPIN_CAP) { atomicAdd(&bar[XB_TMO], 1u); break; } }
    }
    nloc = mine > 0u ? mine : 1u; nx = cnt > 0u ? cnt : 1u;
}
__device__ __forceinline__ void xcd_barrier(const XcdBarrier& b) {
    asm volatile("s_waitcnt vmcnt(0)" ::: "memory");
    __syncthreads();
    if (threadIdx.x == 0) {
        unsigned* bar = b.bar;
        __builtin_amdgcn_s_waitcnt(0);
        unsigned nloc = b.st[0], nx = b.st[1];
        if (nloc == 0u) { xcd_barrier_complete(bar, b.x, nloc, nx); b.st[0] = nloc; b.st[1] = nx; }
        const unsigned old = xb_add(&bar[XB_XSUB(b.x)], 1u);
        const unsigned gen = old / nloc;
        if (old + 1u == (gen + 1u) * nloc) {
            __builtin_amdgcn_fence(__ATOMIC_RELEASE, "agent");
            asm volatile("s_waitcnt vmcnt(0)" ::: "memory");
            const unsigned og = xb_add(&bar[XB_TOP], 1u);
            const unsigned tg = og / nx;
            if (og + 1u == (tg + 1u) * nx) xb_add(&bar[XB_TOPGEN], 1u);
            else XB_SPIN(xb_ld(&bar[XB_TOPGEN]) == tg, bar);
            __builtin_amdgcn_fence(__ATOMIC_ACQUIRE, "agent");
            xb_add(&bar[XB_XGEN(b.x)], 1u);
            asm volatile("s_waitcnt vmcnt(0)" ::: "memory");
        } else {
            XB_SPIN(xb_ld(&bar[XB_XGEN(b.x)]) == gen, bar);
            __builtin_amdgcn_fence(__ATOMIC_ACQUIRE, "agent");
            asm volatile("s_waitcnt vmcnt(0)" ::: "memory");
        }
    }
    __syncthreads();
}

namespace g8 {
constexpr int BM = 256, BK = 64, HALF = 128, HTB = HALF * BK * 2, STAGE_BYTES = 8 * HTB, NXCD = 8, WGM = 8;
__device__ __forceinline__ int lds_byte(int r, int c) { const int st = (r >> 4) * 2 + (c >> 5), rr = r & 15, cc = c & 31, ob = rr * 64 + cc * 2; return st * 1024 + (ob ^ (((ob >> 9) & 1) << 5)); }
__device__ __forceinline__ void stage_rc(int b, int& R, int& C) { const int st = b / 1024, sb = b % 1024, swz = sb ^ (((sb >> 9) & 1) << 5); R = (st >> 1) * 16 + swz / 64; C = (st & 1) * 32 + (swz % 64) / 2; }
__device__ __forceinline__ int perm32(int rho) { const int n = rho >> 4, i = rho & 15; return 8 * (i >> 2) + 4 * n + (i & 3); }
struct Unit { int pm, pn, aux; };
struct AOff { unsigned o[2][2]; };

__device__ __forceinline__ bool static_order(int i, int G, int c, int nM, int nN, int& pm, int& pn) {
    const int nwg = nM * nN; const long L = (long)i * G + c; if (L >= nwg) return false;
    int wgid = (int)L; { const int q = nwg / NXCD, r = nwg % NXCD, xcd = wgid % NXCD, off = wgid / NXCD; wgid = (xcd < r ? xcd * (q + 1) : r * (q + 1) + (xcd - r) * q) + off; }
    const int nig = WGM * nN, gid = wgid / nig, fm = gid * WGM, gsz = (nM - fm) < WGM ? (nM - fm) : WGM;
    pm = fm + ((wgid % nig) % gsz); pn = (wgid % nig) / gsz; return true;
}
struct DenseP {
    const char* A; const char* B; int lda, ldb, K, nM, nN, G, c;
    __device__ __forceinline__ bool next(int i, Unit& u) const { u.aux = 0; return static_order(i, G, c, nM, nN, u.pm, u.pn); }
    __device__ __forceinline__ void aoff(const Unit& u, const int (&R)[2], const int (&C)[2], AOff& o) const {
#pragma unroll
        for (int h = 0; h < 2; ++h)
#pragma unroll
            for (int i = 0; i < 2; ++i) o.o[h][i] = (unsigned)(((u.pm * BM + h * HALF + R[i]) * lda + C[i]) * 2);
    }
    __device__ __forceinline__ const char* bbase(const Unit& u, int kt) const { return B + ((size_t)u.pn * BM * ldb + (size_t)kt * BK) * 2; }
};

template <class Prov, class Epi, bool F8 = false>
__device__ __forceinline__ void gemm_phase(LAS unsigned char* lds, const Prov& P, const Epi& E) {
    int tid = threadIdx.x; asm volatile("" : "+v"(tid));
    const int wid = __builtin_amdgcn_readfirstlane(tid >> 6), lane = tid & 63, wr = wid >> 2, wc = wid & 3, fr = lane & 15, fq = lane >> 4;
    const int K = P.K, nt = K / BK;
    unsigned voffB[2];
#pragma unroll
    for (int i = 0; i < 2; ++i) { int R_, C_; stage_rc(tid * 16 + i * 8192, R_, C_); const int Rb = (R_ & ~31) + perm32(R_ & 31); voffB[i] = (unsigned)(Rb * P.ldb + C_) * 2u; }
#define G8_AOFF(u, dst) do { int t_ = tid; asm volatile("" : "+v"(t_)); int R[2], C[2]; _Pragma("unroll") for (int i_ = 0; i_ < 2; ++i_) stage_rc(t_ * 16 + i_ * 8192, R[i_], C[i_]); P.aoff(u, R, C, dst); } while (0)
    const size_t hstepB = (size_t)HALF * P.ldb * 2;
    const unsigned ldsw = (unsigned)wid * 1024u;
    const int aoff = lds_byte(wr * 64 + fr, fq * 8), boff = lds_byte(wc * 32 + fr, fq * 8);
#define G8_SA(b, h) (((b) * 2 + (h)) * HTB)
#define G8_SB(b, h) ((4 + (b) * 2 + (h)) * HTB)
#define G8_STAGE_A(bufoff, h, AO, kb) do { _Pragma("unroll") for (int _i = 0; _i < 2; ++_i) \
        __builtin_amdgcn_global_load_lds((const unsigned*)(P.A + (size_t)((AO).o[h][_i] + (kb))), (LAS unsigned*)(lds + (bufoff) + ldsw + _i * 8192), 16, 0, 0); } while (0)
#define G8_STAGE_A2(bufoff, h, kb) do { _Pragma("unroll") for (int _i = 0; _i < 2; ++_i) \
        __builtin_amdgcn_global_load_lds((const unsigned*)(P.A + (size_t)((last ? nA.o[h][_i] : cA.o[h][_i]) + (kb))), (LAS unsigned*)(lds + (bufoff) + ldsw + _i * 8192), 16, 0, 0); } while (0)
#define G8_STAGE_B(bufoff, bp) do { _Pragma("unroll") for (int _i = 0; _i < 2; ++_i) \
        __builtin_amdgcn_global_load_lds((const unsigned*)((bp) + voffB[_i]), (LAS unsigned*)(lds + (bufoff) + ldsw + _i * 8192), 16, 0, 0); } while (0)
    typedef int v8i_ __attribute__((ext_vector_type(8))); typedef int v4i_ __attribute__((ext_vector_type(4)));
#define G8_LDA(dst, b, h) do { _Pragma("unroll") for (int m = 0; m < 4; ++m) { if constexpr (F8) { const v4i_ x0_ = *(const LAS v4i_*)(lds + G8_SA(b, h) + aoff + m * 2048), x1_ = *(const LAS v4i_*)(lds + G8_SA(b, h) + aoff + m * 2048 + 1024); \
            dst##8[m] = (v8i_){x0_[0], x0_[1], x0_[2], x0_[3], x1_[0], x1_[1], x1_[2], x1_[3]}; } \
        else { _Pragma("unroll") for (int k = 0; k < 2; ++k) dst[m][k] = *(const LAS bf16x8*)(lds + G8_SA(b, h) + aoff + m * 2048 + k * 1024); } } } while (0)
#define G8_LDB(dst, b, h) do { _Pragma("unroll") for (int n = 0; n < 2; ++n) { if constexpr (F8) { const v4i_ x0_ = *(const LAS v4i_*)(lds + G8_SB(b, h) + boff + n * 2048), x1_ = *(const LAS v4i_*)(lds + G8_SB(b, h) + boff + n * 2048 + 1024); \
            dst##8[n] = (v8i_){x0_[0], x0_[1], x0_[2], x0_[3], x1_[0], x1_[1], x1_[2], x1_[3]}; } \
        else { _Pragma("unroll") for (int k = 0; k < 2; ++k) dst[n][k] = *(const LAS bf16x8*)(lds + G8_SB(b, h) + boff + n * 2048 + k * 1024); } } } while (0)
#define G8_MMA(ai, bj, At, Bt) do { __builtin_amdgcn_s_setprio(1); _Pragma("unroll") for (int m = 0; m < 4; ++m) _Pragma("unroll") for (int n = 0; n < 2; ++n) { \
        if constexpr (F8) asm volatile("v_mfma_scale_f32_16x16x128_f8f6f4 %0, %1, %2, %0, %3, %3 op_sel_hi:[0,0,0]" : "+v"(acc[ai][bj][m][n]) : "v"(Bt##8[n]), "v"(At##8[m]), "v"(sc8));   \
        else { _Pragma("unroll") for (int k = 0; k < 2; ++k) acc[ai][bj][m][n] = __builtin_amdgcn_mfma_f32_16x16x32_bf16(Bt[n][k], At[m][k], acc[ai][bj][m][n], 0, 0, 0); } } \
        __builtin_amdgcn_s_setprio(0); } while (0)
#define G8_WAIT_V(n) asm volatile("s_waitcnt vmcnt(" #n ")" ::: "memory")
#define G8_WAIT_L(n) asm volatile("s_waitcnt lgkmcnt(" #n ")" ::: "memory")
#define G8_BAR __builtin_amdgcn_s_barrier()
#define G8_SCHED __builtin_amdgcn_sched_barrier(0)
    Unit cur, nxt; int ui = 0;
    if (!P.next(0, cur)) return;
    f32x4 acc[2][2][4][2];
#pragma unroll
    for (int a = 0; a < 2; ++a)
#pragma unroll
        for (int b = 0; b < 2; ++b)
#pragma unroll
            for (int m = 0; m < 4; ++m)
#pragma unroll
                for (int n = 0; n < 2; ++n) acc[a][b][m][n] = (f32x4){0.f, 0.f, 0.f, 0.f};
    int sc8 = 0x7f7f7f7f; asm volatile("" : "+v"(sc8));
    bf16x8 At[4][2], B0[2][2], B1[2][2]; v8i_ At8[4], B08[2], B18[2];
    AOff cA, nA;
    G8_AOFF(cur, cA);
    {   const char* b0 = P.bbase(cur, 0); const char* b1 = P.bbase(cur, 1);
        G8_STAGE_B(G8_SB(0, 0), b0); G8_STAGE_B(G8_SB(0, 1), b0 + hstepB); G8_STAGE_A(G8_SA(0, 0), 0, cA, 0u); G8_STAGE_A(G8_SA(0, 1), 1, cA, 0u);
        if (wr == 1) G8_BAR;
        G8_WAIT_V(2); G8_BAR;
        G8_STAGE_B(G8_SB(1, 0), b1); G8_STAGE_A(G8_SA(1, 0), 0, cA, 128u); G8_STAGE_B(G8_SB(1, 1), b1 + hstepB);
        G8_WAIT_V(6); G8_BAR; }
    for (;;) {
        const bool has_next = P.next(ui + 1, nxt);
        if (has_next) G8_AOFF(nxt, nA); else { nA = cA; nxt = cur; }
        for (int t = 0; t < nt; t += 2) {
            const bool last = (t == nt - 2);
            const unsigned kb1 = (unsigned)(t + 1) * 128u;
            const unsigned kb2 = last ? 0u : (unsigned)(t + 2) * 128u, kb3 = kb2 + 128u;
            const char* b2 = last ? P.bbase(nxt, 0) : P.bbase(cur, t + 2);
            const char* b3 = last ? P.bbase(nxt, 1) : P.bbase(cur, t + 3);
            G8_LDB(B0, 0, 0); G8_LDB(B1, 0, 1); G8_SCHED; G8_LDA(At, 0, 0); G8_STAGE_A(G8_SA(1, 1), 1, cA, kb1);
            G8_WAIT_V(8); G8_WAIT_L(0); G8_BAR; G8_MMA(0, 0, At, B0); G8_MMA(0, 1, At, B1); G8_BAR; G8_SCHED;
            G8_LDA(At, 0, 1); G8_STAGE_B(G8_SB(0, 0), b2); G8_STAGE_B(G8_SB(0, 1), b2 + hstepB); G8_STAGE_A2(G8_SA(0, 0), 0, kb2);
            G8_WAIT_V(8); G8_WAIT_L(0); G8_BAR; G8_MMA(1, 0, At, B0); G8_MMA(1, 1, At, B1); G8_BAR; G8_SCHED;
            G8_LDB(B0, 1, 0); G8_LDB(B1, 1, 1); G8_SCHED; G8_LDA(At, 1, 0); G8_STAGE_A2(G8_SA(0, 1), 1, kb2);
            G8_WAIT_V(8); G8_WAIT_L(0); G8_BAR; G8_MMA(0, 0, At, B0); G8_MMA(0, 1, At, B1); G8_BAR; G8_SCHED;
            G8_LDA(At, 1, 1); G8_STAGE_B(G8_SB(1, 0), b3); G8_STAGE_B(G8_SB(1, 1), b3 + hstepB); G8_STAGE_A2(G8_SA(1, 0), 0, kb3);
            G8_WAIT_V(8); G8_WAIT_L(0); G8_BAR; G8_MMA(1, 0, At, B0); G8_MMA(1, 1, At, B1); G8_BAR; G8_SCHED;
        }
        if (wr == 0) G8_BAR;
        if constexpr (F8) asm volatile("s_nop 15\n\ts_nop 15" ::: "memory");
        E(acc, cur, wr, wc, fr, fq);
        if (!has_next) break;
#pragma unroll
        for (int a = 0; a < 2; ++a)
#pragma unroll
            for (int b = 0; b < 2; ++b)
#pragma unroll
                for (int m = 0; m < 4; ++m)
#pragma unroll
                    for (int n = 0; n < 2; ++n) acc[a][b][m][n] = (f32x4){0.f, 0.f, 0.f, 0.f};
        cur = nxt; cA = nA; ++ui;
        if (wr == 1) G8_BAR;
    }
    G8_WAIT_V(0);
    G8_BAR;
#undef G8_SA
#undef G8_SB
#undef G8_STAGE_A
#undef G8_STAGE_A2
#undef G8_AOFF
#undef G8_STAGE_B
#undef G8_LDA
#undef G8_LDB
#undef G8_MMA
#undef G8_WAIT_V
#undef G8_WAIT_L
#undef G8_BAR
#undef G8_SCHED
}
}
using g8::Unit;


struct EpiQKV {
    const float* hpx; const float* cosA; const float* sinA; bf16_t* Q; bf16_t* Kk; bf16_t* V; float* kmean; unsigned char* Q8; unsigned char* K8; int pn0; float ascale;
    __device__ __forceinline__ void operator()(const f32x4 (&acc)[2][2][4][2], const Unit& u0, int wr, int wc, int fr, int fq) const {
        Unit u = u0; u.pn += pn0;
        const int t = u.pn >> 2;
        const int bb = u.pm >> 5;
        if (t < 2) {
            const int hh = 2 * (u.pn & 3) + (wc >> 1), j0 = 32 * (wc & 1) + 8 * fq;
            bf16_t* dst0 = (t == 0 ? Q : Kk) + ((size_t)(bb * NH + hh) * NS) * 128;
            f32x4 ks[2][2] = {{{0.f, 0.f, 0.f, 0.f}, {0.f, 0.f, 0.f, 0.f}}, {{0.f, 0.f, 0.f, 0.f}, {0.f, 0.f, 0.f, 0.f}}};
#pragma unroll
            for (int ai = 0; ai < 2; ++ai)
#pragma unroll
                for (int m = 0; m < 4; ++m) {
                    const int row = u.pm * 256 + 128 * ai + 64 * wr + 16 * m + fr, s = row & (NS - 1);
                    const float rs = row_rs<16>(hpx + (size_t)row * 16, 1.0f / 1024.0f) * ascale;
                    f32x4 o1[2], o2[2];
#pragma unroll
                    for (int n = 0; n < 2; ++n) {
                        const f32x4 cs = *(const f32x4*)(cosA + (size_t)s * 64 + j0 + 4 * n), sn = *(const f32x4*)(sinA + (size_t)s * 64 + j0 + 4 * n);
                        const f32x4 x1 = acc[ai][0][m][n] * rs, x2 = acc[ai][1][m][n] * rs;
                        o1[n] = x1 * cs - x2 * sn; o2[n] = x1 * sn + x2 * cs;
                        ks[0][n] += o1[n]; ks[1][n] += o2[n];
                    }
                    if (t == 0) { bf16_t* d = dst0 + (size_t)s * 128 + j0; *(u32x4*)d = pack8(o1[0], o1[1]); *(u32x4*)(d + 64) = pack8(o2[0], o2[1]); }
                    {   unsigned char* d8 = (t == 0 ? Q8 : K8) + ((size_t)(bb * NH + hh) * NS + s) * 128 + j0;
                        u32x2 w1, w2; w1.x = pack4_fp8(o1[0]); w1.y = pack4_fp8(o1[1]); w2.x = pack4_fp8(o2[0]); w2.y = pack4_fp8(o2[1]);
                        *(u32x2*)d8 = w1; *(u32x2*)(d8 + 64) = w2; }
                }
            if (t == 1) {
#pragma unroll
                for (int q = 0; q < 2; ++q)
#pragma unroll
                    for (int n = 0; n < 2; ++n)
#pragma unroll
                        for (int e = 0; e < 4; ++e) { float v = ks[q][n][e]; v += __shfl_xor(v, 1); v += __shfl_xor(v, 2); v += __shfl_xor(v, 4); v += __shfl_xor(v, 8); ks[q][n][e] = v; }
                if (fr == 0) {
                    float* km = kmean + ((size_t)(bb * NH + hh) * 32 + (u.pm & 31)) * 128 + j0;
#pragma unroll
                    for (int q = 0; q < 2; ++q)
#pragma unroll
                        for (int n = 0; n < 2; ++n)
#pragma unroll
                            for (int e = 0; e < 4; ++e) atomicAdd(km + 64 * q + 4 * n + e, ks[q][n][e]);
                }
            }
        } else {
            const int d0 = 32 * wc + 8 * fq;
#pragma unroll
            for (int ai = 0; ai < 2; ++ai)
#pragma unroll
                for (int m = 0; m < 4; ++m) {
                    const int row = u.pm * 256 + 128 * ai + 64 * wr + 16 * m + fr, s = row & (NS - 1);
                    const float rs = row_rs<16>(hpx + (size_t)row * 16, 1.0f / 1024.0f) * ascale;
#pragma unroll
                    for (int bj = 0; bj < 2; ++bj) {
                        const int hh = 2 * (u.pn - 8) + bj;
                        bf16_t* d = V + ((size_t)(bb * NH + hh) * NS + s) * 128 + d0;
                        *(u32x4*)d = pack8(acc[ai][bj][m][0] * rs, acc[ai][bj][m][1] * rs);
                    }
                }
        }
    }
};

__device__ __forceinline__ void unpack8(u32x4 w, f32x4& a, f32x4& b) {
#pragma unroll
    for (int e = 0; e < 2; ++e) { a[2 * e] = __builtin_bit_cast(float, w[e] << 16); a[2 * e + 1] = __builtin_bit_cast(float, w[e] & 0xffff0000u);
                                  b[2 * e] = __builtin_bit_cast(float, w[2 + e] << 16); b[2 * e + 1] = __builtin_bit_cast(float, w[2 + e] & 0xffff0000u); }
}
struct EpiResid {
    const bf16_t* base; bf16_t* hb; float* hp; float ascale;
    __device__ __forceinline__ void operator()(const f32x4 (&acc)[2][2][4][2], const Unit& u, int wr, int wc, int fr, int fq) const {
#pragma unroll
        for (int ai = 0; ai < 2; ++ai)
#pragma unroll
            for (int m = 0; m < 4; ++m) {
                const int row = u.pm * 256 + 128 * ai + 64 * wr + 16 * m + fr;
                float ss = 0.f;
#pragma unroll
                for (int bj = 0; bj < 2; ++bj) {
                    const size_t off = (size_t)row * 1024 + u.pn * 256 + 128 * bj + 32 * wc + 8 * fq;
                    f32x4 b0, b1; unpack8(*(const u32x4*)(base + off), b0, b1);
                    const f32x4 v0 = acc[ai][bj][m][0] * ascale + b0, v1 = acc[ai][bj][m][1] * ascale + b1;
                    *(u32x4*)(hb + off) = pack8(v0, v1);
                    ss += dot4(v0) + dot4(v1);
                }
                ss += __shfl_xor(ss, 16); ss += __shfl_xor(ss, 32);
                if (fq == 0) hp[(size_t)row * 16 + u.pn * 4 + wc] = ss;
                if (m & 1) asm volatile("" ::: "memory");
            }
    }
};
namespace at {
constexpr int KVBLK = 64, SHM_V = KVBLK * 128 * 2;
constexpr float THR = 8.f;
#define AT_SBAR() __builtin_amdgcn_sched_barrier(0)
__device__ __forceinline__ int v_st(int k, int c) { const int kk = (k & ~0xC) | ((k & 4) << 1) | ((k & 8) >> 1); return ((kk >> 3) * 4 + (c >> 5)) * 512 + ((kk & 7) * 32 + (c & 31)) * 2; }
__device__ __forceinline__ int v_rd_base(int lane) { return ((lane & 3) << 3) | (((lane >> 2) & 3) << 6) | (((lane >> 4) & 1) << 5) | (((lane >> 5) & 1) << 8); }
constexpr int v_rd_off(int d0, int ks, int half) { return d0 * 512 + ks * 4096 + half * 2048; }
__device__ __forceinline__ int crow(int r, int hi) { return (r & 3) + 8 * (r >> 2) + 4 * hi; }

template <int DQK> constexpr int krow() { return DQK == 192 ? 400 : DQK * 2; }
template <int DQK> __device__ __forceinline__ int kswz(int row, int colB) { return DQK == 192 ? row * 400 + colB : row * (DQK * 2) + (colB ^ ((row & 7) << 4)); }

__device__ __forceinline__ void mask_causal(f32x16& p0, f32x16& p1, int dq) {
    const float NEG = -__builtin_inff();
#pragma unroll
    for (int r = 0; r < 16; ++r) {
        const int c = (r & 3) + 8 * (r >> 2);
        if (dq - c < 0) p0[r] = NEG;
        if (dq - c - 32 < 0) p1[r] = NEG;
    }
}
__device__ __forceinline__ void mask_all(f32x16& p0, f32x16& p1, bool keep) {
    const float NEG = -__builtin_inff();
#pragma unroll
    for (int r = 0; r < 16; ++r) { p0[r] = keep ? p0[r] : NEG; p1[r] = keep ? p1[r] : NEG; }
}
__device__ __forceinline__ void partialSM(f32x16& p0, f32x16& p1, float& m_reg, float& mn, float& alpha, const float SC, const float C2) {
    float pmax = p0[0];
#pragma unroll
    for (int r = 1; r < 16; ++r) pmax = fmaxf(pmax, p0[r]);
#pragma unroll
    for (int r = 0; r < 16; ++r) pmax = fmaxf(pmax, p1[r]);
    { auto rr = __builtin_amdgcn_permlane32_swap(__float_as_uint(pmax), __float_as_uint(pmax), false, false);
      pmax = fmaxf(__uint_as_float(rr[0]), __uint_as_float(rr[1])); }
    if (__builtin_expect(__all((pmax - m_reg) * SC <= THR), 1)) { mn = m_reg; alpha = 1.f; }
    else { mn = fmaxf(m_reg, pmax); alpha = __builtin_amdgcn_exp2f((m_reg - mn) * C2); m_reg = mn; }
    const float mnL = -mn * C2;
#pragma unroll
    for (int r = 0; r < 16; ++r) p0[r] = fmaf(p0[r], C2, mnL);
#pragma unroll
    for (int r = 0; r < 16; ++r) p1[r] = fmaf(p1[r], C2, mnL);
#pragma unroll
    for (int r = 0; r < 16; ++r) p0[r] = __builtin_amdgcn_exp2f(p0[r]);
}
__device__ __forceinline__ void partialSM8(f32x16& p0, f32x16& p1, float& m_reg, float& mn, float& alpha, const float SC, const float C2) {
    float pmax = p0[0];
#pragma unroll
    for (int r = 1; r < 16; ++r) pmax = fmaxf(pmax, p0[r]);
#pragma unroll
    for (int r = 0; r < 16; ++r) pmax = fmaxf(pmax, p1[r]);
    { auto rr = __builtin_amdgcn_permlane32_swap(__float_as_uint(pmax), __float_as_uint(pmax), false, false);
      pmax = fmaxf(__uint_as_float(rr[0]), __uint_as_float(rr[1])); }
    if (__builtin_expect(__all((pmax - m_reg) * SC <= 4.0f), 1)) { mn = m_reg; alpha = 1.f; }
    else { mn = fmaxf(m_reg, pmax); alpha = __builtin_amdgcn_exp2f((m_reg - mn) * C2); m_reg = mn; }
    const float mnL = -mn * C2;
#pragma unroll
    for (int r = 0; r < 16; ++r) p0[r] = fmaf(p0[r], C2, mnL);
#pragma unroll
    for (int r = 0; r < 16; ++r) p1[r] = fmaf(p1[r], C2, mnL);
#pragma unroll
    for (int r = 0; r < 16; ++r) p0[r] = __builtin_amdgcn_exp2f(p0[r]);
}
__device__ __forceinline__ void finishSM(f32x16& p0, f32x16& p1, float alpha, float& l_reg, bf16x8& pa0, bf16x8& pa1, bf16x8& pa2, bf16x8& pa3) {
#pragma unroll
    for (int r = 0; r < 16; ++r) p1[r] = __builtin_amdgcn_exp2f(p1[r]);
    float ps = 0;
#pragma unroll
    for (int r = 0; r < 16; ++r) ps += p0[r];
#pragma unroll
    for (int r = 0; r < 16; ++r) ps += p1[r];
    { auto rr = __builtin_amdgcn_permlane32_swap(__float_as_uint(ps), __float_as_uint(ps), false, false);
      ps = __uint_as_float(rr[0]) + __uint_as_float(rr[1]); }
    l_reg = l_reg * alpha + ps;
#define AT_PK4(P, B_, OUT) do { unsigned a0 = cvtpk(P[B_+0], P[B_+1]), a1 = cvtpk(P[B_+2], P[B_+3]);                          \
        unsigned b0 = cvtpk(P[B_+4], P[B_+5]), b1 = cvtpk(P[B_+6], P[B_+7]);                                             \
        auto r0 = __builtin_amdgcn_permlane32_swap(a0, b0, false, false); auto r1 = __builtin_amdgcn_permlane32_swap(a1, b1, false, false); \
        u32x4 w = {r0[0], r1[0], r0[1], r1[1]}; OUT = __builtin_bit_cast(bf16x8, w); } while (0)
    AT_PK4(p0, 0, pa0); AT_PK4(p0, 8, pa1); AT_PK4(p1, 0, pa2); AT_PK4(p1, 8, pa3);
#undef AT_PK4
}
template <int DQK>
__device__ __forceinline__ void qkt(f32x16& p0, f32x16& p1, const char* Kt, int r32, int hi, const bf16x8* qr, bool act) {
    if (!act) { const float NEG = -__builtin_inff();
#pragma unroll
        for (int r = 0; r < 16; ++r) { p0[r] = NEG; p1[r] = NEG; } return; }
    p0 = f32x16{}; p1 = f32x16{};
    const char* kb[4];
#pragma unroll
    for (int dd = 0; dd < 4; ++dd) kb[dd] = Kt + kswz<DQK>(r32, (dd * 16 + hi * 8) * 2);
#pragma unroll
    for (int d0 = 0; d0 < DQK / 16; ++d0) { const char* a = kb[d0 & 3] + (d0 >> 2) * 128;
        bf16x8 b0 = *reinterpret_cast<const bf16x8*>(a);
        bf16x8 b1 = *reinterpret_cast<const bf16x8*>(a + 32 * krow<DQK>());
        p0 = __builtin_amdgcn_mfma_f32_32x32x16_bf16(b0, qr[d0], p0, 0, 0, 0);
        p1 = __builtin_amdgcn_mfma_f32_32x32x16_bf16(b1, qr[d0], p1, 0, 0, 0); }
}
template <int VB>
__device__ __forceinline__ void pv_tile(f32x16* o, int vb0, bf16x8 pa0, bf16x8 pa1, bf16x8 pa2, bf16x8 pa3, bool act) {
    if (!act) return;
#define AT_TRRD(dst, off) asm volatile("ds_read_b64_tr_b16 %0, %1 offset:%2" : "=&v"(dst) : "v"(vb0), "i"(off) : "memory")
#define AT_PV_RD(S, d0) do { constexpr int b_ = VB * SHM_V + v_rd_off(d0, 0, 0); \
        AT_TRRD(S[0], b_); AT_TRRD(S[1], b_ + 2048); AT_TRRD(S[2], b_ + 4096); AT_TRRD(S[3], b_ + 6144); AT_TRRD(S[4], b_ + 8192); AT_TRRD(S[5], b_ + 10240); AT_TRRD(S[6], b_ + 12288); AT_TRRD(S[7], b_ + 14336); } while (0)
#define AT_PV_MM(S, d0) do { \
        o[d0] = __builtin_amdgcn_mfma_f32_32x32x16_bf16((bf16x8){S[0][0], S[0][1], S[0][2], S[0][3], S[1][0], S[1][1], S[1][2], S[1][3]}, pa0, o[d0], 0, 0, 0);   \
        o[d0] = __builtin_amdgcn_mfma_f32_32x32x16_bf16((bf16x8){S[2][0], S[2][1], S[2][2], S[2][3], S[3][0], S[3][1], S[3][2], S[3][3]}, pa1, o[d0], 0, 0, 0);   \
        o[d0] = __builtin_amdgcn_mfma_f32_32x32x16_bf16((bf16x8){S[4][0], S[4][1], S[4][2], S[4][3], S[5][0], S[5][1], S[5][2], S[5][3]}, pa2, o[d0], 0, 0, 0);   \
        o[d0] = __builtin_amdgcn_mfma_f32_32x32x16_bf16((bf16x8){S[6][0], S[6][1], S[6][2], S[6][3], S[7][0], S[7][1], S[7][2], S[7][3]}, pa3, o[d0], 0, 0, 0); } while (0)
    s16x4 sa[8], sb[8];
    AT_PV_RD(sa, 0); AT_PV_RD(sb, 1);
    asm volatile("s_waitcnt lgkmcnt(8)" ::: "memory"); AT_SBAR(); AT_PV_MM(sa, 0); AT_SBAR();
    AT_PV_RD(sa, 2);
    asm volatile("s_waitcnt lgkmcnt(8)" ::: "memory"); AT_SBAR(); AT_PV_MM(sb, 1); AT_SBAR();
    AT_PV_RD(sb, 3);
    asm volatile("s_waitcnt lgkmcnt(8)" ::: "memory"); AT_SBAR(); AT_PV_MM(sa, 2); AT_SBAR();
    asm volatile("s_waitcnt lgkmcnt(0)" ::: "memory"); AT_SBAR(); AT_PV_MM(sb, 3);
#undef AT_PV_RD
#undef AT_PV_MM
#undef AT_TRRD
}

__device__ __forceinline__ void ochunk(const f32x16 (&o)[4], int d0, int j, f32x4& c0, f32x4& c1) {
#pragma unroll
    for (int e = 0; e < 4; ++e) { auto rr = __builtin_amdgcn_permlane32_swap(__float_as_uint(o[d0][8 * j + e]), __float_as_uint(o[d0][8 * j + 4 + e]), false, false);
        c0[e] = __uint_as_float(rr[0]); c1[e] = __uint_as_float(rr[1]); }
}
template <int DQK> struct Lds { static constexpr int SHM_K = KVBLK * DQK * 2, K_OFF = 2 * SHM_V, WS_OFF = K_OFF + 2 * SHM_K, BYTES = WS_OFF + NWAVES * 64 * 4, F_OFF = BYTES; };

constexpr int LCAP = 256 * 496;
__device__ __forceinline__ int loff(int n) { return 256 * (31 * n - (n * (n - 1)) / 2); }
struct SparseBufs { unsigned short* lists; unsigned* lcnt; unsigned* selinfo; float* ml; unsigned char* part01; unsigned char* part2; };

struct AttnP { const bf16_t* Qp; const bf16_t* Kn; const bf16_t* Kr; const bf16_t* Vp; bf16_t* Op; int P0, t0, NT, bh, nent; const unsigned short* ents; };

typedef int v8i_t __attribute__((ext_vector_type(8)));
typedef int v4i_t __attribute__((ext_vector_type(4)));
constexpr int K8ROW = 208, SHM_K8 = KVBLK * K8ROW;
constexpr int M8ROW = 144, SHM_M8 = KVBLK * M8ROW;
template <int NSTEP, int ROWB>
__device__ __forceinline__ void qkt8(f32x16& p0, f32x16& p1, const char* Kt, int r32, int hi, const v8i_t* qf) {
    p0 = f32x16{}; p1 = f32x16{};
    const char* kb = Kt + r32 * ROWB + 32 * hi;
#pragma unroll
    for (int s = 0; s < NSTEP; ++s) {
        const v4i_t a0 = *reinterpret_cast<const v4i_t*>(kb + 64 * s), a1 = *reinterpret_cast<const v4i_t*>(kb + 64 * s + 16);
        const v4i_t b0 = *reinterpret_cast<const v4i_t*>(kb + 32 * ROWB + 64 * s), b1 = *reinterpret_cast<const v4i_t*>(kb + 32 * ROWB + 64 * s + 16);
        const v8i_t k0 = {a0[0], a0[1], a0[2], a0[3], a1[0], a1[1], a1[2], a1[3]}, k1 = {b0[0], b0[1], b0[2], b0[3], b1[0], b1[1], b1[2], b1[3]};
        p0 = __builtin_amdgcn_mfma_scale_f32_32x32x64_f8f6f4(k0, qf[s], p0, 0, 0, 0, 0x7f7f7f7f, 0, 0x7f7f7f7f);
        p1 = __builtin_amdgcn_mfma_scale_f32_32x32x64_f8f6f4(k1, qf[s], p1, 0, 0, 0, 0x7f7f7f7f, 0, 0x7f7f7f7f);
    }
}
__device__ __forceinline__ void finishSM8(f32x16& p0, f32x16& p1, float alpha, float& l_reg, v8i_t& pf) {
#pragma unroll
    for (int r = 0; r < 16; ++r) p1[r] = __builtin_amdgcn_exp2f(p1[r]);
    float ps = 0;
#pragma unroll
    for (int r = 0; r < 16; ++r) ps += p0[r];
#pragma unroll
    for (int r = 0; r < 16; ++r) ps += p1[r];
    { auto rr = __builtin_amdgcn_permlane32_swap(__float_as_uint(ps), __float_as_uint(ps), false, false);
      ps = __uint_as_float(rr[0]) + __uint_as_float(rr[1]); }
    l_reg = l_reg * alpha + ps;
#pragma unroll
    for (int g = 0; g < 4; ++g) {
        const unsigned a = pack4_fp8((f32x4){p0[4 * g], p0[4 * g + 1], p0[4 * g + 2], p0[4 * g + 3]}), b = pack4_fp8((f32x4){p1[4 * g], p1[4 * g + 1], p1[4 * g + 2], p1[4 * g + 3]});
        auto rr = __builtin_amdgcn_permlane32_swap(a, b, false, false);
        pf[2 * g] = (int)rr[0]; pf[2 * g + 1] = (int)rr[1]; }
}
constexpr int V8ROW = 80, SHM_V8 = 128 * V8ROW;
__device__ __forceinline__ void pv8(f32x16* o, const char* Vt, int r32, int hi, const v8i_t& pf) {
    const char* vb = Vt + r32 * V8ROW + 32 * hi;
#pragma unroll
    for (int d0 = 0; d0 < 4; ++d0) {
        const v4i_t a0 = *reinterpret_cast<const v4i_t*>(vb + d0 * 32 * V8ROW), a1 = *reinterpret_cast<const v4i_t*>(vb + d0 * 32 * V8ROW + 16);
        const v8i_t vf = {a0[0], a0[1], a0[2], a0[3], a1[0], a1[1], a1[2], a1[3]};
        o[d0] = __builtin_amdgcn_mfma_scale_f32_32x32x64_f8f6f4(vf, pf, o[d0], 0, 0, 0, 0x7f7f7f7f, 0, 0x7f7f7f7f);
    }
}
template <int DQK, int MODE>
__device__ __forceinline__ void attn_unit(char* lds, const AttnP& A, const SparseBufs& SB) {
    constexpr int K_OFF = 3 * SHM_V8;
    constexpr float SC = 0.07216878364870323f;
    constexpr float C2 = 1.4426950408889634f * SC;
    (void)SB;
    int tid = threadIdx.x; asm volatile("" : "+v"(tid));
    const int wid = __builtin_amdgcn_readfirstlane(tid >> 6), lane = tid & 63, r32 = lane & 31, hi = lane >> 5;
    const int NT = A.NT, P0 = A.P0;
    const int qlo = P0 + wid * 32, qm = qlo + r32 - 4 * hi;
    char* V_lds = lds; char* K_lds = lds + K_OFF;
    float m_reg = -1e30f, l_reg = 0; f32x16 o[4] = {};
    const int vr_ = tid >> 2, vc_ = (tid & 3) * 16, vws = vr_ * V8ROW + vc_;
    const int kr_ = tid >> 3, kc_ = (tid & 7) * 16, kws = kr_ * K8ROW + kc_;
    const int rr_ = (tid & 255) >> 2, rc_ = (tid & 3) * 16, kws_r = rr_ * K8ROW + 128 + rc_;
    const bool do_r = tid < 256;
    v8i_t qf[3];
    {   const unsigned qo = (unsigned)((wid * 32 + r32) * 192 + 32 * hi);
#pragma unroll
        for (int s = 0; s < 3; ++s) { const v4i_t x0 = *(const v4i_t*)((const char*)A.Qp + qo + 64 * s), x1 = *(const v4i_t*)((const char*)A.Qp + qo + 64 * s + 16);
            qf[s] = (v8i_t){x0[0], x0[1], x0[2], x0[3], x1[0], x1[1], x1[2], x1[3]}; } }
    v4i_t st_v0, st_k0, st_k2;
    const unsigned lo_v = (unsigned)(vr_ * NS + vc_), lo_k = (unsigned)(kr_ * 128 + kc_), lo_r = (unsigned)(rr_ * 64 + rc_);
#define AT_VMW() asm volatile("s_waitcnt vmcnt(0)" ::: "memory")
    const __amdgpu_buffer_rsrc_t rsV = __builtin_amdgcn_make_buffer_rsrc((void*)A.Vp, 0, NS * 128, 0x00020000), rsK = __builtin_amdgcn_make_buffer_rsrc((void*)A.Kn, 0, NS * 128, 0x00020000);
    const __amdgpu_buffer_rsrc_t rsR = __builtin_amdgcn_make_buffer_rsrc((void*)A.Kr, 0, NS * 64, 0x00020000);
#define AT_BL(rs, vo, so) __builtin_bit_cast(bf16x8, __builtin_amdgcn_raw_buffer_load_b128(rs, (int)(vo), (int)(so), 0))
#define AT_BLI(rs, vo, so) __builtin_bit_cast(v4i_t, __builtin_amdgcn_raw_buffer_load_b128(rs, (int)(vo), (int)(so), 0))
#define AT_SLOAD(k0) do { st_v0 = AT_BLI(rsV, lo_v, (k0)); \
                          st_k0 = AT_BLI(rsK, lo_k, (k0) * 128); if (do_r) st_k2 = AT_BLI(rsR, lo_r, (k0) * 64); } while (0)
#define AT_SWRITE(bf) do { char* vd_ = V_lds + (bf) * SHM_V8; char* kd_ = K_lds + (bf) * SHM_K8; \
                           *(v4i_t*)(vd_ + vws) = st_v0; \
                           *(v4i_t*)(kd_ + kws) = st_k0; if (do_r) *(v4i_t*)(kd_ + kws_r) = st_k2; } while (0)
#define AT_RESC(a) do { if (__any((a) < 1.f)) { _Pragma("unroll") for (int d_ = 0; d_ < 4; ++d_) o[d_] *= (a); } } while (0)
#define AT_KBASE(t) ((t) * KVBLK)
#define AT_MASKT(P0_, P1_, t) do { const int kb_ = AT_KBASE(t); if (kb_ + KVBLK - 1 > qlo) mask_causal(P0_, P1_, qm - kb_); } while (0)
    f32x16 pA0, pA1, pB0, pB1; float mnA, mnB, alA, alB; v8i_t pf;
    AT_SLOAD(AT_KBASE(0)); AT_VMW(); AT_SWRITE(0);
    AT_SLOAD(AT_KBASE(1)); AT_VMW(); AT_SWRITE(1);
    AT_SLOAD(AT_KBASE(2));
    __syncthreads();
    AT_SBAR(); qkt8<3, K8ROW>(pA0, pA1, K_lds, r32, hi, qf);
    AT_MASKT(pA0, pA1, 0); partialSM8(pA0, pA1, m_reg, mnA, alA, SC, C2);
#define AT_STEP(PX0, PX1, mnX, alX, PY0, PY1, alY, t, bc, bp, bn) do {                                                           \
        if ((t) + 1 < NT) { AT_VMW(); AT_SWRITE(bn); if ((t) + 2 < NT) AT_SLOAD(AT_KBASE((t) + 2)); }                            \
        finishSM8(PY0, PY1, alY, l_reg, pf); AT_SBAR();                                                           \
        qkt8<3, K8ROW>(PX0, PX1, K_lds + (bc) * SHM_K8, r32, hi, qf); AT_SBAR();                                                           \
        pv8(o, V_lds + (bp) * SHM_V8, r32, hi, pf); AT_MASKT(PX0, PX1, (t)); partialSM8(PX0, PX1, m_reg, mnX, alX, SC, C2); \
        AT_RESC(alX); __syncthreads(); } while (0)
    int bc = 1, bp = 0, bn = 2;
    for (int t = 1; t + 1 < NT; t += 2) {
        AT_STEP(pB0, pB1, mnB, alB, pA0, pA1, alA, t, bc, bp, bn);
        { const int x = bp; bp = bc; bc = bn; bn = x; }
        AT_STEP(pA0, pA1, mnA, alA, pB0, pB1, alB, t + 1, bc, bp, bn);
        { const int x = bp; bp = bc; bc = bn; bn = x; }
    }
    AT_SBAR(); qkt8<3, K8ROW>(pB0, pB1, K_lds + bc * SHM_K8, r32, hi, qf); AT_SBAR();
    finishSM8(pA0, pA1, alA, l_reg, pf); AT_SBAR();
    pv8(o, V_lds + bp * SHM_V8, r32, hi, pf);
    AT_MASKT(pB0, pB1, NT - 1); partialSM8(pB0, pB1, m_reg, mnB, alB, SC, C2); AT_RESC(alB);
    finishSM8(pB0, pB1, alB, l_reg, pf); AT_SBAR(); pv8(o, V_lds + bc * SHM_V8, r32, hi, pf);
    {
        const float il = __builtin_amdgcn_rcpf(l_reg) * 16.0f;
        unsigned lofs = (unsigned)((wid * 32 + r32) * 1024 + 8 * hi);
        asm volatile("" : "+v"(lofs));
#pragma unroll
        for (int d0 = 0; d0 < 4; ++d0)
#pragma unroll
            for (int j = 0; j < 2; ++j) { f32x4 c0, c1; ochunk(o, d0, j, c0, c1); u32x2 w8; w8.x = pack4_fp8(c0 * il); w8.y = pack4_fp8(c1 * il);
                *(u32x2*)((char*)A.Op + (size_t)(32 * d0 + 16 * j) + lofs) = w8; }
    }
    __syncthreads();
#undef AT_VMW
#undef AT_SLOAD
#undef AT_BL
#undef AT_BLI
#undef AT_SWRITE
#undef AT_RESC
#undef AT_KBASE
#undef AT_MASKT
#undef AT_STEP
}

constexpr int RES_WS = 132096, RES_F = 134144;
__device__ __forceinline__ void moba_stage_kv(char* lds, const bf16_t* K8h  , const bf16_t* Vp, int n) {
    int tid = threadIdx.x; asm volatile("" : "+v"(tid));
    const int sr = tid >> 4, sc = (tid & 15) * 8, vst0 = v_st(sr, sc), vst1 = v_st(32 + sr, sc);
    const int kr_ = tid >> 3, kc_ = (tid & 7) * 16, kws = kr_ * M8ROW + kc_;
    const unsigned lo_a = (unsigned)((sr * 128 + sc) * 2), lo_k = (unsigned)(kr_ * 128 + kc_);
    const __amdgpu_buffer_rsrc_t rsV = __builtin_amdgcn_make_buffer_rsrc((void*)Vp, 0, NS * 256, 0x00020000), rsK = __builtin_amdgcn_make_buffer_rsrc((void*)K8h, 0, NS * 128, 0x00020000);
    bf16x8 kv[4][3];
#pragma unroll
    for (int t = 0; t < 4; ++t) { const int so = (4 * n + t) * 64 * 256;
        kv[t][0] = __builtin_bit_cast(bf16x8, __builtin_amdgcn_raw_buffer_load_b128(rsV, (int)lo_a, so, 0)); kv[t][1] = __builtin_bit_cast(bf16x8, __builtin_amdgcn_raw_buffer_load_b128(rsV, (int)lo_a, so + 8192, 0));
        kv[t][2] = __builtin_bit_cast(bf16x8, __builtin_amdgcn_raw_buffer_load_b128(rsK, (int)lo_k, (4 * n + t) * 64 * 128, 0)); }
#pragma unroll
    for (int t = 0; t < 4; ++t) {
        *(bf16x8*)(lds + t * SHM_V + vst0) = kv[t][0]; *(bf16x8*)(lds + t * SHM_V + vst1) = kv[t][1];
        *(bf16x8*)(lds + 65536 + t * SHM_M8 + kws) = kv[t][2]; }
    __syncthreads();
}
template <int MODE>
__device__ __forceinline__ void moba_rows(char* lds, const bf16_t* Qh  , bf16_t* Op  , int bh, const unsigned short* ents, int nvalid  , int qrow0  , int kb0, const SparseBufs& SB, int wid, int lane) {
    constexpr float SC = 0.08838834764831845f, C2 = 1.4426950408889634f * SC;
    const int r32 = lane & 31, hi = lane >> 5;
    char* V_lds = lds; char* K_lds = lds + 65536;
    float* ws = (float*)(lds + RES_WS) + wid * 64; float* li_l = ws, * al_l = ws + 32;
    const int vb0 = (int)(uintptr_t)V_lds + v_rd_base(lane);
    int ent = -1, srow;
    if (MODE == 2) { const bool valid = r32 < nvalid; const int e = (int)ents[valid ? r32 : 0]; ent = valid ? e : -1; srow = e & 8191; } else srow = qrow0 + r32;
    v8i_t qf[2];
    {   const __amdgpu_buffer_rsrc_t rsQ = __builtin_amdgcn_make_buffer_rsrc((void*)Qh, 0, NS * 128, 0x00020000);
        const unsigned qo = (unsigned)(srow * 128 + hi * 32);
#pragma unroll
        for (int s = 0; s < 2; ++s) { const v4i_t x0 = __builtin_bit_cast(v4i_t, __builtin_amdgcn_raw_buffer_load_b128(rsQ, (int)(qo + 64 * s), 0, 0)), x1 = __builtin_bit_cast(v4i_t, __builtin_amdgcn_raw_buffer_load_b128(rsQ, (int)(qo + 64 * s + 16), 0, 0));
            qf[s] = (v8i_t){x0[0], x0[1], x0[2], x0[3], x1[0], x1[1], x1[2], x1[3]}; } }
    float m_reg = -1e30f, l_reg = 0; f32x16 o[4] = {};
    const int qlo = qrow0, qm = qrow0 + r32 - 4 * hi;
#define MR_ACT(t) (MODE == 2 ? true : (kb0 + (t) * 64 <= qlo + 31))
#define MR_QKT(P0_, P1_, t) do { if (MR_ACT(t)) qkt8<2, M8ROW>(P0_, P1_, K_lds + (t) * SHM_M8, r32, hi, qf); else { const float NEG_ = -__builtin_inff(); _Pragma("unroll") for (int r_ = 0; r_ < 16; ++r_) { P0_[r_] = NEG_; P1_[r_] = NEG_; } } } while (0)
#define MR_MASK(P0_, P1_, t) do { if (MODE == 3) { const int kb_ = kb0 + (t) * 64; if (kb_ + 63 > qlo && kb_ <= qlo + 31) mask_causal(P0_, P1_, qm - kb_); } } while (0)
#define MR_RESC(a) do { if (__any((a) < 1.f)) { _Pragma("unroll") for (int d_ = 0; d_ < 4; ++d_) o[d_] *= (a); } } while (0)
    f32x16 pA0, pA1, pB0, pB1; float mnA, mnB, alA, alB; bf16x8 pa0, pa1, pa2, pa3;
    MR_QKT(pA0, pA1, 0); MR_MASK(pA0, pA1, 0); partialSM(pA0, pA1, m_reg, mnA, alA, SC, C2);
    AT_SBAR(); MR_QKT(pB0, pB1, 1); finishSM(pA0, pA1, alA, l_reg, pa0, pa1, pa2, pa3); AT_SBAR();
    pv_tile<0>(o, vb0, pa0, pa1, pa2, pa3, MR_ACT(0)); MR_MASK(pB0, pB1, 1); partialSM(pB0, pB1, m_reg, mnB, alB, SC, C2); MR_RESC(alB);
    AT_SBAR(); MR_QKT(pA0, pA1, 2); finishSM(pB0, pB1, alB, l_reg, pa0, pa1, pa2, pa3); AT_SBAR();
    pv_tile<1>(o, vb0, pa0, pa1, pa2, pa3, MR_ACT(1)); MR_MASK(pA0, pA1, 2); partialSM(pA0, pA1, m_reg, mnA, alA, SC, C2); MR_RESC(alA);
    AT_SBAR(); MR_QKT(pB0, pB1, 3); finishSM(pA0, pA1, alA, l_reg, pa0, pa1, pa2, pa3); AT_SBAR();
    pv_tile<2>(o, vb0, pa0, pa1, pa2, pa3, MR_ACT(2)); MR_MASK(pB0, pB1, 3); partialSM(pB0, pB1, m_reg, mnB, alB, SC, C2); MR_RESC(alB);
    finishSM(pB0, pB1, alB, l_reg, pa0, pa1, pa2, pa3); AT_SBAR(); pv_tile<3>(o, vb0, pa0, pa1, pa2, pa3, MR_ACT(3));
#undef MR_ACT
#undef MR_QKT
#undef MR_MASK
#undef MR_RESC
    if (MODE == 2) {
        if (hi == 0 && ent >= 0) { f32x2_t mlv = {m_reg, l_reg}; *(f32x2_t*)(SB.ml + ((size_t)(ent >> 13) * (NB * NH * NS) + (size_t)bh * NS + srow) * 2) = mlv; }
        const float il = __builtin_amdgcn_rcpf(l_reg) * 16.0f;
        const int slot = ent >> 13;
        unsigned char* pb = SB.part01 + (size_t)slot * ((size_t)NB * NH * NS * 128);
        unsigned po = (unsigned)((bh * NS + srow) * 128 + 8 * hi); asm volatile("" : "+v"(po));
#pragma unroll
        for (int d0 = 0; d0 < 4; ++d0)
#pragma unroll
            for (int j = 0; j < 2; ++j) { f32x4 c0, c1; ochunk(o, d0, j, c0, c1); c0 *= il; c1 *= il;
                u32x2 w; int t0 = __builtin_amdgcn_cvt_pk_fp8_f32(c0[0], c0[1], 0, false); t0 = __builtin_amdgcn_cvt_pk_fp8_f32(c0[2], c0[3], t0, true);
                int t1 = __builtin_amdgcn_cvt_pk_fp8_f32(c1[0], c1[1], 0, false); t1 = __builtin_amdgcn_cvt_pk_fp8_f32(c1[2], c1[3], t1, true);
                w.x = (unsigned)t0; w.y = (unsigned)t1;
                if (ent >= 0) *(u32x2*)(pb + po + 32 * d0 + 16 * j) = w; }
    } else {
        const int s = qrow0 + r32; const unsigned si = SB.selinfo[(size_t)bh * NS + s];
        float mk[3], lk[3]; float M = m_reg;
#pragma unroll
        for (int k = 0; k < 3; ++k) { const bool v = ((si >> (8 * k)) & 255u) < 32u; mk[k] = -1e30f; lk[k] = 0.f;
            if (v) { const f32x2_t t = *(const f32x2_t*)(SB.ml + ((size_t)k * (NB * NH * NS) + (size_t)bh * NS + s) * 2); mk[k] = t[0]; lk[k] = t[1]; }
            M = fmaxf(M, mk[k]); }
        const float w_own = __builtin_amdgcn_exp2f((m_reg - M) * C2);
        float den = w_own * l_reg, wk[3];
#pragma unroll
        for (int k = 0; k < 3; ++k) { wk[k] = lk[k] * __builtin_amdgcn_exp2f((mk[k] - M) * C2); den += wk[k]; }
        const float inv = __builtin_amdgcn_rcpf(den), f_own = w_own * inv;
#pragma unroll
        for (int k = 0; k < 3; ++k) wk[k] *= inv;
        unsigned po = (unsigned)((bh * NS + s) * 128 + 8 * hi); asm volatile("" : "+v"(po));
        const int b = bh >> 3, h = bh & 7;
        char* orow = (char*)Op + ((size_t)(b * NS + s) * 1024 + h * 128 + 8 * hi);
        u32x2 pw[3][8];
#pragma unroll
        for (int k = 0; k < 3; ++k) { const unsigned char* pb = SB.part01 + (size_t)k * ((size_t)NB * NH * NS * 128);
#pragma unroll
            for (int c = 0; c < 8; ++c) pw[k][c] = *(const u32x2*)(pb + po + c * 16); }
#pragma unroll
        for (int k = 0; k < 3; ++k) wk[k] *= (1.0f / 16.0f);
#pragma unroll
        for (int d0 = 0; d0 < 4; ++d0)
#pragma unroll
            for (int j = 0; j < 2; ++j) { f32x4 c0, c1; ochunk(o, d0, j, c0, c1); c0 *= f_own; c1 *= f_own;
#pragma unroll
                for (int k = 0; k < 3; ++k) { const bool use = wk[k] != 0.f;
                    const int w0 = use ? (int)pw[k][2 * d0 + j].x : 0, w1 = use ? (int)pw[k][2 * d0 + j].y : 0;
                    const f32x2_t a0 = __builtin_amdgcn_cvt_pk_f32_fp8(w0, false), a1 = __builtin_amdgcn_cvt_pk_f32_fp8(w0, true), a2 = __builtin_amdgcn_cvt_pk_f32_fp8(w1, false), a3 = __builtin_amdgcn_cvt_pk_f32_fp8(w1, true);
                    c0[0] += a0[0] * wk[k]; c0[1] += a0[1] * wk[k]; c0[2] += a1[0] * wk[k]; c0[3] += a1[1] * wk[k];
                    c1[0] += a2[0] * wk[k]; c1[1] += a2[1] * wk[k]; c1[2] += a3[0] * wk[k]; c1[3] += a3[1] * wk[k]; }
                u32x2 w8; w8.x = pack4_fp8(c0 * 16.0f); w8.y = pack4_fp8(c1 * 16.0f); *(u32x2*)(orow + (32 * d0 + 16 * j)) = w8; }
    }
}
__device__ __forceinline__ void moba_own_unit(char* lds, const bf16_t* Qh, const bf16_t* Kn, const bf16_t* Vp, bf16_t* O, int bh, int qb, const SparseBufs& SB) {
    int tid = threadIdx.x; asm volatile("" : "+v"(tid));
    const int wid = __builtin_amdgcn_readfirstlane(tid >> 6), lane = tid & 63;
    moba_stage_kv(lds, Kn, Vp, qb);
    moba_rows<3>(lds, Qh, O, bh, nullptr, 0, qb * 256 + wid * 32, qb * 256, SB, wid, lane);
    __syncthreads();
}
__device__ __forceinline__ void moba_gather_unit(char* lds, const bf16_t* Qh, const bf16_t* Kn, const bf16_t* Vp, int bh, int n, const unsigned short* ents, int nrows, const SparseBufs& SB) {
    int tid = threadIdx.x; asm volatile("" : "+v"(tid));
    const int wid = __builtin_amdgcn_readfirstlane(tid >> 6), lane = tid & 63;
    moba_stage_kv(lds, Kn, Vp, n);
    const int ng = (nrows + 31) >> 5;
    for (int g = wid; g < ng; g += NWAVES) { const int nv = nrows - 32 * g; moba_rows<2>(lds, Qh, nullptr, bh, ents + 32 * g, nv < 32 ? nv : 32, 0, 0, SB, wid, lane); }
    __syncthreads();
}

__device__ __forceinline__ void gate_unit(char* lds, const bf16_t* Qp  , const float* kms, int bh, int qb, const SparseBufs& SB) {
    typedef Lds<128> L; constexpr int SHM_K = L::SHM_K;
    int tid = threadIdx.x; asm volatile("" : "+v"(tid));
    const int wid = __builtin_amdgcn_readfirstlane(tid >> 6), lane = tid & 63, r32 = lane & 31, hi = lane >> 5;
    char* K_lds = lds + L::K_OFF;
    int* hist = (int*)(lds + L::WS_OFF); int* base = hist + 32;
    const int sr = tid >> 4, sc = (tid & 15) * 8, kws = kswz<128>(sr, sc * 2);
    bf16x8 qr[8];
    {   const unsigned qo = (unsigned)(((wid * 32 + r32) * 128 + hi * 8) * 2);
#pragma unroll
        for (int d0 = 0; d0 < 8; ++d0) qr[d0] = *(const bf16x8*)((const char*)Qp + qo + d0 * 32); }
    {   unsigned ko = (unsigned)((sr * 128 + sc) * 4); asm volatile("" : "+v"(ko));
        const f32x4 a = *(const f32x4*)((const char*)kms + ko) * (1.0f / 256.0f), b = *(const f32x4*)((const char*)kms + ko + 16) * (1.0f / 256.0f);
        const u32x4 h8 = pack8(a, b);
        f32x4 ha, hb_; unpack8(h8, ha, hb_);
        const u32x4 l8 = pack8(a - ha, b - hb_);
        *(u32x4*)(K_lds + kws) = h8; *(u32x4*)(K_lds + SHM_K + kws) = l8; }
    if (tid < 64) hist[tid] = 0;
    __syncthreads();
    f32x16 g = f32x16{};
    {   const char* kb[4];
#pragma unroll
        for (int dd = 0; dd < 4; ++dd) kb[dd] = K_lds + kswz<128>(r32, (dd * 16 + hi * 8) * 2);
#pragma unroll
        for (int d0 = 0; d0 < 8; ++d0) { const char* a = kb[d0 & 3] + (d0 >> 2) * 128;
            g = __builtin_amdgcn_mfma_f32_32x32x16_bf16(*reinterpret_cast<const bf16x8*>(a), qr[d0], g, 0, 0, 0);
            g = __builtin_amdgcn_mfma_f32_32x32x16_bf16(*reinterpret_cast<const bf16x8*>(a + SHM_K), qr[d0], g, 0, 0, 0); } }
    const float NINF = -__builtin_inff();
    float v1 = NINF, v2 = NINF, v3 = NINF; int i1 = 64, i2 = 65, i3 = 66;
    const int ownl = qb - 4 * hi;
#pragma unroll
    for (int r = 0; r < 16; ++r) {
        const int idx = (r & 3) + 8 * (r >> 2); const float val = (idx < ownl) ? g[r] : NINF;
        const bool c1 = val > v1, c2 = val > v2, c3 = val > v3;
        v3 = c2 ? v2 : (c3 ? val : v3); i3 = c2 ? i2 : (c3 ? idx : i3);
        v2 = c1 ? v1 : (c2 ? val : v2); i2 = c1 ? i1 : (c2 ? idx : i2);
        v1 = c1 ? val : v1;             i1 = c1 ? idx : i1;
    }
    i1 += 4 * hi; i2 += 4 * hi; i3 += 4 * hi;
    float pv_[3]; int pi_[3];
    pv_[0] = __shfl_xor(v1, 32); pv_[1] = __shfl_xor(v2, 32); pv_[2] = __shfl_xor(v3, 32);
    pi_[0] = __shfl_xor(i1, 32); pi_[1] = __shfl_xor(i2, 32); pi_[2] = __shfl_xor(i3, 32);
#pragma unroll
    for (int c = 0; c < 3; ++c) {
        const float val = pv_[c]; const int idx = pi_[c];
        const bool c1 = (val > v1) || (val == v1 && idx < i1), c2 = (val > v2) || (val == v2 && idx < i2), c3 = (val > v3) || (val == v3 && idx < i3);
        v3 = c2 ? v2 : (c3 ? val : v3); i3 = c2 ? i2 : (c3 ? idx : i3);
        v2 = c1 ? v1 : (c2 ? val : v2); i2 = c1 ? i1 : (c2 ? idx : i2);
        v1 = c1 ? val : v1;             i1 = c1 ? idx : i1;
    }
    const int s = qb * 256 + wid * 32 + r32;
    int rk1 = 0, rk2 = 0, rk3 = 0;
    if (hi == 0) {
        SB.selinfo[(size_t)bh * NS + s] = (unsigned)(i1 < 32 ? i1 : 255) | ((unsigned)(i2 < 32 ? i2 : 255) << 8) | ((unsigned)(i3 < 32 ? i3 : 255) << 16);
        if (i1 < 32) rk1 = __hip_atomic_fetch_add(hist + i1, 1, __ATOMIC_RELAXED, __HIP_MEMORY_SCOPE_WORKGROUP);
        if (i2 < 32) rk2 = __hip_atomic_fetch_add(hist + i2, 1, __ATOMIC_RELAXED, __HIP_MEMORY_SCOPE_WORKGROUP);
        if (i3 < 32) rk3 = __hip_atomic_fetch_add(hist + i3, 1, __ATOMIC_RELAXED, __HIP_MEMORY_SCOPE_WORKGROUP);
    }
    __syncthreads();
    if (tid < 32) { const int c = hist[tid]; base[tid] = c > 0 ? (int)__hip_atomic_fetch_add(SB.lcnt + bh * 32 + tid, (unsigned)c, __ATOMIC_RELAXED, __HIP_MEMORY_SCOPE_AGENT) : 0; }
    __syncthreads();
    if (hi == 0) {
        unsigned short* lb = SB.lists + (size_t)bh * LCAP;
        if (i1 < 32) lb[loff(i1) + base[i1] + rk1] = (unsigned short)(s | (0 << 13));
        if (i2 < 32) lb[loff(i2) + base[i2] + rk2] = (unsigned short)(s | (1 << 13));
        if (i3 < 32) lb[loff(i3) + base[i3] + rk3] = (unsigned short)(s | (2 << 13));
    }
    __syncthreads();
}
}
__device__ __forceinline__ int pair_lo(int p) { return p < 3 ? 0 : (p < 5 ? 1 : 2); }
__device__ __forceinline__ int pair_hi(int p) { return p < 3 ? p + 1 : (p < 5 ? p - 1 : 3); }
constexpr int LDS_TB = LDS_MISC + 64;

__device__ __forceinline__ void p_route(const Args& a, LAS unsigned char* lds, int layer, const bf16_t* h, int vcu, int G) {
    int tid = threadIdx.x; asm volatile("" : "+v"(tid));
    const int lane = tid & 63, wave = __builtin_amdgcn_readfirstlane(tid >> 6), i32 = lane & 31, kk = lane >> 5;
    unsigned char* ws = a.ws;
    constexpr int WROW = 2064, WTERM = 20 * WROW, XCH_OFF = 3 * WTERM + 64;
    {   const float* wrt = (const float*)(ws + WS_WRT) + (size_t)layer * 20480;
        for (int i = tid; i < 20480; i += NTHR) { const int k = i / 20, c = i % 20; const float w = wrt[i];
            const unsigned short b0 = (unsigned short)(cvtpk(w, 0.f) & 0xffffu); const float r1 = w - bf2f(b0);
            const unsigned short b1 = (unsigned short)(cvtpk(r1, 0.f) & 0xffffu); const float r2 = r1 - bf2f(b1);
            const unsigned short b2 = (unsigned short)(cvtpk(r2, 0.f) & 0xffffu);
            LAS unsigned short* d = (LAS unsigned short*)(lds + c * WROW) + k;
            d[0] = b0; *(LAS unsigned short*)((LAS unsigned char*)d + WTERM) = b1; *(LAS unsigned short*)((LAS unsigned char*)d + 2 * WTERM) = b2; } }
    __syncthreads();
    float* tokw = (float*)(ws + WS_TOKW); int* list = (int*)(ws + WS_LIST);
    unsigned* cnt = (unsigned*)(ws + WS_CTL) + CW_CNT + layer * 24 * 16;
    const int lrow = i32 < 4 ? i32 : (i32 < 8 ? 12 + i32 : ((i32 & 4) ? -1 : ((i32 >> 3) == 1 ? i32 - 4 : ((i32 >> 3) == 2 ? i32 - 8 : i32 - 12))));
    const LAS unsigned char* wrow = lds + (lrow < 0 ? 0 : lrow) * WROW + 16 * kk;
    const bool wz = lrow < 0;
    const int half = wave & 1, pr = wave >> 1;
    LAS float* xch = (LAS float*)(lds + XCH_OFF) + (pr * 64 + lane) * 17;
    for (int tb = vcu * 4; tb < NT / 32; tb += G * 4) {
        const int task = tb + pr; const bool live = task < NT / 32;
        const int t = (live ? task : 0) * 32 + i32;
        const bf16_t* hrow = h + (size_t)t * 1024 + 512 * half + 8 * kk;
        const LAS unsigned char* wr2 = wrow + 1024 * half;
        f32x16 c = f32x16{}; float ssp = 0.f;
#pragma unroll 8
        for (int it = 0; it < 32; ++it) {
            const u32x4 hw = *(const u32x4*)(hrow + 16 * it);
            f32x4 h0, h1; unpack8(hw, h0, h1); ssp += dot4(h0) + dot4(h1);
            const bf16x8 hf = __builtin_bit_cast(bf16x8, hw);
#pragma unroll
            for (int term = 0; term < 3; ++term) { bf16x8 wf = *(const LAS bf16x8*)(wr2 + term * WTERM + 32 * it);
                if (wz) wf = (bf16x8){0, 0, 0, 0, 0, 0, 0, 0};
                c = __builtin_amdgcn_mfma_f32_32x32x16_bf16(wf, hf, c, 0, 0, 0); }
        }
        LAS int* hist = (LAS int*)(lds + XCH_OFF + 4 * 64 * 17 * 4); LAS int* basel = hist + 32;
        if (tid < 32) hist[tid] = 0;
        if (half == 1) {
#pragma unroll
            for (int e = 0; e < 16; ++e) xch[e] = c[e];
            xch[16] = ssp; }
        __syncthreads();
        if (half == 0) {
#pragma unroll
            for (int e = 0; e < 16; ++e) c[e] += xch[e];
            ssp += xch[16]; }
        const bool sel = half == 0 && live && kk == 0;
        const float ss = ssp + __shfl_xor(ssp, 32);
        float ex[4];
#pragma unroll
        for (int e = 0; e < 4; ++e) ex[e] = __shfl_xor(c[e], 32);
        const float rs = rsqrtf(ss * (1.0f / 1024.0f) + EPS);
        float lg[20];
#pragma unroll
        for (int e = 0; e < 16; ++e) lg[e] = c[e] * rs;
#pragma unroll
        for (int e = 0; e < 4; ++e) lg[16 + e] = ex[e] * rs;
        int gs = 0; float gm = lg[0];
#pragma unroll
        for (int i = 1; i < 4; ++i) if (lg[i] > gm) { gm = lg[i]; gs = i; }
        float den = 0.f;
#pragma unroll
        for (int i = 0; i < 4; ++i) den += __expf(lg[i] - gm);
        const float gwt = 1.0f / den;
        float ein[4];
#pragma unroll
        for (int i = 0; i < 4; ++i) ein[i] = gs == 0 ? lg[4 + i] : (gs == 1 ? lg[8 + i] : (gs == 2 ? lg[12 + i] : lg[16 + i]));
        int i1 = 0; float e1 = ein[0];
#pragma unroll
        for (int i = 1; i < 4; ++i) if (ein[i] > e1) { e1 = ein[i]; i1 = i; }
        int i2 = -1; float e2 = 0.f;
#pragma unroll
        for (int i = 0; i < 4; ++i) if (i != i1 && (i2 < 0 || ein[i] > e2)) { e2 = ein[i]; i2 = i; }
        const float x2 = __expf(e2 - e1), w1 = gwt / (1.0f + x2), w2 = gwt * x2 / (1.0f + x2);
        const int lo = i1 < i2 ? i1 : i2, hi = i1 < i2 ? i2 : i1;
        const int pidx = lo == 0 ? hi - 1 : (lo == 1 ? hi + 1 : 5);
        const int bucket = gs * 6 + pidx;
        int rank = 0;
        if (sel) {
            f32x2_t wv2 = {(i1 == lo) ? w1 : w2, (i1 == lo) ? w2 : w1};
            *(f32x2_t*)(tokw + (size_t)t * 2) = wv2;
            rank = __hip_atomic_fetch_add((int*)(hist + bucket), 1, __ATOMIC_RELAXED, __HIP_MEMORY_SCOPE_WORKGROUP);
        }
        __syncthreads();
        if (tid < 24) { const int cb = hist[tid]; basel[tid] = cb > 0 ? (int)__hip_atomic_fetch_add(cnt + tid * 16, (unsigned)cb, __ATOMIC_RELAXED, __HIP_MEMORY_SCOPE_AGENT) : 0; }
        __syncthreads();
        if (sel) list[(size_t)bucket * NT + basel[bucket] + rank] = t;
        __syncthreads();
    }
    {   const float* p = a.in[1] + (size_t)layer * NT * 256; bf16_t* pb = (bf16_t*)(ws + WS_PB);
        const int gt = vcu * NTHR + tid, NGT = G * NTHR;
        for (int i = gt; i < NT * 256 / 8; i += NGT) { const f32x4 x0 = *(const f32x4*)(p + (size_t)i * 8), x1 = *(const f32x4*)(p + (size_t)i * 8 + 4); *(u32x4*)(pb + (size_t)i * 8) = pack8(x0, x1); } }
    __syncthreads();
}

__device__ __forceinline__ int moe_prefix(const Args& a, LAS unsigned char* lds, int layer) {
    LAS int* tb = (LAS int*)(lds + LDS_TB);
    if (threadIdx.x == 0) { const unsigned* cnt = (const unsigned*)(a.ws + WS_CTL) + CW_CNT + layer * 24 * 16; int s = 0;
        for (int b = 0; b < 24; ++b) { tb[b] = s; s += (int)((__hip_atomic_load(cnt + b * 16, __ATOMIC_RELAXED, __HIP_MEMORY_SCOPE_AGENT) + 255u) >> 8); }
        tb[24] = s; }
    __syncthreads();
    return __builtin_amdgcn_readfirstlane(tb[24]);
}
struct MoeUnits {
    LAS const int* tb; int NRT, G, c;
    __device__ __forceinline__ bool next(int i, Unit& u) const {
        const int L = i * G + c, rt = L >> 2; if (rt >= NRT) return false;
        int b = 0;
        for (int q = 1; q < 24; ++q) b = (tb[q] <= rt) ? q : b;
        u.pm = rt; u.pn = L & 3; u.aux = __builtin_amdgcn_readfirstlane(b); return true;
    }
};
struct MoeGuP {
    const char* A; const char* W; const int* list; const unsigned* cnt; MoeUnits U; int ldb, K;
    __device__ __forceinline__ bool next(int i, Unit& u) const { return U.next(i, u); }
    __device__ __forceinline__ void aoff(const Unit& u, const int (&R)[2], const int (&C)[2], g8::AOff& o) const {
        const int n = (int)cnt[u.aux * 16], p0 = (u.pm - __builtin_amdgcn_readfirstlane(U.tb[u.aux])) * 256;
#pragma unroll
        for (int h = 0; h < 2; ++h)
#pragma unroll
            for (int i = 0; i < 2; ++i) { int pos = p0 + h * 128 + R[i]; pos = pos < n ? pos : n - 1; const int tok = list[(size_t)u.aux * NT + pos]; o.o[h][i] = (unsigned)((tok * 1024 + C[i]) * 2); }
    }
    __device__ __forceinline__ const char* bbase(const Unit& u, int kt) const {
        const int g = u.aux / 6, pi = u.aux % 6, e = g * 4 + ((u.pn < 2) ? pair_lo(pi) : pair_hi(pi));
        return W + ((size_t)(e * 512 + (u.pn & 1) * 256) * 1024 + (size_t)kt * 64) * 2;
    }
};
struct MoeDownP {
    const char* A; const char* W; MoeUnits U; int ldb, K;
    __device__ __forceinline__ bool next(int i, Unit& u) const { return U.next(i, u); }
    __device__ __forceinline__ void aoff(const Unit& u, const int (&R)[2], const int (&C)[2], g8::AOff& o) const {
#pragma unroll
        for (int h = 0; h < 2; ++h)
#pragma unroll
            for (int i = 0; i < 2; ++i) o.o[h][i] = (unsigned)(((u.pm * 256 + h * 128 + R[i]) * 512 + C[i]) * 2);
    }
    __device__ __forceinline__ const char* bbase(const Unit& u, int kt) const {
        const int g = u.aux / 6, pi = u.aux % 6, e = g * 4 + ((kt < 4) ? pair_lo(pi) : pair_hi(pi));
        return W + ((size_t)(e * 1024 + u.pn * 256) * 256 + (size_t)(kt & 3) * 64) * 2;
    }
};
__device__ __forceinline__ float sigmoidf_fast(float x) { return __builtin_amdgcn_rcpf(1.0f + __builtin_amdgcn_exp2f(-1.4426950408889634f * x)); }

struct EpiGateUp {
    const float* hp; const float* tokw; const int* list; const unsigned* cnt; LAS const int* tb; bf16_t* act;
    __device__ __forceinline__ void operator()(const f32x4 (&acc)[2][2][4][2], const Unit& u, int wr, int wc, int fr, int fq) const {
        const int n = (int)cnt[u.aux * 16], p0 = (u.pm - __builtin_amdgcn_readfirstlane(tb[u.aux])) * 256, half = u.pn >> 1;
        int toks[2][4];
#pragma unroll
        for (int ai = 0; ai < 2; ++ai)
#pragma unroll
            for (int m = 0; m < 4; ++m) { int pos = p0 + 128 * ai + 64 * wr + 16 * m + fr; pos = pos < n ? pos : n - 1; toks[ai][m] = list[(size_t)u.aux * NT + pos]; }
#pragma unroll
        for (int ai = 0; ai < 2; ++ai)
#pragma unroll
            for (int m = 0; m < 4; ++m) {
                const int r = 128 * ai + 64 * wr + 16 * m + fr;
                const int tok = toks[ai][m];
                const float rs = row_rs<16>(hp + (size_t)tok * 16, 1.0f / 1024.0f), w = tokw[(size_t)tok * 2 + half];
                f32x4 o[2];
#pragma unroll
                for (int nn = 0; nn < 2; ++nn)
#pragma unroll
                    for (int e = 0; e < 4; ++e) { const float g = acc[ai][0][m][nn][e] * rs, up = acc[ai][1][m][nn][e] * rs; o[nn][e] = g * sigmoidf_fast(g) * up * w; }
                *(u32x4*)(act + (size_t)(u.pm * 256 + r) * 512 + half * 256 + (u.pn & 1) * 128 + 32 * wc + 8 * fq) = pack8(o[0], o[1]);
            }
    }
};
struct EpiDown {
    bf16_t* hb; float* hp; const int* list; const unsigned* cnt; LAS const int* tb;
    __device__ __forceinline__ void operator()(const f32x4 (&acc)[2][2][4][2], const Unit& u, int wr, int wc, int fr, int fq) const {
        const int n = (int)cnt[u.aux * 16], p0 = (u.pm - __builtin_amdgcn_readfirstlane(tb[u.aux])) * 256;
        int toks[2][4];
#pragma unroll
        for (int ai = 0; ai < 2; ++ai)
#pragma unroll
            for (int m = 0; m < 4; ++m) { const int pos = p0 + 128 * ai + 64 * wr + 16 * m + fr; toks[ai][m] = list[(size_t)u.aux * NT + (pos < n ? pos : n - 1)]; }
        asm volatile("" ::: "memory");
#pragma unroll
        for (int ai = 0; ai < 2; ++ai)
#pragma unroll
            for (int m = 0; m < 4; ++m) {
                const int r = 128 * ai + 64 * wr + 16 * m + fr, pos = p0 + r; const bool valid = pos < n;
                const int tok = toks[ai][m];
                float ss = 0.f;
#pragma unroll
                for (int bj = 0; bj < 2; ++bj) {
                    const size_t off = (size_t)tok * 1024 + u.pn * 256 + 128 * bj + 32 * wc + 8 * fq;
                    f32x4 b0, b1; unpack8(*(const u32x4*)(hb + off), b0, b1);
                    const f32x4 v0 = acc[ai][bj][m][0] + b0, v1 = acc[ai][bj][m][1] + b1;
                    if (valid) *(u32x4*)(hb + off) = pack8(v0, v1);
                    ss += dot4(v0) + dot4(v1);
                }
                ss += __shfl_xor(ss, 16); ss += __shfl_xor(ss, 32);
                if (fq == 0 && valid) hp[(size_t)tok * 16 + u.pn * 4 + wc] = ss;
                if (m & 1) asm volatile("" ::: "memory");
            }
    }
};
struct EpiStore {
    bf16_t* O; int ldc;
    __device__ __forceinline__ void operator()(const f32x4 (&acc)[2][2][4][2], const Unit& u, int wr, int wc, int fr, int fq) const {
#pragma unroll
        for (int ai = 0; ai < 2; ++ai)
#pragma unroll
            for (int m = 0; m < 4; ++m) { const int row = u.pm * 256 + 128 * ai + 64 * wr + 16 * m + fr;
#pragma unroll
                for (int bj = 0; bj < 2; ++bj) *(u32x4*)(O + (size_t)row * ldc + u.pn * 256 + 128 * bj + 32 * wc + 8 * fq) = pack8(acc[ai][bj][m][0], acc[ai][bj][m][1]); }
    }
};
struct EpiPle {
    const float* hpin; const bf16_t* pp; const bf16_t* hbi; bf16_t* hbo; float* hp;
    __device__ __forceinline__ void operator()(const f32x4 (&acc)[2][2][4][2], const Unit& u, int wr, int wc, int fr, int fq) const {
#pragma unroll
        for (int ai = 0; ai < 2; ++ai)
#pragma unroll
            for (int m = 0; m < 4; ++m) {
                const int row = u.pm * 256 + 128 * ai + 64 * wr + 16 * m + fr;
                const float rs = row_rs<16>(hpin + (size_t)row * 16, 1.0f / 1024.0f);
                float ss = 0.f;
#pragma unroll
                for (int bj = 0; bj < 2; ++bj) {
                    const size_t off = (size_t)row * 1024 + u.pn * 256 + 128 * bj + 32 * wc + 8 * fq;
                    f32x4 p0, p1, v0, v1; unpack8(*(const u32x4*)(pp + off), p0, p1); unpack8(*(const u32x4*)(hbi + off), v0, v1);
#pragma unroll
                    for (int e = 0; e < 4; ++e) { v0[e] += sigmoidf_fast(acc[ai][bj][m][0][e] * rs) * p0[e]; v1[e] += sigmoidf_fast(acc[ai][bj][m][1][e] * rs) * p1[e]; }
                    *(u32x4*)(hbo + off) = pack8(v0, v1);
                    ss += dot4(v0) + dot4(v1);
                }
                ss += __shfl_xor(ss, 16); ss += __shfl_xor(ss, 32);
                if (fq == 0) hp[(size_t)row * 16 + u.pn * 4 + wc] = ss;
                if (m & 1) asm volatile("" ::: "memory");
            }
    }
};
__device__ __forceinline__ u32x2 pack4(f32x4 a) { u32x2 w = {cvtpk(a[0], a[1]), cvtpk(a[2], a[3])}; return w; }
struct EpiDqkv {
    const float* hp; const float* cosB; const float* sinB; bf16_t* cq; bf16_t* ckv; bf16_t* krope; float* cqp; float* kvp;
    __device__ __forceinline__ void operator()(const f32x4 (&acc)[2][2][4][2], const Unit& u, int wr, int wc, int fr, int fq) const {
#pragma unroll
        for (int ai = 0; ai < 2; ++ai)
#pragma unroll
            for (int m = 0; m < 4; ++m) {
                const int row = u.pm * 256 + 128 * ai + 64 * wr + 16 * m + fr, s = row & (NS - 1);
                const float rs = row_rs<16>(hp + (size_t)row * 16, 1.0f / 1024.0f);
                if (u.pn < 2) {
                    float ss = 0.f;
#pragma unroll
                    for (int bj = 0; bj < 2; ++bj) { const f32x4 v0 = acc[ai][bj][m][0] * rs, v1 = acc[ai][bj][m][1] * rs; ss += dot4(v0) + dot4(v1);
                        const int c = 128 * bj + 32 * wc + 8 * fq;
                        if (u.pn == 0) *(u32x4*)(cq + (size_t)row * 384 + c) = pack8(v0, v1); else *(u32x4*)(ckv + (size_t)row * 256 + c) = pack8(v0, v1); }
                    ss += __shfl_xor(ss, 16); ss += __shfl_xor(ss, 32);
                    if (fq == 0) { if (u.pn == 0) cqp[(size_t)row * 8 + wc] = ss; else kvp[(size_t)row * 4 + wc] = ss; }
                } else {
                    const f32x4 v0 = acc[ai][0][m][0] * rs, v1 = acc[ai][0][m][1] * rs;
                    float ss = dot4(v0) + dot4(v1);
                    *(u32x4*)(cq + (size_t)row * 384 + 256 + 32 * wc + 8 * fq) = pack8(v0, v1);
                    ss += __shfl_xor(ss, 16); ss += __shfl_xor(ss, 32);
                    if (fq == 0) cqp[(size_t)row * 8 + 4 + wc] = ss;
                    if (wc < 2) {
                        const int j = 16 * wc + 4 * fq;
                        const f32x4 cs = *(const f32x4*)(cosB + (size_t)s * 32 + j), sn = *(const f32x4*)(sinB + (size_t)s * 32 + j);
                        const f32x4 x1 = acc[ai][1][m][0] * rs, x2 = acc[ai][1][m][1] * rs;
                        *(unsigned*)((unsigned char*)krope + (size_t)row * 64 + j) = pack4_fp8(x1 * cs - x2 * sn);
                        *(unsigned*)((unsigned char*)krope + (size_t)row * 64 + 32 + j) = pack4_fp8(x1 * sn + x2 * cs);
                    }
                }
            }
    }
};
struct EpiUq {
    const float* cqp; const float* cosB; const float* sinB; bf16_t* q;
    __device__ __forceinline__ void operator()(const f32x4 (&acc)[2][2][4][2], const Unit& u, int wr, int wc, int fr, int fq) const {
        const int bb = u.pm >> 5;
#pragma unroll
        for (int ai = 0; ai < 2; ++ai)
#pragma unroll
            for (int m = 0; m < 4; ++m) {
                const int row = u.pm * 256 + 128 * ai + 64 * wr + 16 * m + fr, s = row & (NS - 1);
                const float rs = row_rs<8>(cqp + (size_t)row * 8, 1.0f / 384.0f);
#pragma unroll
                for (int bj = 0; bj < 2; ++bj) {
                    if (u.pn < 4) {
                        const int hh = 2 * u.pn + bj;
                        u32x2 w8; w8.x = pack4_fp8(acc[ai][bj][m][0] * rs); w8.y = pack4_fp8(acc[ai][bj][m][1] * rs);
                        *(u32x2*)((unsigned char*)q + ((size_t)(bb * NH + hh) * NS + s) * 192 + 32 * wc + 8 * fq) = w8;
                    } else {
                        const int gidx = bj * 4 + wc, hh = 4 * (u.pn - 4) + (gidx >> 1), j = 16 * (gidx & 1) + 4 * fq;
                        const f32x4 cs = *(const f32x4*)(cosB + (size_t)s * 32 + j), sn = *(const f32x4*)(sinB + (size_t)s * 32 + j);
                        const f32x4 x1 = acc[ai][bj][m][0] * rs, x2 = acc[ai][bj][m][1] * rs;
                        unsigned char* d = (unsigned char*)q + ((size_t)(bb * NH + hh) * NS + s) * 192 + 128 + j;
                        *(unsigned*)d = pack4_fp8(x1 * cs - x2 * sn); *(unsigned*)(d + 32) = pack4_fp8(x1 * sn + x2 * cs);
                    }
                }
            }
    }
};
struct EpiKn {
    const float* kvp; unsigned char* kn;
    __device__ __forceinline__ void operator()(const f32x4 (&acc)[2][2][4][2], const Unit& u, int wr, int wc, int fr, int fq) const {
        const int bb = u.pm >> 5;
#pragma unroll
        for (int ai = 0; ai < 2; ++ai)
#pragma unroll
            for (int m = 0; m < 4; ++m) {
                const int row = u.pm * 256 + 128 * ai + 64 * wr + 16 * m + fr, s = row & (NS - 1);
                const float rs = row_rs<4>(kvp + (size_t)row * 4, 1.0f / 256.0f);
#pragma unroll
                for (int bj = 0; bj < 2; ++bj) {
                    u32x2 w8; w8.x = pack4_fp8(acc[ai][bj][m][0] * rs); w8.y = pack4_fp8(acc[ai][bj][m][1] * rs);
                    *(u32x2*)(kn + ((size_t)(bb * NH + 2 * u.pn + bj) * NS + s) * 128 + 32 * wc + 8 * fq) = w8; }
            }
    }
};
struct EpiVT {
    const float* kvp; unsigned char* vt;
    __device__ __forceinline__ void operator()(const f32x4 (&acc)[2][2][4][2], const Unit& u, int wr, int wc, int fr, int fq) const {
        f32x4 rsv[2][2];
#pragma unroll
        for (int bj = 0; bj < 2; ++bj)
#pragma unroll
            for (int n = 0; n < 2; ++n)
#pragma unroll
                for (int e = 0; e < 4; ++e) { const int tok = u.pn * 256 + 128 * bj + 32 * wc + 8 * fq + 4 * n + e; rsv[bj][n][e] = row_rs<4>(kvp + (size_t)tok * 4, 1.0f / 256.0f); }
#pragma unroll
        for (int ai = 0; ai < 2; ++ai)
#pragma unroll
            for (int m = 0; m < 4; ++m) {
                const int hd = u.pm * 256 + 128 * ai + 64 * wr + 16 * m + fr, h = hd >> 7, d = hd & 127;
#pragma unroll
                for (int bj = 0; bj < 2; ++bj) {
                    const int tok = u.pn * 256 + 128 * bj + 32 * wc + 8 * fq, b = tok >> 13, s = tok & (NS - 1);
                    u32x2 w8; w8.x = pack4_fp8(acc[ai][bj][m][0] * rsv[bj][0]); w8.y = pack4_fp8(acc[ai][bj][m][1] * rsv[bj][1]);
                    *(u32x2*)(vt + ((size_t)((b * NH + h) * 128 + d)) * NS + s) = w8; }
            }
    }
};
constexpr float W8SCALE = 32.0f, O8SCALE = 16.0f;
struct WConv { const float* src0; const float* src1; const float* gain; bf16_t* dst; int N0, N1, K, Nout, kind; float f8scale; };
__device__ __forceinline__ int colmap(int kind, int n) {
    if (kind == 6) { kind = 1; n += 1024; }
    switch (kind) {
    case 1: {
        const int pn = n >> 8; if (pn >= 8) return n;
        const int t = pn >> 2, bj = (n >> 7) & 1, r = n & 127, hh = 2 * (pn & 3) + (r >> 6), d = 64 * bj + (r & 63);
        return t * 1024 + hh * 128 + d; }
    case 2: {
        if (n < 256) return n;
        if (n < 512) return 384 + (n - 256);
        if (n < 640) return 256 + (n - 512);
        const int r = n - 640, wc = r >> 5, fq = (r >> 3) & 3, nn = (r >> 2) & 1, i = r & 3;
        if (wc >= 2) return -1;
        return 384 + 256 + 32 * nn + 16 * wc + 4 * fq + i; }
    case 3: {
        if (n < 1024) return (n >> 7) * 192 + (n & 127);
        const int m = n - 1024, pn4 = m >> 8, gidx = (m >> 5) & 7, fq = (m >> 3) & 3, nn = (m >> 2) & 1, i = m & 3;
        const int hh = 4 * pn4 + (gidx >> 1), j = 16 * (gidx & 1) + 4 * fq + i;
        return hh * 192 + 128 + 32 * nn + j; }
    case 4: {
        const int q = n >> 8, bj = (n >> 7) & 1, r = n & 127;
        return bj * 256 + 128 * q + r; }
    case 5: {
        const int half = n >> 10, hd = n & 1023; return (hd >> 7) * 256 + half * 128 + (hd & 127); }
    default: return n;
    }
}
__device__ __forceinline__ void conv_item(const WConv& w, LAS float* scr, int item, int lane) {
    const int nblk = w.Nout / 32, kb = item / nblk, nb = item % nblk, k0 = 64 * kb, n0 = 32 * nb;
    const int n4 = lane & 7, ks = lane >> 3;
    const int s = colmap(w.kind, n0 + 4 * n4);
    const bool z = s < 0, first = s < w.N0;
    const float* sp = first ? w.src0 + s : w.src1 + (s - w.N0);
    const int ld = first ? w.N0 : w.N1;
    f32x4 v[8];
#pragma unroll
    for (int it = 0; it < 8; ++it) { const int k = it * 8 + ks; v[it] = z ? (f32x4){0.f, 0.f, 0.f, 0.f} : *(const f32x4*)(sp + (size_t)(k0 + k) * ld); }
#pragma unroll
    for (int it = 0; it < 8; ++it) { const int k = it * 8 + ks; const float g = w.gain ? w.gain[k0 + k] : 1.0f;
#pragma unroll
        for (int e = 0; e < 4; ++e) scr[k * 33 + 4 * n4 + e] = v[it][e] * g; }
    asm volatile("s_waitcnt lgkmcnt(0)" ::: "memory");
    const int c = lane & 7;
#pragma unroll
    for (int j = 0; j < 4; ++j) { const int n = (lane >> 3) + 8 * j; const LAS float* sv = scr + (8 * c) * 33 + n;
        if (w.f8scale != 0.f) { const float q = w.f8scale; u32x2 o8;
            o8.x = pack4_fp8((f32x4){sv[0 * 33] * q, sv[1 * 33] * q, sv[2 * 33] * q, sv[3 * 33] * q}); o8.y = pack4_fp8((f32x4){sv[4 * 33] * q, sv[5 * 33] * q, sv[6 * 33] * q, sv[7 * 33] * q});
            *(u32x2*)((unsigned char*)w.dst + (size_t)(n0 + n) * w.K + k0 + 8 * c) = o8; }
        else {
        u32x4 o; o.x = cvtpk(sv[0 * 33], sv[1 * 33]); o.y = cvtpk(sv[2 * 33], sv[3 * 33]); o.z = cvtpk(sv[4 * 33], sv[5 * 33]); o.w = cvtpk(sv[6 * 33], sv[7 * 33]);
        *(u32x4*)(w.dst + (size_t)(n0 + n) * w.K + k0 + 8 * c) = o; } }
    asm volatile("s_waitcnt lgkmcnt(0)" ::: "memory");
}
__device__ __forceinline__ bool get_conv(int mi, const Args& a, WConv& w) {
    unsigned char* ws = a.ws;
    w.src1 = nullptr; w.N1 = 0; w.gain = nullptr; w.kind = 0; w.f8scale = 0.f;
    if (mi == 0) { w.src0 = a.in[6]; w.N0 = 3072; w.K = 1024; w.Nout = 1024; w.kind = 1; w.gain = a.in[2]; w.dst = (bf16_t*)(ws + WS_WQKV0); return true; }
    if (mi == 74) { w.src0 = a.in[6]; w.N0 = 3072; w.K = 1024; w.Nout = 2048; w.kind = 6; w.gain = a.in[2]; w.f8scale = W8SCALE; w.dst = (bf16_t*)(ws + WS_WQKV0 + 2 * MiB); return true; }
    if (mi == 1) { w.src0 = a.in[7]; w.N0 = 1024; w.K = 1024; w.Nout = 1024; w.f8scale = W8SCALE; w.dst = (bf16_t*)(ws + WS_WO0); return true; }
    if (mi == 2) { w.src0 = a.in[8]; w.N0 = 384; w.src1 = a.in[11]; w.N1 = 320; w.K = 1024; w.Nout = 768; w.kind = 2; w.gain = a.in[2] + 1024; w.dst = (bf16_t*)(ws + WS_WDQKV); return true; }
    if (mi == 3) { w.src0 = a.in[10]; w.N0 = 1536; w.K = 384; w.Nout = 1536; w.kind = 3; w.gain = a.in[9]; w.dst = (bf16_t*)(ws + WS_WUQ); return true; }
    if (mi == 4) { w.src0 = a.in[13]; w.N0 = 2048; w.K = 256; w.Nout = 2048; w.kind = 5; w.gain = a.in[12]; w.dst = (bf16_t*)(ws + WS_WUKV); return true; }
    if (mi == 5) { w.src0 = a.in[14]; w.N0 = 1024; w.K = 1024; w.Nout = 1024; w.f8scale = W8SCALE; w.dst = (bf16_t*)(ws + WS_WO1); return true; }
    if (mi < 38) { const int le = mi - 6, l = le >> 4;
        w.src0 = a.in[17] + (size_t)le * 1024 * 256; w.N0 = 256; w.src1 = a.in[18] + (size_t)le * 1024 * 256; w.N1 = 256; w.K = 1024; w.Nout = 512; w.kind = 4;
        w.gain = a.in[3] + l * 1024; w.dst = (bf16_t*)(ws + WS_WGU) + (size_t)le * 512 * 1024; return true; }
    if (mi < 70) { const int le = mi - 38;
        w.src0 = a.in[19] + (size_t)le * 256 * 1024; w.N0 = 1024; w.K = 256; w.Nout = 1024; w.dst = (bf16_t*)(ws + WS_WD) + (size_t)le * 1024 * 256; return true; }
    if (mi < 72) { const int l = mi - 70;
        w.src0 = a.in[20] + (size_t)l * 1024 * 1024; w.N0 = 1024; w.K = 1024; w.Nout = 1024; w.gain = a.in[4] + l * 1024; w.dst = (bf16_t*)(ws + WS_WPG) + (size_t)l * 1024 * 1024; return true; }
    if (mi < 74 && mi >= 72) { const int l = mi - 72;
        w.src0 = a.in[21] + (size_t)l * 256 * 1024; w.N0 = 1024; w.K = 256; w.Nout = 1024; w.dst = (bf16_t*)(ws + WS_WPP) + (size_t)l * 1024 * 256; return true; }
    return false;
}

__device__ __forceinline__ void p_prologue(const Args& a, LAS unsigned char* lds, int vcu, int G) {
    int tid = threadIdx.x; asm volatile("" : "+v"(tid));
    const int lane = tid & 63, wave = __builtin_amdgcn_readfirstlane(tid >> 6);
    const int gw = vcu * NWAVES + wave, NGW = G * NWAVES;
    unsigned char* ws = a.ws;
    LAS float* scr = (LAS float*)(lds + wave * 16384);
    int base = 0;
    for (int mi = 0; mi < 75; ++mi) {
        WConv w; get_conv(mi, a, w);
        const int n = (w.K / 64) * (w.Nout / 32);
        int it = (gw - (base % NGW) + NGW) % NGW;
        for (; it < n; it += NGW) conv_item(w, scr, it, lane);
        base += n;
    }
    {   const float* x = a.in[0]; bf16_t* hb = (bf16_t*)(ws + WS_HB); float* hpx = (float*)(ws + WS_HPX);
        for (int m = gw; m < NT; m += 2 * NGW) {
            const int m2 = (m + NGW < NT) ? m + NGW : m;
            const f32x4* xr = (const f32x4*)(x + (size_t)m * 1024) + lane; const f32x4* xr2 = (const f32x4*)(x + (size_t)m2 * 1024) + lane;
            f32x4 v[4], v2[4]; float s = 0.f, s2 = 0.f;
#pragma unroll
            for (int j = 0; j < 4; ++j) { v[j] = xr[64 * j]; v2[j] = xr2[64 * j]; }
#pragma unroll
            for (int j = 0; j < 4; ++j) { s += dot4(v[j]); s2 += dot4(v2[j]); }
            s = wave_sum(s); s2 = wave_sum(s2);
            u32x2* o8 = (u32x2*)(hb + (size_t)m * 1024) + lane; u32x2* o82 = (u32x2*)(hb + (size_t)m2 * 1024) + lane;
            unsigned* x8a = (unsigned*)(ws + WS_X8 + (size_t)m * 1024) + lane; unsigned* x8b = (unsigned*)(ws + WS_X8 + (size_t)m2 * 1024) + lane;
#pragma unroll
            for (int j = 0; j < 4; ++j) { x8a[64 * j] = pack4_fp8(v[j]); x8b[64 * j] = pack4_fp8(v2[j]);
                                          u32x2 o; o.x = cvtpk(v[j][0], v[j][1]); o.y = cvtpk(v[j][2], v[j][3]); o8[64 * j] = o;
                                          u32x2 o2; o2.x = cvtpk(v2[j][0], v2[j][1]); o2.y = cvtpk(v2[j][2], v2[j][3]); o82[64 * j] = o2; }
            if (lane < 16) { hpx[(size_t)m * 16 + lane] = (lane == 0) ? s : 0.f; hpx[(size_t)m2 * 16 + lane] = (lane == 0) ? s2 : 0.f; }
        } }
    {   const int gt = (vcu * NTHR) + tid, NGT = G * NTHR;
        float* cosA = (float*)(ws + WS_COSA); float* sinA = (float*)(ws + WS_SINA); float* cosB = (float*)(ws + WS_COSB); float* sinB = (float*)(ws + WS_SINB);
        for (int i = gt; i < NS * 64; i += NGT) { const int s = i >> 6, j = i & 63; const float inv = powf(10000.0f, -(float)j / 64.0f); float sn, cs; sincosf((float)s * inv, &sn, &cs); cosA[i] = cs; sinA[i] = sn; }
        for (int i = gt; i < NS * 32; i += NGT) { const int s = i >> 5, j = i & 31; const float inv = powf(10000.0f, -(float)j / 32.0f); float sn, cs; sincosf((float)s * inv, &sn, &cs); cosB[i] = cs; sinB[i] = sn; }
        float* km = (float*)(ws + WS_KMEAN);
        for (int i = gt; i < NB * NH * 32 * 128; i += NGT) km[i] = 0.f;
        float* wrt = (float*)(ws + WS_WRT);
        for (int i = gt; i < 2 * 1024 * 20; i += NGT) { const int l = i / 20480, r = i % 20480, k = r / 20, c = r % 20;
            const float g = a.in[3][l * 1024 + k];
            wrt[i] = g * (c < 4 ? a.in[15][(size_t)(l * 1024 + k) * 4 + c] : a.in[16][(size_t)(l * 1024 + k) * 16 + (c - 4)]); }
    }
}

__device__ __forceinline__ at::SparseBufs sparse_bufs(const Args& a) {
    unsigned char* ws = a.ws;
    at::SparseBufs SB;
    SB.lists = (unsigned short*)(ws + WS_R + 200 * MiB); SB.lcnt = (unsigned*)(ws + WS_CTL) + CW_LCNT; SB.selinfo = (unsigned*)(ws + WS_R + 210 * MiB);
    SB.ml = (float*)(ws + WS_R + 192 * MiB); SB.part01 = (unsigned char*)a.out; SB.part2 = ws + WS_PART2;
    return SB;
}
__device__ __forceinline__ void p_attention_mla(const Args& a, unsigned char* ldsg) {
    unsigned char* ws = a.ws;
    const at::SparseBufs SB = sparse_bufs(a);
    for (int L = blockIdx.x; L < 512; L += gridDim.x) {
        const int xcd = L & 7, k = L >> 3, bh = xcd + 8 * (k >> 4), x = k & 15, b = bh >> 3, h = bh & 7;
        for (int pass = 0; pass < 2; ++pass) {
            const int qb = pass ? x : 31 - x, P0 = qb * 256;
            at::AttnP A;
            A.Qp = (const bf16_t*)(ws + WS_Q + ((size_t)bh * NS + P0) * 192); A.Kn = (const bf16_t*)(ws + WS_KN1 + (size_t)bh * NS * 128);
            A.Kr = (const bf16_t*)(ws + WS_KROPE + (size_t)b * NS * 64); A.Vp = (const bf16_t*)(ws + WS_V1 + (size_t)bh * NS * 128);
            A.Op = (bf16_t*)(ws + WS_O + ((size_t)(b * NS + P0) * 1024 + h * 128)); A.P0 = P0; A.t0 = 0; A.NT = (P0 + 256) / 64;
            at::attn_unit<192, 0>((char*)ldsg, A, SB);
        }
    }
}
__device__ __forceinline__ void p_moba_gate(const Args& a, unsigned char* ldsg) {
    unsigned char* ws = a.ws;
    const at::SparseBufs SB = sparse_bufs(a);
    for (int L = blockIdx.x; L < 1024; L += gridDim.x) {
        const int bh = L >> 5, qb = L & 31;
        at::gate_unit((char*)ldsg, (const bf16_t*)(ws + WS_Q) + ((size_t)bh * NS + qb * 256) * 128, (const float*)(ws + WS_KMEAN) + (size_t)bh * 32 * 128, bh, qb, SB);
    }
}
constexpr int MOBA_PART = 512;
__device__ __forceinline__ void p_moba_gather(const Args& a, unsigned char* ldsg) {
    unsigned char* ws = a.ws;
    const at::SparseBufs SB = sparse_bufs(a);
    int tid = threadIdx.x; asm volatile("" : "+v"(tid));
    int* pre = (int*)(ldsg + 139264); int* seg = pre + 1032;
    if (tid < 32) { int s = 0; for (int j = 0; j < 32; ++j) s += (int)((SB.lcnt[tid * 32 + j] + (MOBA_PART - 1)) / MOBA_PART); seg[tid] = s; }
    __syncthreads();
    if (tid < 32) { int s = 0; for (int j = 0; j < tid; ++j) s += seg[j];
        for (int j = 0; j < 32; ++j) { pre[tid * 32 + j] = s; s += (int)((SB.lcnt[tid * 32 + j] + (MOBA_PART - 1)) / MOBA_PART); }
        if (tid == 31) pre[1024] = s; }
    __syncthreads();
    const int NU = __builtin_amdgcn_readfirstlane(pre[1024]);
    for (int u = blockIdx.x; u < NU; u += gridDim.x) {
        int lo = 0, hi = 1024;
        while (hi - lo > 1) { const int mid = (lo + hi) >> 1; if (pre[mid] <= u) lo = mid; else hi = mid; }
        const int li = __builtin_amdgcn_readfirstlane(lo), c = u - __builtin_amdgcn_readfirstlane(pre[lo]), bh = li >> 5, n = li & 31;
        const int cnt = (int)SB.lcnt[li], nrows = (cnt - MOBA_PART * c) < MOBA_PART ? (cnt - MOBA_PART * c) : MOBA_PART;
        at::moba_gather_unit((char*)ldsg, (const bf16_t*)(ws + WS_Q8 + (size_t)bh * NS * 128), (const bf16_t*)(ws + WS_K8 + (size_t)bh * NS * 128), (const bf16_t*)(ws + WS_V0) + (size_t)bh * NS * 128,
                             bh, n, SB.lists + (size_t)bh * at::LCAP + at::loff(n) + MOBA_PART * c, nrows, SB);
    }
}
__device__ __forceinline__ void p_moba_own(const Args& a, unsigned char* ldsg) {
    unsigned char* ws = a.ws;
    const at::SparseBufs SB = sparse_bufs(a);
    for (int L = blockIdx.x; L < 1024; L += gridDim.x) {
        const int bh = L >> 5, qb = L & 31;
        at::moba_own_unit((char*)ldsg, (const bf16_t*)(ws + WS_Q8 + (size_t)bh * NS * 128), (const bf16_t*)(ws + WS_K8 + (size_t)bh * NS * 128), (const bf16_t*)(ws + WS_V0) + (size_t)bh * NS * 128,
                          (bf16_t*)(ws + WS_O), bh, qb, SB);
    }
}

__global__ void __launch_bounds__(NTHR, 2) mega(Args a) {
    extern __shared__ __attribute__((aligned(16))) unsigned char lds_g[];
    LAS unsigned char* lds = (LAS unsigned char*)lds_g;
    const int tid = threadIdx.x;
    const int G = gridDim.x, bx = blockIdx.x, vcu = (G % 8 == 0) ? (bx % 8) * (G / 8) + bx / 8 : bx;
    unsigned char* ws = a.ws;
    volatile LAS unsigned* MISC = (volatile LAS unsigned*)(lds + LDS_MISC);
    for (int u = tid; u < 256; u += NTHR) MISC[u] = 0u;
    __syncthreads();
    XcdBarrier bar = xcd_barrier_post((unsigned*)(ws + WS_CTL) + CW_BAR, MISC);
    const int lo = a.ph_lo, hi = a.ph_hi;
#ifndef DBG_ONLY
#define DBG_EN(k) true
#else
#define DBG_EN(k) ((k) == DBG_ONLY)
#endif
#define IN(k) (DBG_EN(k) && lo <= (k) && (k) < hi)
#ifdef TSTAMP_PHASE
#define TSTAMP(i) do { if (bx == 0 && tid == 0) ((unsigned long long*)(ws + WS_CTL + 65536))[i] = __builtin_amdgcn_s_memrealtime(); } while (0)
#else
#define TSTAMP(i) do { } while (0)
#endif
#define SEAM(k) do { if (IN(k) && IN((k) + 1)) xcd_barrier(bar); TSTAMP((k) + 1); } while (0)
    TSTAMP(0);
    if (IN(0)) { p_prologue(a, lds, vcu, G); }
    SEAM(0);
    if (IN(1)) {
        g8::DenseP P{(const char*)(ws + WS_HB), (const char*)(ws + WS_WQKV0), 1024, 1024, 1024, NT / 256, 4, G, bx};
        EpiQKV E{(const float*)(ws + WS_HPX), (const float*)(ws + WS_COSA), (const float*)(ws + WS_SINA), (bf16_t*)(ws + WS_Q), (bf16_t*)(ws + WS_K0), (bf16_t*)(ws + WS_V0), (float*)(ws + WS_KMEAN), ws + WS_Q8, ws + WS_K8, 0, 1.0f};
        g8::gemm_phase(lds, P, E);
        g8::DenseP P2{(const char*)(ws + WS_X8), (const char*)(ws + WS_WQKV0 + 2 * MiB), 512, 512, 512, NT / 256, 8, G, bx};
        EpiQKV E2{(const float*)(ws + WS_HPX), (const float*)(ws + WS_COSA), (const float*)(ws + WS_SINA), (bf16_t*)(ws + WS_Q), (bf16_t*)(ws + WS_K0), (bf16_t*)(ws + WS_V0), (float*)(ws + WS_KMEAN), ws + WS_Q8, ws + WS_K8, 4, 1.0f / W8SCALE};
        g8::gemm_phase<g8::DenseP, EpiQKV, true>(lds, P2, E2);
    }
    SEAM(1);
    if (IN(2)) { p_moba_gate(a, lds_g); }
    SEAM(2);
    if (IN(3)) { p_moba_gather(a, lds_g); }
    SEAM(3);
    if (IN(4)) { p_moba_own(a, lds_g); }
    SEAM(4);
    if (IN(5)) {
        g8::DenseP P{(const char*)(ws + WS_O), (const char*)(ws + WS_WO0), 512, 512, 512, NT / 256, 4, G, bx};
        EpiResid E{(const bf16_t*)(ws + WS_HB), (bf16_t*)(ws + WS_HB), (float*)(ws + WS_HP0), 1.0f / (W8SCALE * O8SCALE)};
        g8::gemm_phase<g8::DenseP, EpiResid, true>(lds, P, E);
    }
    SEAM(5);
#define MOE_PLE(PB, layer, HBC, HBN) \
    if (IN((PB) + 0)) { p_route(a, lds, (layer), (const bf16_t*)(HBC), vcu, G); } \
    SEAM((PB) + 0); \
    if (IN((PB) + 1)) { \
        const int NRT = moe_prefix(a, lds, (layer)); \
        const unsigned* cnt = (const unsigned*)(ws + WS_CTL) + CW_CNT + (layer) * 24 * 16; \
        MoeUnits U{(LAS const int*)(lds + LDS_TB), NRT, G, bx}; \
        MoeGuP P{(const char*)(HBC), (const char*)(ws + WS_WGU) + (size_t)(layer) * 16 * 512 * 1024 * 2, (const int*)(ws + WS_LIST), cnt, U, 1024, 1024}; \
        EpiGateUp E{(const float*)(ws + WS_HP0), (const float*)(ws + WS_TOKW), (const int*)(ws + WS_LIST), cnt, (LAS const int*)(lds + LDS_TB), (bf16_t*)(ws + WS_ACT)}; \
        g8::gemm_phase(lds, P, E); \
          \
        const int extra_ = (NRT * 4) % G, gpp_ = (extra_ > 0 && (G - extra_) * 10 >= 1536) ? G - extra_ : G, cpp_ = gpp_ == G ? bx : bx - extra_; \
        g8::DenseP P2{(const char*)(ws + WS_PB), (const char*)(ws + WS_WPP) + (size_t)(layer) * 1024 * 256 * 2, 256, 256, 256, NT / 256, 4, gpp_, cpp_ < 0 ? (1 << 28) : cpp_}; \
        EpiStore E2{(bf16_t*)(ws + WS_PP), 1024}; \
        g8::gemm_phase(lds, P2, E2); \
    } \
    SEAM((PB) + 1); \
    if (IN((PB) + 2)) { \
        const int NRT = moe_prefix(a, lds, (layer)); \
        const unsigned* cnt = (const unsigned*)(ws + WS_CTL) + CW_CNT + (layer) * 24 * 16; \
        MoeUnits U{(LAS const int*)(lds + LDS_TB), NRT, G, bx}; \
        MoeDownP P{(const char*)(ws + WS_ACT), (const char*)(ws + WS_WD) + (size_t)(layer) * 16 * 1024 * 256 * 2, U, 256, 512}; \
        EpiDown E{(bf16_t*)(HBC), (float*)(ws + WS_HP1), (const int*)(ws + WS_LIST), cnt, (LAS const int*)(lds + LDS_TB)}; \
        g8::gemm_phase(lds, P, E); \
    } \
    SEAM((PB) + 2); \
    if (IN((PB) + 3)) { \
        g8::DenseP P{(const char*)(HBC), (const char*)(ws + WS_WPG) + (size_t)(layer) * 1024 * 1024 * 2, 1024, 1024, 1024, NT / 256, 4, G, bx}; \
        EpiPle E{(const float*)(ws + WS_HP1), (const bf16_t*)(ws + WS_PP), (const bf16_t*)(HBC), (bf16_t*)(HBN), (float*)(ws + WS_HP2)}; \
        g8::gemm_phase(lds, P, E); \
    } \
    SEAM((PB) + 3);
    MOE_PLE(6, 0, ws + WS_HB, a.out)
    if (IN(10)) {
        g8::DenseP P{(const char*)a.out, (const char*)(ws + WS_WDQKV), 1024, 1024, 1024, NT / 256, 3, G, bx};
        EpiDqkv E{(const float*)(ws + WS_HP2), (const float*)(ws + WS_COSB), (const float*)(ws + WS_SINB), (bf16_t*)(ws + WS_CQ), (bf16_t*)(ws + WS_CKV), (bf16_t*)(ws + WS_KROPE), (float*)(ws + WS_CQP), (float*)(ws + WS_KVP)};
        g8::gemm_phase(lds, P, E);
    }
    SEAM(10);
    if (IN(11)) {
        g8::DenseP P{(const char*)(ws + WS_CQ), (const char*)(ws + WS_WUQ), 384, 384, 384, NT / 256, 6, G, bx};
        EpiUq E{(const float*)(ws + WS_CQP), (const float*)(ws + WS_COSB), (const float*)(ws + WS_SINB), (bf16_t*)(ws + WS_Q)};
        g8::gemm_phase(lds, P, E);
        g8::DenseP P2{(const char*)(ws + WS_CKV), (const char*)(ws + WS_WUKV), 256, 256, 256, NT / 256, 4, G, bx};
        EpiKn E2{(const float*)(ws + WS_KVP), ws + WS_KN1};
        g8::gemm_phase(lds, P2, E2);
        g8::DenseP P3{(const char*)(ws + WS_WUKV) + (size_t)1024 * 256 * 2, (const char*)(ws + WS_CKV), 256, 256, 256, 4, NT / 256, G, bx};
        EpiVT E3{(const float*)(ws + WS_KVP), ws + WS_V1};
        g8::gemm_phase(lds, P3, E3);
    }
    SEAM(11);
    if (IN(12)) { p_attention_mla(a, lds_g); }
    SEAM(12);
    if (IN(13)) {
        g8::DenseP P{(const char*)(ws + WS_O), (const char*)(ws + WS_WO1), 512, 512, 512, NT / 256, 4, G, bx};
        EpiResid E{(const bf16_t*)a.out, (bf16_t*)a.out, (float*)(ws + WS_HP0), 1.0f / (W8SCALE * O8SCALE)};
        g8::gemm_phase<g8::DenseP, EpiResid, true>(lds, P, E);
    }
    SEAM(13);
    MOE_PLE(14, 1, a.out, ws + WS_HB)
    if (IN(18)) {
        int t2 = threadIdx.x; asm volatile("" : "+v"(t2)); const int lane = t2 & 63, wave = t2 >> 6; const float* fg = a.in[5];
        const bf16_t* hfin = (const bf16_t*)(ws + WS_HB);
        for (int mrow = vcu * NWAVES + wave; mrow < NT; mrow += G * NWAVES) {
            f32x4 v[4]; float s = 0.f;
#pragma unroll
            for (int j = 0; j < 2; ++j) { unpack8(*((const u32x4*)(hfin + (size_t)mrow * 1024) + lane + 64 * j), v[2 * j], v[2 * j + 1]); s += dot4(v[2 * j]) + dot4(v[2 * j + 1]); }
            s = wave_sum(s);
            const float r = rsqrtf(s * (1.0f / 1024.0f) + EPS);
            f32x4* xr = (f32x4*)(a.out + (size_t)mrow * 1024);
#pragma unroll
            for (int j = 0; j < 2; ++j) { const int c4 = 2 * (lane + 64 * j);
                xr[c4] = v[2 * j] * r * *((const f32x4*)fg + c4); xr[c4 + 1] = v[2 * j + 1] * r * *((const f32x4*)fg + c4 + 1); }
        }
    }
#ifdef TSTAMP_PHASE
    xcd_barrier(bar);
    if (bx == 0 && tid == 0) { const unsigned long long* ts = (const unsigned long long*)(ws + WS_CTL + 65536);
        const unsigned long long t1 = (TSTAMP_PHASE == 18) ? __builtin_amdgcn_s_memrealtime() : ts[TSTAMP_PHASE + 1];
        a.out[0] += (float)(t1 - ts[TSTAMP_PHASE]) * TSTAMP_SCALE; }
#endif
#undef IN
#undef SEAM
}

constexpr int N_PHASES = 19;
static int g_grid = 0;
static bool setup() {
    if (g_grid) return g_grid > 0;
    int dev = 0, cus = 0;
    if (hipGetDevice(&dev) != hipSuccess || hipDeviceGetAttribute(&cus, hipDeviceAttributeMultiprocessorCount, dev) != hipSuccess) { g_grid = -1; return false; }
    if (hipFuncSetAttribute((const void*)mega, hipFuncAttributeMaxDynamicSharedMemorySize, LDS_BYTES) != hipSuccess) { fprintf(stderr, "hipFuncSetAttribute failed\n"); g_grid = -1; return false; }
    int per_cu = 0;
    if (hipOccupancyMaxActiveBlocksPerMultiprocessor(&per_cu, (const void*)mega, NTHR, LDS_BYTES) != hipSuccess || per_cu < 1) { fprintf(stderr, "occupancy query: %d\n", per_cu); }
    (void)hipGetLastError();
    g_grid = cus;
    return true;
}
static void run_phases(const Args& base, int lo, int hi, bool one_launch, hipStream_t st) {
    if (one_launch) { Args a = base; a.ph_lo = lo; a.ph_hi = hi; hipLaunchKernelGGL(mega, dim3(g_grid), dim3(NTHR), LDS_BYTES, st, a); }
    else for (int p = lo; p < hi; ++p) { Args a = base; a.ph_lo = p; a.ph_hi = p + 1;
#ifdef PROBE_ROUTE
        if (p == 6) { Args b = base; b.ph_lo = 14; b.ph_hi = 15; hipLaunchKernelGGL(mega, dim3(g_grid), dim3(NTHR), LDS_BYTES, st, b); }
        if (p == 14) (void)hipMemsetAsync(base.ws + WS_CTL + (CW_CNT + 24 * 16) * 4, 0, 24 * 16 * 4, st);
#endif
        hipLaunchKernelGGL(mega, dim3(g_grid), dim3(NTHR), LDS_BYTES, st, a);
#ifdef DOUBLE_PHASE
        if (p == DOUBLE_PHASE) hipLaunchKernelGGL(mega, dim3(g_grid), dim3(NTHR), LDS_BYTES, st, a);
#endif
    }
}
}
#ifndef ONE_LAUNCH
#define ONE_LAUNCH 1
#endif
extern "C" void kernel_launch(void* const* d_in, const int* in_sizes, int n_in, void* d_out, int out_size, void* d_ws, size_t ws_size, hipStream_t stream) {
    (void)in_sizes; (void)out_size;
    if (n_in != 22) { fprintf(stderr, "kernel_launch: expected 22 inputs, got %d\n", n_in); return; }
    if (ws_size < fk::WS_END) { fprintf(stderr, "kernel_launch: workspace too small (%zu)\n", ws_size); return; }
    if (!fk::setup()) return;
    (void)hipMemsetAsync((char*)d_ws + fk::WS_CTL, 0, fk::CTL_ZERO_BYTES, stream);
    fk::Args a{};
    for (int i = 0; i < 22; ++i) a.in[i] = (const float*)d_in[i];
    a.out = (float*)d_out; a.ws = (unsigned char*)d_ws;
    fk::run_phases(a, 0, fk::N_PHASES, ONE_LAUNCH != 0, stream);
}
```
